# Optimizing an MI355X kernel written in HIP

```python
import numpy as np
import jax
import jax.numpy as jnp
from jax import lax

D_MODEL = 1024
BATCH = 4
SEQ = 4096
DEPTH = 2

MIX = D_MODEL // 2
GM_CHUNK = 128
GM_GROUPS = 4
GM_GW = MIX // GM_GROUPS
CONV_WIDTH = 4
LRU_BLOCKS = 8
LRU_BW = MIX // LRU_BLOCKS
LRU_C = 8.0
N_HEADS = 8
HEAD_DIM = MIX // N_HEADS
N_KV = 2
HPG = N_HEADS // N_KV
CMP_LEN = 32
CMP_STRIDE = 16
SLC_LEN = 64
SLC_TOPN = 8
WIN = 512
Q_BLOCK = 128
NSA_Q = N_HEADS * HEAD_DIM
NSA_KV = N_KV * HEAD_DIM
POOL_WINDOWS = (2, 4, 8, 16)
POOL_GROUPS = len(POOL_WINDOWS)
POOL_GW = MIX // POOL_GROUPS
N_BRANCH = 4
N_GROUPS = 4
EXPERTS_PER_GROUP = 4
N_EXPERTS = N_GROUPS * EXPERTS_PER_GROUP
EXPERT_TOPK = 2
D_EXPERT = D_MODEL // 2

EPS = 1e-6
NEG_INF = -1e30
FORCE_SCORE = 1e6

IN_SPLITS = (MIX, MIX, MIX, MIX, NSA_Q, 6 * NSA_KV, 3 * N_HEADS, MIX, N_BRANCH * D_MODEL)
N_IN = sum(IN_SPLITS)

kernel_name = 'hybrid_gated_mixers_hier_moe'


def rms_norm(x, g):
    xf = x.astype(jnp.float32)
    y = xf * lax.rsqrt(jnp.mean(xf * xf, axis=-1, keepdims=True) + EPS)
    return (y * g.astype(jnp.float32)).astype(x.dtype)


def gmlp_mixer(u, v, v_norm_g, ws, bs):
    B, S, _ = u.shape
    nc = S // GM_CHUNK
    u = jax.nn.gelu(u)
    v = rms_norm(jax.nn.gelu(v), v_norm_g).reshape(B, nc, GM_CHUNK, GM_GROUPS, GM_GW)
    causal = jnp.tril(jnp.ones((GM_CHUNK, GM_CHUNK), dtype=bool))
    w = jnp.where(causal[None], ws, 0.0)
    mixed = jnp.einsum('gts,bnsgc->bntgc', w, v) + bs.T[:, :, None]
    return u * mixed.reshape(B, S, MIX)


def rglru_mixer(gate_in, x_in, conv_w, conv_b, wa, ba, wx, bx, lam):
    B, S, C = x_in.shape
    f32 = jnp.float32
    xp = jnp.pad(x_in, ((0, 0), (CONV_WIDTH - 1, 0), (0, 0)))
    xc = conv_b + sum(xp[:, k:k + S] * conv_w[k] for k in range(CONV_WIDTH))
    xb = xc.reshape(B, S, LRU_BLOCKS, LRU_BW)
    r = jax.nn.sigmoid(jnp.einsum('bshi,hij->bshj', xb, wa).reshape(B, S, C) + ba)
    i = jax.nn.sigmoid(jnp.einsum('bshi,hij->bshj', xb, wx).reshape(B, S, C) + bx)
    log_a = -LRU_C * r.astype(f32) * jax.nn.softplus(-lam.astype(f32))
    a = jnp.exp(log_a)
    b = jnp.sqrt(-jnp.expm1(2.0 * log_a)) * (i * xc).astype(f32)

    def combine(c1, c2):
        a1, b1 = c1
        a2, b2 = c2
        return a1 * a2, a2 * b1 + b2

    _, h = lax.associative_scan(combine, (a, b), axis=1)
    return jax.nn.gelu(gate_in) * h.astype(x_in.dtype)


def _gather_blocks(blocks, idx):
    return blocks[idx].reshape(idx.shape[0], -1, blocks.shape[-1])


_gather_bg = jax.vmap(jax.vmap(_gather_blocks))


def nsa_mixer(q, kv, gate_logits, cmp_pe, cmp_w1, cmp_w2):
    B, S, _ = q.shape
    f32 = jnp.float32
    scale = HEAD_DIM ** -0.5
    t_pos = jnp.arange(S)
    qh = q.reshape(B, S, N_KV, HPG, HEAD_DIM).transpose(0, 2, 3, 1, 4)
    kv = kv.reshape(B, S, 6, N_KV, HEAD_DIM).transpose(2, 0, 3, 1, 4)

    n_sub = CMP_LEN // CMP_STRIDE
    n_chunk = S // CMP_STRIDE
    n_cmp = n_chunk - n_sub + 1
    chunks = kv[0:2].reshape(2, B, N_KV, n_chunk, CMP_STRIDE, HEAD_DIM)
    blocks = jnp.concatenate([chunks[:, :, :, j:j + n_cmp] for j in range(n_sub)], axis=4)
    blocks = blocks + cmp_pe[:, None, None, None]
    flat = blocks.reshape(2, B, N_KV, n_cmp, CMP_LEN * HEAD_DIM)
    hid = jax.nn.gelu(jnp.einsum('cbgnf,cgfe->cbgne', flat, cmp_w1))
    kvc = jnp.einsum('cbgne,cged->cbgnd', hid, cmp_w2)
    k_c, v_c = kvc[0], kvc[1]
    cmp_end = jnp.arange(n_cmp) * CMP_STRIDE + (CMP_LEN - 1)
    cmp_mask = cmp_end[None, :] <= t_pos[:, None]
    s_c = jnp.einsum('bgjsd,bgnd->bgjsn', qh, k_c).astype(f32) * scale
    p_c = jax.nn.softmax(jnp.where(cmp_mask, s_c, NEG_INF), axis=-1)
    p_c = jnp.where(jnp.any(cmp_mask, axis=-1)[:, None], p_c, 0.0)
    o_cmp = jnp.einsum('bgjsn,bgnd->bgjsd', p_c.astype(q.dtype), v_c)

    n_slc = S // SLC_LEN
    topn = min(SLC_TOPN, n_slc)
    c_start = np.arange(n_cmp) * CMP_STRIDE
    s_start = np.arange(n_slc) * SLC_LEN
    overlap = ((c_start[:, None] <= s_start[None, :] + SLC_LEN - 1)
               & (c_start[:, None] + CMP_LEN - 1 >= s_start[None, :])).astype(np.float32)
    imp = jnp.einsum('bgjsn,nm->bgsm', p_c, jnp.asarray(overlap))
    blk = jnp.arange(n_slc)
    cur = t_pos // SLC_LEN
    causal_blk = blk[None, :] * SLC_LEN <= t_pos[:, None]
    forced = (blk[None, :] == 0) | (blk[None, :] == cur[:, None]) | (blk[None, :] == cur[:, None] - 1)
    score = jnp.where(forced, FORCE_SCORE, jnp.where(causal_blk, imp, -1.0))
    top_val, top_idx = lax.top_k(score, topn)
    top_ok = top_val >= 0.0

    nq = S // Q_BLOCK
    ks_blk = kv[2].reshape(B, N_KV, n_slc, SLC_LEN, HEAD_DIM)
    vs_blk = kv[3].reshape(B, N_KV, n_slc, SLC_LEN, HEAD_DIM)

    def slc_block(args):
        q_b, idx_b, ok_b, t_b = args
        k_sel = _gather_bg(ks_blk, idx_b)
        v_sel = _gather_bg(vs_blk, idx_b)
        k_pos = idx_b[..., None] * SLC_LEN + jnp.arange(SLC_LEN)
        ok = (ok_b[..., None] & (k_pos <= t_b[:, None, None])).reshape(B, N_KV, Q_BLOCK, -1)
        s = jnp.einsum('bgjqd,bgqkd->bgjqk', q_b, k_sel).astype(f32) * scale
        p = jax.nn.softmax(jnp.where(ok[:, :, None], s, NEG_INF), axis=-1)
        return jnp.einsum('bgjqk,bgqkd->bgjqd', p.astype(q_b.dtype), v_sel)

    q_blocks = qh.reshape(B, N_KV, HPG, nq, Q_BLOCK, HEAD_DIM).transpose(3, 0, 1, 2, 4, 5)
    idx_blocks = top_idx.reshape(B, N_KV, nq, Q_BLOCK, topn).transpose(2, 0, 1, 3, 4)
    ok_blocks = top_ok.reshape(B, N_KV, nq, Q_BLOCK, topn).transpose(2, 0, 1, 3, 4)
    o_slc = lax.map(slc_block, (q_blocks, idx_blocks, ok_blocks, t_pos.reshape(nq, Q_BLOCK)))
    o_slc = o_slc.transpose(1, 2, 3, 0, 4, 5).reshape(B, N_KV, HPG, S, HEAD_DIM)

    n_pad = WIN // Q_BLOCK
    band_len = Q_BLOCK * (n_pad + 1)
    kw = jnp.pad(kv[4], ((0, 0), (0, 0), (WIN, 0), (0, 0))).reshape(B, N_KV, nq + n_pad, Q_BLOCK, HEAD_DIM)
    vw = jnp.pad(kv[5], ((0, 0), (0, 0), (WIN, 0), (0, 0))).reshape(B, N_KV, nq + n_pad, Q_BLOCK, HEAD_DIM)
    band_k = jnp.concatenate([kw[:, :, j:j + nq] for j in range(n_pad + 1)], axis=3)
    band_v = jnp.concatenate([vw[:, :, j:j + nq] for j in range(n_pad + 1)], axis=3)
    qb = qh.reshape(B, N_KV, HPG, nq, Q_BLOCK, HEAD_DIM)
    s_w = jnp.einsum('bgjiqd,bgikd->bgjiqk', qb, band_k).astype(f32) * scale
    q_idx = jnp.arange(Q_BLOCK)
    k_idx = jnp.arange(band_len)
    delta = WIN + q_idx[:, None] - k_idx[None, :]
    k_abs = (jnp.arange(nq)[:, None] - n_pad) * Q_BLOCK + k_idx[None, :]
    win_mask = ((delta >= 0) & (delta < WIN))[None] & (k_abs >= 0)[:, None, :]
    p_w = jax.nn.softmax(jnp.where(win_mask, s_w, NEG_INF), axis=-1)
    o_win = jnp.einsum('bgjiqk,bgikd->bgjiqd', p_w.astype(q.dtype), band_v).reshape(B, N_KV, HPG, S, HEAD_DIM)

    g = jax.nn.sigmoid(gate_logits.reshape(B, S, N_KV, HPG, 3).transpose(4, 0, 2, 3, 1))[..., None]
    o = g[0] * o_cmp + g[1] * o_slc + g[2] * o_win
    return o.transpose(0, 3, 1, 2, 4).reshape(B, S, NSA_Q)


def pool_mixer(xd, pool_w, pool_scale):
    B, S, C = xd.shape
    f32 = jnp.float32
    xf = xd.astype(f32)
    csum = jnp.pad(lax.cumsum(xf, axis=1), ((0, 0), (1, 0), (0, 0)))
    t = jnp.arange(S)
    outs = []
    for gi, w in enumerate(POOL_WINDOWS):
        c = csum[:, :, gi * POOL_GW:(gi + 1) * POOL_GW]
        lower = jnp.pad(c[:, :S + 1 - w], ((0, 0), (w - 1, 0), (0, 0)))
        cnt = jnp.minimum(t + 1, w).astype(f32)[None, :, None]
        outs.append((c[:, 1:] - lower) / cnt - xf[:, :, gi * POOL_GW:(gi + 1) * POOL_GW])
    pooled = jnp.stack(outs, axis=2).astype(xd.dtype)
    mixed = jnp.einsum('bsgi,gij->bsgj', pooled, pool_w).reshape(B, S, C)
    return mixed * pool_scale


def hybrid_mixer(h, w_in, gm_norm_g, gm_ws, gm_b, conv_w, conv_b, lru_wa, lru_ba, lru_wx,
                 lru_bx, lru_lambda, cmp_pe, cmp_w1, cmp_w2, pool_w, pool_scale, w_branch, w_out):
    B, S, _ = h.shape
    proj = h @ w_in
    cuts = np.cumsum(IN_SPLITS)[:-1].tolist()
    u, v, gate_b, rec_b, q, kv, nsa_g, xd, mg = jnp.split(proj, cuts, axis=-1)
    y_a = gmlp_mixer(u, v, gm_norm_g, gm_ws, gm_b)
    y_b = rglru_mixer(gate_b, rec_b, conv_w, conv_b, lru_wa, lru_ba, lru_wx, lru_bx, lru_lambda)
    y_c = nsa_mixer(q, kv, nsa_g, cmp_pe, cmp_w1, cmp_w2)
    y_d = pool_mixer(xd, pool_w, pool_scale)
    ys = jnp.stack([y_a, y_b, y_c, y_d])
    branch = jnp.einsum('nbsc,ncd->bsnd', ys, w_branch)
    gates = jax.nn.sigmoid(mg.reshape(B, S, N_BRANCH, D_MODEL))
    merged = jnp.sum(gates * branch, axis=2)
    return merged @ w_out


def hier_moe(h, wr_g, br_g, wr_e, br_e, w_gate, w_up, w_down):
    B, S, D = h.shape
    f32 = jnp.float32
    t = h.reshape(-1, D)
    T = t.shape[0]
    grp_p = jax.nn.softmax((t @ wr_g + br_g).astype(f32), axis=-1)
    grp_w, grp_idx = lax.top_k(grp_p, 1)
    exp_logits = (t @ wr_e + br_e).astype(f32).reshape(T, N_GROUPS, EXPERTS_PER_GROUP)
    in_grp = jnp.einsum('tge,tg->te', exp_logits, jax.nn.one_hot(grp_idx[:, 0], N_GROUPS, dtype=f32))
    top_l, top_e = lax.top_k(in_grp, EXPERT_TOPK)
    top_w = jax.nn.softmax(top_l, axis=-1) * grp_w
    expert_id = grp_idx * EXPERTS_PER_GROUP + top_e
    combine = jnp.sum(jax.nn.one_hot(expert_id, N_EXPERTS, dtype=f32) * top_w[..., None], axis=1)
    hid = jax.nn.silu(jnp.einsum('td,edf->etf', t, w_gate)) * jnp.einsum('td,edf->etf', t, w_up)
    hid = hid * combine.T[:, :, None].astype(hid.dtype)
    out = jnp.einsum('etf,efd->td', hid, w_down)
    return out.reshape(B, S, D)


def setup_inputs(seed: int = 0) -> dict:
    key = jax.random.key(seed)
    ks = iter(jax.random.split(key, 40))
    f32 = jnp.float32
    L = DEPTH

    def nrm(shape, scale):
        return jax.random.normal(next(ks), shape, f32) * scale

    def gain(shape):
        return 1.0 + 0.02 * jax.random.normal(next(ks), shape, f32)

    a_c = jax.random.uniform(next(ks), (L, MIX), f32, minval=0.9, maxval=0.999)
    a0 = a_c ** (1.0 / LRU_C)
    lru_lambda = jnp.log(a0) - jnp.log1p(-a0)
    return {
        'x': nrm((BATCH, SEQ, D_MODEL), 1.0),
        'norm1_g': gain((L, D_MODEL)),
        'w_in': nrm((L, D_MODEL, N_IN), D_MODEL ** -0.5),
        'gm_norm_g': gain((L, MIX)),
        'gm_ws': nrm((L, GM_GROUPS, GM_CHUNK, GM_CHUNK), GM_CHUNK ** -0.5),
        'gm_b': gain((L, GM_GROUPS, GM_CHUNK)),
        'conv_w': nrm((L, CONV_WIDTH, MIX), CONV_WIDTH ** -0.5),
        'conv_b': nrm((L, MIX), 0.02),
        'lru_wa': nrm((L, LRU_BLOCKS, LRU_BW, LRU_BW), LRU_BW ** -0.5),
        'lru_ba': nrm((L, MIX), 0.02),
        'lru_wx': nrm((L, LRU_BLOCKS, LRU_BW, LRU_BW), LRU_BW ** -0.5),
        'lru_bx': nrm((L, MIX), 0.02),
        'lru_lambda': lru_lambda,
        'cmp_pe': nrm((L, 2, CMP_LEN, HEAD_DIM), 0.02),
        'cmp_w1': nrm((L, 2, N_KV, CMP_LEN * HEAD_DIM, HEAD_DIM), (CMP_LEN * HEAD_DIM) ** -0.5),
        'cmp_w2': nrm((L, 2, N_KV, HEAD_DIM, HEAD_DIM), HEAD_DIM ** -0.5),
        'pool_w': nrm((L, POOL_GROUPS, POOL_GW, POOL_GW), POOL_GW ** -0.5),
        'pool_scale': gain((L, MIX)),
        'w_branch': nrm((L, N_BRANCH, MIX, D_MODEL), MIX ** -0.5),
        'w_out': nrm((L, D_MODEL, D_MODEL), D_MODEL ** -0.5),
        'norm2_g': gain((L, D_MODEL)),
        'router_w_group': nrm((L, D_MODEL, N_GROUPS), D_MODEL ** -0.5),
        'router_b_group': nrm((L, N_GROUPS), 0.01),
        'router_w_expert': nrm((L, D_MODEL, N_EXPERTS), D_MODEL ** -0.5),
        'router_b_expert': nrm((L, N_EXPERTS), 0.01),
        'moe_w_gate': nrm((L, N_EXPERTS, D_MODEL, D_EXPERT), D_MODEL ** -0.5),
        'moe_w_up': nrm((L, N_EXPERTS, D_MODEL, D_EXPERT), D_MODEL ** -0.5),
        'moe_w_down': nrm((L, N_EXPERTS, D_EXPERT, D_MODEL), D_EXPERT ** -0.5),
        'final_norm_g': gain((D_MODEL,)),
    }


def reference(x, norm1_g, w_in, gm_norm_g, gm_ws, gm_b, conv_w, conv_b, lru_wa, lru_ba, lru_wx,
              lru_bx, lru_lambda, cmp_pe, cmp_w1, cmp_w2, pool_w, pool_scale, w_branch, w_out,
              norm2_g, router_w_group, router_b_group, router_w_expert, router_b_expert,
              moe_w_gate, moe_w_up, moe_w_down, final_norm_g):
    h = x
    for l in range(DEPTH):
        h = h + hybrid_mixer(rms_norm(h, norm1_g[l]), w_in[l], gm_norm_g[l], gm_ws[l], gm_b[l],
                             conv_w[l], conv_b[l], lru_wa[l], lru_ba[l], lru_wx[l], lru_bx[l],
                             lru_lambda[l], cmp_pe[l], cmp_w1[l], cmp_w2[l], pool_w[l],
                             pool_scale[l], w_branch[l], w_out[l])
        h = h + hier_moe(rms_norm(h, norm2_g[l]), router_w_group[l], router_b_group[l],
                         router_w_expert[l], router_b_expert[l], moe_w_gate[l], moe_w_up[l],
                         moe_w_down[l])
    return rms_norm(h, final_norm_g)
```

```cpp
#include <hip/hip_runtime.h>
#include <cstdio>
#include <cstdint>

#define GAS __attribute__((address_space(1)))
#define LAS __attribute__((address_space(3)))
typedef unsigned short bf16;
typedef unsigned u32x4 __attribute__((ext_vector_type(4)));
typedef unsigned u32x2 __attribute__((ext_vector_type(2)));
typedef float f32x4 __attribute__((ext_vector_type(4)));
typedef float f32x2 __attribute__((ext_vector_type(2)));
typedef short bf16x8 __attribute__((ext_vector_type(8)));
typedef unsigned long long u64;

#ifndef MK_SPLIT
#define MK_SPLIT 0
#endif

constexpr int NB = 4, SEQ = 4096, T = NB * SEQ, D = 1024, MIX = 512, NL = 2;
constexpr int NIN = 7960, NPROJ = 8192, P1W = 4096;
constexpr int C_U = 0, C_V = 512, C_GB = 1024, C_RB = 1536, C_Q = 2048, C_KV = 2560, C_XD = 3328, C_GC = 3840;
constexpr int SRC_GC = 3328, SRC_XD = 3352, SRC_MG = 3864;
constexpr float EPS = 1e-6f;
constexpr int NEXP = 16, DEXP = 512;
constexpr int HID_ROWS = 2 * T + 4096;

constexpr size_t MiB = 1u << 20;
constexpr size_t WS_CTL = 0, CTL_ZERO_BYTES = 1 * MiB;
constexpr size_t WS_KC = 1 * MiB;
constexpr size_t WS_LRUA = 2 * MiB;
constexpr size_t WS_LRUH = 2 * MiB + 512 * 1024;
constexpr size_t WS_LIST = 3 * MiB;
constexpr size_t WS_LISTW = 4 * MiB;
constexpr size_t WS_WIN = 8 * MiB;
constexpr size_t WS_WB = 40 * MiB;
constexpr size_t WS_WOUT = 48 * MiB;
constexpr size_t WS_XN = 52 * MiB;
constexpr size_t WS_P1 = 84 * MiB;
constexpr size_t WS_R = 212 * MiB;
constexpr size_t WS_WGU = 84 * MiB;
constexpr size_t WS_WD = 116 * MiB;
constexpr size_t WS_HID = 132 * MiB;
constexpr size_t WS_Y = 168 * MiB;
constexpr size_t WS_END = 340 * MiB;
static_assert(WS_HID + (size_t)HID_ROWS * 512 * 2 <= WS_Y && WS_Y + (size_t)2 * T * 1024 * 2 <= WS_END, "ws map");

constexpr int CW_BAR = 4096;
constexpr int CW_CNT = 8192;

constexpr int LDS_BYTES = 147456;
constexpr int LDS_CTL = 146432;
constexpr int LDS_MOE = LDS_CTL + 256;

__device__ __forceinline__ unsigned f2bf(float f) { unsigned u = __builtin_bit_cast(unsigned, f); return (u + 0x7fffu + ((u >> 16) & 1u)) >> 16; }
__device__ __forceinline__ unsigned pk2(float lo, float hi) { return f2bf(lo) | (f2bf(hi) << 16); }
__device__ __forceinline__ float bflo(unsigned u) { return __builtin_bit_cast(float, u << 16); }
__device__ __forceinline__ float bfhi(unsigned u) { return __builtin_bit_cast(float, u & 0xffff0000u); }
__device__ __forceinline__ float bf2f(bf16 h) { return __builtin_bit_cast(float, (unsigned)h << 16); }
__device__ __forceinline__ float sigmoidf_(float x) { return 1.0f / (1.0f + __expf(-x)); }
__device__ __forceinline__ float gelu_tanh(float x) { const float z = 1.5957691216057308f * (x + 0.044715f * x * x * x); return x * sigmoidf_(z); }
__device__ __forceinline__ float wave_sum(float v) {
#pragma unroll
    for (int o = 1; o < 64; o <<= 1) v += __shfl_xor(v, o);
    return v;
}
__device__ __forceinline__ u64 mask_lo(int n) { return n >= 64 ? ~0ull : (n <= 0 ? 0ull : ((1ull << n) - 1ull)); }
#define LDS_WAIT() asm volatile("s_waitcnt lgkmcnt(0)" ::: "memory")
__device__ __forceinline__ int opaque_tid() { int t = (int)threadIdx.x; asm volatile("" : "+v"(t)); return t; }

namespace pg8 {
constexpr int BM = 256, BK = 64, HALF = 128, HTB = HALF * BK * 2, NXCD = 8, WGM = 8;
__host__ __device__ __forceinline__ int lds_byte(int r, int c) { const int st = (r >> 4) * 2 + (c >> 5), rr = r & 15, cc = c & 31, ob = rr * 64 + cc * 2; return st * 1024 + (ob ^ (((ob >> 9) & 1) << 5)); }
__host__ __device__ __forceinline__ void stage_rc(int b, int& R, int& C) { const int st = b / 1024, sb = b % 1024, swz = sb ^ (((sb >> 9) & 1) << 5); R = (st >> 1) * 16 + swz / 64; C = (st & 1) * 32 + (swz % 64) / 2; }
__host__ __device__ __forceinline__ int perm32(int rho) { const int n = rho >> 4, i = rho & 15; return 8 * (i >> 2) + 4 * n + (i & 3); }

struct Unit { const char* A; const char* B; int pm, pn, sub, e; };

__device__ __forceinline__ bool static_tile(int i, int G, int c, int nM, int nN, int& pm, int& pn) {
    const int nwg = nM * nN; const long L = (long)i * G + c; if (L >= nwg) return false;
    int wgid = (int)L; { const int q = nwg / NXCD, r = nwg % NXCD, xcd = wgid % NXCD, off = wgid / NXCD; wgid = (xcd < r ? xcd * (q + 1) : r * (q + 1) + (xcd - r) * q) + off; }
    const int nig = WGM * nN, gid = wgid / nig, fm = gid * WGM, gsz = (nM - fm) < WGM ? (nM - fm) : WGM;
    pm = fm + ((wgid % nig) % gsz); pn = (wgid % nig) / gsz; return true;
}

template <class Epi, class Sched, bool ALIGN_EPI>
__device__ __forceinline__ void gemm_phase(LAS unsigned char* lds, const int K, const Sched& S, const Epi& E) {
    const int tid = opaque_tid(), wid = __builtin_amdgcn_readfirstlane(tid >> 6), lane = tid & 63, wr = wid >> 2, wc = wid & 3, fr = lane & 15, fq = lane >> 4;
    const int nt = K / BK;
    unsigned voffB[2];
#pragma unroll
    for (int i = 0; i < 2; ++i) { int R, C; stage_rc(tid * 16 + i * 8192, R, C); const int Rb = (R & ~31) + perm32(R & 31); voffB[i] = (unsigned)(Rb * K + C) * 2u; }
    const size_t kstep = (size_t)(BK * 2);
    const size_t hstepB = (size_t)HALF * K * 2;
    const unsigned ldsw = (unsigned)wid * 1024u;
    const int aoff = lds_byte(wr * 64 + fr, fq * 8), boff = lds_byte(wc * 32 + fr, fq * 8);
#define PG8_SA(b, h) (((b) * 2 + (h)) * HTB)
#define PG8_SB(b, h) ((4 + (b) * 2 + (h)) * HTB)
#define PG8_STAGE(bufoff, gbase, voff) do { _Pragma("unroll") for (int _i = 0; _i < 2; ++_i) \
        __builtin_amdgcn_global_load_lds((const unsigned*)((const char*)(gbase) + (voff)[_i]), (LAS unsigned*)(lds + (bufoff) + ldsw + _i * 8192), 16, 0, 0); } while (0)
#define PG8_LDA(dst, b, h) do { _Pragma("unroll") for (int m = 0; m < 4; ++m) _Pragma("unroll") for (int k = 0; k < 2; ++k) dst[m][k] = *(const LAS bf16x8*)(lds + PG8_SA(b, h) + aoff + m * 2048 + k * 1024); } while (0)
#define PG8_LDB(dst, b, h) do { _Pragma("unroll") for (int n = 0; n < 2; ++n) _Pragma("unroll") for (int k = 0; k < 2; ++k) dst[n][k] = *(const LAS bf16x8*)(lds + PG8_SB(b, h) + boff + n * 2048 + k * 1024); } while (0)
#define PG8_MMA(ai, bj, At, Bt) do { __builtin_amdgcn_s_setprio(1); _Pragma("unroll") for (int m = 0; m < 4; ++m) _Pragma("unroll") for (int n = 0; n < 2; ++n) _Pragma("unroll") for (int k = 0; k < 2; ++k) \
        acc[ai][bj][m][n] = __builtin_amdgcn_mfma_f32_16x16x32_bf16(Bt[n][k], At[m][k], acc[ai][bj][m][n], 0, 0, 0); __builtin_amdgcn_s_setprio(0); } while (0)
#define PG8_WAIT_V(n) asm volatile("s_waitcnt vmcnt(" #n ")" ::: "memory")
#define PG8_WAIT_L(n) asm volatile("s_waitcnt lgkmcnt(" #n ")" ::: "memory")
#define PG8_BAR __builtin_amdgcn_s_barrier()
#define PG8_SCHED __builtin_amdgcn_sched_barrier(0)
#define PG8_ZERO() do { _Pragma("unroll") for (int a = 0; a < 2; ++a) _Pragma("unroll") for (int b = 0; b < 2; ++b) _Pragma("unroll") for (int m = 0; m < 4; ++m) _Pragma("unroll") for (int n = 0; n < 2; ++n) acc[a][b][m][n] = (f32x4){0.f, 0.f, 0.f, 0.f}; } while (0)
    Unit cur, nxt; int ui = 0;
    if (!S.next(0, cur)) return;
    f32x4 acc[2][2][4][2];
    PG8_ZERO();
    bf16x8 At[4][2], B0[2][2], B1[2][2];
    unsigned voA[2][2], voN[2][2];
    S.a_off(cur, voA);
    const char* cA = cur.A; const char* cB = cur.B;
    PG8_STAGE(PG8_SB(0, 0), cB, voffB); PG8_STAGE(PG8_SB(0, 1), cB + hstepB, voffB); PG8_STAGE(PG8_SA(0, 0), cA, voA[0]); PG8_STAGE(PG8_SA(0, 1), cA, voA[1]);
    if (wr == 1) PG8_BAR;
    PG8_WAIT_V(2); PG8_BAR;
    PG8_STAGE(PG8_SB(1, 0), cB + kstep, voffB); PG8_STAGE(PG8_SA(1, 0), cA + kstep, voA[0]); PG8_STAGE(PG8_SB(1, 1), cB + hstepB + kstep, voffB);
    PG8_WAIT_V(6); PG8_BAR;
    for (;;) {
        const bool has_next = S.next(ui + 1, nxt);
        const char* nA = has_next ? nxt.A : cA; const char* nB = has_next ? nxt.B : cB;
        if (has_next) S.a_off(nxt, voN); else { voN[0][0] = voA[0][0]; voN[0][1] = voA[0][1]; voN[1][0] = voA[1][0]; voN[1][1] = voA[1][1]; }
        for (int t = 0; t < nt; t += 2) {
            const bool last = (t == nt - 2);
            const char* a1 = cA + (size_t)(t + 1) * kstep;
            const char* a2 = last ? nA : cA + (size_t)(t + 2) * kstep; const char* b2 = last ? nB : cB + (size_t)(t + 2) * kstep;
            const char* a3 = a2 + kstep; const char* b3 = b2 + kstep;
            PG8_LDB(B0, 0, 0); PG8_LDB(B1, 0, 1); PG8_SCHED; PG8_LDA(At, 0, 0); PG8_STAGE(PG8_SA(1, 1), a1, voA[1]);
            PG8_WAIT_V(8); PG8_WAIT_L(0); PG8_BAR; PG8_MMA(0, 0, At, B0); PG8_MMA(0, 1, At, B1); PG8_BAR; PG8_SCHED;
            if (last) { voA[0][0] = voN[0][0]; voA[0][1] = voN[0][1]; voA[1][0] = voN[1][0]; voA[1][1] = voN[1][1]; }
            PG8_LDA(At, 0, 1); PG8_STAGE(PG8_SB(0, 0), b2, voffB); PG8_STAGE(PG8_SB(0, 1), b2 + hstepB, voffB); PG8_STAGE(PG8_SA(0, 0), a2, voA[0]);
            PG8_WAIT_V(8); PG8_WAIT_L(0); PG8_BAR; PG8_MMA(1, 0, At, B0); PG8_MMA(1, 1, At, B1); PG8_BAR; PG8_SCHED;
            PG8_LDB(B0, 1, 0); PG8_LDB(B1, 1, 1); PG8_SCHED; PG8_LDA(At, 1, 0); PG8_STAGE(PG8_SA(0, 1), a2, voA[1]);
            PG8_WAIT_V(8); PG8_WAIT_L(0); PG8_BAR; PG8_MMA(0, 0, At, B0); PG8_MMA(0, 1, At, B1); PG8_BAR; PG8_SCHED;
            PG8_LDA(At, 1, 1); PG8_STAGE(PG8_SB(1, 0), b3, voffB); PG8_STAGE(PG8_SB(1, 1), b3 + hstepB, voffB); PG8_STAGE(PG8_SA(1, 0), a3, voA[0]);
            PG8_WAIT_V(8); PG8_WAIT_L(0); PG8_BAR; PG8_MMA(1, 0, At, B0); PG8_MMA(1, 1, At, B1); PG8_BAR; PG8_SCHED;
        }
        if constexpr (ALIGN_EPI) { if (wr == 0) PG8_BAR; }
        int tz = lane; asm volatile("" : "+v"(tz));
        const bool z = E(acc, cur, wr, wc, tz & 15, tz >> 4);
        if (!has_next) break;
        if (z) PG8_ZERO();
        cur = nxt; cA = nA; cB = nB; ++ui;
        if constexpr (ALIGN_EPI) { if (wr == 1) PG8_BAR; }
    }
    PG8_WAIT_V(0);
    if constexpr (!ALIGN_EPI) { if (wr == 0) PG8_BAR; }
    PG8_BAR;
#undef PG8_SA
#undef PG8_SB
#undef PG8_STAGE
#undef PG8_LDA
#undef PG8_LDB
#undef PG8_MMA
#undef PG8_WAIT_V
#undef PG8_WAIT_L
#undef PG8_BAR
#undef PG8_SCHED
#undef PG8_ZERO
}
}

#define XB_TMO      128
#define XB_XCNT(j)  (256  + 64 * (j))
#define XB_XSUB(j)  (1280 + 64 * (j))
#define XB_XGEN(j)  (2304 + 64 * (j))
#define XB_TOP      3328
#define XB_TOPGEN   3392
#define XCD_BAR_WORDS 3456
#define XB_SPIN_CAP (1u << 23)
__device__ __forceinline__ unsigned xb_ld(unsigned* p)              { return __hip_atomic_load(p, __ATOMIC_RELAXED, __HIP_MEMORY_SCOPE_AGENT); }
__device__ __forceinline__ unsigned xb_add(unsigned* p, unsigned v) { return __hip_atomic_fetch_add(p, v, __ATOMIC_RELAXED, __HIP_MEMORY_SCOPE_AGENT); }
__device__ __forceinline__ unsigned xb_xcc_id() { return (unsigned)__builtin_amdgcn_s_getreg((3 << 11) | 20) & 0xFu; }
#define XB_SPIN(cond, bar) do { unsigned _sp = 0; while (cond) { __builtin_amdgcn_s_sleep(1); \
    if ((++_sp & 255u) == 0u) { if (xb_ld(&(bar)[XB_TMO])) break; if (_sp > XB_SPIN_CAP) { atomicAdd(&(bar)[XB_TMO], 1u); break; } } } } while (0)
struct XcdBarrier { unsigned* bar; unsigned x; volatile LAS unsigned* st; };
__device__ __forceinline__ XcdBarrier xcd_barrier_post(unsigned* bar, volatile LAS unsigned* st) {
    XcdBarrier b; b.bar = bar; b.x = xb_xcc_id(); b.st = st;
    if (threadIdx.x == 0) (void)xb_add(&bar[XB_XCNT(b.x)], 1u);
    return b;
}
__device__ __forceinline__ void xcd_barrier_complete(unsigned* bar, unsigned x, unsigned& nloc, unsigned& nx) {
    const unsigned G = gridDim.x * gridDim.y * gridDim.z;
    unsigned sum, cnt, mine, sp = 0u;
    for (;;) {
        sum = 0u; cnt = 0u; mine = 0u;
#pragma unroll
        for (unsigned j = 0; j < 16; ++j) { const unsigned c = xb_ld(&bar[XB_XCNT(j)]); sum += c; cnt += (c > 0u) ? 1u : 0u; mine = (j == x) ? c : mine; }
        if (sum == G) break;
        __builtin_amdgcn_s_sleep(1);
        if ((++sp & 255u) == 0u) { if (xb_ld(&bar[XB_TMO])) break; if (sp > XB_SPIN_CAP) { atomicAdd(&bar[XB_TMO], 1u); break; } }
    }
    nloc = mine > 0u ? mine : 1u; nx = cnt > 0u ? cnt : 1u;
}
__device__ __forceinline__ void xcd_barrier(const XcdBarrier& b) {
    asm volatile("s_waitcnt vmcnt(0)" ::: "memory");
    __syncthreads();
    if (threadIdx.x == 0) {
        unsigned* bar = b.bar;
        __builtin_amdgcn_s_waitcnt(0);
        unsigned nloc = b.st[0], nx = b.st[1];
        if (nloc == 0u) { xcd_barrier_complete(bar, b.x, nloc, nx); b.st[0] = nloc; b.st[1] = nx; }
        const unsigned old = xb_add(&bar[XB_XSUB(b.x)], 1u);
        const unsigned gen = old / nloc;
        if (old + 1u == (gen + 1u) * nloc) {
            __builtin_amdgcn_fence(__ATOMIC_RELEASE, "agent");
            asm volatile("s_waitcnt vmcnt(0)" ::: "memory");
            const unsigned og = xb_add(&bar[XB_TOP], 1u);
            const unsigned tg = og / nx;
            if (og + 1u == (tg + 1u) * nx) xb_add(&bar[XB_TOPGEN], 1u);
            else XB_SPIN(xb_ld(&bar[XB_TOPGEN]) == tg, bar);
            __builtin_amdgcn_fence(__ATOMIC_ACQUIRE, "agent");
            xb_add(&bar[XB_XGEN(b.x)], 1u);
            asm volatile("s_waitcnt vmcnt(0)" ::: "memory");
        } else {
            XB_SPIN(xb_ld(&bar[XB_XGEN(b.x)]) == gen, bar);
            __builtin_amdgcn_fence(__ATOMIC_ACQUIRE, "agent");
            asm volatile("s_waitcnt vmcnt(0)" ::: "memory");
        }
    }
    __syncthreads();
}

struct Args { const float* in[29]; float* out; unsigned char* ws; int ph_lo, ph_hi; };
enum { I_X = 0, I_N1G, I_WIN, I_GMNG, I_GMWS, I_GMB, I_CONVW, I_CONVB, I_LWA, I_LBA, I_LWX, I_LBX, I_LLAM, I_PE, I_CW1, I_CW2, I_PW, I_PS, I_WBR, I_WOUT, I_N2G, I_RWG, I_RBG, I_RWE, I_RBE, I_MG, I_MU, I_MD, I_FNG };

#define CAS __attribute__((address_space(4)))
__device__ __forceinline__ unsigned long long karg_u64(int off) { const CAS char* kp = (const CAS char*)__builtin_amdgcn_kernarg_segment_ptr(); asm volatile("" : "+s"(kp)); return *(const CAS unsigned long long*)(kp + off); }
#define ARG_IN(k) ((const float*)karg_u64(8 * (k)))
#define ARG_OUT() ((float*)karg_u64(8 * 29))
#define ARG_WS() ((unsigned char*)karg_u64(8 * 30))
template <class F>
__device__ __forceinline__ void tr_item(const float* W, int K, int N, bf16* WT, float* scr, int kb, int nb, int lane, F dst) {
    const int k0 = 64 * kb, n0 = 32 * nb;
    const int nn = n0 + (lane & 31);
#pragma unroll 8
    for (int i = 0; i < 32; ++i) { const int kk = 2 * i + (lane >> 5); scr[kk * 33 + (lane & 31)] = (nn < N) ? W[(size_t)(k0 + kk) * N + nn] : 0.f; }
    LDS_WAIT(); asm volatile("" ::: "memory");
    const int c = lane & 7;
#pragma unroll
    for (int j = 0; j < 4; ++j) { const int nl = (lane >> 3) + 8 * j; const int n = n0 + nl; const float* s = scr + (8 * c) * 33 + nl;
        u32x4 o; o.x = pk2(s[0 * 33], s[1 * 33]); o.y = pk2(s[2 * 33], s[3 * 33]); o.z = pk2(s[4 * 33], s[5 * 33]); o.w = pk2(s[6 * 33], s[7 * 33]);
        if (n < N) *(u32x4*)(WT + (size_t)dst(n) * K + k0 + 8 * c) = o; }
    LDS_WAIT(); asm volatile("" ::: "memory");
}
__device__ __forceinline__ int win_dst_row(int s) {
    if (s < SRC_GC) return s;
    if (s < SRC_XD) return C_GC + (s - SRC_GC);
    if (s < SRC_MG) return C_XD + (s - SRC_XD);
    const int n = (s - SRC_MG) >> 10, d = (s - SRC_MG) & 1023;
    return P1W + 256 * (d >> 6) + 128 * (n >> 1) + 32 * ((d >> 4) & 3) + 8 * ((d >> 2) & 3) + 4 * (n & 1) + (d & 3);
}
template <int MODE>
__device__ __forceinline__ void norm_row(const float* xrow, float* hrow, const bf16* y0, const bf16* y1, const float* g, bf16* xn, int lane) {
    f32x4 v[4]; float ss = 0.f;
#pragma unroll
    for (int j = 0; j < 4; ++j) {
        const int c = 4 * lane + 256 * j;
        v[j] = *(const f32x4*)((MODE == 0 ? xrow : hrow) + c);
        if (MODE != 0) { const u32x2 a = *(const u32x2*)(y0 + c), b = *(const u32x2*)(y1 + c);
            v[j].x += bflo(a.x) + bflo(b.x); v[j].y += bfhi(a.x) + bfhi(b.x); v[j].z += bflo(a.y) + bflo(b.y); v[j].w += bfhi(a.y) + bfhi(b.y); }
        ss += (v[j].x * v[j].x + v[j].y * v[j].y) + (v[j].z * v[j].z + v[j].w * v[j].w);
    }
    const float rstd = rsqrtf(wave_sum(ss) * (1.f / D) + EPS);
#pragma unroll
    for (int j = 0; j < 4; ++j) {
        const int c = 4 * lane + 256 * j;
        const f32x4 gg = *(const f32x4*)(g + c);
        if (MODE == 2) { *(f32x4*)(hrow + c) = (f32x4){v[j].x * rstd * gg.x, v[j].y * rstd * gg.y, v[j].z * rstd * gg.z, v[j].w * rstd * gg.w}; }
        else { *(f32x4*)(hrow + c) = v[j];
            u32x2 o; o.x = pk2(v[j].x * rstd * gg.x, v[j].y * rstd * gg.y); o.y = pk2(v[j].z * rstd * gg.z, v[j].w * rstd * gg.w); *(u32x2*)(xn + c) = o; }
    }
}

struct SchedDense {
    const bf16* A; const bf16* Bt; int lda, K, nM, nN, G, c;
    __device__ __forceinline__ bool next(int i, pg8::Unit& u) const {
        int pm, pn; if (!pg8::static_tile(i, G, c, nM, nN, pm, pn)) return false;
        u.pm = pm; u.pn = pn; u.sub = 0; u.e = 0; u.A = (const char*)(A + (size_t)pm * 256 * lda); u.B = (const char*)(Bt + (size_t)pn * 256 * K); return true;
    }
    __device__ __forceinline__ void a_off(const pg8::Unit&, unsigned (&vo)[2][2]) const {
        const int tz = opaque_tid();
#pragma unroll
        for (int i = 0; i < 2; ++i) { int R, C; pg8::stage_rc(tz * 16 + i * 8192, R, C);
#pragma unroll
            for (int h = 0; h < 2; ++h) vo[h][i] = (unsigned)((h * 128 + R) * lda + C) * 2u; }
    }
};
struct SchedMerge {
    const bf16* P1; const bf16* Wb; int G, c;
    __device__ __forceinline__ bool next(int i, pg8::Unit& u) const {
        const int ti = i >> 2, sub = i & 3; int pm, pn; if (!pg8::static_tile(ti, G, c, T / 256, 4, pm, pn)) return false;
        const int ycol = (sub == 0) ? C_U : (sub == 1) ? C_GB : (sub == 2) ? C_Q : C_V;
        u.pm = pm; u.pn = pn; u.sub = sub; u.e = 0;
        u.A = (const char*)(P1 + (size_t)pm * 256 * P1W + ycol); u.B = (const char*)(Wb + ((size_t)sub * 1024 + (size_t)pn * 256) * 512); return true;
    }
    __device__ __forceinline__ void a_off(const pg8::Unit&, unsigned (&vo)[2][2]) const {
        const int tz = opaque_tid();
#pragma unroll
        for (int i = 0; i < 2; ++i) { int R, C; pg8::stage_rc(tz * 16 + i * 8192, R, C);
#pragma unroll
            for (int h = 0; h < 2; ++h) vo[h][i] = (unsigned)((h * 128 + R) * P1W + C) * 2u; }
    }
};
struct SchedMoe {
    const bf16* A; const bf16* Bt; const unsigned* list; int lda, K, brows  , G, c; bool gather; const LAS int* tab;
    __device__ __forceinline__ bool next(int i, pg8::Unit& u) const {
        const int L = i * G + c; const int tot = __builtin_amdgcn_readfirstlane(tab[16]); if (L >= 4 * tot) return false;
        const int rtg = L >> 2, pn = L & 3; int e = 0, st = 0;
#pragma unroll
        for (int k = 1; k < 16; ++k) { const int tk = __builtin_amdgcn_readfirstlane(tab[k]); if (rtg >= tk) { e = k; st = tk; } }
        u.e = e; u.pm = rtg; u.sub = rtg - st; u.pn = pn;
        u.A = gather ? (const char*)A : (const char*)(A + (size_t)rtg * 256 * lda);
        u.B = (const char*)(Bt + ((size_t)e * brows + (size_t)pn * 256) * K); return true;
    }
    __device__ __forceinline__ void a_off(const pg8::Unit& u, unsigned (&vo)[2][2]) const {
        const int cnt = __builtin_amdgcn_readfirstlane(tab[32 + u.e]); const unsigned* le = list + (size_t)u.e * T + u.sub * 256;
        int tz = (int)threadIdx.x; asm volatile("" : "+v"(tz));
#pragma unroll
        for (int i = 0; i < 2; ++i) { int R, C; pg8::stage_rc(tz * 16 + i * 8192, R, C);
#pragma unroll
            for (int h = 0; h < 2; ++h) {
                int row = h * 128 + R;
                if (gather) { row = (u.sub * 256 + row < cnt) ? (int)(le[row] & 0x3fffu) : 0; }
                vo[h][i] = (unsigned)(row * lda + C) * 2u;
            } }
    }
};

struct EpiProj {
    bf16* P1; bf16* Rr;
    __device__ __forceinline__ bool operator()(f32x4 (&acc)[2][2][4][2], const pg8::Unit& u, int wr, int wc, int fr, int fq) const {
        const int row0 = u.pm * 256 + wr * 64 + fr;
        if (u.pn < 16) {
            const int act = (u.pn < 6) ? 1 : (u.pn == 15 ? 2 : 0);
#pragma unroll
            for (int ai = 0; ai < 2; ++ai)
#pragma unroll
                for (int m = 0; m < 4; ++m) { bf16* rowp = P1 + (size_t)(row0 + ai * 128 + m * 16) * P1W + u.pn * 256 + wc * 32 + 8 * fq;
#pragma unroll
                    for (int bj = 0; bj < 2; ++bj) { f32x4 v0 = acc[ai][bj][m][0], v1 = acc[ai][bj][m][1];
                        if (act == 1) { v0 = (f32x4){gelu_tanh(v0.x), gelu_tanh(v0.y), gelu_tanh(v0.z), gelu_tanh(v0.w)}; v1 = (f32x4){gelu_tanh(v1.x), gelu_tanh(v1.y), gelu_tanh(v1.z), gelu_tanh(v1.w)}; }
                        else if (act == 2) { v0 = (f32x4){sigmoidf_(v0.x), sigmoidf_(v0.y), sigmoidf_(v0.z), sigmoidf_(v0.w)}; v1 = (f32x4){sigmoidf_(v1.x), sigmoidf_(v1.y), sigmoidf_(v1.z), sigmoidf_(v1.w)}; }
                        u32x4 w; w.x = pk2(v0.x, v0.y); w.y = pk2(v0.z, v0.w); w.z = pk2(v1.x, v1.y); w.w = pk2(v1.z, v1.w);
                        *(u32x4*)(rowp + bj * 128) = w; } }
        } else {
            const int dcol = 64 * (u.pn - 16) + 16 * wc + 4 * fq;
#pragma unroll
            for (int ai = 0; ai < 2; ++ai)
#pragma unroll
                for (int m = 0; m < 4; ++m) { const size_t row = (size_t)(row0 + ai * 128 + m * 16);
                    float r0[4], r1[4], r2[4], r3[4];
#pragma unroll
                    for (int i = 0; i < 4; ++i) {
                        const float g0 = fmaxf(sigmoidf_(acc[ai][0][m][0][i]), 1e-20f), g1 = fmaxf(sigmoidf_(acc[ai][0][m][1][i]), 1e-20f);
                        const float g2 = fmaxf(sigmoidf_(acc[ai][1][m][0][i]), 1e-20f), g3 = fmaxf(sigmoidf_(acc[ai][1][m][1][i]), 1e-20f);
                        r0[i] = g0 / g1; r1[i] = g1 / g2; r2[i] = g2 / g3; r3[i] = g3; }
                    u32x2 w;
                    w.x = pk2(r0[0], r0[1]); w.y = pk2(r0[2], r0[3]); *(u32x2*)(Rr + ((size_t)0 * T + row) * 1024 + dcol) = w;
                    w.x = pk2(r1[0], r1[1]); w.y = pk2(r1[2], r1[3]); *(u32x2*)(Rr + ((size_t)1 * T + row) * 1024 + dcol) = w;
                    w.x = pk2(r2[0], r2[1]); w.y = pk2(r2[2], r2[3]); *(u32x2*)(Rr + ((size_t)2 * T + row) * 1024 + dcol) = w;
                    w.x = pk2(r3[0], r3[1]); w.y = pk2(r3[2], r3[3]); *(u32x2*)(Rr + ((size_t)3 * T + row) * 1024 + dcol) = w; }
        }
        return true;
    }
};
struct EpiMerge {
    const bf16* Rr; bf16* O;
    __device__ __forceinline__ bool operator()(f32x4 (&acc)[2][2][4][2], const pg8::Unit& u, int wr, int wc, int fr, int fq) const {
        const int row0 = u.pm * 256 + wr * 64 + fr, col0 = u.pn * 256 + wc * 32 + 8 * fq;
        const bf16* Rn = Rr + (size_t)u.sub * T * 1024;
#pragma unroll
        for (int ai = 0; ai < 2; ++ai)
#pragma unroll
            for (int m = 0; m < 4; ++m) { const size_t ro = (size_t)(row0 + ai * 128 + m * 16) * 1024 + col0;
#pragma unroll
                for (int bj = 0; bj < 2; ++bj) { const u32x4 r = *(const u32x4*)(Rn + ro + bj * 128);
                    f32x4& v0 = acc[ai][bj][m][0]; f32x4& v1 = acc[ai][bj][m][1];
                    v0.x *= bflo(r.x); v0.y *= bfhi(r.x); v0.z *= bflo(r.y); v0.w *= bfhi(r.y); v1.x *= bflo(r.z); v1.y *= bfhi(r.z); v1.z *= bflo(r.w); v1.w *= bfhi(r.w);
                    if (u.sub == 3) { u32x4 w; w.x = pk2(v0.x, v0.y); w.y = pk2(v0.z, v0.w); w.z = pk2(v1.x, v1.y); w.w = pk2(v1.z, v1.w); *(u32x4*)(O + ro + bj * 128) = w; } } }
        return u.sub == 3;
    }
};
struct EpiWout {
    float* H;
    __device__ __forceinline__ bool operator()(f32x4 (&acc)[2][2][4][2], const pg8::Unit& u, int wr, int wc, int fr, int fq) const {
        const int row0 = u.pm * 256 + wr * 64 + fr, col0 = u.pn * 256 + wc * 32 + 8 * fq;
#pragma unroll
        for (int ai = 0; ai < 2; ++ai)
#pragma unroll
            for (int m = 0; m < 4; ++m) { float* rp = H + (size_t)(row0 + ai * 128 + m * 16) * 1024 + col0;
#pragma unroll
                for (int bj = 0; bj < 2; ++bj)
#pragma unroll
                    for (int n = 0; n < 2; ++n) { f32x4* p = (f32x4*)(rp + bj * 128 + 4 * n); f32x4 h = *p; h = h + acc[ai][bj][m][n]; *p = h; } }
        return true;
    }
};
struct EpiGateUp {
    bf16* HID; const float* lw; const LAS int* tab;
    __device__ __forceinline__ bool operator()(f32x4 (&acc)[2][2][4][2], const pg8::Unit& u, int wr, int wc, int fr, int fq) const {
        const int cnt = __builtin_amdgcn_readfirstlane(tab[32 + u.e]);
#pragma unroll
        for (int ai = 0; ai < 2; ++ai)
#pragma unroll
            for (int m = 0; m < 4; ++m) { const int rl = ai * 128 + wr * 64 + m * 16 + fr; const int lr = u.sub * 256 + rl;
                const bool ok = lr < cnt; const float w = ok ? lw[(size_t)u.e * T + lr] : 0.f;
                float o[8];
#pragma unroll
                for (int n = 0; n < 2; ++n)
#pragma unroll
                    for (int i = 0; i < 4; ++i) { const float g = acc[ai][0][m][n][i], up = acc[ai][1][m][n][i]; o[4 * n + i] = ok ? g * sigmoidf_(g) * up * w : 0.f; }
                u32x4 wv; wv.x = pk2(o[0], o[1]); wv.y = pk2(o[2], o[3]); wv.z = pk2(o[4], o[5]); wv.w = pk2(o[6], o[7]);
                *(u32x4*)(HID + ((size_t)u.pm * 256 + rl) * 512 + u.pn * 128 + wc * 32 + 8 * fq) = wv; }
        return true;
    }
};
struct EpiDown {
    bf16* Y; const unsigned* list; const LAS int* tab;
    __device__ __forceinline__ bool operator()(f32x4 (&acc)[2][2][4][2], const pg8::Unit& u, int wr, int wc, int fr, int fq) const {
        const int cnt = __builtin_amdgcn_readfirstlane(tab[32 + u.e]);
#pragma unroll
        for (int ai = 0; ai < 2; ++ai)
#pragma unroll
            for (int m = 0; m < 4; ++m) { const int rl = ai * 128 + wr * 64 + m * 16 + fr; const int lr = u.sub * 256 + rl;
                if (lr < cnt) { const unsigned en = list[(size_t)u.e * T + lr]; const unsigned tok = en & 0x3fffu, slot = en >> 14;
                    bf16* rp = Y + ((size_t)slot * T + tok) * 1024 + u.pn * 256 + wc * 32 + 8 * fq;
#pragma unroll
                    for (int bj = 0; bj < 2; ++bj) { const f32x4 v0 = acc[ai][bj][m][0], v1 = acc[ai][bj][m][1];
                        u32x4 w; w.x = pk2(v0.x, v0.y); w.y = pk2(v0.z, v0.w); w.z = pk2(v1.x, v1.y); w.w = pk2(v1.z, v1.w); *(u32x4*)(rp + bj * 128) = w; } } }
        return true;
    }
};

__device__ __forceinline__ void gmlp_unit(float* lds, bf16* P1, const float* gng, const float* gws, const float* gmb, int unit) {
    const int tid = opaque_tid(); const int c = unit >> 2, g = unit & 3; const size_t t0 = (size_t)c * 128;
    float* Wt = lds; float* Vn = lds + 16384; float* rs = lds + 32768;
    __syncthreads();
    {
        const int tk = tid >> 2, qu = tid & 3; const bf16* vp = P1 + (t0 + tk) * P1W + C_V + qu * 128; float ss = 0.f;
#pragma unroll 4
        for (int i = 0; i < 16; ++i) { const u32x4 w = *(const u32x4*)(vp + 8 * i);
            ss += bflo(w.x) * bflo(w.x) + bfhi(w.x) * bfhi(w.x) + bflo(w.y) * bflo(w.y) + bfhi(w.y) * bfhi(w.y) + bflo(w.z) * bflo(w.z) + bfhi(w.z) * bfhi(w.z) + bflo(w.w) * bflo(w.w) + bfhi(w.w) * bfhi(w.w); }
        ss += __shfl_xor(ss, 1); ss += __shfl_xor(ss, 2);
        if (qu == 0) rs[tk] = rsqrtf(ss * (1.f / 512.f) + EPS);
    }
    for (int e = tid; e < 128 * 128; e += 512) { const int t = e >> 7, s = e & 127; Wt[e] = (s <= t) ? gws[(size_t)g * 16384 + e] : 0.f; }
    __syncthreads();
    for (int e = tid; e < 128 * 16; e += 512) { const int s = e >> 4, c8 = (e & 15) * 8; const u32x4 w = *(const u32x4*)(P1 + (t0 + s) * P1W + C_V + g * 128 + c8);
        const float r = rs[s]; const float* gp = gng + g * 128 + c8; float* o = Vn + s * 128 + c8;
        o[0] = bflo(w.x) * r * gp[0]; o[1] = bfhi(w.x) * r * gp[1]; o[2] = bflo(w.y) * r * gp[2]; o[3] = bfhi(w.y) * r * gp[3];
        o[4] = bflo(w.z) * r * gp[4]; o[5] = bfhi(w.z) * r * gp[5]; o[6] = bflo(w.w) * r * gp[6]; o[7] = bfhi(w.w) * r * gp[7]; }
    __syncthreads();
    const int tg = tid >> 5, c4 = (tid & 31) * 4;
    f32x4 acc[8];
#pragma unroll
    for (int k = 0; k < 8; ++k) acc[k] = (f32x4){0.f, 0.f, 0.f, 0.f};
    const int smax = tg * 8 + 7;
    for (int s = 0; s <= smax; ++s) { const f32x4 v = *(const f32x4*)(Vn + s * 128 + c4);
#pragma unroll
        for (int k = 0; k < 8; ++k) { const float w = Wt[(tg * 8 + k) * 128 + s]; acc[k] = acc[k] + v * w; } }
#pragma unroll
    for (int k = 0; k < 8; ++k) { const int tl = tg * 8 + k; const float bb = gmb[g * 128 + tl];
        bf16* up = P1 + (t0 + tl) * P1W + C_U + g * 128 + c4; const u32x2 uu = *(const u32x2*)up;
        u32x2 o; o.x = pk2(bflo(uu.x) * (acc[k].x + bb), bfhi(uu.x) * (acc[k].y + bb)); o.y = pk2(bflo(uu.y) * (acc[k].z + bb), bfhi(uu.y) * (acc[k].w + bb)); *(u32x2*)up = o; }
}

__device__ __forceinline__ void lru_unit(float* lds, const bf16* P1, bf16* XN, float* AGA, float* AGH, const float* convw, const float* convb, const float* wa, const float* ba, const float* wx, const float* bx, const float* lam, int unit) {
    const int tid = opaque_tid(); const int h = unit & 7, tile = (unit >> 3) & 63, b = unit >> 9; const int ch0 = h * 64;
    const size_t row0 = (size_t)b * SEQ + tile * 64;
    float* xc = lds; float* Wa = lds + 4096; float* Wx = lds + 8192; float* av = lds + 12288; float* bv = lds + 16384;
    __syncthreads();
    {
        const int tt = tid >> 3, c8 = (tid & 7) * 8; const int ts = tile * 64 + tt;
        float o[8];
#pragma unroll
        for (int i = 0; i < 8; ++i) o[i] = convb[ch0 + c8 + i];
#pragma unroll
        for (int k = 0; k < 4; ++k) { const int sp = ts + k - 3; if (sp >= 0) { const u32x4 w = *(const u32x4*)(P1 + ((size_t)b * SEQ + sp) * P1W + C_RB + ch0 + c8); const float* cw = convw + k * 512 + ch0 + c8;
                o[0] += bflo(w.x) * cw[0]; o[1] += bfhi(w.x) * cw[1]; o[2] += bflo(w.y) * cw[2]; o[3] += bfhi(w.y) * cw[3]; o[4] += bflo(w.z) * cw[4]; o[5] += bfhi(w.z) * cw[5]; o[6] += bflo(w.w) * cw[6]; o[7] += bfhi(w.w) * cw[7]; } }
#pragma unroll
        for (int i = 0; i < 8; ++i) xc[tt * 64 + c8 + i] = o[i];
    }
    for (int e = tid; e < 4096; e += 512) { Wa[e] = wa[(size_t)h * 4096 + e]; Wx[e] = wx[(size_t)h * 4096 + e]; }
    __syncthreads();
    {
        const int co = tid & 63, tg = tid >> 6; float ar[8], ai[8];
#pragma unroll
        for (int k = 0; k < 8; ++k) { ar[k] = 0.f; ai[k] = 0.f; }
        for (int ci = 0; ci < 64; ++ci) { const float wav = Wa[ci * 64 + co], wxv = Wx[ci * 64 + co];
#pragma unroll
            for (int k = 0; k < 8; ++k) { const float x = xc[(tg * 8 + k) * 64 + ci]; ar[k] += x * wav; ai[k] += x * wxv; } }
        const float bav = ba[ch0 + co], bxv = bx[ch0 + co]; const float lm = lam[ch0 + co];
        const float sp = (-lm > 20.f) ? -lm : log1pf(__expf(-lm));
#pragma unroll
        for (int k = 0; k < 8; ++k) { const int tt = tg * 8 + k; const float r = sigmoidf_(ar[k] + bav), ig = sigmoidf_(ai[k] + bxv);
            const float la = -8.0f * r * sp; const float a = __expf(la); const float bt = sqrtf(fmaxf(-expm1f(2.0f * la), 0.f)) * (ig * xc[tt * 64 + co]);
            av[tt * 64 + co] = a; bv[tt * 64 + co] = bt; }
    }
    __syncthreads();
    if (tid < 64) { float hr = 0.f, ac = 1.f;
        for (int tt = 0; tt < 64; ++tt) { const float a = av[tt * 64 + tid], bt = bv[tt * 64 + tid]; hr = a * hr + bt; ac *= a; bv[tt * 64 + tid] = hr; av[tt * 64 + tid] = ac; }
        AGA[((size_t)b * 64 + tile) * 512 + ch0 + tid] = ac; AGH[((size_t)b * 64 + tile) * 512 + ch0 + tid] = hr; }
    __syncthreads();
    {   const int tt = tid >> 3, c8 = (tid & 7) * 8; const float* hp = bv + tt * 64 + c8; const float* ap = av + tt * 64 + c8;
        u32x4 w; w.x = pk2(hp[0], hp[1]); w.y = pk2(hp[2], hp[3]); w.z = pk2(hp[4], hp[5]); w.w = pk2(hp[6], hp[7]);
        *(u32x4*)(XN + (row0 + tt) * 1024 + ch0 + c8) = w;
        w.x = pk2(ap[0], ap[1]); w.y = pk2(ap[2], ap[3]); w.z = pk2(ap[4], ap[5]); w.w = pk2(ap[6], ap[7]);
        *(u32x4*)(XN + (row0 + tt) * 1024 + 512 + ch0 + c8) = w; }
}
__device__ __forceinline__ void lrufix_unit(bf16* P1, const bf16* XN, const float* AGA, const float* AGH, int unit) {
    const int ch = opaque_tid(); const int tile = unit & 63, b = unit >> 6;
    float c = 0.f;
    for (int i = 0; i < tile; ++i) { const float a = AGA[((size_t)b * 64 + i) * 512 + ch], hh = AGH[((size_t)b * 64 + i) * 512 + ch]; c = a * c + hh; }
    const size_t row0 = (size_t)b * SEQ + tile * 64;
    for (int tt = 0; tt < 64; ++tt) { const float hl = bf2f(XN[(row0 + tt) * 1024 + ch]), ac = bf2f(XN[(row0 + tt) * 1024 + 512 + ch]);
        bf16* gp = P1 + (row0 + tt) * P1W + C_GB + ch; *gp = (bf16)f2bf(bf2f(*gp) * (hl + ac * c)); }
}
__device__ __forceinline__ void pool_unit(float* lds, bf16* P1, const float* pw, const float* ps, int unit) {
    const int tid = opaque_tid(); const int gi = unit & 3, tile = (unit >> 2) & 63, b = unit >> 8; const int w = 2 << gi;
    float* xs = lds; float* Pw = lds + 10240; float* pl = lds + 26624;
    __syncthreads();
    for (int e = tid; e < 79 * 16; e += 512) { const int r = e >> 4, c8 = (e & 15) * 8; const int sp = tile * 64 + r - 15; float* o = xs + r * 128 + c8;
        if (sp >= 0) { const u32x4 v = *(const u32x4*)(P1 + ((size_t)b * SEQ + sp) * P1W + C_XD + gi * 128 + c8);
            o[0] = bflo(v.x); o[1] = bfhi(v.x); o[2] = bflo(v.y); o[3] = bfhi(v.y); o[4] = bflo(v.z); o[5] = bfhi(v.z); o[6] = bflo(v.w); o[7] = bfhi(v.w); }
        else { o[0] = 0.f; o[1] = 0.f; o[2] = 0.f; o[3] = 0.f; o[4] = 0.f; o[5] = 0.f; o[6] = 0.f; o[7] = 0.f; } }
    for (int e = tid; e < 16384; e += 512) Pw[e] = pw[(size_t)gi * 16384 + e];
    __syncthreads();
    {   const int ci = tid & 127, tq = tid >> 7;
        for (int k = 0; k < 16; ++k) { const int tt = tq * 16 + k; const int ts = tile * 64 + tt; float s = 0.f;
            for (int j = 0; j < w; ++j) s += xs[(tt + 15 - j) * 128 + ci];
            const int cnt = (ts + 1 < w) ? ts + 1 : w;
            pl[tt * 128 + ci] = s / (float)cnt - xs[(tt + 15) * 128 + ci]; } }
    __syncthreads();
    {   const int co = tid & 127, tq = tid >> 7; float acc[16];
#pragma unroll
        for (int k = 0; k < 16; ++k) acc[k] = 0.f;
        for (int ci = 0; ci < 128; ++ci) { const float wv = Pw[ci * 128 + co];
#pragma unroll
            for (int k = 0; k < 16; ++k) acc[k] += pl[(tq * 16 + k) * 128 + ci] * wv; }
        const float sc = ps[gi * 128 + co];
#pragma unroll
        for (int k = 0; k < 16; ++k) P1[((size_t)b * SEQ + tile * 64 + tq * 16 + k) * P1W + C_V + gi * 128 + co] = (bf16)f2bf(acc[k] * sc); }
}
__device__ __forceinline__ void cmp_unit(float* lds, const bf16* P1, float* KC, const float* pe, const float* w1, const float* w2, int unit) {
    const int tid = opaque_tid(); const int q = unit & 15, g = (unit >> 4) & 1, b = (unit >> 5) & 3, c = unit >> 7;
    float* Fl = lds; float* hid = lds + 32768;
    const float* pec = pe + (size_t)c * 2048; const float* w1c = w1 + ((size_t)c * 2 + g) * 2048 * 64; const float* w2c = w2 + ((size_t)c * 2 + g) * 4096;
    __syncthreads();
    for (int e = tid; e < 16 * 256; e += 512) { const int nl = e >> 8, l = (e >> 3) & 31, c8 = (e & 7) * 8; const int n = q * 16 + nl; float* o = Fl + nl * 2048 + l * 64 + c8;
        if (n < 255) { const u32x4 v = *(const u32x4*)(P1 + ((size_t)b * SEQ + n * 16 + l) * P1W + C_KV + (c * 2 + g) * 64 + c8); const float* pp = pec + l * 64 + c8;
            o[0] = bflo(v.x) + pp[0]; o[1] = bfhi(v.x) + pp[1]; o[2] = bflo(v.y) + pp[2]; o[3] = bfhi(v.y) + pp[3]; o[4] = bflo(v.z) + pp[4]; o[5] = bfhi(v.z) + pp[5]; o[6] = bflo(v.w) + pp[6]; o[7] = bfhi(v.w) + pp[7]; }
        else { o[0] = 0.f; o[1] = 0.f; o[2] = 0.f; o[3] = 0.f; o[4] = 0.f; o[5] = 0.f; o[6] = 0.f; o[7] = 0.f; } }
    __syncthreads();
    {   const int e = tid & 63, ng = tid >> 6; float a0 = 0.f, a1 = 0.f; const float* f0 = Fl + (ng * 2) * 2048; const float* f1 = f0 + 2048;
#pragma unroll 8
        for (int f = 0; f < 2048; ++f) { const float wv = w1c[(size_t)f * 64 + e]; a0 += f0[f] * wv; a1 += f1[f] * wv; }
        hid[(ng * 2) * 64 + e] = gelu_tanh(a0); hid[(ng * 2 + 1) * 64 + e] = gelu_tanh(a1); }
    __syncthreads();
    {   const int d = tid & 63, ng = tid >> 6; float a0 = 0.f, a1 = 0.f;
        for (int e = 0; e < 64; ++e) { const float wv = w2c[e * 64 + d]; a0 += hid[(ng * 2) * 64 + e] * wv; a1 += hid[(ng * 2 + 1) * 64 + e] * wv; }
        const int n0 = q * 16 + ng * 2; float* kp = KC + ((((size_t)c * NB + b) * 2 + g) * 256) * 64;
        if (n0 < 255) kp[(size_t)n0 * 64 + d] = a0;
        if (n0 + 1 < 255) kp[(size_t)(n0 + 1) * 64 + d] = a1; }
}

__device__ __forceinline__ void attend_tile(const f32x2 (&q)[16], f32x2 (&o)[16], float& m, float& l, const float* Kt, const float* Vt, u64 vm) {
    if (!__any(vm != 0ull)) return;
#pragma unroll 1
    for (int kc = 0; kc < 8; ++kc) {
        const unsigned bits = (unsigned)(vm >> (8 * kc)) & 0xffu;
        if (!__any(bits != 0u)) continue;
        float s[8]; float mx = m;
#pragma unroll
        for (int kk = 0; kk < 8; ++kk) { const float* kr = Kt + (kc * 8 + kk) * 64; f32x2 a2 = {0.f, 0.f};
#pragma unroll
            for (int d4 = 0; d4 < 8; ++d4) { const f32x4 kv = *(const f32x4*)(kr + 4 * d4); a2 = q[2 * d4] * (f32x2){kv.x, kv.y} + a2; a2 = q[2 * d4 + 1] * (f32x2){kv.z, kv.w} + a2; }
            float a = a2.x + a2.y; a += __shfl_xor(a, 1);
            const bool ok = (bits >> kk) & 1u; s[kk] = ok ? a : -1e30f; mx = fmaxf(mx, s[kk]); }
        const float sc = __expf(m - mx); m = mx; l *= sc;
#pragma unroll
        for (int d = 0; d < 16; ++d) o[d] = o[d] * sc;
#pragma unroll
        for (int kk = 0; kk < 8; ++kk) { const bool ok = (bits >> kk) & 1u; const float p = ok ? __expf(s[kk] - mx) : 0.f; l += p; const float* vr = Vt + (kc * 8 + kk) * 64; const f32x2 pp = {p, p};
#pragma unroll
            for (int d4 = 0; d4 < 8; ++d4) { const f32x4 vv = *(const f32x4*)(vr + 4 * d4); o[2 * d4] = pp * (f32x2){vv.x, vv.y} + o[2 * d4]; o[2 * d4 + 1] = pp * (f32x2){vv.z, vv.w} + o[2 * d4 + 1]; } }
    }
}
__device__ __forceinline__ void stage_kv_bf16(float* Kt, float* Vt, const bf16* kp, const bf16* vp, int tid) {
    const int r = tid >> 3, c8 = (tid & 7) * 8;
    const u32x4 a = *(const u32x4*)(kp + (size_t)r * P1W + c8), b = *(const u32x4*)(vp + (size_t)r * P1W + c8);
    float* o = Kt + r * 64 + c8; o[0] = bflo(a.x); o[1] = bfhi(a.x); o[2] = bflo(a.y); o[3] = bfhi(a.y); o[4] = bflo(a.z); o[5] = bfhi(a.z); o[6] = bflo(a.w); o[7] = bfhi(a.w);
    o = Vt + r * 64 + c8; o[0] = bflo(b.x); o[1] = bfhi(b.x); o[2] = bflo(b.y); o[3] = bfhi(b.y); o[4] = bflo(b.z); o[5] = bfhi(b.z); o[6] = bflo(b.w); o[7] = bfhi(b.w);
}
__device__ __forceinline__ void attn_unit(float* lds, bf16* P1, const float* KC, int unit) {
    const int tid = opaque_tid(); const int ti = unit & 63, g = (unit >> 6) & 1, b = unit >> 7;
    const int s0 = ti * 64; const int tk = tid >> 3; const int ts = s0 + tk; const int j = (tid >> 1) & 3, hd = g * 4 + j, hf = tid & 1;
    const size_t row = (size_t)b * SEQ + ts;
    float* Kt = lds + 32 * hf; float* Vt = lds + 4096 + 32 * hf; float* imp = lds + 8192;
    f32x2 q[16], o[16];
    bf16* const op = P1 + row * P1W + C_Q + hd * 64 + 32 * hf;
    {
#pragma unroll
        for (int i = 0; i < 4; ++i) { const u32x4 w = *(const u32x4*)(op + 8 * i);
            q[4 * i] = (f32x2){bflo(w.x) * 0.125f, bfhi(w.x) * 0.125f}; q[4 * i + 1] = (f32x2){bflo(w.y) * 0.125f, bfhi(w.y) * 0.125f};
            q[4 * i + 2] = (f32x2){bflo(w.z) * 0.125f, bfhi(w.z) * 0.125f}; q[4 * i + 3] = (f32x2){bflo(w.w) * 0.125f, bfhi(w.w) * 0.125f}; } }
    const float g0 = bf2f(P1[row * P1W + C_GC + hd * 3 + 0]), g1 = bf2f(P1[row * P1W + C_GC + hd * 3 + 1]), g2 = bf2f(P1[row * P1W + C_GC + hd * 3 + 2]);
    const int nv = (ts >= 31) ? ((((ts + 1) >> 4) - 1 > 255) ? 255 : ((ts + 1) >> 4) - 1) : 0;
    const int nvmax = ((s0 + 64) >> 4) - 1; const int nkt = (nvmax + 63) >> 6;
    const float* kcp = KC + ((((size_t)0 * NB + b) * 2 + g) * 256) * 64; const float* vcp = KC + ((((size_t)1 * NB + b) * 2 + g) * 256) * 64;
    float m = -1e30f, l = 0.f;
#pragma unroll
    for (int d = 0; d < 16; ++d) o[d] = (f32x2){0.f, 0.f};
    for (int kt = 0; kt < nkt; ++kt) {
        __syncthreads();
        { const int r = tid >> 3, c8 = (tid & 7) * 8; const int n = kt * 64 + r;
          f32x4 a0 = {0.f, 0.f, 0.f, 0.f}, a1 = a0, b0 = a0, b1 = a0;
          if (n < 255) { a0 = *(const f32x4*)(kcp + (size_t)n * 64 + c8); a1 = *(const f32x4*)(kcp + (size_t)n * 64 + c8 + 4); b0 = *(const f32x4*)(vcp + (size_t)n * 64 + c8); b1 = *(const f32x4*)(vcp + (size_t)n * 64 + c8 + 4); }
          *(f32x4*)(lds + r * 64 + c8) = a0; *(f32x4*)(lds + r * 64 + c8 + 4) = a1; *(f32x4*)(lds + 4096 + r * 64 + c8) = b0; *(f32x4*)(lds + 4096 + r * 64 + c8 + 4) = b1; }
        __syncthreads();
        attend_tile(q, o, m, l, Kt, Vt, mask_lo(nv - kt * 64));
    }
    {   const float inv = (nv > 0) ? g0 / l : 0.f;
#pragma unroll
        for (int i = 0; i < 4; ++i) { u32x4 w; w.x = pk2(o[4 * i].x * inv, o[4 * i].y * inv); w.y = pk2(o[4 * i + 1].x * inv, o[4 * i + 1].y * inv); w.z = pk2(o[4 * i + 2].x * inv, o[4 * i + 2].y * inv); w.w = pk2(o[4 * i + 3].x * inv, o[4 * i + 3].y * inv);
            *(u32x4*)(op + 8 * i) = w; } }
    {   const float invl = (nv > 0) ? 1.f / l : 0.f; float carry = 0.f;
        for (int kt = 0; kt < 4; ++kt) {
            __syncthreads();
            if (kt < nkt) { const int r = tid >> 3, c8 = (tid & 7) * 8; const int n = kt * 64 + r;
                f32x4 a0 = {0.f, 0.f, 0.f, 0.f}, a1 = a0;
                if (n < 255) { a0 = *(const f32x4*)(kcp + (size_t)n * 64 + c8); a1 = *(const f32x4*)(kcp + (size_t)n * 64 + c8 + 4); }
                *(f32x4*)(lds + r * 64 + c8) = a0; *(f32x4*)(lds + r * 64 + c8 + 4) = a1; }
            __syncthreads();
#pragma unroll 1
            for (int mg = 0; mg < 16; ++mg) {
                float sum = carry;
                if (kt < nkt) {
#pragma unroll
                    for (int k4 = 0; k4 < 4; ++k4) { const int kk = mg * 4 + k4; const int n = kt * 64 + kk; const float* kr = Kt + kk * 64; f32x2 a2 = {0.f, 0.f};
#pragma unroll
                        for (int d4 = 0; d4 < 8; ++d4) { const f32x4 kv = *(const f32x4*)(kr + 4 * d4); a2 = q[2 * d4] * (f32x2){kv.x, kv.y} + a2; a2 = q[2 * d4 + 1] * (f32x2){kv.z, kv.w} + a2; }
                        float a = a2.x + a2.y; a += __shfl_xor(a, 1);
                        const float p = (n < nv) ? __expf(a - m) * invl : 0.f; sum += p; if (k4 == 3) carry = p; }
                } else carry = 0.f;
                sum += __shfl_xor(sum, 2); sum += __shfl_xor(sum, 4);
                if ((tid & 7) == 0) imp[tk * 64 + kt * 16 + mg] = sum;
            }
        }
    }
    __syncthreads();
    const int cur = ti;
    u64 sel = 1ull | (1ull << cur) | (cur >= 1 ? (1ull << (cur - 1)) : 0ull);
    if ((tid & 7) == 0) { const int npick = (cur - 2) < 5 ? (cur - 2) : 5; const float* ip = imp + tk * 64;
        for (int pk = 0; pk < npick; ++pk) { float best = -1.f; int bi = 1;
            for (int mm = 1; mm <= cur - 2; ++mm) { const float v = ip[mm]; if (!((sel >> mm) & 1ull) && v > best) { best = v; bi = mm; } }
            sel |= 1ull << bi; } }
    { unsigned lo = (unsigned)sel, hi = (unsigned)(sel >> 32); lo = __shfl(lo, (tid & 63) & ~7); hi = __shfl(hi, (tid & 63) & ~7); sel = ((u64)hi << 32) | lo; }
    m = -1e30f; l = 0.f;
#pragma unroll
    for (int d = 0; d < 16; ++d) o[d] = (f32x2){0.f, 0.f};
    {   const bf16* kb = P1 + (size_t)b * SEQ * P1W + C_KV + (2 * 2 + g) * 64; const bf16* vb = P1 + (size_t)b * SEQ * P1W + C_KV + (3 * 2 + g) * 64;
        for (int mb = 0; mb <= cur; ++mb) {
            __syncthreads();
            stage_kv_bf16(lds, lds + 4096, kb + (size_t)mb * 64 * P1W, vb + (size_t)mb * 64 * P1W, tid);
            __syncthreads();
            u64 vm = 0ull; if ((sel >> mb) & 1ull) vm = (mb == cur) ? mask_lo((ts & 63) + 1) : ~0ull;
            attend_tile(q, o, m, l, Kt, Vt, vm);
        } }
    {   const float inv = g1 / l;
#pragma unroll
        for (int i = 0; i < 4; ++i) { const u32x4 p = *(const u32x4*)(op + 8 * i); u32x4 w;
            w.x = pk2(bflo(p.x) + o[4 * i].x * inv, bfhi(p.x) + o[4 * i].y * inv); w.y = pk2(bflo(p.y) + o[4 * i + 1].x * inv, bfhi(p.y) + o[4 * i + 1].y * inv);
            w.z = pk2(bflo(p.z) + o[4 * i + 2].x * inv, bfhi(p.z) + o[4 * i + 2].y * inv); w.w = pk2(bflo(p.w) + o[4 * i + 3].x * inv, bfhi(p.w) + o[4 * i + 3].y * inv);
            *(u32x4*)(op + 8 * i) = w; } }
    m = -1e30f; l = 0.f;
#pragma unroll
    for (int d = 0; d < 16; ++d) o[d] = (f32x2){0.f, 0.f};
    {   const bf16* kb = P1 + (size_t)b * SEQ * P1W + C_KV + (4 * 2 + g) * 64; const bf16* vb = P1 + (size_t)b * SEQ * P1W + C_KV + (5 * 2 + g) * 64;
        const int mlo = (ti >= 8) ? ti - 8 : 0;
        for (int mb = mlo; mb <= cur; ++mb) {
            __syncthreads();
            stage_kv_bf16(lds, lds + 4096, kb + (size_t)mb * 64 * P1W, vb + (size_t)mb * 64 * P1W, tid);
            __syncthreads();
            const int lo = ts - 511 - mb * 64, hi = ts - mb * 64;
            u64 vm = 0ull; if (hi >= 0 && lo <= 63) vm = mask_lo(hi + 1) & ~mask_lo(lo);
            attend_tile(q, o, m, l, Kt, Vt, vm);
        } }
    {   const float inv = g2 / l;
#pragma unroll
        for (int i = 0; i < 4; ++i) { const u32x4 p = *(const u32x4*)(op + 8 * i); u32x4 w;
            w.x = pk2(bflo(p.x) + o[4 * i].x * inv, bfhi(p.x) + o[4 * i].y * inv); w.y = pk2(bflo(p.y) + o[4 * i + 1].x * inv, bfhi(p.y) + o[4 * i + 1].y * inv);
            w.z = pk2(bflo(p.z) + o[4 * i + 2].x * inv, bfhi(p.z) + o[4 * i + 2].y * inv); w.w = pk2(bflo(p.w) + o[4 * i + 3].x * inv, bfhi(p.w) + o[4 * i + 3].y * inv);
            *(u32x4*)(op + 8 * i) = w; } }
}

constexpr int NPH = 1 + 9 * NL;
__global__ void __launch_bounds__(512, 2) fwd_kernel(Args args) {
    extern __shared__ __attribute__((aligned(16))) unsigned char lds_raw[];
    LAS unsigned char* ldsl = (LAS unsigned char*)lds_raw;
    float* ldsf = (float*)lds_raw;
    const int G = gridDim.x, bx = blockIdx.x, NGW = G * 8;
#define PHASE_IDS() const int tid = opaque_tid(), lane = tid & 63, wave = __builtin_amdgcn_readfirstlane(tid >> 6), gw = bx * 8 + wave; (void)lane; (void)gw
#define ws ARG_WS()
#define ctl ((unsigned*)(ws + WS_CTL))
#define H ARG_OUT()
#define XN ((bf16*)(ws + WS_XN))
#define P1 ((bf16*)(ws + WS_P1))
#define Rr ((bf16*)(ws + WS_R))
#define WIN ((bf16*)(ws + WS_WIN))
#define WB ((bf16*)(ws + WS_WB))
#define WOUT ((bf16*)(ws + WS_WOUT))
#define WGU ((bf16*)(ws + WS_WGU))
#define WD ((bf16*)(ws + WS_WD))
#define HID ((bf16*)(ws + WS_HID))
#define Y ((bf16*)(ws + WS_Y))
#define KC ((float*)(ws + WS_KC))
#define AGA ((float*)(ws + WS_LRUA))
#define AGH ((float*)(ws + WS_LRUH))
#define LIST ((unsigned*)(ws + WS_LIST))
#define LISTW ((float*)(ws + WS_LISTW))
    { PHASE_IDS(); for (int u = tid; u < (LDS_BYTES - LDS_CTL) / 4; u += 512) ((LAS unsigned*)(ldsl + LDS_CTL))[u] = 0u; }
    __syncthreads();
    XcdBarrier bar; bar.bar = ctl + CW_BAR; bar.x = 0; bar.st = nullptr;
    if (!MK_SPLIT) bar = xcd_barrier_post(ctl + CW_BAR, (volatile LAS unsigned*)(ldsl + LDS_CTL + 32));
    const int lo = args.ph_lo, hi = args.ph_hi;
#define IN(k) (lo <= (k) && (k) < hi)
#define SEAM(k) do { if (!MK_SPLIT && IN((k) + 1)) xcd_barrier(bar); } while (0)
    const LAS int* tab = (const LAS int*)(ldsl + LDS_MOE);

    if (IN(0)) {
        PHASE_IDS();
        float* scr = ldsf + wave * 4096;
        constexpr int IT_WIN = 16 * 249, IT_WB = 8 * 32, IT_WO = 16 * 32;
        constexpr int NIT = NL * IT_WIN + NL * 4 * IT_WB + NL * IT_WO;
        for (int it = gw; it < NIT; it += NGW) {
            int r = it;
            if (r < NL * IT_WIN) { const int l = r / IT_WIN; r -= l * IT_WIN; tr_item(ARG_IN(I_WIN) + (size_t)l * D * NIN, D, NIN, WIN + (size_t)l * NPROJ * D, scr, r / 249, r % 249, lane, [](int s) { return win_dst_row(s); }); continue; }
            r -= NL * IT_WIN;
            if (r < NL * 4 * IT_WB) { const int ln = r / IT_WB; r -= ln * IT_WB; tr_item(ARG_IN(I_WBR) + (size_t)ln * 512 * 1024, 512, 1024, WB + (size_t)ln * 1024 * 512, scr, r / 32, r % 32, lane, [](int s) { return s; }); continue; }
            r -= NL * 4 * IT_WB;
            { const int l = r / IT_WO; r -= l * IT_WO; tr_item(ARG_IN(I_WOUT) + (size_t)l * 1024 * 1024, 1024, 1024, WOUT + (size_t)l * 1024 * 1024, scr, r / 32, r % 32, lane, [](int s) { return s; }); }
        }
        for (int e = bx * 512 + tid; e < NL * 232 * 128; e += G * 512) { const int l = e / (232 * 128), rr = (e / 128) % 232, c8 = (e % 128) * 8;
            *(u32x4*)(WIN + ((size_t)l * NPROJ + C_GC + 24 + rr) * D + c8) = (u32x4){0u, 0u, 0u, 0u}; }
        for (int m = gw; m < T; m += NGW) norm_row<0>(ARG_IN(I_X) + (size_t)m * D, H + (size_t)m * D, nullptr, nullptr, ARG_IN(I_N1G), XN + (size_t)m * D, lane);
    }
    SEAM(0);

    for (int l = 0; l < NL; ++l) {
        const int pb = 1 + 9 * l;
        if (IN(pb + 0)) {
            SchedDense S{XN, WIN + (size_t)l * NPROJ * D, D, D, T / 256, NPROJ / 256, G, bx};
            EpiProj E{P1, Rr};
            pg8::gemm_phase<EpiProj, SchedDense, true>(ldsl, D, S, E);
        }
        SEAM(pb + 0);
        if (IN(pb + 1)) {
            constexpr int U_LRU = NB * 64 * 8, U_GM = 128 * 4, U_CMP = 256;
            for (int u = bx; u < U_LRU + U_GM + U_CMP; u += G) {
                if (u < U_CMP) cmp_unit(ldsf, P1, KC, ARG_IN(I_PE) + (size_t)l * 2 * 2048, ARG_IN(I_CW1) + (size_t)l * 4 * 2048 * 64, ARG_IN(I_CW2) + (size_t)l * 4 * 4096, u);
                else if (u < U_CMP + U_GM) gmlp_unit(ldsf, P1, ARG_IN(I_GMNG) + l * 512, ARG_IN(I_GMWS) + (size_t)l * 4 * 16384, ARG_IN(I_GMB) + l * 512, u - U_CMP);
                else lru_unit(ldsf, P1, XN, AGA, AGH, ARG_IN(I_CONVW) + l * 2048, ARG_IN(I_CONVB) + l * 512, ARG_IN(I_LWA) + (size_t)l * 8 * 4096, ARG_IN(I_LBA) + l * 512,
                              ARG_IN(I_LWX) + (size_t)l * 8 * 4096, ARG_IN(I_LBX) + l * 512, ARG_IN(I_LLAM) + l * 512, u - U_CMP - U_GM);
            }
            __syncthreads();
        }
        SEAM(pb + 1);
        if (IN(pb + 2)) {
            constexpr int U_AT = NB * 2 * 64, U_PL = NB * 64 * 4, U_FX = NB * 64;
            for (int u = bx; u < U_AT + U_PL + U_FX; u += G) {
                if (u < U_AT) { const int k = u >> 3, bg = u & 7; const int ti = (u < 256) ? 63 - k : k - 32; attn_unit(ldsf, P1, KC, (bg << 6) | ti); }
                else if (u < U_AT + U_PL) pool_unit(ldsf, P1, ARG_IN(I_PW) + (size_t)l * 4 * 16384, ARG_IN(I_PS) + l * 512, u - U_AT);
                else lrufix_unit(P1, XN, AGA, AGH, u - U_AT - U_PL);
            }
            __syncthreads();
        }
        SEAM(pb + 2);
        if (IN(pb + 3)) {
            SchedMerge S{P1, WB + (size_t)l * 4 * 1024 * 512, G, bx};
            EpiMerge E{Rr, XN};
            pg8::gemm_phase<EpiMerge, SchedMerge, false>(ldsl, 512, S, E);
        }
        SEAM(pb + 3);
        if (IN(pb + 4)) {
            SchedDense S{XN, WOUT + (size_t)l * 1024 * 1024, D, D, T / 256, 4, G, bx};
            EpiWout E{H};
            pg8::gemm_phase<EpiWout, SchedDense, false>(ldsl, D, S, E);
        }
        SEAM(pb + 4);
        if (IN(pb + 5)) {
            PHASE_IDS();
            {   float* scr = ldsf + wave * 4096;
                constexpr int IT_G = 16 * 16, IT_D = 8 * 32;
                for (int it = gw; it < 16 * (2 * IT_G + IT_D); it += NGW) {
                    const int e = it / (2 * IT_G + IT_D); int r = it % (2 * IT_G + IT_D);
                    if (r < IT_G) tr_item(ARG_IN(I_MG) + ((size_t)l * 16 + e) * 1024 * 512, 1024, 512, WGU + (size_t)e * 1024 * 1024, scr, r / 16, r % 16, lane, [](int s) { return 256 * (s >> 7) + (s & 127); });
                    else if (r < 2 * IT_G) { r -= IT_G; tr_item(ARG_IN(I_MU) + ((size_t)l * 16 + e) * 1024 * 512, 1024, 512, WGU + (size_t)e * 1024 * 1024, scr, r / 16, r % 16, lane, [](int s) { return 256 * (s >> 7) + 128 + (s & 127); }); }
                    else { r -= 2 * IT_G; tr_item(ARG_IN(I_MD) + ((size_t)l * 16 + e) * 512 * 1024, 512, 1024, WD + (size_t)e * 1024 * 512, scr, r / 32, r % 32, lane, [](int s) { return s; }); }
                }
            }
            __syncthreads();
            for (int e = tid; e < 1024 * 20; e += 512) { const int k = e / 20, o = e % 20;
                ldsf[o * 1024 + k] = (o < 4) ? ARG_IN(I_RWG)[(size_t)l * 4096 + k * 4 + o] : ARG_IN(I_RWE)[(size_t)l * 16384 + k * 16 + (o - 4)]; }
            __syncthreads();
            const float* g2 = ARG_IN(I_N2G) + l * D; const float* bg = ARG_IN(I_RBG) + l * 4; const float* be = ARG_IN(I_RBE) + l * 16;
            unsigned* cnt = ctl + CW_CNT + 64 * l;
            for (int m = gw; m < T; m += NGW) {
                const float* hr = H + (size_t)m * D; f32x4 v[4]; float ss = 0.f;
#pragma unroll
                for (int jj = 0; jj < 4; ++jj) { v[jj] = *(const f32x4*)(hr + 4 * lane + 256 * jj); ss += (v[jj].x * v[jj].x + v[jj].y * v[jj].y) + (v[jj].z * v[jj].z + v[jj].w * v[jj].w); }
                const float rstd = rsqrtf(wave_sum(ss) * (1.f / D) + EPS);
#pragma unroll
                for (int jj = 0; jj < 4; ++jj) { const f32x4 gg = *(const f32x4*)(g2 + 4 * lane + 256 * jj); v[jj].x *= rstd * gg.x; v[jj].y *= rstd * gg.y; v[jj].z *= rstd * gg.z; v[jj].w *= rstd * gg.w;
                    u32x2 o; o.x = pk2(v[jj].x, v[jj].y); o.y = pk2(v[jj].z, v[jj].w); *(u32x2*)(XN + (size_t)m * D + 4 * lane + 256 * jj) = o; }
                float lg[20];
#pragma unroll
                for (int o = 0; o < 20; ++o) { float a = 0.f;
#pragma unroll
                    for (int jj = 0; jj < 4; ++jj) { const f32x4 wv = *(const f32x4*)(ldsf + o * 1024 + 4 * lane + 256 * jj); a += v[jj].x * wv.x + v[jj].y * wv.y + v[jj].z * wv.z + v[jj].w * wv.w; }
                    lg[o] = wave_sum(a); if ((o & 3) == 3) __builtin_amdgcn_sched_barrier(0); }
                float gl[4]; int grp = 0; float gmx;
#pragma unroll
                for (int k = 0; k < 4; ++k) gl[k] = lg[k] + bg[k];
                gmx = gl[0];
#pragma unroll
                for (int k = 1; k < 4; ++k) if (gl[k] > gmx) { gmx = gl[k]; grp = k; }
                float den = 0.f;
#pragma unroll
                for (int k = 0; k < 4; ++k) den += __expf(gl[k] - gmx);
                const float grpw = 1.f / den;
                float el[4];
#pragma unroll
                for (int k = 0; k < 4; ++k) { float vsel = 0.f;
#pragma unroll
                    for (int gg = 0; gg < 4; ++gg) vsel = (grp == gg) ? (lg[4 + gg * 4 + k] + be[gg * 4 + k]) : vsel;
                    el[k] = vsel; }
                int i1 = 0; float m1 = el[0];
#pragma unroll
                for (int k = 1; k < 4; ++k) if (el[k] > m1) { m1 = el[k]; i1 = k; }
                int i2 = -1; float m2 = 0.f;
#pragma unroll
                for (int k = 0; k < 4; ++k) if (k != i1 && (i2 < 0 || el[k] > m2)) { m2 = el[k]; i2 = k; }
                const float ex = __expf(m2 - m1); const float w1 = grpw / (1.f + ex), w2 = grpw * ex / (1.f + ex);
                if (lane == 0) {
                    const int e1 = grp * 4 + i1, e2 = grp * 4 + i2;
                    const unsigned p1 = atomicAdd(&cnt[e1], 1u); LIST[(size_t)e1 * T + p1] = (unsigned)m; LISTW[(size_t)e1 * T + p1] = w1;
                    const unsigned p2 = atomicAdd(&cnt[e2], 1u); LIST[(size_t)e2 * T + p2] = (unsigned)m | (1u << 14); LISTW[(size_t)e2 * T + p2] = w2;
                }
            }
            __syncthreads();
        }
        SEAM(pb + 5);
        if (IN(pb + 6) || IN(pb + 7)) {
            __syncthreads();
            if (threadIdx.x == 0) { LAS int* tw = (LAS int*)(ldsl + LDS_MOE); int acc = 0;
                for (int e = 0; e < 16; ++e) { const int c = (int)__hip_atomic_load(ctl + CW_CNT + 64 * l + e, __ATOMIC_RELAXED, __HIP_MEMORY_SCOPE_AGENT); tw[e] = acc; tw[32 + e] = c; acc += (c + 255) >> 8; }
                tw[16] = acc; }
            __syncthreads();
        }
        if (IN(pb + 6)) {
            SchedMoe S{XN, WGU, LIST, D, D, 1024, G, bx, true, tab};
            EpiGateUp E{HID, LISTW, tab};
            pg8::gemm_phase<EpiGateUp, SchedMoe, true>(ldsl, D, S, E);
        }
        SEAM(pb + 6);
        if (IN(pb + 7)) {
            SchedMoe S{HID, WD, LIST, 512, 512, 1024, G, bx, false, tab};
            EpiDown E{Y, LIST, tab};
            pg8::gemm_phase<EpiDown, SchedMoe, true>(ldsl, 512, S, E);
        }
        SEAM(pb + 7);
        if (IN(pb + 8)) {
            PHASE_IDS();
            if (l + 1 < NL) { for (int m = gw; m < T; m += NGW) norm_row<1>(nullptr, H + (size_t)m * D, Y + (size_t)m * D, Y + ((size_t)T + m) * D, ARG_IN(I_N1G) + (l + 1) * D, XN + (size_t)m * D, lane); }
            else { for (int m = gw; m < T; m += NGW) norm_row<2>(nullptr, H + (size_t)m * D, Y + (size_t)m * D, Y + ((size_t)T + m) * D, ARG_IN(I_FNG), nullptr, lane); }
        }
        if (l + 1 < NL) SEAM(pb + 8);
    }
#undef IN
#undef SEAM
#undef ws
#undef ctl
#undef H
#undef XN
#undef P1
#undef Rr
#undef WIN
#undef WB
#undef WOUT
#undef WGU
#undef WD
#undef HID
#undef Y
#undef KC
#undef AGA
#undef AGH
#undef LIST
#undef LISTW
}

extern "C" void kernel_launch(void* const* d_in, const int* in_sizes, int n_in, void* d_out, int out_size, void* d_ws, size_t ws_size, hipStream_t stream) {
    static int grid = 0;
    if (grid == 0) {
        if (n_in != 29 || in_sizes[0] != T * D || out_size != T * D || ws_size < WS_END) { fprintf(stderr, "kernel_launch: unexpected shapes / workspace (%d inputs, ws %zu < %zu); nothing launched\n", n_in, ws_size, (size_t)WS_END); grid = -1; return; }
        int dev = 0, cus = 0;
        if (hipGetDevice(&dev) != hipSuccess || hipDeviceGetAttribute(&cus, hipDeviceAttributeMultiprocessorCount, dev) != hipSuccess) { grid = -1; return; }
        if (hipFuncSetAttribute((const void*)fwd_kernel, hipFuncAttributeMaxDynamicSharedMemorySize, LDS_BYTES) != hipSuccess) { fprintf(stderr, "kernel_launch: hipFuncSetAttribute failed\n"); grid = -1; return; }
        int per_cu = 0;
        if (hipOccupancyMaxActiveBlocksPerMultiprocessor(&per_cu, (const void*)fwd_kernel, 512, LDS_BYTES) != hipSuccess || per_cu < 1) { fprintf(stderr, "kernel_launch: occupancy query says %d\n", per_cu); }
        (void)hipGetLastError();
        grid = cus;
    }
    if (grid < 0) return;
    if (hipMemsetAsync((char*)d_ws + WS_CTL, 0, CTL_ZERO_BYTES, stream) != hipSuccess) return;
    Args a{};
    for (int i = 0; i < 29; ++i) a.in[i] = (const float*)d_in[i];
    a.out = (float*)d_out; a.ws = (unsigned char*)d_ws;
#if MK_SPLIT
    for (int p = 0; p < NPH; ++p) { a.ph_lo = p; a.ph_hi = p + 1; hipLaunchKernelGGL(fwd_kernel, dim3(grid), dim3(512), LDS_BYTES, stream, a); }
#else
    a.ph_lo = 0; a.ph_hi = NPH;
    hipLaunchKernelGGL(fwd_kernel, dim3(grid), dim3(512), LDS_BYTES, stream, a);
#endif
}
```

```cpp
#include <hip/hip_runtime.h>
#include <cstdio>
#include <cstdint>

#define GAS __attribute__((address_space(1)))
#define LAS __attribute__((address_space(3)))
typedef unsigned short bf16;
typedef unsigned u32x4 __attribute__((ext_vector_type(4)));
typedef unsigned u32x2 __attribute__((ext_vector_type(2)));
typedef float f32x4 __attribute__((ext_vector_type(4)));
typedef float f32x2 __attribute__((ext_vector_type(2)));
typedef short bf16x8 __attribute__((ext_vector_type(8)));
typedef unsigned long long u64;

#ifndef MK_SPLIT
#define MK_SPLIT 0
#endif

constexpr int NB = 4, SEQ = 4096, T = NB * SEQ, D = 1024, MIX = 512, NL = 2;
constexpr int NIN = 7960, NPROJ = 8192, P1W = 4096;
constexpr int C_U = 0, C_V = 512, C_GB = 1024, C_RB = 1536, C_Q = 2048, C_KV = 2560, C_XD = 3328, C_GC = 3840;
constexpr int SRC_GC = 3328, SRC_XD = 3352, SRC_MG = 3864;
constexpr float EPS = 1e-6f;
constexpr int NEXP = 16, DEXP = 512;
constexpr int HID_ROWS = 2 * T + 4096;

constexpr size_t MiB = 1u << 20;
constexpr size_t WS_CTL = 0, CTL_ZERO_BYTES = 1 * MiB;
constexpr size_t WS_KC = 1 * MiB;
constexpr size_t WS_LRUA = 2 * MiB;
constexpr size_t WS_LRUH = 2 * MiB + 512 * 1024;
constexpr size_t WS_LIST = 3 * MiB;
constexpr size_t WS_LISTW = 4 * MiB;
constexpr size_t WS_WIN = 8 * MiB;
constexpr size_t WS_WB = 40 * MiB;
constexpr size_t WS_WOUT = 48 * MiB;
constexpr size_t WS_XN = 52 * MiB;
constexpr size_t WS_P1 = 84 * MiB;
constexpr size_t WS_R = 212 * MiB;
constexpr size_t WS_WGU = 84 * MiB;
constexpr size_t WS_WD = 116 * MiB;
constexpr size_t WS_HID = 132 * MiB;
constexpr size_t WS_Y = 168 * MiB;
constexpr size_t WS_END = 340 * MiB;
static_assert(WS_HID + (size_t)HID_ROWS * 512 * 2 <= WS_Y && WS_Y + (size_t)2 * T * 1024 * 2 <= WS_END, "ws map");

constexpr int CW_BAR = 4096;
constexpr int CW_CNT = 8192;

constexpr int LDS_BYTES = 147456;
constexpr int LDS_CTL = 146432;
constexpr int LDS_MOE = LDS_CTL + 256;

__device__ __forceinline__ unsigned f2bf(float f) { unsigned u = __builtin_bit_cast(unsigned, f); return (u + 0x7fffu + ((u >> 16) & 1u)) >> 16; }
__device__ __forceinline__ unsigned pk2(float lo, float hi) { return f2bf(lo) | (f2bf(hi) << 16); }
__device__ __forceinline__ float bflo(unsigned u) { return __builtin_bit_cast(float, u << 16); }
__device__ __forceinline__ float bfhi(unsigned u) { return __builtin_bit_cast(float, u & 0xffff0000u); }
__device__ __forceinline__ float bf2f(bf16 h) { return __builtin_bit_cast(float, (unsigned)h << 16); }
__device__ __forceinline__ float sigmoidf_(float x) { return 1.0f / (1.0f + __expf(-x)); }
__device__ __forceinline__ float gelu_tanh(float x) { const float z = 1.5957691216057308f * (x + 0.044715f * x * x * x); return x * sigmoidf_(z); }
__device__ __forceinline__ float wave_sum(float v) {
#pragma unroll
    for (int o = 1; o < 64; o <<= 1) v += __shfl_xor(v, o);
    return v;
}
__device__ __forceinline__ u64 mask_lo(int n) { return n >= 64 ? ~0ull : (n <= 0 ? 0ull : ((1ull << n) - 1ull)); }
#define LDS_WAIT() asm volatile("s_waitcnt lgkmcnt(0)" ::: "memory")
__device__ __forceinline__ int opaque_tid() { int t = (int)threadIdx.x; asm volatile("" : "+v"(t)); return t; }

namespace pg8 {
constexpr int BM = 256, BK = 64, HALF = 128, HTB = HALF * BK * 2, NXCD = 8, WGM = 8;
__host__ __device__ __forceinline__ int lds_byte(int r, int c) { const int st = (r >> 4) * 2 + (c >> 5), rr = r & 15, cc = c & 31, ob = rr * 64 + cc * 2; return st * 1024 + (ob ^ (((ob >> 9) & 1) << 5)); }
__host__ __device__ __forceinline__ void stage_rc(int b, int& R, int& C) { const int st = b / 1024, sb = b % 1024, swz = sb ^ (((sb >> 9) & 1) << 5); R = (st >> 1) * 16 + swz / 64; C = (st & 1) * 32 + (swz % 64) / 2; }
__host__ __device__ __forceinline__ int perm32(int rho) { const int n = rho >> 4, i = rho & 15; return 8 * (i >> 2) + 4 * n + (i & 3); }

struct Unit { const char* A; const char* B; int pm, pn, sub, e; };

__device__ __forceinline__ bool static_tile(int i, int G, int c, int nM, int nN, int& pm, int& pn) {
    const int nwg = nM * nN; const long L = (long)i * G + c; if (L >= nwg) return false;
    int wgid = (int)L; { const int q = nwg / NXCD, r = nwg % NXCD, xcd = wgid % NXCD, off = wgid / NXCD; wgid = (xcd < r ? xcd * (q + 1) : r * (q + 1) + (xcd - r) * q) + off; }
    const int nig = WGM * nN, gid = wgid / nig, fm = gid * WGM, gsz = (nM - fm) < WGM ? (nM - fm) : WGM;
    pm = fm + ((wgid % nig) % gsz); pn = (wgid % nig) / gsz; return true;
}

template <class Epi, class Sched, bool ALIGN_EPI>
__device__ __forceinline__ void gemm_phase(LAS unsigned char* lds, const int K, const Sched& S, const Epi& E) {
    const int tid = opaque_tid(), wid = __builtin_amdgcn_readfirstlane(tid >> 6), lane = tid & 63, wr = wid >> 2, wc = wid & 3, fr = lane & 15, fq = lane >> 4;
    const int nt = K / BK;
    unsigned voffB[2];
#pragma unroll
    for (int i = 0; i < 2; ++i) { int R, C; stage_rc(tid * 16 + i * 8192, R, C); const int Rb = (R & ~31) + perm32(R & 31); voffB[i] = (unsigned)(Rb * K + C) * 2u; }
    const size_t kstep = (size_t)(BK * 2);
    const size_t hstepB = (size_t)HALF * K * 2;
    const unsigned ldsw = (unsigned)wid * 1024u;
    const int aoff = lds_byte(wr * 64 + fr, fq * 8), boff = lds_byte(wc * 32 + fr, fq * 8);
#define PG8_SA(b, h) (((b) * 2 + (h)) * HTB)
#define PG8_SB(b, h) ((4 + (b) * 2 + (h)) * HTB)
#define PG8_STAGE(bufoff, gbase, voff) do { _Pragma("unroll") for (int _i = 0; _i < 2; ++_i) \
        __builtin_amdgcn_global_load_lds((const unsigned*)((const char*)(gbase) + (voff)[_i]), (LAS unsigned*)(lds + (bufoff) + ldsw + _i * 8192), 16, 0, 0); } while (0)
#define PG8_LDA(dst, b, h) do { _Pragma("unroll") for (int m = 0; m < 4; ++m) _Pragma("unroll") for (int k = 0; k < 2; ++k) dst[m][k] = *(const LAS bf16x8*)(lds + PG8_SA(b, h) + aoff + m * 2048 + k * 1024); } while (0)
#define PG8_LDB(dst, b, h) do { _Pragma("unroll") for (int n = 0; n < 2; ++n) _Pragma("unroll") for (int k = 0; k < 2; ++k) dst[n][k] = *(const LAS bf16x8*)(lds + PG8_SB(b, h) + boff + n * 2048 + k * 1024); } while (0)
#define PG8_MMA(ai, bj, At, Bt) do { __builtin_amdgcn_s_setprio(1); _Pragma("unroll") for (int m = 0; m < 4; ++m) _Pragma("unroll") for (int n = 0; n < 2; ++n) _Pragma("unroll") for (int k = 0; k < 2; ++k) \
        acc[ai][bj][m][n] = __builtin_amdgcn_mfma_f32_16x16x32_bf16(Bt[n][k], At[m][k], acc[ai][bj][m][n], 0, 0, 0); __builtin_amdgcn_s_setprio(0); } while (0)
#define PG8_WAIT_V(n) asm volatile("s_waitcnt vmcnt(" #n ")" ::: "memory")
#define PG8_WAIT_L(n) asm volatile("s_waitcnt lgkmcnt(" #n ")" ::: "memory")
#define PG8_BAR __builtin_amdgcn_s_barrier()
#define PG8_SCHED __builtin_amdgcn_sched_barrier(0)
#define PG8_ZERO() do { _Pragma("unroll") for (int a = 0; a < 2; ++a) _Pragma("unroll") for (int b = 0; b < 2; ++b) _Pragma("unroll") for (int m = 0; m < 4; ++m) _Pragma("unroll") for (int n = 0; n < 2; ++n) acc[a][b][m][n] = (f32x4){0.f, 0.f, 0.f, 0.f}; } while (0)
    Unit cur, nxt; int ui = 0;
    if (!S.next(0, cur)) return;
    f32x4 acc[2][2][4][2];
    PG8_ZERO();
    bf16x8 At[4][2], B0[2][2], B1[2][2];
    unsigned voA[2][2], voN[2][2];
    S.a_off(cur, voA);
    const char* cA = cur.A; const char* cB = cur.B;
    PG8_STAGE(PG8_SB(0, 0), cB, voffB); PG8_STAGE(PG8_SB(0, 1), cB + hstepB, voffB); PG8_STAGE(PG8_SA(0, 0), cA, voA[0]); PG8_STAGE(PG8_SA(0, 1), cA, voA[1]);
    if (wr == 1) PG8_BAR;
    PG8_WAIT_V(2); PG8_BAR;
    PG8_STAGE(PG8_SB(1, 0), cB + kstep, voffB); PG8_STAGE(PG8_SA(1, 0), cA + kstep, voA[0]); PG8_STAGE(PG8_SB(1, 1), cB + hstepB + kstep, voffB);
    PG8_WAIT_V(6); PG8_BAR;
    for (;;) {
        const bool has_next = S.next(ui + 1, nxt);
        const char* nA = has_next ? nxt.A : cA; const char* nB = has_next ? nxt.B : cB;
        if (has_next) S.a_off(nxt, voN); else { voN[0][0] = voA[0][0]; voN[0][1] = voA[0][1]; voN[1][0] = voA[1][0]; voN[1][1] = voA[1][1]; }
        for (int t = 0; t < nt; t += 2) {
            const bool last = (t == nt - 2);
            const char* a1 = cA + (size_t)(t + 1) * kstep;
            const char* a2 = last ? nA : cA + (size_t)(t + 2) * kstep; const char* b2 = last ? nB : cB + (size_t)(t + 2) * kstep;
            const char* a3 = a2 + kstep; const char* b3 = b2 + kstep;
            PG8_LDB(B0, 0, 0); PG8_LDB(B1, 0, 1); PG8_SCHED; PG8_LDA(At, 0, 0); PG8_STAGE(PG8_SA(1, 1), a1, voA[1]);
            PG8_WAIT_V(8); PG8_WAIT_L(0); PG8_BAR; PG8_MMA(0, 0, At, B0); PG8_MMA(0, 1, At, B1); PG8_BAR; PG8_SCHED;
            if (last) { voA[0][0] = voN[0][0]; voA[0][1] = voN[0][1]; voA[1][0] = voN[1][0]; voA[1][1] = voN[1][1]; }
            PG8_LDA(At, 0, 1); PG8_STAGE(PG8_SB(0, 0), b2, voffB); PG8_STAGE(PG8_SB(0, 1), b2 + hstepB, voffB); PG8_STAGE(PG8_SA(0, 0), a2, voA[0]);
            PG8_WAIT_V(8); PG8_WAIT_L(0); PG8_BAR; PG8_MMA(1, 0, At, B0); PG8_MMA(1, 1, At, B1); PG8_BAR; PG8_SCHED;
            PG8_LDB(B0, 1, 0); PG8_LDB(B1, 1, 1); PG8_SCHED; PG8_LDA(At, 1, 0); PG8_STAGE(PG8_SA(0, 1), a2, voA[1]);
            PG8_WAIT_V(8); PG8_WAIT_L(0); PG8_BAR; PG8_MMA(0, 0, At, B0); PG8_MMA(0, 1, At, B1); PG8_BAR; PG8_SCHED;
            PG8_LDA(At, 1, 1); PG8_STAGE(PG8_SB(1, 0), b3, voffB); PG8_STAGE(PG8_SB(1, 1), b3 + hstepB, voffB); PG8_STAGE(PG8_SA(1, 0), a3, voA[0]);
            PG8_WAIT_V(8); PG8_WAIT_L(0); PG8_BAR; PG8_MMA(1, 0, At, B0); PG8_MMA(1, 1, At, B1); PG8_BAR; PG8_SCHED;
        }
        if constexpr (ALIGN_EPI) { if (wr == 0) PG8_BAR; }
        int tz = lane; asm volatile("" : "+v"(tz));
        const bool z = E(acc, cur, wr, wc, tz & 15, tz >> 4);
        if (!has_next) break;
        if (z) PG8_ZERO();
        cur = nxt; cA = nA; cB = nB; ++ui;
        if constexpr (ALIGN_EPI) { if (wr == 1) PG8_BAR; }
    }
    PG8_WAIT_V(0);
    if constexpr (!ALIGN_EPI) { if (wr == 0) PG8_BAR; }
    PG8_BAR;
#undef PG8_SA
#undef PG8_SB
#undef PG8_STAGE
#undef PG8_LDA
#undef PG8_LDB
#undef PG8_MMA
#undef PG8_WAIT_V
#undef PG8_WAIT_L
#undef PG8_BAR
#undef PG8_SCHED
#undef PG8_ZERO
}
}

#define XB_TMO      128
#define XB_XCNT(j)  (256  + 64 * (j))
#define XB_XSUB(j)  (1280 + 64 * (j))
#define XB_XGEN(j)  (2304 + 64 * (j))
#define XB_TOP      3328
#define XB_TOPGEN   3392
#define XCD_BAR_WORDS 3456
#define XB_SPIN_CAP (1u << 23)
__device__ __forceinline__ unsigned xb_ld(unsigned* p)              { return __hip_atomic_load(p, __ATOMIC_RELAXED, __HIP_MEMORY_SCOPE_AGENT); }
__device__ __forceinline__ unsigned xb_add(unsigned* p, unsigned v) { return __hip_atomic_fetch_add(p, v, __ATOMIC_RELAXED, __HIP_MEMORY_SCOPE_AGENT); }
__device__ __forceinline__ unsigned xb_xcc_id() { return (unsigned)__builtin_amdgcn_s_getreg((3 << 11) | 20) & 0xFu; }
#define XB_SPIN(cond, bar) do { unsigned _sp = 0; while (cond) { __builtin_amdgcn_s_sleep(1); \
    if ((++_sp & 255u) == 0u) { if (xb_ld(&(bar)[XB_TMO])) break; if (_sp > XB_SPIN_CAP) { atomicAdd(&(bar)[XB_TMO], 1u); break; } } } } while (0)
struct XcdBarrier { unsigned* bar; unsigned x; volatile LAS unsigned* st; };
__device__ __forceinline__ XcdBarrier xcd_barrier_post(unsigned* bar, volatile LAS unsigned* st) {
    XcdBarrier b; b.bar = bar; b.x = xb_xcc_id(); b.st = st;
    if (threadIdx.x == 0) (void)xb_add(&bar[XB_XCNT(b.x)], 1u);
    return b;
}
__device__ __forceinline__ void xcd_barrier_complete(unsigned* bar, unsigned x, unsigned& nloc, unsigned& nx) {
    const unsigned G = gridDim.x * gridDim.y * gridDim.z;
    unsigned sum, cnt, mine, sp = 0u;
    for (;;) {
        sum = 0u; cnt = 0u; mine = 0u;
#pragma unroll
        for (unsigned j = 0; j < 16; ++j) { const unsigned c = xb_ld(&bar[XB_XCNT(j)]); sum += c; cnt += (c > 0u) ? 1u : 0u; mine = (j == x) ? c : mine; }
        if (sum == G) break;
        __builtin_amdgcn_s_sleep(1);
        if ((++sp & 255u) == 0u) { if (xb_ld(&bar[XB_TMO])) break; if (sp > XB_SPIN_CAP) { atomicAdd(&bar[XB_TMO], 1u); break; } }
    }
    nloc = mine > 0u ? mine : 1u; nx = cnt > 0u ? cnt : 1u;
}
__device__ __forceinline__ void xcd_barrier(const XcdBarrier& b) {
    asm volatile("s_waitcnt vmcnt(0)" ::: "memory");
    __syncthreads();
    if (threadIdx.x == 0) {
        unsigned* bar = b.bar;
        __builtin_amdgcn_s_waitcnt(0);
        unsigned nloc = b.st[0], nx = b.st[1];
        if (nloc == 0u) { xcd_barrier_complete(bar, b.x, nloc, nx); b.st[0] = nloc; b.st[1] = nx; }
        const unsigned old = xb_add(&bar[XB_XSUB(b.x)], 1u);
        const unsigned gen = old / nloc;
        if (old + 1u == (gen + 1u) * nloc) {
            __builtin_amdgcn_fence(__ATOMIC_RELEASE, "agent");
            asm volatile("s_waitcnt vmcnt(0)" ::: "memory");
            const unsigned og = xb_add(&bar[XB_TOP], 1u);
            const unsigned tg = og / nx;
            if (og + 1u == (tg + 1u) * nx) xb_add(&bar[XB_TOPGEN], 1u);
            else XB_SPIN(xb_ld(&bar[XB_TOPGEN]) == tg, bar);
            __builtin_amdgcn_fence(__ATOMIC_ACQUIRE, "agent");
            xb_add(&bar[XB_XGEN(b.x)], 1u);
            asm volatile("s_waitcnt vmcnt(0)" ::: "memory");
        } else {
            XB_SPIN(xb_ld(&bar[XB_XGEN(b.x)]) == gen, bar);
            __builtin_amdgcn_fence(__ATOMIC_ACQUIRE, "agent");
            asm volatile("s_waitcnt vmcnt(0)" ::: "memory");
        }
    }
    __syncthreads();
}

struct Args { const float* in[29]; float* out; unsigned char* ws; int ph_lo, ph_hi; };
enum { I_X = 0, I_N1G, I_WIN, I_GMNG, I_GMWS, I_GMB, I_CONVW, I_CONVB, I_LWA, I_LBA, I_LWX, I_LBX, I_LLAM, I_PE, I_CW1, I_CW2, I_PW, I_PS, I_WBR, I_WOUT, I_N2G, I_RWG, I_RBG, I_RWE, I_RBE, I_MG, I_MU, I_MD, I_FNG };

#define CAS __attribute__((address_space(4)))
__device__ __forceinline__ unsigned long long karg_u64(int off) { const CAS char* kp = (const CAS char*)__builtin_amdgcn_kernarg_segment_ptr(); asm volatile("" : "+s"(kp)); return *(const CAS unsigned long long*)(kp + off); }
#define ARG_IN(k) ((const float*)karg_u64(8 * (k)))
#define ARG_OUT() ((float*)karg_u64(8 * 29))
#define ARG_WS() ((unsigned char*)karg_u64(8 * 30))
template <class F>
__device__ __forceinline__ void tr_item(const float* W, int K, int N, bf16* WT, float* scr, int kb, int nb, int lane, F dst) {
    const int k0 = 64 * kb, n0 = 32 * nb;
    const int nn = n0 + (lane & 31);
#pragma unroll 8
    for (int i = 0; i < 32; ++i) { const int kk = 2 * i + (lane >> 5); scr[kk * 33 + (lane & 31)] = (nn < N) ? W[(size_t)(k0 + kk) * N + nn] : 0.f; }
    LDS_WAIT(); asm volatile("" ::: "memory");
    const int c = lane & 7;
#pragma unroll
    for (int j = 0; j < 4; ++j) { const int nl = (lane >> 3) + 8 * j; const int n = n0 + nl; const float* s = scr + (8 * c) * 33 + nl;
        u32x4 o; o.x = pk2(s[0 * 33], s[1 * 33]); o.y = pk2(s[2 * 33], s[3 * 33]); o.z = pk2(s[4 * 33], s[5 * 33]); o.w = pk2(s[6 * 33], s[7 * 33]);
        if (n < N) *(u32x4*)(WT + (size_t)dst(n) * K + k0 + 8 * c) = o; }
    LDS_WAIT(); asm volatile("" ::: "memory");
}
__device__ __forceinline__ int win_dst_row(int s) {
    if (s < SRC_GC) return s;
    if (s < SRC_XD) return C_GC + (s - SRC_GC);
    if (s < SRC_MG) return C_XD + (s - SRC_XD);
    const int n = (s - SRC_MG) >> 10, d = (s - SRC_MG) & 1023;
    return P1W + 256 * (d >> 6) + 128 * (n >> 1) + 32 * ((d >> 4) & 3) + 8 * ((d >> 2) & 3) + 4 * (n & 1) + (d & 3);
}
template <int MODE>
__device__ __forceinline__ void norm_row(const float* xrow, float* hrow, const bf16* y0, const bf16* y1, const float* g, bf16* xn, int lane) {
    f32x4 v[4]; float ss = 0.f;
#pragma unroll
    for (int j = 0; j < 4; ++j) {
        const int c = 4 * lane + 256 * j;
        v[j] = *(const f32x4*)((MODE == 0 ? xrow : hrow) + c);
        if (MODE != 0) { const u32x2 a = *(const u32x2*)(y0 + c), b = *(const u32x2*)(y1 + c);
            v[j].x += bflo(a.x) + bflo(b.x); v[j].y += bfhi(a.x) + bfhi(b.x); v[j].z += bflo(a.y) + bflo(b.y); v[j].w += bfhi(a.y) + bfhi(b.y); }
        ss += (v[j].x * v[j].x + v[j].y * v[j].y) + (v[j].z * v[j].z + v[j].w * v[j].w);
    }
    const float rstd = rsqrtf(wave_sum(ss) * (1.f / D) + EPS);
#pragma unroll
    for (int j = 0; j < 4; ++j) {
        const int c = 4 * lane + 256 * j;
        const f32x4 gg = *(const f32x4*)(g + c);
        if (MODE == 2) { *(f32x4*)(hrow + c) = (f32x4){v[j].x * rstd * gg.x, v[j].y * rstd * gg.y, v[j].z * rstd * gg.z, v[j].w * rstd * gg.w}; }
        else { *(f32x4*)(hrow + c) = v[j];
            u32x2 o; o.x = pk2(v[j].x * rstd * gg.x, v[j].y * rstd * gg.y); o.y = pk2(v[j].z * rstd * gg.z, v[j].w * rstd * gg.w); *(u32x2*)(xn + c) = o; }
    }
}

struct SchedDense {
    const bf16* A; const bf16* Bt; int lda, K, nM, nN, G, c;
    __device__ __forceinline__ bool next(int i, pg8::Unit& u) const {
        int pm, pn; if (!pg8::static_tile(i, G, c, nM, nN, pm, pn)) return false;
        u.pm = pm; u.pn = pn; u.sub = 0; u.e = 0; u.A = (const char*)(A + (size_t)pm * 256 * lda); u.B = (const char*)(Bt + (size_t)pn * 256 * K); return true;
    }
    __device__ __forceinline__ void a_off(const pg8::Unit&, unsigned (&vo)[2][2]) const {
        const int tz = opaque_tid();
#pragma unroll
        for (int i = 0; i < 2; ++i) { int R, C; pg8::stage_rc(tz * 16 + i * 8192, R, C);
#pragma unroll
            for (int h = 0; h < 2; ++h) vo[h][i] = (unsigned)((h * 128 + R) * lda + C) * 2u; }
    }
};
struct SchedMerge {
    const bf16* P1; const bf16* Wb; int G, c;
    __device__ __forceinline__ bool next(int i, pg8::Unit& u) const {
        const int ti = i >> 2, sub = i & 3; int pm, pn; if (!pg8::static_tile(ti, G, c, T / 256, 4, pm, pn)) return false;
        const int ycol = (sub == 0) ? C_U : (sub == 1) ? C_GB : (sub == 2) ? C_Q : C_V;
        u.pm = pm; u.pn = pn; u.sub = sub; u.e = 0;
        u.A = (const char*)(P1 + (size_t)pm * 256 * P1W + ycol); u.B = (const char*)(Wb + ((size_t)sub * 1024 + (size_t)pn * 256) * 512); return true;
    }
    __device__ __forceinline__ void a_off(const pg8::Unit&, unsigned (&vo)[2][2]) const {
        const int tz = opaque_tid();
#pragma unroll
        for (int i = 0; i < 2; ++i) { int R, C; pg8::stage_rc(tz * 16 + i * 8192, R, C);
#pragma unroll
            for (int h = 0; h < 2; ++h) vo[h][i] = (unsigned)((h * 128 + R) * P1W + C) * 2u; }
    }
};
struct SchedMoe {
    const bf16* A; const bf16* Bt; const unsigned* list; int lda, K, brows  , G, c; bool gather; const LAS int* tab;
    __device__ __forceinline__ bool next(int i, pg8::Unit& u) const {
        const int L = i * G + c; const int tot = __builtin_amdgcn_readfirstlane(tab[16]); if (L >= 4 * tot) return false;
        const int rtg = L >> 2, pn = L & 3; int e = 0, st = 0;
#pragma unroll
        for (int k = 1; k < 16; ++k) { const int tk = __builtin_amdgcn_readfirstlane(tab[k]); if (rtg >= tk) { e = k; st = tk; } }
        u.e = e; u.pm = rtg; u.sub = rtg - st; u.pn = pn;
        u.A = gather ? (const char*)A : (const char*)(A + (size_t)rtg * 256 * lda);
        u.B = (const char*)(Bt + ((size_t)e * brows + (size_t)pn * 256) * K); return true;
    }
    __device__ __forceinline__ void a_off(const pg8::Unit& u, unsigned (&vo)[2][2]) const {
        const int cnt = __builtin_amdgcn_readfirstlane(tab[32 + u.e]); const unsigned* le = list + (size_t)u.e * T + u.sub * 256;
        int tz = (int)threadIdx.x; asm volatile("" : "+v"(tz));
#pragma unroll
        for (int i = 0; i < 2; ++i) { int R, C; pg8::stage_rc(tz * 16 + i * 8192, R, C);
#pragma unroll
            for (int h = 0; h < 2; ++h) {
                int row = h * 128 + R;
                if (gather) { row = (u.sub * 256 + row < cnt) ? (int)(le[row] & 0x3fffu) : 0; }
                vo[h][i] = (unsigned)(row * lda + C) * 2u;
            } }
    }
};

struct EpiProj {
    bf16* P1; bf16* Rr;
    __device__ __forceinline__ bool operator()(f32x4 (&acc)[2][2][4][2], const pg8::Unit& u, int wr, int wc, int fr, int fq) const {
        const int row0 = u.pm * 256 + wr * 64 + fr;
        if (u.pn < 16) {
            const int act = (u.pn < 6) ? 1 : (u.pn == 15 ? 2 : 0);
#pragma unroll
            for (int ai = 0; ai < 2; ++ai)
#pragma unroll
                for (int m = 0; m < 4; ++m) { bf16* rowp = P1 + (size_t)(row0 + ai * 128 + m * 16) * P1W + u.pn * 256 + wc * 32 + 8 * fq;
#pragma unroll
                    for (int bj = 0; bj < 2; ++bj) { f32x4 v0 = acc[ai][bj][m][0], v1 = acc[ai][bj][m][1];
                        if (act == 1) { v0 = (f32x4){gelu_tanh(v0.x), gelu_tanh(v0.y), gelu_tanh(v0.z), gelu_tanh(v0.w)}; v1 = (f32x4){gelu_tanh(v1.x), gelu_tanh(v1.y), gelu_tanh(v1.z), gelu_tanh(v1.w)}; }
                        else if (act == 2) { v0 = (f32x4){sigmoidf_(v0.x), sigmoidf_(v0.y), sigmoidf_(v0.z), sigmoidf_(v0.w)}; v1 = (f32x4){sigmoidf_(v1.x), sigmoidf_(v1.y), sigmoidf_(v1.z), sigmoidf_(v1.w)}; }
                        u32x4 w; w.x = pk2(v0.x, v0.y); w.y = pk2(v0.z, v0.w); w.z = pk2(v1.x, v1.y); w.w = pk2(v1.z, v1.w);
                        *(u32x4*)(rowp + bj * 128) = w; } }
        } else {
            const int dcol = 64 * (u.pn - 16) + 16 * wc + 4 * fq;
#pragma unroll
            for (int ai = 0; ai < 2; ++ai)
#pragma unroll
                for (int m = 0; m < 4; ++m) { const size_t row = (size_t)(row0 + ai * 128 + m * 16);
                    float r0[4], r1[4], r2[4], r3[4];
#pragma unroll
                    for (int i = 0; i < 4; ++i) {
                        const float g0 = fmaxf(sigmoidf_(acc[ai][0][m][0][i]), 1e-20f), g1 = fmaxf(sigmoidf_(acc[ai][0][m][1][i]), 1e-20f);
                        const float g2 = fmaxf(sigmoidf_(acc[ai][1][m][0][i]), 1e-20f), g3 = fmaxf(sigmoidf_(acc[ai][1][m][1][i]), 1e-20f);
                        r0[i] = g0 / g1; r1[i] = g1 / g2; r2[i] = g2 / g3; r3[i] = g3; }
                    u32x2 w;
                    w.x = pk2(r0[0], r0[1]); w.y = pk2(r0[2], r0[3]); *(u32x2*)(Rr + ((size_t)0 * T + row) * 1024 + dcol) = w;
                    w.x = pk2(r1[0], r1[1]); w.y = pk2(r1[2], r1[3]); *(u32x2*)(Rr + ((size_t)1 * T + row) * 1024 + dcol) = w;
                    w.x = pk2(r2[0], r2[1]); w.y = pk2(r2[2], r2[3]); *(u32x2*)(Rr + ((size_t)2 * T + row) * 1024 + dcol) = w;
                    w.x = pk2(r3[0], r3[1]); w.y = pk2(r3[2], r3[3]); *(u32x2*)(Rr + ((size_t)3 * T + row) * 1024 + dcol) = w; }
        }
        return true;
    }
};
struct EpiMerge {
    const bf16* Rr; bf16* O;
    __device__ __forceinline__ bool operator()(f32x4 (&acc)[2][2][4][2], const pg8::Unit& u, int wr, int wc, int fr, int fq) const {
        const int row0 = u.pm * 256 + wr * 64 + fr, col0 = u.pn * 256 + wc * 32 + 8 * fq;
        const bf16* Rn = Rr + (size_t)u.sub * T * 1024;
#pragma unroll
        for (int ai = 0; ai < 2; ++ai)
#pragma unroll
            for (int m = 0; m < 4; ++m) { const size_t ro = (size_t)(row0 + ai * 128 + m * 16) * 1024 + col0;
#pragma unroll
                for (int bj = 0; bj < 2; ++bj) { const u32x4 r = *(const u32x4*)(Rn + ro + bj * 128);
                    f32x4& v0 = acc[ai][bj][m][0]; f32x4& v1 = acc[ai][bj][m][1];
                    v0.x *= bflo(r.x); v0.y *= bfhi(r.x); v0.z *= bflo(r.y); v0.w *= bfhi(r.y); v1.x *= bflo(r.z); v1.y *= bfhi(r.z); v1.z *= bflo(r.w); v1.w *= bfhi(r.w);
                    if (u.sub == 3) { u32x4 w; w.x = pk2(v0.x, v0.y); w.y = pk2(v0.z, v0.w); w.z = pk2(v1.x, v1.y); w.w = pk2(v1.z, v1.w); *(u32x4*)(O + ro + bj * 128) = w; } } }
        return u.sub == 3;
    }
};
struct EpiWout {
    float* H;
    __device__ __forceinline__ bool operator()(f32x4 (&acc)[2][2][4][2], const pg8::Unit& u, int wr, int wc, int fr, int fq) const {
        const int row0 = u.pm * 256 + wr * 64 + fr, col0 = u.pn * 256 + wc * 32 + 8 * fq;
#pragma unroll
        for (int ai = 0; ai < 2; ++ai)
#pragma unroll
            for (int m = 0; m < 4; ++m) { float* rp = H + (size_t)(row0 + ai * 128 + m * 16) * 1024 + col0;
#pragma unroll
                for (int bj = 0; bj < 2; ++bj)
#pragma unroll
                    for (int n = 0; n < 2; ++n) { f32x4* p = (f32x4*)(rp + bj * 128 + 4 * n); f32x4 h = *p; h = h + acc[ai][bj][m][n]; *p = h; } }
        return true;
    }
};
struct EpiGateUp {
    bf16* HID; const float* lw; const LAS int* tab;
    __device__ __forceinline__ bool operator()(f32x4 (&acc)[2][2][4][2], const pg8::Unit& u, int wr, int wc, int fr, int fq) const {
        const int cnt = __builtin_amdgcn_readfirstlane(tab[32 + u.e]);
#pragma unroll
        for (int ai = 0; ai < 2; ++ai)
#pragma unroll
            for (int m = 0; m < 4; ++m) { const int rl = ai * 128 + wr * 64 + m * 16 + fr; const int lr = u.sub * 256 + rl;
                const bool ok = lr < cnt; const float w = ok ? lw[(size_t)u.e * T + lr] : 0.f;
                float o[8];
#pragma unroll
                for (int n = 0; n < 2; ++n)
#pragma unroll
                    for (int i = 0; i < 4; ++i) { const float g = acc[ai][0][m][n][i], up = acc[ai][1][m][n][i]; o[4 * n + i] = ok ? g * sigmoidf_(g) * up * w : 0.f; }
                u32x4 wv; wv.x = pk2(o[0], o[1]); wv.y = pk2(o[2], o[3]); wv.z = pk2(o[4], o[5]); wv.w = pk2(o[6], o[7]);
                *(u32x4*)(HID + ((size_t)u.pm * 256 + rl) * 512 + u.pn * 128 + wc * 32 + 8 * fq) = wv; }
        return true;
    }
};
struct EpiDown {
    bf16* Y; const unsigned* list; const LAS int* tab;
    __device__ __forceinline__ bool operator()(f32x4 (&acc)[2][2][4][2], const pg8::Unit& u, int wr, int wc, int fr, int fq) const {
        const int cnt = __builtin_amdgcn_readfirstlane(tab[32 + u.e]);
#pragma unroll
        for (int ai = 0; ai < 2; ++ai)
#pragma unroll
            for (int m = 0; m < 4; ++m) { const int rl = ai * 128 + wr * 64 + m * 16 + fr; const int lr = u.sub * 256 + rl;
                if (lr < cnt) { const unsigned en = list[(size_t)u.e * T + lr]; const unsigned tok = en & 0x3fffu, slot = en >> 14;
                    bf16* rp = Y + ((size_t)slot * T + tok) * 1024 + u.pn * 256 + wc * 32 + 8 * fq;
#pragma unroll
                    for (int bj = 0; bj < 2; ++bj) { const f32x4 v0 = acc[ai][bj][m][0], v1 = acc[ai][bj][m][1];
                        u32x4 w; w.x = pk2(v0.x, v0.y); w.y = pk2(v0.z, v0.w); w.z = pk2(v1.x, v1.y); w.w = pk2(v1.z, v1.w); *(u32x4*)(rp + bj * 128) = w; } } }
        return true;
    }
};

__device__ __forceinline__ void gmlp_unit(float* lds, bf16* P1, const float* gng, const float* gws, const float* gmb, int unit) {
    const int tid = opaque_tid(); const int c = unit >> 2, g = unit & 3; const size_t t0 = (size_t)c * 128;
    float* Wt = lds; float* Vn = lds + 16384; float* rs = lds + 32768;
    __syncthreads();
    {
        const int tk = tid >> 2, qu = tid & 3; const bf16* vp = P1 + (t0 + tk) * P1W + C_V + qu * 128; float ss = 0.f;
#pragma unroll 4
        for (int i = 0; i < 16; ++i) { const u32x4 w = *(const u32x4*)(vp + 8 * i);
            ss += bflo(w.x) * bflo(w.x) + bfhi(w.x) * bfhi(w.x) + bflo(w.y) * bflo(w.y) + bfhi(w.y) * bfhi(w.y) + bflo(w.z) * bflo(w.z) + bfhi(w.z) * bfhi(w.z) + bflo(w.w) * bflo(w.w) + bfhi(w.w) * bfhi(w.w); }
        ss += __shfl_xor(ss, 1); ss += __shfl_xor(ss, 2);
        if (qu == 0) rs[tk] = rsqrtf(ss * (1.f / 512.f) + EPS);
    }
    for (int e = tid; e < 128 * 128; e += 512) { const int t = e >> 7, s = e & 127; Wt[e] = (s <= t) ? gws[(size_t)g * 16384 + e] : 0.f; }
    __syncthreads();
    for (int e = tid; e < 128 * 16; e += 512) { const int s = e >> 4, c8 = (e & 15) * 8; const u32x4 w = *(const u32x4*)(P1 + (t0 + s) * P1W + C_V + g * 128 + c8);
        const float r = rs[s]; const float* gp = gng + g * 128 + c8; float* o = Vn + s * 128 + c8;
        o[0] = bflo(w.x) * r * gp[0]; o[1] = bfhi(w.x) * r * gp[1]; o[2] = bflo(w.y) * r * gp[2]; o[3] = bfhi(w.y) * r * gp[3];
        o[4] = bflo(w.z) * r * gp[4]; o[5] = bfhi(w.z) * r * gp[5]; o[6] = bflo(w.w) * r * gp[6]; o[7] = bfhi(w.w) * r * gp[7]; }
    __syncthreads();
    const int tg = tid >> 5, c4 = (tid & 31) * 4;
    f32x4 acc[8];
#pragma unroll
    for (int k = 0; k < 8; ++k) acc[k] = (f32x4){0.f, 0.f, 0.f, 0.f};
    const int smax = tg * 8 + 7;
    for (int s = 0; s <= smax; ++s) { const f32x4 v = *(const f32x4*)(Vn + s * 128 + c4);
#pragma unroll
        for (int k = 0; k < 8; ++k) { const float w = Wt[(tg * 8 + k) * 128 + s]; acc[k] = acc[k] + v * w; } }
#pragma unroll
    for (int k = 0; k < 8; ++k) { const int tl = tg * 8 + k; const float bb = gmb[g * 128 + tl];
        bf16* up = P1 + (t0 + tl) * P1W + C_U + g * 128 + c4; const u32x2 uu = *(const u32x2*)up;
        u32x2 o; o.x = pk2(bflo(uu.x) * (acc[k].x + bb), bfhi(uu.x) * (acc[k].y + bb)); o.y = pk2(bflo(uu.y) * (acc[k].z + bb), bfhi(uu.y) * (acc[k].w + bb)); *(u32x2*)up = o; }
}

__device__ __forceinline__ void lru_unit(float* lds, const bf16* P1, bf16* XN, float* AGA, float* AGH, const float* convw, const float* convb, const float* wa, const float* ba, const float* wx, const float* bx, const float* lam, int unit) {
    const int tid = opaque_tid(); const int h = unit & 7, tile = (unit >> 3) & 63, b = unit >> 9; const int ch0 = h * 64;
    const size_t row0 = (size_t)b * SEQ + tile * 64;
    float* xc = lds; float* Wa = lds + 4096; float* Wx = lds + 8192; float* av = lds + 12288; float* bv = lds + 16384;
    __syncthreads();
    {
        const int tt = tid >> 3, c8 = (tid & 7) * 8; const int ts = tile * 64 + tt;
        float o[8];
#pragma unroll
        for (int i = 0; i < 8; ++i) o[i] = convb[ch0 + c8 + i];
#pragma unroll
        for (int k = 0; k < 4; ++k) { const int sp = ts + k - 3; if (sp >= 0) { const u32x4 w = *(const u32x4*)(P1 + ((size_t)b * SEQ + sp) * P1W + C_RB + ch0 + c8); const float* cw = convw + k * 512 + ch0 + c8;
                o[0] += bflo(w.x) * cw[0]; o[1] += bfhi(w.x) * cw[1]; o[2] += bflo(w.y) * cw[2]; o[3] += bfhi(w.y) * cw[3]; o[4] += bflo(w.z) * cw[4]; o[5] += bfhi(w.z) * cw[5]; o[6] += bflo(w.w) * cw[6]; o[7] += bfhi(w.w) * cw[7]; } }
#pragma unroll
        for (int i = 0; i < 8; ++i) xc[tt * 64 + c8 + i] = o[i];
    }
    for (int e = tid; e < 4096; e += 512) { Wa[e] = wa[(size_t)h * 4096 + e]; Wx[e] = wx[(size_t)h * 4096 + e]; }
    __syncthreads();
    {
        const int co = tid & 63, tg = tid >> 6; float ar[8], ai[8];
#pragma unroll
        for (int k = 0; k < 8; ++k) { ar[k] = 0.f; ai[k] = 0.f; }
        for (int ci = 0; ci < 64; ++ci) { const float wav = Wa[ci * 64 + co], wxv = Wx[ci * 64 + co];
#pragma unroll
            for (int k = 0; k < 8; ++k) { const float x = xc[(tg * 8 + k) * 64 + ci]; ar[k] += x * wav; ai[k] += x * wxv; } }
        const float bav = ba[ch0 + co], bxv = bx[ch0 + co]; const float lm = lam[ch0 + co];
        const float sp = (-lm > 20.f) ? -lm : log1pf(__expf(-lm));
#pragma unroll
        for (int k = 0; k < 8; ++k) { const int tt = tg * 8 + k; const float r = sigmoidf_(ar[k] + bav), ig = sigmoidf_(ai[k] + bxv);
            const float la = -8.0f * r * sp; const float a = __expf(la); const float bt = sqrtf(fmaxf(-expm1f(2.0f * la), 0.f)) * (ig * xc[tt * 64 + co]);
            av[tt * 64 + co] = a; bv[tt * 64 + co] = bt; }
    }
    __syncthreads();
    if (tid < 64) { float hr = 0.f, ac = 1.f;
        for (int tt = 0; tt < 64; ++tt) { const float a = av[tt * 64 + tid], bt = bv[tt * 64 + tid]; hr = a * hr + bt; ac *= a; bv[tt * 64 + tid] = hr; av[tt * 64 + tid] = ac; }
        AGA[((size_t)b * 64 + tile) * 512 + ch0 + tid] = ac; AGH[((size_t)b * 64 + tile) * 512 + ch0 + tid] = hr; }
    __syncthreads();
    {   const int tt = tid >> 3, c8 = (tid & 7) * 8; const float* hp = bv + tt * 64 + c8; const float* ap = av + tt * 64 + c8;
        u32x4 w; w.x = pk2(hp[0], hp[1]); w.y = pk2(hp[2], hp[3]); w.z = pk2(hp[4], hp[5]); w.w = pk2(hp[6], hp[7]);
        *(u32x4*)(XN + (row0 + tt) * 1024 + ch0 + c8) = w;
        w.x = pk2(ap[0], ap[1]); w.y = pk2(ap[2], ap[3]); w.z = pk2(ap[4], ap[5]); w.w = pk2(ap[6], ap[7]);
        *(u32x4*)(XN + (row0 + tt) * 1024 + 512 + ch0 + c8) = w; }
}
__device__ __forceinline__ void lrufix_unit(bf16* P1, const bf16* XN, const float* AGA, const float* AGH, int unit) {
    const int ch = opaque_tid(); const int tile = unit & 63, b = unit >> 6;
    float c = 0.f;
    for (int i = 0; i < tile; ++i) { const float a = AGA[((size_t)b * 64 + i) * 512 + ch], hh = AGH[((size_t)b * 64 + i) * 512 + ch]; c = a * c + hh; }
    const size_t row0 = (size_t)b * SEQ + tile * 64;
    for (int tt = 0; tt < 64; ++tt) { const float hl = bf2f(XN[(row0 + tt) * 1024 + ch]), ac = bf2f(XN[(row0 + tt) * 1024 + 512 + ch]);
        bf16* gp = P1 + (row0 + tt) * P1W + C_GB + ch; *gp = (bf16)f2bf(bf2f(*gp) * (hl + ac * c)); }
}
__device__ __forceinline__ void pool_unit(float* lds, bf16* P1, const float* pw, const float* ps, int unit) {
    const int tid = opaque_tid(); const int gi = unit & 3, tile = (unit >> 2) & 63, b = unit >> 8; const int w = 2 << gi;
    float* xs = lds; float* Pw = lds + 10240; float* pl = lds + 26624;
    __syncthreads();
    for (int e = tid; e < 79 * 16; e += 512) { const int r = e >> 4, c8 = (e & 15) * 8; const int sp = tile * 64 + r - 15; float* o = xs + r * 128 + c8;
        if (sp >= 0) { const u32x4 v = *(const u32x4*)(P1 + ((size_t)b * SEQ + sp) * P1W + C_XD + gi * 128 + c8);
            o[0] = bflo(v.x); o[1] = bfhi(v.x); o[2] = bflo(v.y); o[3] = bfhi(v.y); o[4] = bflo(v.z); o[5] = bfhi(v.z); o[6] = bflo(v.w); o[7] = bfhi(v.w); }
        else { o[0] = 0.f; o[1] = 0.f; o[2] = 0.f; o[3] = 0.f; o[4] = 0.f; o[5] = 0.f; o[6] = 0.f; o[7] = 0.f; } }
    for (int e = tid; e < 16384; e += 512) Pw[e] = pw[(size_t)gi * 16384 + e];
    __syncthreads();
    {   const int ci = tid & 127, tq = tid >> 7;
        for (int k = 0; k < 16; ++k) { const int tt = tq * 16 + k; const int ts = tile * 64 + tt; float s = 0.f;
            for (int j = 0; j < w; ++j) s += xs[(tt + 15 - j) * 128 + ci];
            const int cnt = (ts + 1 < w) ? ts + 1 : w;
            pl[tt * 128 + ci] = s / (float)cnt - xs[(tt + 15) * 128 + ci]; } }
    __syncthreads();
    {   const int co = tid & 127, tq = tid >> 7; float acc[16];
#pragma unroll
        for (int k = 0; k < 16; ++k) acc[k] = 0.f;
        for (int ci = 0; ci < 128; ++ci) { const float wv = Pw[ci * 128 + co];
#pragma unroll
            for (int k = 0; k < 16; ++k) acc[k] += pl[(tq * 16 + k) * 128 + ci] * wv; }
        const float sc = ps[gi * 128 + co];
#pragma unroll
        for (int k = 0; k < 16; ++k) P1[((size_t)b * SEQ + tile * 64 + tq * 16 + k) * P1W + C_V + gi * 128 + co] = (bf16)f2bf(acc[k] * sc); }
}
__device__ __forceinline__ void cmp_unit(float* lds, const bf16* P1, float* KC, const float* pe, const float* w1, const float* w2, int unit) {
    const int tid = opaque_tid(); const int q = unit & 15, g = (unit >> 4) & 1, b = (unit >> 5) & 3, c = unit >> 7;
    float* Fl = lds; float* hid = lds + 32768;
    const float* pec = pe + (size_t)c * 2048; const float* w1c = w1 + ((size_t)c * 2 + g) * 2048 * 64; const float* w2c = w2 + ((size_t)c * 2 + g) * 4096;
    __syncthreads();
    for (int e = tid; e < 16 * 256; e += 512) { const int nl = e >> 8, l = (e >> 3) & 31, c8 = (e & 7) * 8; const int n = q * 16 + nl; float* o = Fl + nl * 2048 + l * 64 + c8;
        if (n < 255) { const u32x4 v = *(const u32x4*)(P1 + ((size_t)b * SEQ + n * 16 + l) * P1W + C_KV + (c * 2 + g) * 64 + c8); const float* pp = pec + l * 64 + c8;
            o[0] = bflo(v.x) + pp[0]; o[1] = bfhi(v.x) + pp[1]; o[2] = bflo(v.y) + pp[2]; o[3] = bfhi(v.y) + pp[3]; o[4] = bflo(v.z) + pp[4]; o[5] = bfhi(v.z) + pp[5]; o[6] = bflo(v.w) + pp[6]; o[7] = bfhi(v.w) + pp[7]; }
        else { o[0] = 0.f; o[1] = 0.f; o[2] = 0.f; o[3] = 0.f; o[4] = 0.f; o[5] = 0.f; o[6] = 0.f; o[7] = 0.f; } }
    __syncthreads();
    {   const int e = tid & 63, ng = tid >> 6; float a0 = 0.f, a1 = 0.f; const float* f0 = Fl + (ng * 2) * 2048; const float* f1 = f0 + 2048;
#pragma unroll 8
        for (int f = 0; f < 2048; ++f) { const float wv = w1c[(size_t)f * 64 + e]; a0 += f0[f] * wv; a1 += f1[f] * wv; }
        hid[(ng * 2) * 64 + e] = gelu_tanh(a0); hid[(ng * 2 + 1) * 64 + e] = gelu_tanh(a1); }
    __syncthreads();
    {   const int d = tid & 63, ng = tid >> 6; float a0 = 0.f, a1 = 0.f;
        for (int e = 0; e < 64; ++e) { const float wv = w2c[e * 64 + d]; a0 += hid[(ng * 2) * 64 + e] * wv; a1 += hid[(ng * 2 + 1) * 64 + e] * wv; }
        const int n0 = q * 16 + ng * 2; float* kp = KC + ((((size_t)c * NB + b) * 2 + g) * 256) * 64;
        if (n0 < 255) kp[(size_t)n0 * 64 + d] = a0;
        if (n0 + 1 < 255) kp[(size_t)(n0 + 1) * 64 + d] = a1; }
}

__device__ __forceinline__ void attend_tile(const f32x2 (&q)[16], f32x2 (&o)[16], float& m, float& l, const float* Kt, const float* Vt, u64 vm) {
    if (!__any(vm != 0ull)) return;
#pragma unroll 1
    for (int kc = 0; kc < 8; ++kc) {
        const unsigned bits = (unsigned)(vm >> (8 * kc)) & 0xffu;
        if (!__any(bits != 0u)) continue;
        float s[8]; float mx = m;
#pragma unroll
        for (int kk = 0; kk < 8; ++kk) { const float* kr = Kt + (kc * 8 + kk) * 64; f32x2 a2 = {0.f, 0.f};
#pragma unroll
            for (int d4 = 0; d4 < 8; ++d4) { const f32x4 kv = *(const f32x4*)(kr + 4 * d4); a2 = q[2 * d4] * (f32x2){kv.x, kv.y} + a2; a2 = q[2 * d4 + 1] * (f32x2){kv.z, kv.w} + a2; }
            float a = a2.x + a2.y; a += __shfl_xor(a, 1);
            const bool ok = (bits >> kk) & 1u; s[kk] = ok ? a : -1e30f; mx = fmaxf(mx, s[kk]); }
        const float sc = __expf(m - mx); m = mx; l *= sc;
#pragma unroll
        for (int d = 0; d < 16; ++d) o[d] = o[d] * sc;
#pragma unroll
        for (int kk = 0; kk < 8; ++kk) { const bool ok = (bits >> kk) & 1u; const float p = ok ? __expf(s[kk] - mx) : 0.f; l += p; const float* vr = Vt + (kc * 8 + kk) * 64; const f32x2 pp = {p, p};
#pragma unroll
            for (int d4 = 0; d4 < 8; ++d4) { const f32x4 vv = *(const f32x4*)(vr + 4 * d4); o[2 * d4] = pp * (f32x2){vv.x, vv.y} + o[2 * d4]; o[2 * d4 + 1] = pp * (f32x2){vv.z, vv.w} + o[2 * d4 + 1]; } }
    }
}
__device__ __forceinline__ void stage_kv_bf16(float* Kt, float* Vt, const bf16* kp, const bf16* vp, int tid) {
    const int r = tid >> 3, c8 = (tid & 7) * 8;
    const u32x4 a = *(const u32x4*)(kp + (size_t)r * P1W + c8), b = *(const u32x4*)(vp + (size_t)r * P1W + c8);
    float* o = Kt + r * 64 + c8; o[0] = bflo(a.x); o[1] = bfhi(a.x); o[2] = bflo(a.y); o[3] = bfhi(a.y); o[4] = bflo(a.z); o[5] = bfhi(a.z); o[6] = bflo(a.w); o[7] = bfhi(a.w);
    o = Vt + r * 64 + c8; o[0] = bflo(b.x); o[1] = bfhi(b.x); o[2] = bflo(b.y); o[3] = bfhi(b.y); o[4] = bflo(b.z); o[5] = bfhi(b.z); o[6] = bflo(b.w); o[7] = bfhi(b.w);
}
__device__ __forceinline__ void attn_unit(float* lds, bf16* P1, const float* KC, int unit) {
    const int tid = opaque_tid(); const int ti = unit & 63, g = (unit >> 6) & 1, b = unit >> 7;
    const int s0 = ti * 64; const int tk = tid >> 3; const int ts = s0 + tk; const int j = (tid >> 1) & 3, hd = g * 4 + j, hf = tid & 1;
    const size_t row = (size_t)b * SEQ + ts;
    float* Kt = lds + 32 * hf; float* Vt = lds + 4096 + 32 * hf; float* imp = lds + 8192;
    f32x2 q[16], o[16];
    bf16* const op = P1 + row * P1W + C_Q + hd * 64 + 32 * hf;
    {
#pragma unroll
        for (int i = 0; i < 4; ++i) { const u32x4 w = *(const u32x4*)(op + 8 * i);
            q[4 * i] = (f32x2){bflo(w.x) * 0.125f, bfhi(w.x) * 0.125f}; q[4 * i + 1] = (f32x2){bflo(w.y) * 0.125f, bfhi(w.y) * 0.125f};
            q[4 * i + 2] = (f32x2){bflo(w.z) * 0.125f, bfhi(w.z) * 0.125f}; q[4 * i + 3] = (f32x2){bflo(w.w) * 0.125f, bfhi(w.w) * 0.125f}; } }
    const float g0 = bf2f(P1[row * P1W + C_GC + hd * 3 + 0]), g1 = bf2f(P1[row * P1W + C_GC + hd * 3 + 1]), g2 = bf2f(P1[row * P1W + C_GC + hd * 3 + 2]);
    const int nv = (ts >= 31) ? ((((ts + 1) >> 4) - 1 > 255) ? 255 : ((ts + 1) >> 4) - 1) : 0;
    const int nvmax = ((s0 + 64) >> 4) - 1; const int nkt = (nvmax + 63) >> 6;
    const float* kcp = KC + ((((size_t)0 * NB + b) * 2 + g) * 256) * 64; const float* vcp = KC + ((((size_t)1 * NB + b) * 2 + g) * 256) * 64;
    float m = -1e30f, l = 0.f;
#pragma unroll
    for (int d = 0; d < 16; ++d) o[d] = (f32x2){0.f, 0.f};
    for (int kt = 0; kt < nkt; ++kt) {
        __syncthreads();
        { const int r = tid >> 3, c8 = (tid & 7) * 8; const int n = kt * 64 + r;
          f32x4 a0 = {0.f, 0.f, 0.f, 0.f}, a1 = a0, b0 = a0, b1 = a0;
          if (n < 255) { a0 = *(const f32x4*)(kcp + (size_t)n * 64 + c8); a1 = *(const f32x4*)(kcp + (size_t)n * 64 + c8 + 4); b0 = *(const f32x4*)(vcp + (size_t)n * 64 + c8); b1 = *(const f32x4*)(vcp + (size_t)n * 64 + c8 + 4); }
          *(f32x4*)(lds + r * 64 + c8) = a0; *(f32x4*)(lds + r * 64 + c8 + 4) = a1; *(f32x4*)(lds + 4096 + r * 64 + c8) = b0; *(f32x4*)(lds + 4096 + r * 64 + c8 + 4) = b1; }
        __syncthreads();
        attend_tile(q, o, m, l, Kt, Vt, mask_lo(nv - kt * 64));
    }
    {   const float inv = (nv > 0) ? g0 / l : 0.f;
#pragma unroll
        for (int i = 0; i < 4; ++i) { u32x4 w; w.x = pk2(o[4 * i].x * inv, o[4 * i].y * inv); w.y = pk2(o[4 * i + 1].x * inv, o[4 * i + 1].y * inv); w.z = pk2(o[4 * i + 2].x * inv, o[4 * i + 2].y * inv); w.w = pk2(o[4 * i + 3].x * inv, o[4 * i + 3].y * inv);
            *(u32x4*)(op + 8 * i) = w; } }
    {   const float invl = (nv > 0) ? 1.f / l : 0.f; float carry = 0.f;
        for (int kt = 0; kt < 4; ++kt) {
            __syncthreads();
            if (kt < nkt) { const int r = tid >> 3, c8 = (tid & 7) * 8; const int n = kt * 64 + r;
                f32x4 a0 = {0.f, 0.f, 0.f, 0.f}, a1 = a0;
                if (n < 255) { a0 = *(const f32x4*)(kcp + (size_t)n * 64 + c8); a1 = *(const f32x4*)(kcp + (size_t)n * 64 + c8 + 4); }
                *(f32x4*)(lds + r * 64 + c8) = a0; *(f32x4*)(lds + r * 64 + c8 + 4) = a1; }
            __syncthreads();
#pragma unroll 1
            for (int mg = 0; mg < 16; ++mg) {
                float sum = carry;
                if (kt < nkt) {
#pragma unroll
                    for (int k4 = 0; k4 < 4; ++k4) { const int kk = mg * 4 + k4; const int n = kt * 64 + kk; const float* kr = Kt + kk * 64; f32x2 a2 = {0.f, 0.f};
#pragma unroll
                        for (int d4 = 0; d4 < 8; ++d4) { const f32x4 kv = *(const f32x4*)(kr + 4 * d4); a2 = q[2 * d4] * (f32x2){kv.x, kv.y} + a2; a2 = q[2 * d4 + 1] * (f32x2){kv.z, kv.w} + a2; }
                        float a = a2.x + a2.y; a += __shfl_xor(a, 1);
                        const float p = (n < nv) ? __expf(a - m) * invl : 0.f; sum += p; if (k4 == 3) carry = p; }
                } else carry = 0.f;
                sum += __shfl_xor(sum, 2); sum += __shfl_xor(sum, 4);
                if ((tid & 7) == 0) imp[tk * 64 + kt * 16 + mg] = sum;
            }
        }
    }
    __syncthreads();
    const int cur = ti;
    u64 sel = 1ull | (1ull << cur) | (cur >= 1 ? (1ull << (cur - 1)) : 0ull);
    if ((tid & 7) == 0) { const int npick = (cur - 2) < 5 ? (cur - 2) : 5; const float* ip = imp + tk * 64;
        for (int pk = 0; pk < npick; ++pk) { float best = -1.f; int bi = 1;
            for (int mm = 1; mm <= cur - 2; ++mm) { const float v = ip[mm]; if (!((sel >> mm) & 1ull) && v > best) { best = v; bi = mm; } }
            sel |= 1ull << bi; } }
    { unsigned lo = (unsigned)sel, hi = (unsigned)(sel >> 32); lo = __shfl(lo, (tid & 63) & ~7); hi = __shfl(hi, (tid & 63) & ~7); sel = ((u64)hi << 32) | lo; }
    m = -1e30f; l = 0.f;
#pragma unroll
    for (int d = 0; d < 16; ++d) o[d] = (f32x2){0.f, 0.f};
    {   const bf16* kb = P1 + (size_t)b * SEQ * P1W + C_KV + (2 * 2 + g) * 64; const bf16* vb = P1 + (size_t)b * SEQ * P1W + C_KV + (3 * 2 + g) * 64;
        for (int mb = 0; mb <= cur; ++mb) {
            __syncthreads();
            stage_kv_bf16(lds, lds + 4096, kb + (size_t)mb * 64 * P1W, vb + (size_t)mb * 64 * P1W, tid);
            __syncthreads();
            u64 vm = 0ull; if ((sel >> mb) & 1ull) vm = (mb == cur) ? mask_lo((ts & 63) + 1) : ~0ull;
            attend_tile(q, o, m, l, Kt, Vt, vm);
        } }
    {   const float inv = g1 / l;
#pragma unroll
        for (int i = 0; i < 4; ++i) { const u32x4 p = *(const u32x4*)(op + 8 * i); u32x4 w;
            w.x = pk2(bflo(p.x) + o[4 * i].x * inv, bfhi(p.x) + o[4 * i].y * inv); w.y = pk2(bflo(p.y) + o[4 * i + 1].x * inv, bfhi(p.y) + o[4 * i + 1].y * inv);
            w.z = pk2(bflo(p.z) + o[4 * i + 2].x * inv, bfhi(p.z) + o[4 * i + 2].y * inv); w.w = pk2(bflo(p.w) + o[4 * i + 3].x * inv, bfhi(p.w) + o[4 * i + 3].y * inv);
            *(u32x4*)(op + 8 * i) = w; } }
    m = -1e30f; l = 0.f;
#pragma unroll
    for (int d = 0; d < 16; ++d) o[d] = (f32x2){0.f, 0.f};
    {   const bf16* kb = P1 + (size_t)b * SEQ * P1W + C_KV + (4 * 2 + g) * 64; const bf16* vb = P1 + (size_t)b * SEQ * P1W + C_KV + (5 * 2 + g) * 64;
        const int mlo = (ti >= 8) ? ti - 8 : 0;
        for (int mb = mlo; mb <= cur; ++mb) {
            __syncthreads();
            stage_kv_bf16(lds, lds + 4096, kb + (size_t)mb * 64 * P1W, vb + (size_t)mb * 64 * P1W, tid);
            __syncthreads();
            const int lo = ts - 511 - mb * 64, hi = ts - mb * 64;
            u64 vm = 0ull; if (hi >= 0 && lo <= 63) vm = mask_lo(hi + 1) & ~mask_lo(lo);
            attend_tile(q, o, m, l, Kt, Vt, vm);
        } }
    {   const float inv = g2 / l;
#pragma unroll
        for (int i = 0; i < 4; ++i) { const u32x4 p = *(const u32x4*)(op + 8 * i); u32x4 w;
            w.x = pk2(bflo(p.x) + o[4 * i].x * inv, bfhi(p.x) + o[4 * i].y * inv); w.y = pk2(bflo(p.y) + o[4 * i + 1].x * inv, bfhi(p.y) + o[4 * i + 1].y * inv);
            w.z = pk2(bflo(p.z) + o[4 * i + 2].x * inv, bfhi(p.z) + o[4 * i + 2].y * inv); w.w = pk2(bflo(p.w) + o[4 * i + 3].x * inv, bfhi(p.w) + o[4 * i + 3].y * inv);
            *(u32x4*)(op + 8 * i) = w; } }
}

typedef float f32x16 __attribute__((ext_vector_type(16)));
typedef short s16x4 __attribute__((ext_vector_type(4)));
typedef __bf16 bf16x2_t __attribute__((ext_vector_type(2)));
constexpr int AT_KB = 8320, AT_VB = 8192;
constexpr int AT_K0 = 0, AT_V0 = 2 * AT_KB, AT_IMP = AT_V0 + 2 * AT_VB, AT_SEL = AT_IMP + 16384, AT_SELU = AT_SEL + 512;
constexpr float AT_C2 = 0.125f * 1.4426950408889634f;
__device__ __forceinline__ unsigned cvtpk_bf16(float lo, float hi) { f32x2 v = {lo, hi}; bf16x2_t b = __builtin_convertvector(v, bf16x2_t); return __builtin_bit_cast(unsigned, b); }
__device__ __forceinline__ int crow(int r, int h) { return (r & 3) + 8 * (r >> 2) + 4 * h; }
struct AtRegs { u32x4 k, v; };
__device__ __forceinline__ AtRegs at_load_bf16(const bf16* kp, const bf16* vp, int tid) {
    AtRegs r; const int key = tid >> 3, c = tid & 7;
    r.k = *(const u32x4*)(kp + (size_t)key * P1W + 8 * c); r.v = *(const u32x4*)(vp + (size_t)key * P1W + 8 * c); return r;
}
__device__ __forceinline__ AtRegs at_load_f32(const float* kp, const float* vp, int n0, int tid) {
    AtRegs r; const int key = tid >> 3, c = tid & 7; const int n = n0 + key;
    if (n < 255) { const f32x4 a0 = *(const f32x4*)(kp + (size_t)n * 64 + 8 * c), a1 = *(const f32x4*)(kp + (size_t)n * 64 + 8 * c + 4), b0 = *(const f32x4*)(vp + (size_t)n * 64 + 8 * c), b1 = *(const f32x4*)(vp + (size_t)n * 64 + 8 * c + 4);
        r.k = (u32x4){pk2(a0.x, a0.y), pk2(a0.z, a0.w), pk2(a1.x, a1.y), pk2(a1.z, a1.w)}; r.v = (u32x4){pk2(b0.x, b0.y), pk2(b0.z, b0.w), pk2(b1.x, b1.y), pk2(b1.z, b1.w)}; }
    else { r.k = (u32x4){0u, 0u, 0u, 0u}; r.v = (u32x4){0u, 0u, 0u, 0u}; }
    return r;
}
__device__ __forceinline__ void at_store(LAS unsigned char* lds, int buf, const AtRegs& r, int tid) {
    const int key = tid >> 3, c = tid & 7;
    *(LAS u32x4*)(lds + AT_K0 + buf * AT_KB + c * 1040 + key * 16) = r.k;
    *(LAS u32x4*)(lds + AT_V0 + buf * AT_VB + (c >> 2) * 4096 + key * 64 + (c & 3) * 16) = r.v;
}
__device__ __forceinline__ void at_qk(f32x16& p0, f32x16& p1, const LAS unsigned char* kb, const bf16x8 (&qr)[4], int r32, int h) {
    const f32x16 z = {0.f, 0.f, 0.f, 0.f, 0.f, 0.f, 0.f, 0.f, 0.f, 0.f, 0.f, 0.f, 0.f, 0.f, 0.f, 0.f};
    p0 = z; p1 = z;
#pragma unroll
    for (int d0 = 0; d0 < 4; ++d0) {
        const bf16x8 k0 = *(const LAS bf16x8*)(kb + (2 * d0 + h) * 1040 + r32 * 16);
        const bf16x8 k1 = *(const LAS bf16x8*)(kb + (2 * d0 + h) * 1040 + (32 + r32) * 16);
        p0 = __builtin_amdgcn_mfma_f32_32x32x16_bf16(k0, qr[d0], p0, 0, 0, 0);
        p1 = __builtin_amdgcn_mfma_f32_32x32x16_bf16(k1, qr[d0], p1, 0, 0, 0);
    }
}
__device__ __forceinline__ void at_step(const LAS unsigned char* lds, int buf, const bf16x8 (&qr)[4], f32x16 (&o)[2], float& m, float& l, u64 vm, int lane) {
    if (!__any(vm != 0ull)) return;
    const int r32 = lane & 31, h = lane >> 5;
    f32x16 p0, p1;
    at_qk(p0, p1, lds + AT_K0 + buf * AT_KB, qr, r32, h);
    const bool full = __all(vm == ~0ull);
    const unsigned vlo = (unsigned)vm, vhi = (unsigned)(vm >> 32);
    float rm = -INFINITY;
#pragma unroll
    for (int r = 0; r < 16; ++r) {
        float a = p0[r] * AT_C2, b = p1[r] * AT_C2;
        if (!full) { const int kx = crow(r, h); a = ((vlo >> kx) & 1u) ? a : -INFINITY; b = ((vhi >> kx) & 1u) ? b : -INFINITY; }
        p0[r] = a; p1[r] = b; rm = fmaxf(rm, fmaxf(a, b));
    }
    rm = fmaxf(rm, __shfl_xor(rm, 32));
    const float mn = fmaxf(m, rm); const float f = __builtin_amdgcn_exp2f(m - mn); m = mn;
    float ls = 0.f;
#pragma unroll
    for (int r = 0; r < 16; ++r) { p0[r] = __builtin_amdgcn_exp2f(p0[r] - mn); p1[r] = __builtin_amdgcn_exp2f(p1[r] - mn); ls += p0[r] + p1[r]; }
    l = l * f + ls;
#pragma unroll
    for (int r = 0; r < 16; ++r) { o[0][r] *= f; o[1][r] *= f; }
    const LAS unsigned char* vb = lds + AT_V0 + buf * AT_VB + ((lane >> 4) & 1) * 32 + (lane & 3) * 8 + (4 * h + ((lane & 15) >> 2)) * 64;
#pragma unroll
    for (int ks = 0; ks < 4; ++ks) {
        u32x4 pw;
        if (ks == 0) pw = (u32x4){cvtpk_bf16(p0[0], p0[1]), cvtpk_bf16(p0[2], p0[3]), cvtpk_bf16(p0[4], p0[5]), cvtpk_bf16(p0[6], p0[7])};
        else if (ks == 1) pw = (u32x4){cvtpk_bf16(p0[8], p0[9]), cvtpk_bf16(p0[10], p0[11]), cvtpk_bf16(p0[12], p0[13]), cvtpk_bf16(p0[14], p0[15])};
        else if (ks == 2) pw = (u32x4){cvtpk_bf16(p1[0], p1[1]), cvtpk_bf16(p1[2], p1[3]), cvtpk_bf16(p1[4], p1[5]), cvtpk_bf16(p1[6], p1[7])};
        else pw = (u32x4){cvtpk_bf16(p1[8], p1[9]), cvtpk_bf16(p1[10], p1[11]), cvtpk_bf16(p1[12], p1[13]), cvtpk_bf16(p1[14], p1[15])};
        const bf16x8 pf = __builtin_bit_cast(bf16x8, pw);
#pragma unroll
        for (int db = 0; db < 2; ++db) {
            const s16x4 lo = __builtin_bit_cast(s16x4, __builtin_amdgcn_ds_read_tr16_b64_v4i16((LAS s16x4*)(vb + db * 4096 + ks * 1024)));
            const s16x4 hi = __builtin_bit_cast(s16x4, __builtin_amdgcn_ds_read_tr16_b64_v4i16((LAS s16x4*)(vb + db * 4096 + ks * 1024 + 512)));
            const bf16x8 vf = (bf16x8){lo[0], lo[1], lo[2], lo[3], hi[0], hi[1], hi[2], hi[3]};
            o[db] = __builtin_amdgcn_mfma_f32_32x32x16_bf16(vf, pf, o[db], 0, 0, 0);
        }
    }
}
__device__ __forceinline__ void at_fold(f32x16 (&ot)[2], f32x16 (&o)[2], float& m, float& l, float gate, bool valid) {
    const float lt = l + __shfl_xor(l, 32); const float inv = (valid && lt > 0.f) ? gate / lt : 0.f;
#pragma unroll
    for (int r = 0; r < 16; ++r) { ot[0][r] += o[0][r] * inv; ot[1][r] += o[1][r] * inv; o[0][r] = 0.f; o[1][r] = 0.f; }
    m = -1e30f; l = 0.f;
}
__device__ __forceinline__ void attn_unit_mfma(LAS unsigned char* lds, bf16* P1, const float* KC, int unit) {
    const int tid = opaque_tid(); const int lane = tid & 63, w = __builtin_amdgcn_readfirstlane(tid >> 6), r32 = lane & 31, h = lane >> 5;
    const int ti = unit & 63, g = (unit >> 6) & 1, b = unit >> 7;
    const int tq = 8 * w + (r32 >> 2), j = r32 & 3, hd = 4 * g + j; const int ts = 64 * ti + tq;
    const size_t row = (size_t)b * SEQ + ts;
    LAS float* IMP = (LAS float*)(lds + AT_IMP); LAS u64* SEL = (LAS u64*)(lds + AT_SEL); LAS unsigned* SELU = (LAS unsigned*)(lds + AT_SELU);
    __syncthreads();
    for (int e = tid; e < 4096; e += 512) IMP[e] = 0.f;
    if (tid < 2) SELU[tid] = 0u;
    bf16x8 qr[4];
    { const bf16* qp = P1 + row * P1W + C_Q + hd * 64 + 8 * h;
#pragma unroll
      for (int d0 = 0; d0 < 4; ++d0) qr[d0] = *(const bf16x8*)(qp + 16 * d0); }
    const float g0 = bf2f(P1[row * P1W + C_GC + hd * 3 + 0]), g1 = bf2f(P1[row * P1W + C_GC + hd * 3 + 1]), g2 = bf2f(P1[row * P1W + C_GC + hd * 3 + 2]);
    f32x16 o[2], ot[2];
#pragma unroll
    for (int r = 0; r < 16; ++r) { o[0][r] = 0.f; o[1][r] = 0.f; ot[0][r] = 0.f; ot[1][r] = 0.f; }
    float m = -1e30f, l = 0.f;
    const int nv = (ts >= 31) ? ((((ts + 1) >> 4) - 1 > 255) ? 255 : ((ts + 1) >> 4) - 1) : 0;
    const int nkt = (4 * ti + 3 + 63) >> 6;
    const float* kcp = KC + ((((size_t)0 * NB + b) * 2 + g) * 256) * 64; const float* vcp = KC + ((((size_t)1 * NB + b) * 2 + g) * 256) * 64;
    {   AtRegs rg = at_load_f32(kcp, vcp, 0, tid); at_store(lds, 0, rg, tid); __syncthreads();
        for (int kt = 0; kt < nkt; ++kt) {
            if (kt + 1 < nkt) rg = at_load_f32(kcp, vcp, 64 * (kt + 1), tid);
            at_step(lds, kt & 1, qr, o, m, l, mask_lo(nv - 64 * kt), lane);
            if (kt + 1 < nkt) at_store(lds, (kt + 1) & 1, rg, tid);
            __syncthreads();
        }
        const float lt = l + __shfl_xor(l, 32); const float invl = (nv > 0 && lt > 0.f) ? 1.f / lt : 0.f;
        float prevL = 0.f;
        rg = at_load_f32(kcp, vcp, 0, tid); at_store(lds, 0, rg, tid); __syncthreads();
        for (int kt = 0; kt < nkt; ++kt) {
            if (kt + 1 < nkt) rg = at_load_f32(kcp, vcp, 64 * (kt + 1), tid);
            f32x16 p0, p1; at_qk(p0, p1, lds + AT_K0 + (kt & 1) * AT_KB, qr, r32, h);
            const u64 vm = mask_lo(nv - 64 * kt); const unsigned vlo = (unsigned)vm, vhi = (unsigned)(vm >> 32);
#pragma unroll
            for (int r = 0; r < 16; ++r) { const int kx = crow(r, h);
                p0[r] = ((vlo >> kx) & 1u) ? __builtin_amdgcn_exp2f(p0[r] * AT_C2 - m) * invl : 0.f;
                p1[r] = ((vhi >> kx) & 1u) ? __builtin_amdgcn_exp2f(p1[r] * AT_C2 - m) * invl : 0.f; }
#pragma unroll
            for (int hh = 0; hh < 2; ++hh) {
                float G[4], Lp[4];
#pragma unroll
                for (int q4 = 0; q4 < 4; ++q4) { const float a0 = hh ? p1[4 * q4] : p0[4 * q4], a1 = hh ? p1[4 * q4 + 1] : p0[4 * q4 + 1], a2 = hh ? p1[4 * q4 + 2] : p0[4 * q4 + 2], a3 = hh ? p1[4 * q4 + 3] : p0[4 * q4 + 3];
                    G[q4] = (a0 + a1) + (a2 + a3); Lp[q4] = __shfl_xor(a3, 32); }
#pragma unroll
                for (int q4 = 0; q4 < 4; ++q4) {
                    const float carry = h ? Lp[q4] : (q4 == 0 ? prevL : Lp[q4 - 1]);
                    float v = G[q4] + carry; v += __shfl_xor(v, 1); v += __shfl_xor(v, 2);
                    if (j == 0) IMP[tq * 64 + 16 * kt + 8 * hh + 2 * q4 + h] = v;
                }
                prevL = Lp[3];
            }
            if (kt + 1 < nkt) at_store(lds, (kt + 1) & 1, rg, tid);
            __syncthreads();
        }
    }
    at_fold(ot, o, m, l, g0, nv > 0);
    __syncthreads();
    const int cur = ti;
    if (tid < 64) {
        u64 sel = 1ull | (1ull << cur) | (cur >= 1 ? (1ull << (cur - 1)) : 0ull);
        const int npick = (cur - 2) < 5 ? (cur - 2) : 5; const LAS float* ip = IMP + tid * 64;
        for (int pk = 0; pk < npick; ++pk) { float best = -1.f; int bi = 1;
            for (int mm = 1; mm <= cur - 2; ++mm) { const float v = ip[mm]; if (!((sel >> mm) & 1ull) && v > best) { best = v; bi = mm; } }
            sel |= 1ull << bi; }
        SEL[tid] = sel; atomicOr((unsigned*)&SELU[0], (unsigned)sel); atomicOr((unsigned*)&SELU[1], (unsigned)(sel >> 32));
    }
    __syncthreads();
    const u64 sel = SEL[tq];
    const u64 selu = ((u64)SELU[1] << 32) | (u64)SELU[0];
    {   const bf16* kb = P1 + (size_t)b * SEQ * P1W + C_KV + (2 * 2 + g) * 64; const bf16* vbp = P1 + (size_t)b * SEQ * P1W + C_KV + (3 * 2 + g) * 64;
        u64 rem = selu; int mb = __builtin_ctzll(rem); rem &= rem - 1; int it = 0;
        AtRegs rg = at_load_bf16(kb + (size_t)mb * 64 * P1W, vbp + (size_t)mb * 64 * P1W, tid); at_store(lds, 0, rg, tid); __syncthreads();
        for (;;) {
            const bool more = rem != 0ull; int mbn = 0;
            if (more) { mbn = __builtin_ctzll(rem); rem &= rem - 1; rg = at_load_bf16(kb + (size_t)mbn * 64 * P1W, vbp + (size_t)mbn * 64 * P1W, tid); }
            u64 vm = 0ull; if ((sel >> mb) & 1ull) vm = (mb == cur) ? mask_lo((ts & 63) + 1) : ~0ull;
            at_step(lds, it & 1, qr, o, m, l, vm, lane);
            if (more) at_store(lds, (it + 1) & 1, rg, tid);
            __syncthreads();
            if (!more) break;
            mb = mbn; ++it;
        }
    }
    at_fold(ot, o, m, l, g1, true);
    {   const bf16* kb = P1 + (size_t)b * SEQ * P1W + C_KV + (4 * 2 + g) * 64; const bf16* vbp = P1 + (size_t)b * SEQ * P1W + C_KV + (5 * 2 + g) * 64;
        const int mlo = (ti >= 8) ? ti - 8 : 0;
        AtRegs rg = at_load_bf16(kb + (size_t)mlo * 64 * P1W, vbp + (size_t)mlo * 64 * P1W, tid); at_store(lds, 0, rg, tid); __syncthreads();
        for (int mb = mlo; mb <= cur; ++mb) {
            if (mb < cur) rg = at_load_bf16(kb + (size_t)(mb + 1) * 64 * P1W, vbp + (size_t)(mb + 1) * 64 * P1W, tid);
            const int lo = ts - 511 - mb * 64, hi = ts - mb * 64;
            u64 vm = 0ull; if (hi >= 0 && lo <= 63) vm = mask_lo(hi + 1) & ~mask_lo(lo);
            at_step(lds, (mb - mlo) & 1, qr, o, m, l, vm, lane);
            if (mb < cur) at_store(lds, (mb - mlo + 1) & 1, rg, tid);
            __syncthreads();
        }
    }
    at_fold(ot, o, m, l, g2, true);
    {   bf16* op = P1 + row * P1W + C_Q + hd * 64 + 4 * h;
#pragma unroll
        for (int db = 0; db < 2; ++db)
#pragma unroll
            for (int q4 = 0; q4 < 4; ++q4) { u32x2 wv; wv.x = cvtpk_bf16(ot[db][4 * q4], ot[db][4 * q4 + 1]); wv.y = cvtpk_bf16(ot[db][4 * q4 + 2], ot[db][4 * q4 + 3]); *(u32x2*)(op + 32 * db + 8 * q4) = wv; } }
}

constexpr int NPH = 1 + 9 * NL;
__global__ void __launch_bounds__(512, 2) fwd_kernel(Args args) {
    extern __shared__ __attribute__((aligned(16))) unsigned char lds_raw[];
    LAS unsigned char* ldsl = (LAS unsigned char*)lds_raw;
    float* ldsf = (float*)lds_raw;
    const int G = gridDim.x, bx = blockIdx.x, NGW = G * 8;
#define PHASE_IDS() const int tid = opaque_tid(), lane = tid & 63, wave = __builtin_amdgcn_readfirstlane(tid >> 6), gw = bx * 8 + wave; (void)lane; (void)gw
#define ws ARG_WS()
#define ctl ((unsigned*)(ws + WS_CTL))
#define H ARG_OUT()
#define XN ((bf16*)(ws + WS_XN))
#define P1 ((bf16*)(ws + WS_P1))
#define Rr ((bf16*)(ws + WS_R))
#define WIN ((bf16*)(ws + WS_WIN))
#define WB ((bf16*)(ws + WS_WB))
#define WOUT ((bf16*)(ws + WS_WOUT))
#define WGU ((bf16*)(ws + WS_WGU))
#define WD ((bf16*)(ws + WS_WD))
#define HID ((bf16*)(ws + WS_HID))
#define Y ((bf16*)(ws + WS_Y))
#define KC ((float*)(ws + WS_KC))
#define AGA ((float*)(ws + WS_LRUA))
#define AGH ((float*)(ws + WS_LRUH))
#define LIST ((unsigned*)(ws + WS_LIST))
#define LISTW ((float*)(ws + WS_LISTW))
    { PHASE_IDS(); for (int u = tid; u < (LDS_BYTES - LDS_CTL) / 4; u += 512) ((LAS unsigned*)(ldsl + LDS_CTL))[u] = 0u; }
    __syncthreads();
    XcdBarrier bar; bar.bar = ctl + CW_BAR; bar.x = 0; bar.st = nullptr;
    if (!MK_SPLIT) bar = xcd_barrier_post(ctl + CW_BAR, (volatile LAS unsigned*)(ldsl + LDS_CTL + 32));
    const int lo = args.ph_lo, hi = args.ph_hi;
#define IN(k) (lo <= (k) && (k) < hi)
#define SEAM(k) do { if (!MK_SPLIT && IN((k) + 1)) xcd_barrier(bar); } while (0)
    const LAS int* tab = (const LAS int*)(ldsl + LDS_MOE);

    if (IN(0)) {
        PHASE_IDS();
        float* scr = ldsf + wave * 4096;
        constexpr int IT_WIN = 16 * 249, IT_WB = 8 * 32, IT_WO = 16 * 32;
        constexpr int NIT = NL * IT_WIN + NL * 4 * IT_WB + NL * IT_WO;
        for (int it = gw; it < NIT; it += NGW) {
            int r = it;
            if (r < NL * IT_WIN) { const int l = r / IT_WIN; r -= l * IT_WIN; tr_item(ARG_IN(I_WIN) + (size_t)l * D * NIN, D, NIN, WIN + (size_t)l * NPROJ * D, scr, r / 249, r % 249, lane, [](int s) { return win_dst_row(s); }); continue; }
            r -= NL * IT_WIN;
            if (r < NL * 4 * IT_WB) { const int ln = r / IT_WB; r -= ln * IT_WB; tr_item(ARG_IN(I_WBR) + (size_t)ln * 512 * 1024, 512, 1024, WB + (size_t)ln * 1024 * 512, scr, r / 32, r % 32, lane, [](int s) { return s; }); continue; }
            r -= NL * 4 * IT_WB;
            { const int l = r / IT_WO; r -= l * IT_WO; tr_item(ARG_IN(I_WOUT) + (size_t)l * 1024 * 1024, 1024, 1024, WOUT + (size_t)l * 1024 * 1024, scr, r / 32, r % 32, lane, [](int s) { return s; }); }
        }
        for (int e = bx * 512 + tid; e < NL * 232 * 128; e += G * 512) { const int l = e / (232 * 128), rr = (e / 128) % 232, c8 = (e % 128) * 8;
            *(u32x4*)(WIN + ((size_t)l * NPROJ + C_GC + 24 + rr) * D + c8) = (u32x4){0u, 0u, 0u, 0u}; }
        for (int m = gw; m < T; m += NGW) norm_row<0>(ARG_IN(I_X) + (size_t)m * D, H + (size_t)m * D, nullptr, nullptr, ARG_IN(I_N1G), XN + (size_t)m * D, lane);
    }
    SEAM(0);

    for (int l = 0; l < NL; ++l) {
        const int pb = 1 + 9 * l;
        if (IN(pb + 0)) {
            SchedDense S{XN, WIN + (size_t)l * NPROJ * D, D, D, T / 256, NPROJ / 256, G, bx};
            EpiProj E{P1, Rr};
            pg8::gemm_phase<EpiProj, SchedDense, true>(ldsl, D, S, E);
        }
        SEAM(pb + 0);
        if (IN(pb + 1)) {
            constexpr int U_LRU = NB * 64 * 8, U_GM = 128 * 4, U_CMP = 256;
            for (int u = bx; u < U_LRU + U_GM + U_CMP; u += G) {
                if (u < U_CMP) cmp_unit(ldsf, P1, KC, ARG_IN(I_PE) + (size_t)l * 2 * 2048, ARG_IN(I_CW1) + (size_t)l * 4 * 2048 * 64, ARG_IN(I_CW2) + (size_t)l * 4 * 4096, u);
                else if (u < U_CMP + U_GM) gmlp_unit(ldsf, P1, ARG_IN(I_GMNG) + l * 512, ARG_IN(I_GMWS) + (size_t)l * 4 * 16384, ARG_IN(I_GMB) + l * 512, u - U_CMP);
                else lru_unit(ldsf, P1, XN, AGA, AGH, ARG_IN(I_CONVW) + l * 2048, ARG_IN(I_CONVB) + l * 512, ARG_IN(I_LWA) + (size_t)l * 8 * 4096, ARG_IN(I_LBA) + l * 512,
                              ARG_IN(I_LWX) + (size_t)l * 8 * 4096, ARG_IN(I_LBX) + l * 512, ARG_IN(I_LLAM) + l * 512, u - U_CMP - U_GM);
            }
            __syncthreads();
        }
        SEAM(pb + 1);
        if (IN(pb + 2)) {
            constexpr int U_AT = NB * 2 * 64, U_PL = NB * 64 * 4, U_FX = NB * 64;
            for (int u = bx; u < U_AT + U_PL + U_FX; u += G) {
                if (u < U_AT) { const int k = u >> 3, bg = u & 7; const int ti = (u < 256) ? 63 - k : k - 32; attn_unit_mfma(ldsl, P1, KC, (bg << 6) | ti); }
                else if (u < U_AT + U_PL) pool_unit(ldsf, P1, ARG_IN(I_PW) + (size_t)l * 4 * 16384, ARG_IN(I_PS) + l * 512, u - U_AT);
                else lrufix_unit(P1, XN, AGA, AGH, u - U_AT - U_PL);
            }
            __syncthreads();
        }
        SEAM(pb + 2);
        if (IN(pb + 3)) {
            SchedMerge S{P1, WB + (size_t)l * 4 * 1024 * 512, G, bx};
            EpiMerge E{Rr, XN};
            pg8::gemm_phase<EpiMerge, SchedMerge, false>(ldsl, 512, S, E);
        }
        SEAM(pb + 3);
        if (IN(pb + 4)) {
            SchedDense S{XN, WOUT + (size_t)l * 1024 * 1024, D, D, T / 256, 4, G, bx};
            EpiWout E{H};
            pg8::gemm_phase<EpiWout, SchedDense, false>(ldsl, D, S, E);
        }
        SEAM(pb + 4);
        if (IN(pb + 5)) {
            PHASE_IDS();
            {   float* scr = ldsf + wave * 4096;
                constexpr int IT_G = 16 * 16, IT_D = 8 * 32;
                for (int it = gw; it < 16 * (2 * IT_G + IT_D); it += NGW) {
                    const int e = it / (2 * IT_G + IT_D); int r = it % (2 * IT_G + IT_D);
                    if (r < IT_G) tr_item(ARG_IN(I_MG) + ((size_t)l * 16 + e) * 1024 * 512, 1024, 512, WGU + (size_t)e * 1024 * 1024, scr, r / 16, r % 16, lane, [](int s) { return 256 * (s >> 7) + (s & 127); });
                    else if (r < 2 * IT_G) { r -= IT_G; tr_item(ARG_IN(I_MU) + ((size_t)l * 16 + e) * 1024 * 512, 1024, 512, WGU + (size_t)e * 1024 * 1024, scr, r / 16, r % 16, lane, [](int s) { return 256 * (s >> 7) + 128 + (s & 127); }); }
                    else { r -= 2 * IT_G; tr_item(ARG_IN(I_MD) + ((size_t)l * 16 + e) * 512 * 1024, 512, 1024, WD + (size_t)e * 1024 * 512, scr, r / 32, r % 32, lane, [](int s) { return s; }); }
                }
            }
            __syncthreads();
            for (int e = tid; e < 1024 * 20; e += 512) { const int k = e / 20, o = e % 20;
                ldsf[o * 1024 + k] = (o < 4) ? ARG_IN(I_RWG)[(size_t)l * 4096 + k * 4 + o] : ARG_IN(I_RWE)[(size_t)l * 16384 + k * 16 + (o - 4)]; }
            __syncthreads();
            const float* g2 = ARG_IN(I_N2G) + l * D; const float* bg = ARG_IN(I_RBG) + l * 4; const float* be = ARG_IN(I_RBE) + l * 16;
            unsigned* cnt = ctl + CW_CNT + 64 * l;
            for (int m = gw; m < T; m += NGW) {
                const float* hr = H + (size_t)m * D; f32x4 v[4]; float ss = 0.f;
#pragma unroll
                for (int jj = 0; jj < 4; ++jj) { v[jj] = *(const f32x4*)(hr + 4 * lane + 256 * jj); ss += (v[jj].x * v[jj].x + v[jj].y * v[jj].y) + (v[jj].z * v[jj].z + v[jj].w * v[jj].w); }
                const float rstd = rsqrtf(wave_sum(ss) * (1.f / D) + EPS);
#pragma unroll
                for (int jj = 0; jj < 4; ++jj) { const f32x4 gg = *(const f32x4*)(g2 + 4 * lane + 256 * jj); v[jj].x *= rstd * gg.x; v[jj].y *= rstd * gg.y; v[jj].z *= rstd * gg.z; v[jj].w *= rstd * gg.w;
                    u32x2 o; o.x = pk2(v[jj].x, v[jj].y); o.y = pk2(v[jj].z, v[jj].w); *(u32x2*)(XN + (size_t)m * D + 4 * lane + 256 * jj) = o; }
                float lg[20];
#pragma unroll
                for (int o = 0; o < 20; ++o) { float a = 0.f;
#pragma unroll
                    for (int jj = 0; jj < 4; ++jj) { const f32x4 wv = *(const f32x4*)(ldsf + o * 1024 + 4 * lane + 256 * jj); a += v[jj].x * wv.x + v[jj].y * wv.y + v[jj].z * wv.z + v[jj].w * wv.w; }
                    lg[o] = wave_sum(a); if ((o & 3) == 3) __builtin_amdgcn_sched_barrier(0); }
                float gl[4]; int grp = 0; float gmx;
#pragma unroll
                for (int k = 0; k < 4; ++k) gl[k] = lg[k] + bg[k];
                gmx = gl[0];
#pragma unroll
                for (int k = 1; k < 4; ++k) if (gl[k] > gmx) { gmx = gl[k]; grp = k; }
                float den = 0.f;
#pragma unroll
                for (int k = 0; k < 4; ++k) den += __expf(gl[k] - gmx);
                const float grpw = 1.f / den;
                float el[4];
#pragma unroll
                for (int k = 0; k < 4; ++k) { float vsel = 0.f;
#pragma unroll
                    for (int gg = 0; gg < 4; ++gg) vsel = (grp == gg) ? (lg[4 + gg * 4 + k] + be[gg * 4 + k]) : vsel;
                    el[k] = vsel; }
                int i1 = 0; float m1 = el[0];
#pragma unroll
                for (int k = 1; k < 4; ++k) if (el[k] > m1) { m1 = el[k]; i1 = k; }
                int i2 = -1; float m2 = 0.f;
#pragma unroll
                for (int k = 0; k < 4; ++k) if (k != i1 && (i2 < 0 || el[k] > m2)) { m2 = el[k]; i2 = k; }
                const float ex = __expf(m2 - m1); const float w1 = grpw / (1.f + ex), w2 = grpw * ex / (1.f + ex);
                if (lane == 0) {
                    const int e1 = grp * 4 + i1, e2 = grp * 4 + i2;
                    const unsigned p1 = atomicAdd(&cnt[e1], 1u); LIST[(size_t)e1 * T + p1] = (unsigned)m; LISTW[(size_t)e1 * T + p1] = w1;
                    const unsigned p2 = atomicAdd(&cnt[e2], 1u); LIST[(size_t)e2 * T + p2] = (unsigned)m | (1u << 14); LISTW[(size_t)e2 * T + p2] = w2;
                }
            }
            __syncthreads();
        }
        SEAM(pb + 5);
        if (IN(pb + 6) || IN(pb + 7)) {
            __syncthreads();
            if (threadIdx.x == 0) { LAS int* tw = (LAS int*)(ldsl + LDS_MOE); int acc = 0;
                for (int e = 0; e < 16; ++e) { const int c = (int)__hip_atomic_load(ctl + CW_CNT + 64 * l + e, __ATOMIC_RELAXED, __HIP_MEMORY_SCOPE_AGENT); tw[e] = acc; tw[32 + e] = c; acc += (c + 255) >> 8; }
                tw[16] = acc; }
            __syncthreads();
        }
        if (IN(pb + 6)) {
            SchedMoe S{XN, WGU, LIST, D, D, 1024, G, bx, true, tab};
            EpiGateUp E{HID, LISTW, tab};
            pg8::gemm_phase<EpiGateUp, SchedMoe, true>(ldsl, D, S, E);
        }
        SEAM(pb + 6);
        if (IN(pb + 7)) {
            SchedMoe S{HID, WD, LIST, 512, 512, 1024, G, bx, false, tab};
            EpiDown E{Y, LIST, tab};
            pg8::gemm_phase<EpiDown, SchedMoe, true>(ldsl, 512, S, E);
        }
        SEAM(pb + 7);
        if (IN(pb + 8)) {
            PHASE_IDS();
            if (l + 1 < NL) { for (int m = gw; m < T; m += NGW) norm_row<1>(nullptr, H + (size_t)m * D, Y + (size_t)m * D, Y + ((size_t)T + m) * D, ARG_IN(I_N1G) + (l + 1) * D, XN + (size_t)m * D, lane); }
            else { for (int m = gw; m < T; m += NGW) norm_row<2>(nullptr, H + (size_t)m * D, Y + (size_t)m * D, Y + ((size_t)T + m) * D, ARG_IN(I_FNG), nullptr, lane); }
        }
        if (l + 1 < NL) SEAM(pb + 8);
    }
#undef IN
#undef SEAM
#undef ws
#undef ctl
#undef H
#undef XN
#undef P1
#undef Rr
#undef WIN
#undef WB
#undef WOUT
#undef WGU
#undef WD
#undef HID
#undef Y
#undef KC
#undef AGA
#undef AGH
#undef LIST
#undef LISTW
}

extern "C" void kernel_launch(void* const* d_in, const int* in_sizes, int n_in, void* d_out, int out_size, void* d_ws, size_t ws_size, hipStream_t stream) {
    static int grid = 0;
    if (grid == 0) {
        if (n_in != 29 || in_sizes[0] != T * D || out_size != T * D || ws_size < WS_END) { fprintf(stderr, "kernel_launch: unexpected shapes / workspace (%d inputs, ws %zu < %zu); nothing launched\n", n_in, ws_size, (size_t)WS_END); grid = -1; return; }
        int dev = 0, cus = 0;
        if (hipGetDevice(&dev) != hipSuccess || hipDeviceGetAttribute(&cus, hipDeviceAttributeMultiprocessorCount, dev) != hipSuccess) { grid = -1; return; }
        if (hipFuncSetAttribute((const void*)fwd_kernel, hipFuncAttributeMaxDynamicSharedMemorySize, LDS_BYTES) != hipSuccess) { fprintf(stderr, "kernel_launch: hipFuncSetAttribute failed\n"); grid = -1; return; }
        int per_cu = 0;
        if (hipOccupancyMaxActiveBlocksPerMultiprocessor(&per_cu, (const void*)fwd_kernel, 512, LDS_BYTES) != hipSuccess || per_cu < 1) { fprintf(stderr, "kernel_launch: occupancy query says %d\n", per_cu); }
        (void)hipGetLastError();
        grid = cus;
    }
    if (grid < 0) return;
    if (hipMemsetAsync((char*)d_ws + WS_CTL, 0, CTL_ZERO_BYTES, stream) != hipSuccess) return;
    Args a{};
    for (int i = 0; i < 29; ++i) a.in[i] = (const float*)d_in[i];
    a.out = (float*)d_out; a.ws = (unsigned char*)d_ws;
#if MK_SPLIT
    for (int p = 0; p < NPH; ++p) { a.ph_lo = p; a.ph_hi = p + 1; hipLaunchKernelGGL(fwd_kernel, dim3(grid), dim3(512), LDS_BYTES, stream, a); }
#else
    a.ph_lo = 0; a.ph_hi = NPH;
    hipLaunchKernelGGL(fwd_kernel, dim3(grid), dim3(512), LDS_BYTES, stream, a);
#endif
}
```

```cpp
#include <hip/hip_runtime.h>
#include <cstdio>
#include <cstdint>

#define GAS __attribute__((address_space(1)))
#define LAS __attribute__((address_space(3)))
typedef unsigned short bf16;
typedef unsigned u32x4 __attribute__((ext_vector_type(4)));
typedef unsigned u32x2 __attribute__((ext_vector_type(2)));
typedef float f32x4 __attribute__((ext_vector_type(4)));
typedef float f32x2 __attribute__((ext_vector_type(2)));
typedef short bf16x8 __attribute__((ext_vector_type(8)));
typedef unsigned long long u64;

#ifndef MK_SPLIT
#define MK_SPLIT 0
#endif

constexpr int NB = 4, SEQ = 4096, T = NB * SEQ, D = 1024, MIX = 512, NL = 2;
constexpr int NIN = 7960, NPROJ = 8192, P1W = 4096;
constexpr int C_U = 0, C_V = 512, C_GB = 1024, C_RB = 1536, C_Q = 2048, C_KV = 2560, C_XD = 3328, C_GC = 3840;
constexpr int SRC_GC = 3328, SRC_XD = 3352, SRC_MG = 3864;
constexpr float EPS = 1e-6f;
constexpr int NEXP = 16, DEXP = 512;
constexpr int HID_ROWS = 2 * T + 4096;

constexpr size_t MiB = 1u << 20;
constexpr size_t WS_CTL = 0, CTL_ZERO_BYTES = 1 * MiB;
constexpr size_t WS_KC = 1 * MiB;
constexpr size_t WS_LRUA = 2 * MiB;
constexpr size_t WS_LRUH = 2 * MiB + 512 * 1024;
constexpr size_t WS_LIST = 3 * MiB;
constexpr size_t WS_LISTW = 4 * MiB;
constexpr size_t WS_W1T = 5 * MiB;
constexpr size_t WS_LWT = 7 * MiB;
constexpr size_t WS_PWT = 7 * MiB + 256 * 1024;
constexpr size_t WS_WIN = 8 * MiB;
constexpr size_t WS_WB = 40 * MiB;
constexpr size_t WS_WOUT = 48 * MiB;
constexpr size_t WS_XN = 52 * MiB;
constexpr size_t WS_P1 = 84 * MiB;
constexpr size_t WS_R = 212 * MiB;
constexpr size_t WS_WGU = 84 * MiB;
constexpr size_t WS_WD = 116 * MiB;
constexpr size_t WS_HID = 132 * MiB;
constexpr size_t WS_Y = 168 * MiB;
constexpr size_t WS_END = 340 * MiB;
static_assert(WS_HID + (size_t)HID_ROWS * 512 * 2 <= WS_Y && WS_Y + (size_t)2 * T * 1024 * 2 <= WS_END, "ws map");

constexpr int CW_BAR = 4096;
constexpr int CW_CNT = 8192;

__device__ __forceinline__ unsigned f2bf(float f) { unsigned u = __builtin_bit_cast(unsigned, f); return (u + 0x7fffu + ((u >> 16) & 1u)) >> 16; }
__device__ __forceinline__ unsigned pk2(float lo, float hi) { return f2bf(lo) | (f2bf(hi) << 16); }
__device__ __forceinline__ float bflo(unsigned u) { return __builtin_bit_cast(float, u << 16); }
__device__ __forceinline__ float bfhi(unsigned u) { return __builtin_bit_cast(float, u & 0xffff0000u); }
__device__ __forceinline__ float bf2f(bf16 h) { return __builtin_bit_cast(float, (unsigned)h << 16); }
__device__ __forceinline__ float sigmoidf_(float x) { return 1.0f / (1.0f + __expf(-x)); }
__device__ __forceinline__ float gelu_tanh(float x) { const float z = 1.5957691216057308f * (x + 0.044715f * x * x * x); return x * sigmoidf_(z); }
__device__ __forceinline__ float wave_sum(float v) {
#pragma unroll
    for (int o = 1; o < 64; o <<= 1) v += __shfl_xor(v, o);
    return v;
}
__device__ __forceinline__ u64 mask_lo(int n) { return n >= 64 ? ~0ull : (n <= 0 ? 0ull : ((1ull << n) - 1ull)); }
#define LDS_WAIT() asm volatile("s_waitcnt lgkmcnt(0)" ::: "memory")
#ifndef PROBE_PH
#define PROBE_PH -1
#endif
constexpr int LDS_BYTES = 147456;
constexpr int LDS_CTL = 146432;
constexpr int LDS_MOE = LDS_CTL + 256;
__device__ __forceinline__ bool is_dry() {
#if PROBE_PH >= 0
    extern __shared__ __attribute__((aligned(16))) unsigned char lds_raw_[]; return ((volatile LAS int*)((LAS unsigned char*)lds_raw_ + LDS_CTL + 64))[0] != 0;
#else
    return false;
#endif
}
#define GST(...) do { if (!is_dry()) { __VA_ARGS__; } } while (0)
__device__ __forceinline__ int opaque_tid() { int t = (int)threadIdx.x; asm volatile("" : "+v"(t)); return t; }

namespace pg8 {
constexpr int BM = 256, BK = 64, HALF = 128, HTB = HALF * BK * 2, NXCD = 8, WGM = 8;
__host__ __device__ __forceinline__ int lds_byte(int r, int c) { const int st = (r >> 4) * 2 + (c >> 5), rr = r & 15, cc = c & 31, ob = rr * 64 + cc * 2; return st * 1024 + (ob ^ (((ob >> 9) & 1) << 5)); }
__host__ __device__ __forceinline__ void stage_rc(int b, int& R, int& C) { const int st = b / 1024, sb = b % 1024, swz = sb ^ (((sb >> 9) & 1) << 5); R = (st >> 1) * 16 + swz / 64; C = (st & 1) * 32 + (swz % 64) / 2; }
__host__ __device__ __forceinline__ int perm32(int rho) { const int n = rho >> 4, i = rho & 15; return 8 * (i >> 2) + 4 * n + (i & 3); }

struct Unit { const char* A; const char* B; int pm, pn, sub, e; };

__device__ __forceinline__ bool static_tile(int i, int G, int c, int nM, int nN, int& pm, int& pn) {
    const int nwg = nM * nN; const long L = (long)i * G + c; if (L >= nwg) return false;
    int wgid = (int)L; { const int q = nwg / NXCD, r = nwg % NXCD, xcd = wgid % NXCD, off = wgid / NXCD; wgid = (xcd < r ? xcd * (q + 1) : r * (q + 1) + (xcd - r) * q) + off; }
    const int nig = WGM * nN, gid = wgid / nig, fm = gid * WGM, gsz = (nM - fm) < WGM ? (nM - fm) : WGM;
    pm = fm + ((wgid % nig) % gsz); pn = (wgid % nig) / gsz; return true;
}

template <class Epi, class Sched, bool ALIGN_EPI>
__device__ __forceinline__ void gemm_phase(LAS unsigned char* lds, const int K, const Sched& S, const Epi& E) {
    const int tid = opaque_tid(), wid = __builtin_amdgcn_readfirstlane(tid >> 6), lane = tid & 63, wr = wid >> 2, wc = wid & 3, fr = lane & 15, fq = lane >> 4;
    const int nt = K / BK;
    unsigned voffB[2];
#pragma unroll
    for (int i = 0; i < 2; ++i) { int R, C; stage_rc(tid * 16 + i * 8192, R, C); const int Rb = (R & ~31) + perm32(R & 31); voffB[i] = (unsigned)(Rb * K + C) * 2u; }
    const size_t kstep = (size_t)(BK * 2);
    const size_t hstepB = (size_t)HALF * K * 2;
    const unsigned ldsw = (unsigned)wid * 1024u;
    const int aoff = lds_byte(wr * 64 + fr, fq * 8), boff = lds_byte(wc * 32 + fr, fq * 8);
#define PG8_SA(b, h) (((b) * 2 + (h)) * HTB)
#define PG8_SB(b, h) ((4 + (b) * 2 + (h)) * HTB)
#define PG8_STAGE(bufoff, gbase, voff) do { _Pragma("unroll") for (int _i = 0; _i < 2; ++_i) \
        __builtin_amdgcn_global_load_lds((const unsigned*)((const char*)(gbase) + (voff)[_i]), (LAS unsigned*)(lds + (bufoff) + ldsw + _i * 8192), 16, 0, 0); } while (0)
#define PG8_LDA(dst, b, h) do { _Pragma("unroll") for (int m = 0; m < 4; ++m) _Pragma("unroll") for (int k = 0; k < 2; ++k) dst[m][k] = *(const LAS bf16x8*)(lds + PG8_SA(b, h) + aoff + m * 2048 + k * 1024); } while (0)
#define PG8_LDB(dst, b, h) do { _Pragma("unroll") for (int n = 0; n < 2; ++n) _Pragma("unroll") for (int k = 0; k < 2; ++k) dst[n][k] = *(const LAS bf16x8*)(lds + PG8_SB(b, h) + boff + n * 2048 + k * 1024); } while (0)
#define PG8_MMA(ai, bj, At, Bt) do { __builtin_amdgcn_s_setprio(1); _Pragma("unroll") for (int m = 0; m < 4; ++m) _Pragma("unroll") for (int n = 0; n < 2; ++n) _Pragma("unroll") for (int k = 0; k < 2; ++k) \
        acc[ai][bj][m][n] = __builtin_amdgcn_mfma_f32_16x16x32_bf16(Bt[n][k], At[m][k], acc[ai][bj][m][n], 0, 0, 0); __builtin_amdgcn_s_setprio(0); } while (0)
#define PG8_WAIT_V(n) asm volatile("s_waitcnt vmcnt(" #n ")" ::: "memory")
#define PG8_WAIT_L(n) asm volatile("s_waitcnt lgkmcnt(" #n ")" ::: "memory")
#define PG8_BAR __builtin_amdgcn_s_barrier()
#define PG8_SCHED __builtin_amdgcn_sched_barrier(0)
#define PG8_ZERO() do { _Pragma("unroll") for (int a = 0; a < 2; ++a) _Pragma("unroll") for (int b = 0; b < 2; ++b) _Pragma("unroll") for (int m = 0; m < 4; ++m) _Pragma("unroll") for (int n = 0; n < 2; ++n) acc[a][b][m][n] = (f32x4){0.f, 0.f, 0.f, 0.f}; } while (0)
    Unit cur, nxt; int ui = 0;
    if (!S.next(0, cur)) return;
    f32x4 acc[2][2][4][2];
    PG8_ZERO();
    bf16x8 At[4][2], B0[2][2], B1[2][2];
    unsigned voA[2][2], voN[2][2];
    S.a_off(cur, voA);
    const char* cA = cur.A; const char* cB = cur.B;
    PG8_STAGE(PG8_SB(0, 0), cB, voffB); PG8_STAGE(PG8_SB(0, 1), cB + hstepB, voffB); PG8_STAGE(PG8_SA(0, 0), cA, voA[0]); PG8_STAGE(PG8_SA(0, 1), cA, voA[1]);
    if (wr == 1) PG8_BAR;
    PG8_WAIT_V(2); PG8_BAR;
    PG8_STAGE(PG8_SB(1, 0), cB + kstep, voffB); PG8_STAGE(PG8_SA(1, 0), cA + kstep, voA[0]); PG8_STAGE(PG8_SB(1, 1), cB + hstepB + kstep, voffB);
    PG8_WAIT_V(6); PG8_BAR;
    for (;;) {
        const bool has_next = S.next(ui + 1, nxt);
        const char* nA = has_next ? nxt.A : cA; const char* nB = has_next ? nxt.B : cB;
        if (has_next) S.a_off(nxt, voN); else { voN[0][0] = voA[0][0]; voN[0][1] = voA[0][1]; voN[1][0] = voA[1][0]; voN[1][1] = voA[1][1]; }
        for (int t = 0; t < nt; t += 2) {
            const bool last = (t == nt - 2);
            const char* a1 = cA + (size_t)(t + 1) * kstep;
            const char* a2 = last ? nA : cA + (size_t)(t + 2) * kstep; const char* b2 = last ? nB : cB + (size_t)(t + 2) * kstep;
            const char* a3 = a2 + kstep; const char* b3 = b2 + kstep;
            PG8_LDB(B0, 0, 0); PG8_LDB(B1, 0, 1); PG8_SCHED; PG8_LDA(At, 0, 0); PG8_STAGE(PG8_SA(1, 1), a1, voA[1]);
            PG8_WAIT_V(8); PG8_WAIT_L(0); PG8_BAR; PG8_MMA(0, 0, At, B0); PG8_MMA(0, 1, At, B1); PG8_BAR; PG8_SCHED;
            if (last) { voA[0][0] = voN[0][0]; voA[0][1] = voN[0][1]; voA[1][0] = voN[1][0]; voA[1][1] = voN[1][1]; }
            PG8_LDA(At, 0, 1); PG8_STAGE(PG8_SB(0, 0), b2, voffB); PG8_STAGE(PG8_SB(0, 1), b2 + hstepB, voffB); PG8_STAGE(PG8_SA(0, 0), a2, voA[0]);
            PG8_WAIT_V(8); PG8_WAIT_L(0); PG8_BAR; PG8_MMA(1, 0, At, B0); PG8_MMA(1, 1, At, B1); PG8_BAR; PG8_SCHED;
            PG8_LDB(B0, 1, 0); PG8_LDB(B1, 1, 1); PG8_SCHED; PG8_LDA(At, 1, 0); PG8_STAGE(PG8_SA(0, 1), a2, voA[1]);
            PG8_WAIT_V(8); PG8_WAIT_L(0); PG8_BAR; PG8_MMA(0, 0, At, B0); PG8_MMA(0, 1, At, B1); PG8_BAR; PG8_SCHED;
            PG8_LDA(At, 1, 1); PG8_STAGE(PG8_SB(1, 0), b3, voffB); PG8_STAGE(PG8_SB(1, 1), b3 + hstepB, voffB); PG8_STAGE(PG8_SA(1, 0), a3, voA[0]);
            PG8_WAIT_V(8); PG8_WAIT_L(0); PG8_BAR; PG8_MMA(1, 0, At, B0); PG8_MMA(1, 1, At, B1); PG8_BAR; PG8_SCHED;
        }
        if constexpr (ALIGN_EPI) { if (wr == 0) PG8_BAR; }
        int tz = lane; asm volatile("" : "+v"(tz));
        const bool z = E(acc, cur, wr, wc, tz & 15, tz >> 4);
        if (!has_next) break;
        if (z) PG8_ZERO();
        cur = nxt; cA = nA; cB = nB; ++ui;
        if constexpr (ALIGN_EPI) { if (wr == 1) PG8_BAR; }
    }
    PG8_WAIT_V(0);
    if constexpr (!ALIGN_EPI) { if (wr == 0) PG8_BAR; }
    PG8_BAR;
#undef PG8_SA
#undef PG8_SB
#undef PG8_STAGE
#undef PG8_LDA
#undef PG8_LDB
#undef PG8_MMA
#undef PG8_WAIT_V
#undef PG8_WAIT_L
#undef PG8_BAR
#undef PG8_SCHED
#undef PG8_ZERO
}
}

#define XB_TMO      128
#define XB_XCNT(j)  (256  + 64 * (j))
#define XB_XSUB(j)  (1280 + 64 * (j))
#define XB_XGEN(j)  (2304 + 64 * (j))
#define XB_TOP      3328
#define XB_TOPGEN   3392
#define XCD_BAR_WORDS 3456
#define XB_SPIN_CAP (1u << 23)
__device__ __forceinline__ unsigned xb_ld(unsigned* p)              { return __hip_atomic_load(p, __ATOMIC_RELAXED, __HIP_MEMORY_SCOPE_AGENT); }
__device__ __forceinline__ unsigned xb_add(unsigned* p, unsigned v) { return __hip_atomic_fetch_add(p, v, __ATOMIC_RELAXED, __HIP_MEMORY_SCOPE_AGENT); }
__device__ __forceinline__ unsigned xb_xcc_id() { return (unsigned)__builtin_amdgcn_s_getreg((3 << 11) | 20) & 0xFu; }
#define XB_SPIN(cond, bar) do { unsigned _sp = 0; while (cond) { __builtin_amdgcn_s_sleep(1); \
    if ((++_sp & 255u) == 0u) { if (xb_ld(&(bar)[XB_TMO])) break; if (_sp > XB_SPIN_CAP) { atomicAdd(&(bar)[XB_TMO], 1u); break; } } } } while (0)
struct XcdBarrier { unsigned* bar; unsigned x; volatile LAS unsigned* st; };
__device__ __forceinline__ XcdBarrier xcd_barrier_post(unsigned* bar, volatile LAS unsigned* st) {
    XcdBarrier b; b.bar = bar; b.x = xb_xcc_id(); b.st = st;
    if (threadIdx.x == 0) (void)xb_add(&bar[XB_XCNT(b.x)], 1u);
    return b;
}
__device__ __forceinline__ void xcd_barrier_complete(unsigned* bar, unsigned x, unsigned& nloc, unsigned& nx) {
    const unsigned G = gridDim.x * gridDim.y * gridDim.z;
    unsigned sum, cnt, mine, sp = 0u;
    for (;;) {
        sum = 0u; cnt = 0u; mine = 0u;
#pragma unroll
        for (unsigned j = 0; j < 16; ++j) { const unsigned c = xb_ld(&bar[XB_XCNT(j)]); sum += c; cnt += (c > 0u) ? 1u : 0u; mine = (j == x) ? c : mine; }
        if (sum == G) break;
        __builtin_amdgcn_s_sleep(1);
        if ((++sp & 255u) == 0u) { if (xb_ld(&bar[XB_TMO])) break; if (sp > XB_SPIN_CAP) { atomicAdd(&bar[XB_TMO], 1u); break; } }
    }
    nloc = mine > 0u ? mine : 1u; nx = cnt > 0u ? cnt : 1u;
}
__device__ __forceinline__ void xcd_barrier(const XcdBarrier& b) {
    asm volatile("s_waitcnt vmcnt(0)" ::: "memory");
    __syncthreads();
    if (threadIdx.x == 0) {
        unsigned* bar = b.bar;
        __builtin_amdgcn_s_waitcnt(0);
        unsigned nloc = b.st[0], nx = b.st[1];
        if (nloc == 0u) { xcd_barrier_complete(bar, b.x, nloc, nx); b.st[0] = nloc; b.st[1] = nx; }
        const unsigned old = xb_add(&bar[XB_XSUB(b.x)], 1u);
        const unsigned gen = old / nloc;
        if (old + 1u == (gen + 1u) * nloc) {
            __builtin_amdgcn_fence(__ATOMIC_RELEASE, "agent");
            asm volatile("s_waitcnt vmcnt(0)" ::: "memory");
            const unsigned og = xb_add(&bar[XB_TOP], 1u);
            const unsigned tg = og / nx;
            if (og + 1u == (tg + 1u) * nx) xb_add(&bar[XB_TOPGEN], 1u);
            else XB_SPIN(xb_ld(&bar[XB_TOPGEN]) == tg, bar);
            __builtin_amdgcn_fence(__ATOMIC_ACQUIRE, "agent");
            xb_add(&bar[XB_XGEN(b.x)], 1u);
            asm volatile("s_waitcnt vmcnt(0)" ::: "memory");
        } else {
            XB_SPIN(xb_ld(&bar[XB_XGEN(b.x)]) == gen, bar);
            __builtin_amdgcn_fence(__ATOMIC_ACQUIRE, "agent");
            asm volatile("s_waitcnt vmcnt(0)" ::: "memory");
        }
    }
    __syncthreads();
}

struct Args { const float* in[29]; float* out; unsigned char* ws; int ph_lo, ph_hi; };
enum { I_X = 0, I_N1G, I_WIN, I_GMNG, I_GMWS, I_GMB, I_CONVW, I_CONVB, I_LWA, I_LBA, I_LWX, I_LBX, I_LLAM, I_PE, I_CW1, I_CW2, I_PW, I_PS, I_WBR, I_WOUT, I_N2G, I_RWG, I_RBG, I_RWE, I_RBE, I_MG, I_MU, I_MD, I_FNG };

#define CAS __attribute__((address_space(4)))
__device__ __forceinline__ unsigned long long karg_u64(int off) { const CAS char* kp = (const CAS char*)__builtin_amdgcn_kernarg_segment_ptr(); asm volatile("" : "+s"(kp)); return *(const CAS unsigned long long*)(kp + off); }
#define ARG_IN(k) ((const float*)karg_u64(8 * (k)))
#define ARG_OUT() ((float*)karg_u64(8 * 29))
#define ARG_WS() ((unsigned char*)karg_u64(8 * 30))
template <class F>
__device__ __forceinline__ void tr_item(const float* W, int K, int N, bf16* WT, float* scr, int kb, int nb, int lane, F dst) {
    const int k0 = 64 * kb, n0 = 32 * nb;
    const int nn = n0 + (lane & 31);
#pragma unroll 8
    for (int i = 0; i < 32; ++i) { const int kk = 2 * i + (lane >> 5); scr[kk * 33 + (lane & 31)] = (nn < N) ? W[(size_t)(k0 + kk) * N + nn] : 0.f; }
    LDS_WAIT(); asm volatile("" ::: "memory");
    const int c = lane & 7;
#pragma unroll
    for (int j = 0; j < 4; ++j) { const int nl = (lane >> 3) + 8 * j; const int n = n0 + nl; const float* s = scr + (8 * c) * 33 + nl;
        u32x4 o; o.x = pk2(s[0 * 33], s[1 * 33]); o.y = pk2(s[2 * 33], s[3 * 33]); o.z = pk2(s[4 * 33], s[5 * 33]); o.w = pk2(s[6 * 33], s[7 * 33]);
        if (n < N) GST(*(u32x4*)(WT + (size_t)dst(n) * K + k0 + 8 * c) = o); }
    LDS_WAIT(); asm volatile("" ::: "memory");
}
__device__ __forceinline__ int win_dst_row(int s) {
    if (s < SRC_GC) return s;
    if (s < SRC_XD) return C_GC + (s - SRC_GC);
    if (s < SRC_MG) return C_XD + (s - SRC_XD);
    const int n = (s - SRC_MG) >> 10, d = (s - SRC_MG) & 1023;
    return P1W + 256 * (d >> 6) + 128 * (n >> 1) + 32 * ((d >> 4) & 3) + 8 * ((d >> 2) & 3) + 4 * (n & 1) + (d & 3);
}
template <int MODE>
__device__ __forceinline__ void norm_row(const float* xrow, float* hrow, const bf16* y0, const bf16* y1, const float* g, bf16* xn, int lane) {
    f32x4 v[4]; float ss = 0.f;
#pragma unroll
    for (int j = 0; j < 4; ++j) {
        const int c = 4 * lane + 256 * j;
        v[j] = *(const f32x4*)((MODE == 0 ? xrow : hrow) + c);
        if (MODE != 0) { const u32x2 a = *(const u32x2*)(y0 + c), b = *(const u32x2*)(y1 + c);
            v[j].x += bflo(a.x) + bflo(b.x); v[j].y += bfhi(a.x) + bfhi(b.x); v[j].z += bflo(a.y) + bflo(b.y); v[j].w += bfhi(a.y) + bfhi(b.y); }
        ss += (v[j].x * v[j].x + v[j].y * v[j].y) + (v[j].z * v[j].z + v[j].w * v[j].w);
    }
    const float rstd = rsqrtf(wave_sum(ss) * (1.f / D) + EPS);
#pragma unroll
    for (int j = 0; j < 4; ++j) {
        const int c = 4 * lane + 256 * j;
        const f32x4 gg = *(const f32x4*)(g + c);
        if (MODE == 2) { GST(*(f32x4*)(hrow + c) = (f32x4){v[j].x * rstd * gg.x, v[j].y * rstd * gg.y, v[j].z * rstd * gg.z, v[j].w * rstd * gg.w}); }
        else { GST(*(f32x4*)(hrow + c) = v[j]);
            u32x2 o; o.x = pk2(v[j].x * rstd * gg.x, v[j].y * rstd * gg.y); o.y = pk2(v[j].z * rstd * gg.z, v[j].w * rstd * gg.w); GST(*(u32x2*)(xn + c) = o); }
    }
}

struct SchedDense {
    const bf16* A; const bf16* Bt; int lda, K, nM, nN, G, c;
    __device__ __forceinline__ bool next(int i, pg8::Unit& u) const {
        int pm, pn; if (!pg8::static_tile(i, G, c, nM, nN, pm, pn)) return false;
        u.pm = pm; u.pn = pn; u.sub = 0; u.e = 0; u.A = (const char*)(A + (size_t)pm * 256 * lda); u.B = (const char*)(Bt + (size_t)pn * 256 * K); return true;
    }
    __device__ __forceinline__ void a_off(const pg8::Unit&, unsigned (&vo)[2][2]) const {
        const int tz = opaque_tid();
#pragma unroll
        for (int i = 0; i < 2; ++i) { int R, C; pg8::stage_rc(tz * 16 + i * 8192, R, C);
#pragma unroll
            for (int h = 0; h < 2; ++h) vo[h][i] = (unsigned)((h * 128 + R) * lda + C) * 2u; }
    }
};
struct SchedMerge {
    const bf16* P1; const bf16* Wb; int G, c;
    __device__ __forceinline__ bool next(int i, pg8::Unit& u) const {
        const int ti = i >> 2, sub = i & 3; int pm, pn; if (!pg8::static_tile(ti, G, c, T / 256, 4, pm, pn)) return false;
        const int ycol = (sub == 0) ? C_U : (sub == 1) ? C_GB : (sub == 2) ? C_Q : C_V;
        u.pm = pm; u.pn = pn; u.sub = sub; u.e = 0;
        u.A = (const char*)(P1 + (size_t)pm * 256 * P1W + ycol); u.B = (const char*)(Wb + ((size_t)sub * 1024 + (size_t)pn * 256) * 512); return true;
    }
    __device__ __forceinline__ void a_off(const pg8::Unit&, unsigned (&vo)[2][2]) const {
        const int tz = opaque_tid();
#pragma unroll
        for (int i = 0; i < 2; ++i) { int R, C; pg8::stage_rc(tz * 16 + i * 8192, R, C);
#pragma unroll
            for (int h = 0; h < 2; ++h) vo[h][i] = (unsigned)((h * 128 + R) * P1W + C) * 2u; }
    }
};
struct SchedMoe {
    const bf16* A; const bf16* Bt; const unsigned* list; int lda, K, brows  , G, c; bool gather; const LAS int* tab;
    __device__ __forceinline__ bool next(int i, pg8::Unit& u) const {
        const int L = i * G + c; const int tot = __builtin_amdgcn_readfirstlane(tab[16]); if (L >= 4 * tot) return false;
        const int rtg = L >> 2, pn = L & 3; int e = 0, st = 0;
#pragma unroll
        for (int k = 1; k < 16; ++k) { const int tk = __builtin_amdgcn_readfirstlane(tab[k]); if (rtg >= tk) { e = k; st = tk; } }
        u.e = e; u.pm = rtg; u.sub = rtg - st; u.pn = pn;
        u.A = gather ? (const char*)A : (const char*)(A + (size_t)rtg * 256 * lda);
        u.B = (const char*)(Bt + ((size_t)e * brows + (size_t)pn * 256) * K); return true;
    }
    __device__ __forceinline__ void a_off(const pg8::Unit& u, unsigned (&vo)[2][2]) const {
        const int cnt = __builtin_amdgcn_readfirstlane(tab[32 + u.e]); const unsigned* le = list + (size_t)u.e * T + u.sub * 256;
        int tz = (int)threadIdx.x; asm volatile("" : "+v"(tz));
#pragma unroll
        for (int i = 0; i < 2; ++i) { int R, C; pg8::stage_rc(tz * 16 + i * 8192, R, C);
#pragma unroll
            for (int h = 0; h < 2; ++h) {
                int row = h * 128 + R;
                if (gather) { row = (u.sub * 256 + row < cnt) ? (int)(le[row] & 0x3fffu) : 0; }
                vo[h][i] = (unsigned)(row * lda + C) * 2u;
            } }
    }
};

struct EpiProj {
    bf16* P1; bf16* Rr;
    __device__ __forceinline__ bool operator()(f32x4 (&acc)[2][2][4][2], const pg8::Unit& u, int wr, int wc, int fr, int fq) const {
        const int row0 = u.pm * 256 + wr * 64 + fr;
        if (u.pn < 16) {
            const int act = (u.pn < 6) ? 1 : (u.pn == 15 ? 2 : 0);
#pragma unroll
            for (int ai = 0; ai < 2; ++ai)
#pragma unroll
                for (int m = 0; m < 4; ++m) { bf16* rowp = P1 + (size_t)(row0 + ai * 128 + m * 16) * P1W + u.pn * 256 + wc * 32 + 8 * fq;
#pragma unroll
                    for (int bj = 0; bj < 2; ++bj) { f32x4 v0 = acc[ai][bj][m][0], v1 = acc[ai][bj][m][1];
                        if (act == 1) { v0 = (f32x4){gelu_tanh(v0.x), gelu_tanh(v0.y), gelu_tanh(v0.z), gelu_tanh(v0.w)}; v1 = (f32x4){gelu_tanh(v1.x), gelu_tanh(v1.y), gelu_tanh(v1.z), gelu_tanh(v1.w)}; }
                        else if (act == 2) { v0 = (f32x4){sigmoidf_(v0.x), sigmoidf_(v0.y), sigmoidf_(v0.z), sigmoidf_(v0.w)}; v1 = (f32x4){sigmoidf_(v1.x), sigmoidf_(v1.y), sigmoidf_(v1.z), sigmoidf_(v1.w)}; }
                        u32x4 w; w.x = pk2(v0.x, v0.y); w.y = pk2(v0.z, v0.w); w.z = pk2(v1.x, v1.y); w.w = pk2(v1.z, v1.w);
                        GST(*(u32x4*)(rowp + bj * 128) = w); } }
        } else {
            const int dcol = 64 * (u.pn - 16) + 16 * wc + 4 * fq;
#pragma unroll
            for (int ai = 0; ai < 2; ++ai)
#pragma unroll
                for (int m = 0; m < 4; ++m) { const size_t row = (size_t)(row0 + ai * 128 + m * 16);
                    float r0[4], r1[4], r2[4], r3[4];
#pragma unroll
                    for (int i = 0; i < 4; ++i) {
                        const float g0 = fmaxf(sigmoidf_(acc[ai][0][m][0][i]), 1e-20f), g1 = fmaxf(sigmoidf_(acc[ai][0][m][1][i]), 1e-20f);
                        const float g2 = fmaxf(sigmoidf_(acc[ai][1][m][0][i]), 1e-20f), g3 = fmaxf(sigmoidf_(acc[ai][1][m][1][i]), 1e-20f);
                        r0[i] = g0 / g1; r1[i] = g1 / g2; r2[i] = g2 / g3; r3[i] = g3; }
                    u32x2 w;
                    w.x = pk2(r0[0], r0[1]); w.y = pk2(r0[2], r0[3]); GST(*(u32x2*)(Rr + ((size_t)0 * T + row) * 1024 + dcol) = w);
                    w.x = pk2(r1[0], r1[1]); w.y = pk2(r1[2], r1[3]); GST(*(u32x2*)(Rr + ((size_t)1 * T + row) * 1024 + dcol) = w);
                    w.x = pk2(r2[0], r2[1]); w.y = pk2(r2[2], r2[3]); GST(*(u32x2*)(Rr + ((size_t)2 * T + row) * 1024 + dcol) = w);
                    w.x = pk2(r3[0], r3[1]); w.y = pk2(r3[2], r3[3]); GST(*(u32x2*)(Rr + ((size_t)3 * T + row) * 1024 + dcol) = w); }
        }
        return true;
    }
};
struct EpiMerge {
    const bf16* Rr; bf16* O;
    __device__ __forceinline__ bool operator()(f32x4 (&acc)[2][2][4][2], const pg8::Unit& u, int wr, int wc, int fr, int fq) const {
        const int row0 = u.pm * 256 + wr * 64 + fr, col0 = u.pn * 256 + wc * 32 + 8 * fq;
        const bf16* Rn = Rr + (size_t)u.sub * T * 1024;
#pragma unroll
        for (int ai = 0; ai < 2; ++ai)
#pragma unroll
            for (int m = 0; m < 4; ++m) { const size_t ro = (size_t)(row0 + ai * 128 + m * 16) * 1024 + col0;
#pragma unroll
                for (int bj = 0; bj < 2; ++bj) { const u32x4 r = *(const u32x4*)(Rn + ro + bj * 128);
                    f32x4& v0 = acc[ai][bj][m][0]; f32x4& v1 = acc[ai][bj][m][1];
                    v0.x *= bflo(r.x); v0.y *= bfhi(r.x); v0.z *= bflo(r.y); v0.w *= bfhi(r.y); v1.x *= bflo(r.z); v1.y *= bfhi(r.z); v1.z *= bflo(r.w); v1.w *= bfhi(r.w);
                    if (u.sub == 3) { u32x4 w; w.x = pk2(v0.x, v0.y); w.y = pk2(v0.z, v0.w); w.z = pk2(v1.x, v1.y); w.w = pk2(v1.z, v1.w); GST(*(u32x4*)(O + ro + bj * 128) = w); } } }
        return u.sub == 3;
    }
};
struct EpiWout {
    float* H;
    __device__ __forceinline__ bool operator()(f32x4 (&acc)[2][2][4][2], const pg8::Unit& u, int wr, int wc, int fr, int fq) const {
        const int row0 = u.pm * 256 + wr * 64 + fr, col0 = u.pn * 256 + wc * 32 + 8 * fq;
#pragma unroll
        for (int ai = 0; ai < 2; ++ai)
#pragma unroll
            for (int m = 0; m < 4; ++m) { float* rp = H + (size_t)(row0 + ai * 128 + m * 16) * 1024 + col0;
#pragma unroll
                for (int bj = 0; bj < 2; ++bj)
#pragma unroll
                    for (int n = 0; n < 2; ++n) { f32x4* p = (f32x4*)(rp + bj * 128 + 4 * n); f32x4 h = *p; h = h + acc[ai][bj][m][n]; GST(*p = h); } }
        return true;
    }
};
struct EpiGateUp {
    bf16* HID; const float* lw; const LAS int* tab;
    __device__ __forceinline__ bool operator()(f32x4 (&acc)[2][2][4][2], const pg8::Unit& u, int wr, int wc, int fr, int fq) const {
        const int cnt = __builtin_amdgcn_readfirstlane(tab[32 + u.e]);
#pragma unroll
        for (int ai = 0; ai < 2; ++ai)
#pragma unroll
            for (int m = 0; m < 4; ++m) { const int rl = ai * 128 + wr * 64 + m * 16 + fr; const int lr = u.sub * 256 + rl;
                const bool ok = lr < cnt; const float w = ok ? lw[(size_t)u.e * T + lr] : 0.f;
                float o[8];
#pragma unroll
                for (int n = 0; n < 2; ++n)
#pragma unroll
                    for (int i = 0; i < 4; ++i) { const float g = acc[ai][0][m][n][i], up = acc[ai][1][m][n][i]; o[4 * n + i] = ok ? g * sigmoidf_(g) * up * w : 0.f; }
                u32x4 wv; wv.x = pk2(o[0], o[1]); wv.y = pk2(o[2], o[3]); wv.z = pk2(o[4], o[5]); wv.w = pk2(o[6], o[7]);
                GST(*(u32x4*)(HID + ((size_t)u.pm * 256 + rl) * 512 + u.pn * 128 + wc * 32 + 8 * fq) = wv); }
        return true;
    }
};
struct EpiDown {
    bf16* Y; const unsigned* list; const LAS int* tab;
    __device__ __forceinline__ bool operator()(f32x4 (&acc)[2][2][4][2], const pg8::Unit& u, int wr, int wc, int fr, int fq) const {
        const int cnt = __builtin_amdgcn_readfirstlane(tab[32 + u.e]);
#pragma unroll
        for (int ai = 0; ai < 2; ++ai)
#pragma unroll
            for (int m = 0; m < 4; ++m) { const int rl = ai * 128 + wr * 64 + m * 16 + fr; const int lr = u.sub * 256 + rl;
                if (lr < cnt) { const unsigned en = list[(size_t)u.e * T + lr]; const unsigned tok = en & 0x3fffu, slot = en >> 14;
                    bf16* rp = Y + ((size_t)slot * T + tok) * 1024 + u.pn * 256 + wc * 32 + 8 * fq;
#pragma unroll
                    for (int bj = 0; bj < 2; ++bj) { const f32x4 v0 = acc[ai][bj][m][0], v1 = acc[ai][bj][m][1];
                        u32x4 w; w.x = pk2(v0.x, v0.y); w.y = pk2(v0.z, v0.w); w.z = pk2(v1.x, v1.y); w.w = pk2(v1.z, v1.w); GST(*(u32x4*)(rp + bj * 128) = w); } } }
        return true;
    }
};

__device__ __forceinline__ void gmlp_unit(float* lds, bf16* P1, const float* gng, const float* gws, const float* gmb, int unit) {
    const int tid = opaque_tid(); const int c = unit >> 2, g = unit & 3; const size_t t0 = (size_t)c * 128;
    float* Wt = lds; float* Vn = lds + 16384; float* rs = lds + 32768;
    __syncthreads();
    {
        const int tk = tid >> 2, qu = tid & 3; const bf16* vp = P1 + (t0 + tk) * P1W + C_V + qu * 128; float ss = 0.f;
#pragma unroll 4
        for (int i = 0; i < 16; ++i) { const u32x4 w = *(const u32x4*)(vp + 8 * i);
            ss += bflo(w.x) * bflo(w.x) + bfhi(w.x) * bfhi(w.x) + bflo(w.y) * bflo(w.y) + bfhi(w.y) * bfhi(w.y) + bflo(w.z) * bflo(w.z) + bfhi(w.z) * bfhi(w.z) + bflo(w.w) * bflo(w.w) + bfhi(w.w) * bfhi(w.w); }
        ss += __shfl_xor(ss, 1); ss += __shfl_xor(ss, 2);
        if (qu == 0) rs[tk] = rsqrtf(ss * (1.f / 512.f) + EPS);
    }
    for (int e = tid; e < 128 * 128; e += 512) { const int t = e >> 7, s = e & 127; Wt[e] = (s <= t) ? gws[(size_t)g * 16384 + e] : 0.f; }
    __syncthreads();
    for (int e = tid; e < 128 * 16; e += 512) { const int s = e >> 4, c8 = (e & 15) * 8; const u32x4 w = *(const u32x4*)(P1 + (t0 + s) * P1W + C_V + g * 128 + c8);
        const float r = rs[s]; const float* gp = gng + g * 128 + c8; float* o = Vn + s * 128 + c8;
        o[0] = bflo(w.x) * r * gp[0]; o[1] = bfhi(w.x) * r * gp[1]; o[2] = bflo(w.y) * r * gp[2]; o[3] = bfhi(w.y) * r * gp[3];
        o[4] = bflo(w.z) * r * gp[4]; o[5] = bfhi(w.z) * r * gp[5]; o[6] = bflo(w.w) * r * gp[6]; o[7] = bfhi(w.w) * r * gp[7]; }
    __syncthreads();
    const int tg = tid >> 5, c4 = (tid & 31) * 4;
    f32x4 acc[8];
#pragma unroll
    for (int k = 0; k < 8; ++k) acc[k] = (f32x4){0.f, 0.f, 0.f, 0.f};
    const int smax = tg * 8 + 7;
    for (int s = 0; s <= smax; ++s) { const f32x4 v = *(const f32x4*)(Vn + s * 128 + c4);
#pragma unroll
        for (int k = 0; k < 8; ++k) { const float w = Wt[(tg * 8 + k) * 128 + s]; acc[k] = acc[k] + v * w; } }
#pragma unroll
    for (int k = 0; k < 8; ++k) { const int tl = tg * 8 + k; const float bb = gmb[g * 128 + tl];
        bf16* up = P1 + (t0 + tl) * P1W + C_U + g * 128 + c4; const u32x2 uu = *(const u32x2*)up;
        u32x2 o; o.x = pk2(bflo(uu.x) * (acc[k].x + bb), bfhi(uu.x) * (acc[k].y + bb)); o.y = pk2(bflo(uu.y) * (acc[k].z + bb), bfhi(uu.y) * (acc[k].w + bb)); GST(*(u32x2*)up = o); }
}

__device__ __forceinline__ void lru_unit(float* lds, const bf16* P1, bf16* XN, float* AGA, float* AGH, const float* convw, const float* convb, const float* wa, const float* ba, const float* wx, const float* bx, const float* lam, int unit) {
    const int tid = opaque_tid(); const int h = unit & 7, tile = (unit >> 3) & 63, b = unit >> 9; const int ch0 = h * 64;
    const size_t row0 = (size_t)b * SEQ + tile * 64;
    float* xc = lds; float* Wa = lds + 4096; float* Wx = lds + 8192; float* av = lds + 12288; float* bv = lds + 16384;
    __syncthreads();
    {
        const int tt = tid >> 3, c8 = (tid & 7) * 8; const int ts = tile * 64 + tt;
        float o[8];
#pragma unroll
        for (int i = 0; i < 8; ++i) o[i] = convb[ch0 + c8 + i];
#pragma unroll
        for (int k = 0; k < 4; ++k) { const int sp = ts + k - 3; if (sp >= 0) { const u32x4 w = *(const u32x4*)(P1 + ((size_t)b * SEQ + sp) * P1W + C_RB + ch0 + c8); const float* cw = convw + k * 512 + ch0 + c8;
                o[0] += bflo(w.x) * cw[0]; o[1] += bfhi(w.x) * cw[1]; o[2] += bflo(w.y) * cw[2]; o[3] += bfhi(w.y) * cw[3]; o[4] += bflo(w.z) * cw[4]; o[5] += bfhi(w.z) * cw[5]; o[6] += bflo(w.w) * cw[6]; o[7] += bfhi(w.w) * cw[7]; } }
#pragma unroll
        for (int i = 0; i < 8; ++i) xc[tt * 64 + c8 + i] = o[i];
    }
    for (int e = tid; e < 4096; e += 512) { Wa[e] = wa[(size_t)h * 4096 + e]; Wx[e] = wx[(size_t)h * 4096 + e]; }
    __syncthreads();
    {
        const int co = tid & 63, tg = tid >> 6; float ar[8], ai[8];
#pragma unroll
        for (int k = 0; k < 8; ++k) { ar[k] = 0.f; ai[k] = 0.f; }
        for (int ci = 0; ci < 64; ++ci) { const float wav = Wa[ci * 64 + co], wxv = Wx[ci * 64 + co];
#pragma unroll
            for (int k = 0; k < 8; ++k) { const float x = xc[(tg * 8 + k) * 64 + ci]; ar[k] += x * wav; ai[k] += x * wxv; } }
        const float bav = ba[ch0 + co], bxv = bx[ch0 + co]; const float lm = lam[ch0 + co];
        const float sp = (-lm > 20.f) ? -lm : log1pf(__expf(-lm));
#pragma unroll
        for (int k = 0; k < 8; ++k) { const int tt = tg * 8 + k; const float r = sigmoidf_(ar[k] + bav), ig = sigmoidf_(ai[k] + bxv);
            const float la = -8.0f * r * sp; const float a = __expf(la); const float bt = sqrtf(fmaxf(-expm1f(2.0f * la), 0.f)) * (ig * xc[tt * 64 + co]);
            av[tt * 64 + co] = a; bv[tt * 64 + co] = bt; }
    }
    __syncthreads();
    if (tid < 64) { float hr = 0.f, ac = 1.f;
        for (int tt = 0; tt < 64; ++tt) { const float a = av[tt * 64 + tid], bt = bv[tt * 64 + tid]; hr = a * hr + bt; ac *= a; bv[tt * 64 + tid] = hr; av[tt * 64 + tid] = ac; }
        GST(AGA[((size_t)b * 64 + tile) * 512 + ch0 + tid] = ac); GST(AGH[((size_t)b * 64 + tile) * 512 + ch0 + tid] = hr); }
    __syncthreads();
    {   const int tt = tid >> 3, c8 = (tid & 7) * 8; const float* hp = bv + tt * 64 + c8; const float* ap = av + tt * 64 + c8;
        u32x4 w; w.x = pk2(hp[0], hp[1]); w.y = pk2(hp[2], hp[3]); w.z = pk2(hp[4], hp[5]); w.w = pk2(hp[6], hp[7]);
        GST(*(u32x4*)(XN + (row0 + tt) * 1024 + ch0 + c8) = w);
        w.x = pk2(ap[0], ap[1]); w.y = pk2(ap[2], ap[3]); w.z = pk2(ap[4], ap[5]); w.w = pk2(ap[6], ap[7]);
        GST(*(u32x4*)(XN + (row0 + tt) * 1024 + 512 + ch0 + c8) = w); }
}
__device__ __forceinline__ void lrufix_unit(bf16* P1, const bf16* XN, const float* AGA, const float* AGH, int unit) {
    const int ch = opaque_tid(); const int tile = unit & 63, b = unit >> 6;
    float c = 0.f;
    for (int i = 0; i < tile; ++i) { const float a = AGA[((size_t)b * 64 + i) * 512 + ch], hh = AGH[((size_t)b * 64 + i) * 512 + ch]; c = a * c + hh; }
    const size_t row0 = (size_t)b * SEQ + tile * 64;
    for (int tt = 0; tt < 64; ++tt) { const float hl = bf2f(XN[(row0 + tt) * 1024 + ch]), ac = bf2f(XN[(row0 + tt) * 1024 + 512 + ch]);
        bf16* gp = P1 + (row0 + tt) * P1W + C_GB + ch; GST(*gp = (bf16)f2bf(bf2f(*gp) * (hl + ac * c))); }
}
__device__ __forceinline__ void pool_unit(float* lds, bf16* P1, const float* pw, const float* ps, int unit) {
    const int tid = opaque_tid(); const int gi = unit & 3, tile = (unit >> 2) & 63, b = unit >> 8; const int w = 2 << gi;
    float* xs = lds; float* Pw = lds + 10240; float* pl = lds + 26624;
    __syncthreads();
    for (int e = tid; e < 79 * 16; e += 512) { const int r = e >> 4, c8 = (e & 15) * 8; const int sp = tile * 64 + r - 15; float* o = xs + r * 128 + c8;
        if (sp >= 0) { const u32x4 v = *(const u32x4*)(P1 + ((size_t)b * SEQ + sp) * P1W + C_XD + gi * 128 + c8);
            o[0] = bflo(v.x); o[1] = bfhi(v.x); o[2] = bflo(v.y); o[3] = bfhi(v.y); o[4] = bflo(v.z); o[5] = bfhi(v.z); o[6] = bflo(v.w); o[7] = bfhi(v.w); }
        else { o[0] = 0.f; o[1] = 0.f; o[2] = 0.f; o[3] = 0.f; o[4] = 0.f; o[5] = 0.f; o[6] = 0.f; o[7] = 0.f; } }
    for (int e = tid; e < 16384; e += 512) Pw[e] = pw[(size_t)gi * 16384 + e];
    __syncthreads();
    {   const int ci = tid & 127, tq = tid >> 7;
        for (int k = 0; k < 16; ++k) { const int tt = tq * 16 + k; const int ts = tile * 64 + tt; float s = 0.f;
            for (int j = 0; j < w; ++j) s += xs[(tt + 15 - j) * 128 + ci];
            const int cnt = (ts + 1 < w) ? ts + 1 : w;
            pl[tt * 128 + ci] = s / (float)cnt - xs[(tt + 15) * 128 + ci]; } }
    __syncthreads();
    {   const int co = tid & 127, tq = tid >> 7; float acc[16];
#pragma unroll
        for (int k = 0; k < 16; ++k) acc[k] = 0.f;
        for (int ci = 0; ci < 128; ++ci) { const float wv = Pw[ci * 128 + co];
#pragma unroll
            for (int k = 0; k < 16; ++k) acc[k] += pl[(tq * 16 + k) * 128 + ci] * wv; }
        const float sc = ps[gi * 128 + co];
#pragma unroll
        for (int k = 0; k < 16; ++k) GST(P1[((size_t)b * SEQ + tile * 64 + tq * 16 + k) * P1W + C_V + gi * 128 + co] = (bf16)f2bf(acc[k] * sc)); }
}
__device__ __forceinline__ void cmp_unit(float* lds, const bf16* P1, float* KC, const float* pe, const float* w1, const float* w2, int unit) {
    const int tid = opaque_tid(); const int q = unit & 15, g = (unit >> 4) & 1, b = (unit >> 5) & 3, c = unit >> 7;
    float* Fl = lds; float* hid = lds + 32768;
    const float* pec = pe + (size_t)c * 2048; const float* w1c = w1 + ((size_t)c * 2 + g) * 2048 * 64; const float* w2c = w2 + ((size_t)c * 2 + g) * 4096;
    __syncthreads();
    for (int e = tid; e < 16 * 256; e += 512) { const int nl = e >> 8, l = (e >> 3) & 31, c8 = (e & 7) * 8; const int n = q * 16 + nl; float* o = Fl + nl * 2048 + l * 64 + c8;
        if (n < 255) { const u32x4 v = *(const u32x4*)(P1 + ((size_t)b * SEQ + n * 16 + l) * P1W + C_KV + (c * 2 + g) * 64 + c8); const float* pp = pec + l * 64 + c8;
            o[0] = bflo(v.x) + pp[0]; o[1] = bfhi(v.x) + pp[1]; o[2] = bflo(v.y) + pp[2]; o[3] = bfhi(v.y) + pp[3]; o[4] = bflo(v.z) + pp[4]; o[5] = bfhi(v.z) + pp[5]; o[6] = bflo(v.w) + pp[6]; o[7] = bfhi(v.w) + pp[7]; }
        else { o[0] = 0.f; o[1] = 0.f; o[2] = 0.f; o[3] = 0.f; o[4] = 0.f; o[5] = 0.f; o[6] = 0.f; o[7] = 0.f; } }
    __syncthreads();
    {   const int e = tid & 63, ng = tid >> 6; float a0 = 0.f, a1 = 0.f; const float* f0 = Fl + (ng * 2) * 2048; const float* f1 = f0 + 2048;
#pragma unroll 8
        for (int f = 0; f < 2048; ++f) { const float wv = w1c[(size_t)f * 64 + e]; a0 += f0[f] * wv; a1 += f1[f] * wv; }
        hid[(ng * 2) * 64 + e] = gelu_tanh(a0); hid[(ng * 2 + 1) * 64 + e] = gelu_tanh(a1); }
    __syncthreads();
    {   const int d = tid & 63, ng = tid >> 6; float a0 = 0.f, a1 = 0.f;
        for (int e = 0; e < 64; ++e) { const float wv = w2c[e * 64 + d]; a0 += hid[(ng * 2) * 64 + e] * wv; a1 += hid[(ng * 2 + 1) * 64 + e] * wv; }
        const int n0 = q * 16 + ng * 2; float* kp = KC + ((((size_t)c * NB + b) * 2 + g) * 256) * 64;
        if (n0 < 255) GST(kp[(size_t)n0 * 64 + d] = a0);
        if (n0 + 1 < 255) GST(kp[(size_t)(n0 + 1) * 64 + d] = a1); }
}

__device__ __forceinline__ void lru_unit2(LAS unsigned char* lds, const bf16* P1, bf16* XN, float* AGA, float* AGH, const float* convw, const float* convb,
                                          const bf16* WaT, const bf16* WxT, const float* ba, const float* bx, const float* lam, int unit) {
    const int tid = opaque_tid(); const int lane = tid & 63, w = __builtin_amdgcn_readfirstlane(tid >> 6);
    const int tile = unit & 63, b = unit >> 6; const int ch0 = w * 64;
    const size_t row0 = (size_t)b * SEQ + tile * 64;
    LAS unsigned char* wl = lds + w * 17536;
    LAS bf16* xcb = (LAS bf16*)wl; LAS float* AL = (LAS float*)(wl + 9216); LAS float* BL = (LAS float*)(wl + 9216 + 4160);
    __syncthreads();
    const int i16 = lane & 15, kb = lane >> 4;
    bf16x8 bfa[4][2], bfx[4][2]; float cba[4], cbx[4], csp[4];
#pragma unroll
    for (int n = 0; n < 4; ++n) {
#pragma unroll
        for (int ks = 0; ks < 2; ++ks) { bfa[n][ks] = *(const bf16x8*)(WaT + ((size_t)ch0 + 16 * n + i16) * 64 + 32 * ks + 8 * kb); bfx[n][ks] = *(const bf16x8*)(WxT + ((size_t)ch0 + 16 * n + i16) * 64 + 32 * ks + 8 * kb); }
        const int co = ch0 + 16 * n + i16; cba[n] = ba[co]; cbx[n] = bx[co]; const float lm = lam[co]; csp[n] = 8.0f * ((-lm > 20.f) ? -lm : log1pf(__expf(-lm)));
    }
    {
        const int tl = lane >> 3, c8 = (lane & 7) * 8; float cw[4][8], cb8[8];
#pragma unroll
        for (int i = 0; i < 8; ++i) { cb8[i] = convb[ch0 + c8 + i];
#pragma unroll
            for (int k = 0; k < 4; ++k) cw[k][i] = convw[k * 512 + ch0 + c8 + i]; }
#pragma unroll 2
        for (int p = 0; p < 8; ++p) { const int tok = 8 * p + tl; const int ts = tile * 64 + tok; float o[8];
#pragma unroll
            for (int i = 0; i < 8; ++i) o[i] = cb8[i];
#pragma unroll
            for (int k = 0; k < 4; ++k) { const int sp = ts + k - 3; if (sp >= 0) { const u32x4 v = *(const u32x4*)(P1 + ((size_t)b * SEQ + sp) * P1W + C_RB + ch0 + c8);
                    o[0] += bflo(v.x) * cw[k][0]; o[1] += bfhi(v.x) * cw[k][1]; o[2] += bflo(v.y) * cw[k][2]; o[3] += bfhi(v.y) * cw[k][3]; o[4] += bflo(v.z) * cw[k][4]; o[5] += bfhi(v.z) * cw[k][5]; o[6] += bflo(v.w) * cw[k][6]; o[7] += bfhi(v.w) * cw[k][7]; } }
            *(LAS u32x4*)(xcb + tok * 72 + c8) = (u32x4){pk2(o[0], o[1]), pk2(o[2], o[3]), pk2(o[4], o[5]), pk2(o[6], o[7])}; }
    }
    LDS_WAIT(); asm volatile("" ::: "memory");
    float hr = 0.f, ac = 1.f;
#pragma unroll 1
    for (int nt = 0; nt < 4; ++nt) {
        bf16x8 af[2];
#pragma unroll
        for (int ks = 0; ks < 2; ++ks) af[ks] = *(const LAS bf16x8*)(xcb + (16 * nt + i16) * 72 + 32 * ks + 8 * kb);
        f32x4 da[4], dx[4];
#pragma unroll
        for (int n = 0; n < 4; ++n) { da[n] = (f32x4){0.f, 0.f, 0.f, 0.f}; dx[n] = da[n];
#pragma unroll
            for (int ks = 0; ks < 2; ++ks) { da[n] = __builtin_amdgcn_mfma_f32_16x16x32_bf16(af[ks], bfa[n][ks], da[n], 0, 0, 0); dx[n] = __builtin_amdgcn_mfma_f32_16x16x32_bf16(af[ks], bfx[n][ks], dx[n], 0, 0, 0); } }
#pragma unroll
        for (int n = 0; n < 4; ++n)
#pragma unroll
            for (int r = 0; r < 4; ++r) { const int tokl = 4 * kb + r, co = 16 * n + i16; const float xcv = bf2f(xcb[(16 * nt + tokl) * 72 + co]);
                const float rg = sigmoidf_(da[n][r] + cba[n]), ig = sigmoidf_(dx[n][r] + cbx[n]); const float a = __expf(-rg * csp[n]);
                AL[tokl * 65 + co] = a; BL[tokl * 65 + co] = sqrtf(fmaxf(1.0f - a * a, 0.f)) * (ig * xcv); }
        LDS_WAIT(); asm volatile("" ::: "memory");
#pragma unroll
        for (int tt = 0; tt < 16; ++tt) { const float a = AL[tt * 65 + lane], bt = BL[tt * 65 + lane]; hr = a * hr + bt; ac *= a;
            GST(XN[(row0 + 16 * nt + tt) * 1024 + ch0 + lane] = (bf16)f2bf(hr)); GST(XN[(row0 + 16 * nt + tt) * 1024 + 512 + ch0 + lane] = (bf16)f2bf(ac)); }
        LDS_WAIT(); asm volatile("" ::: "memory");
    }
    GST(AGA[((size_t)b * 64 + tile) * 512 + ch0 + lane] = ac); GST(AGH[((size_t)b * 64 + tile) * 512 + ch0 + lane] = hr);
}
__device__ __forceinline__ void cmp_unit2(LAS unsigned char* lds, const bf16* P1, float* KC, const float* pe, const bf16* W1T, const float* w2, int unit) {
    const int tid = opaque_tid(); const int lane = tid & 63, w = __builtin_amdgcn_readfirstlane(tid >> 6);
    const int q = unit & 15, g = (unit >> 4) & 1, b = (unit >> 5) & 3, c = unit >> 7;
    LAS bf16* Fl = (LAS bf16*)lds;
    LAS float* part = (LAS float*)(lds + 65792);
    LAS float* hid = (LAS float*)(lds + 65792 + 32768);
    const float* pec = pe + (size_t)c * 2048; const bf16* w1t = W1T + ((size_t)c * 2 + g) * 64 * 2048; const float* w2c = w2 + ((size_t)c * 2 + g) * 4096;
    __syncthreads();
    for (int e = tid; e < 16 * 256; e += 512) { const int nl = e >> 8, l = (e >> 3) & 31, c8 = (e & 7) * 8; const int n = q * 16 + nl; u32x4 o = {0u, 0u, 0u, 0u};
        if (n < 255) { const u32x4 v = *(const u32x4*)(P1 + ((size_t)b * SEQ + n * 16 + l) * P1W + C_KV + (c * 2 + g) * 64 + c8); const float* pp = pec + l * 64 + c8;
            o = (u32x4){pk2(bflo(v.x) + pp[0], bfhi(v.x) + pp[1]), pk2(bflo(v.y) + pp[2], bfhi(v.y) + pp[3]), pk2(bflo(v.z) + pp[4], bfhi(v.z) + pp[5]), pk2(bflo(v.w) + pp[6], bfhi(v.w) + pp[7])}; }
        *(LAS u32x4*)(Fl + nl * 2056 + l * 64 + c8) = o; }
    __syncthreads();
    {   const int i16 = lane & 15, kb = lane >> 4; f32x4 acc[4];
#pragma unroll
        for (int n = 0; n < 4; ++n) acc[n] = (f32x4){0.f, 0.f, 0.f, 0.f};
#pragma unroll 2
        for (int ks = 0; ks < 8; ++ks) { const int f0 = 256 * w + 32 * ks + 8 * kb;
            const bf16x8 af = *(const LAS bf16x8*)(Fl + i16 * 2056 + f0);
#pragma unroll
            for (int n = 0; n < 4; ++n) { const bf16x8 bfr = *(const bf16x8*)(w1t + (size_t)(16 * n + i16) * 2048 + f0); acc[n] = __builtin_amdgcn_mfma_f32_16x16x32_bf16(af, bfr, acc[n], 0, 0, 0); } }
#pragma unroll
        for (int n = 0; n < 4; ++n)
#pragma unroll
            for (int r = 0; r < 4; ++r) part[(w * 16 + 4 * kb + r) * 64 + 16 * n + i16] = acc[n][r];
    }
    __syncthreads();
    for (int e = tid; e < 1024; e += 512) { float a = 0.f;
#pragma unroll
        for (int ww = 0; ww < 8; ++ww) a += part[ww * 1024 + e];
        hid[e] = gelu_tanh(a); }
    __syncthreads();
    {   const int d = tid & 63, ng = tid >> 6; float a0 = 0.f, a1 = 0.f;
        for (int e = 0; e < 64; ++e) { const float wv = w2c[e * 64 + d]; a0 += hid[(ng * 2) * 64 + e] * wv; a1 += hid[(ng * 2 + 1) * 64 + e] * wv; }
        const int n0 = q * 16 + ng * 2; float* kp = KC + ((((size_t)c * NB + b) * 2 + g) * 256) * 64;
        if (n0 < 255) GST(kp[(size_t)n0 * 64 + d] = a0);
        if (n0 + 1 < 255) GST(kp[(size_t)(n0 + 1) * 64 + d] = a1); }
}

__device__ __forceinline__ void gmlp_unit2(LAS unsigned char* lds, bf16* P1, const float* gng, const float* gws, const float* gmb, int unit) {
    typedef float f32x16_ __attribute__((ext_vector_type(16))); typedef short s16x4_ __attribute__((ext_vector_type(4)));
    const int tid = opaque_tid(); const int lane = tid & 63, w = __builtin_amdgcn_readfirstlane(tid >> 6), r32 = lane & 31, h = lane >> 5;
    const int c = unit >> 2, g = unit & 3; const size_t t0 = (size_t)c * 128;
    LAS unsigned char* VN = lds; LAS unsigned char* WT = lds + 32768; LAS float* rs = (LAS float*)(lds + 67584);
    __syncthreads();
    {   const int tk = tid >> 2, qu = tid & 3; const bf16* vp = P1 + (t0 + tk) * P1W + C_V + qu * 128; float ss = 0.f;
#pragma unroll 4
        for (int i = 0; i < 16; ++i) { const u32x4 x = *(const u32x4*)(vp + 8 * i);
            ss += bflo(x.x) * bflo(x.x) + bfhi(x.x) * bfhi(x.x) + bflo(x.y) * bflo(x.y) + bfhi(x.y) * bfhi(x.y) + bflo(x.z) * bflo(x.z) + bfhi(x.z) * bfhi(x.z) + bflo(x.w) * bflo(x.w) + bfhi(x.w) * bfhi(x.w); }
        ss += __shfl_xor(ss, 1); ss += __shfl_xor(ss, 2);
        if (qu == 0) rs[tk] = rsqrtf(ss * (1.f / 512.f) + EPS);
    }
#pragma unroll
    for (int k = 0; k < 4; ++k) { const int e = tid + 512 * k; const int t = e >> 4, s8 = (e & 15) * 8; const float* wp = gws + (size_t)g * 16384 + t * 128 + s8;
        const f32x4 a = *(const f32x4*)wp, bq = *(const f32x4*)(wp + 4);
        const float v0 = (s8 + 0 <= t) ? a.x : 0.f, v1 = (s8 + 1 <= t) ? a.y : 0.f, v2 = (s8 + 2 <= t) ? a.z : 0.f, v3 = (s8 + 3 <= t) ? a.w : 0.f;
        const float v4 = (s8 + 4 <= t) ? bq.x : 0.f, v5 = (s8 + 5 <= t) ? bq.y : 0.f, v6 = (s8 + 6 <= t) ? bq.z : 0.f, v7 = (s8 + 7 <= t) ? bq.w : 0.f;
        *(LAS u32x4*)(WT + t * 272 + s8 * 2) = (u32x4){pk2(v0, v1), pk2(v2, v3), pk2(v4, v5), pk2(v6, v7)}; }
    __syncthreads();
#pragma unroll
    for (int k = 0; k < 4; ++k) { const int e = tid + 512 * k; const int sr = e >> 4, c8 = e & 15; const u32x4 x = *(const u32x4*)(P1 + (t0 + sr) * P1W + C_V + g * 128 + 8 * c8);
        const float r = rs[sr]; const float* gp = gng + g * 128 + 8 * c8;
        *(LAS u32x4*)(VN + (c8 >> 2) * 8192 + sr * 64 + (c8 & 3) * 16) = (u32x4){pk2(bflo(x.x) * r * gp[0], bfhi(x.x) * r * gp[1]), pk2(bflo(x.y) * r * gp[2], bfhi(x.y) * r * gp[3]), pk2(bflo(x.z) * r * gp[4], bfhi(x.z) * r * gp[5]), pk2(bflo(x.w) * r * gp[6], bfhi(x.w) * r * gp[7])}; }
    __syncthreads();
    const int cb = w & 3, pr = w >> 2;
    const LAS unsigned char* vb = VN + cb * 8192 + ((lane >> 4) & 1) * 32 + (lane & 3) * 8 + (8 * h + ((lane & 15) >> 2)) * 64;
#pragma unroll
    for (int half = 0; half < 2; ++half) {
        const int tb = pr ? (1 + half) : (3 * half);
        f32x16_ acc;
#pragma unroll
        for (int r = 0; r < 16; ++r) acc[r] = 0.f;
        const LAS unsigned char* wrow = WT + (32 * tb + r32) * 272 + 16 * h;
        for (int ks = 0; ks < 2 * tb + 2; ++ks) {
            const bf16x8 wf = *(const LAS bf16x8*)(wrow + 32 * ks);
            const s16x4_ lo = __builtin_bit_cast(s16x4_, __builtin_amdgcn_ds_read_tr16_b64_v4i16((LAS s16x4_*)(vb + ks * 1024)));
            const s16x4_ hi = __builtin_bit_cast(s16x4_, __builtin_amdgcn_ds_read_tr16_b64_v4i16((LAS s16x4_*)(vb + ks * 1024 + 256)));
            const bf16x8 vf = (bf16x8){lo[0], lo[1], lo[2], lo[3], hi[0], hi[1], hi[2], hi[3]};
            acc = __builtin_amdgcn_mfma_f32_32x32x16_bf16(vf, wf, acc, 0, 0, 0);
        }
        const int tl = 32 * tb + r32; const float bb = gmb[g * 128 + tl];
        bf16* up = P1 + (t0 + tl) * P1W + C_U + g * 128 + 32 * cb + 4 * h;
#pragma unroll
        for (int q4 = 0; q4 < 4; ++q4) { const u32x2 uu = *(const u32x2*)(up + 8 * q4);
            u32x2 o; o.x = pk2(bflo(uu.x) * (acc[4 * q4] + bb), bfhi(uu.x) * (acc[4 * q4 + 1] + bb)); o.y = pk2(bflo(uu.y) * (acc[4 * q4 + 2] + bb), bfhi(uu.y) * (acc[4 * q4 + 3] + bb));
            GST(*(u32x2*)(up + 8 * q4) = o); }
    }
}
__device__ __forceinline__ void pool_unit2(LAS unsigned char* lds, bf16* P1, const bf16* pwT, const float* ps, int unit) {
    typedef float f32x16_ __attribute__((ext_vector_type(16)));
    const int tid = opaque_tid(); const int lane = tid & 63, w = __builtin_amdgcn_readfirstlane(tid >> 6), r32 = lane & 31, h = lane >> 5;
    const int gi = unit & 3, tile = (unit >> 2) & 63, b = unit >> 8; const int wn = 2 << gi;
    LAS float* xs = (LAS float*)lds; LAS bf16* PL = (LAS bf16*)(lds + 40448);
    __syncthreads();
    for (int e = tid; e < 79 * 16; e += 512) { const int r = e >> 4, c8 = (e & 15) * 8; const int sp = tile * 64 + r - 15; f32x4 a = {0.f, 0.f, 0.f, 0.f}, bq = a;
        if (sp >= 0) { const u32x4 v = *(const u32x4*)(P1 + ((size_t)b * SEQ + sp) * P1W + C_XD + gi * 128 + c8); a = (f32x4){bflo(v.x), bfhi(v.x), bflo(v.y), bfhi(v.y)}; bq = (f32x4){bflo(v.z), bfhi(v.z), bflo(v.w), bfhi(v.w)}; }
        *(LAS f32x4*)(xs + r * 128 + c8) = a; *(LAS f32x4*)(xs + r * 128 + c8 + 4) = bq; }
    __syncthreads();
    {   const int ci = tid & 127, tq = tid >> 7;
        for (int k = 0; k < 16; ++k) { const int tt = tq * 16 + k; const int ts = tile * 64 + tt; float sacc = 0.f;
            for (int jj = 0; jj < wn; ++jj) sacc += xs[(tt + 15 - jj) * 128 + ci];
            const int cnt = (ts + 1 < wn) ? ts + 1 : wn;
            PL[tt * 136 + ci] = (bf16)f2bf(sacc / (float)cnt - xs[(tt + 15) * 128 + ci]); } }
    __syncthreads();
    {   const int cob = w >> 1, tokb = w & 1; f32x16_ acc;
#pragma unroll
        for (int r = 0; r < 16; ++r) acc[r] = 0.f;
        const bf16* wrow = pwT + (size_t)(32 * cob + r32) * 128 + 8 * h; const LAS bf16* prow = PL + (32 * tokb + r32) * 136 + 8 * h;
#pragma unroll
        for (int ks = 0; ks < 8; ++ks) { const bf16x8 wf = *(const bf16x8*)(wrow + 16 * ks); const bf16x8 pf = *(const LAS bf16x8*)(prow + 16 * ks);
            acc = __builtin_amdgcn_mfma_f32_32x32x16_bf16(wf, pf, acc, 0, 0, 0); }
        bf16* op = P1 + ((size_t)b * SEQ + tile * 64 + 32 * tokb + r32) * P1W + C_V + gi * 128 + 32 * cob + 4 * h; const float* sp = ps + gi * 128 + 32 * cob + 4 * h;
#pragma unroll
        for (int q4 = 0; q4 < 4; ++q4) { const f32x4 sc = *(const f32x4*)(sp + 8 * q4);
            u32x2 o; o.x = pk2(acc[4 * q4] * sc.x, acc[4 * q4 + 1] * sc.y); o.y = pk2(acc[4 * q4 + 2] * sc.z, acc[4 * q4 + 3] * sc.w); GST(*(u32x2*)(op + 8 * q4) = o); }
    }
}
__device__ __forceinline__ void lrufix_unit2(bf16* P1, const bf16* XN, const float* AGA, const float* AGH, int unit) {
    const int tid = opaque_tid(); const int cg = tid & 63, tl = tid >> 6; const int tile = unit & 63, b = unit >> 6;
    float c[8];
#pragma unroll
    for (int i = 0; i < 8; ++i) c[i] = 0.f;
    for (int i = 0; i < tile; ++i) { const float* ap = AGA + ((size_t)b * 64 + i) * 512 + 8 * cg; const float* hp = AGH + ((size_t)b * 64 + i) * 512 + 8 * cg;
        const f32x4 a0 = *(const f32x4*)ap, a1 = *(const f32x4*)(ap + 4), h0 = *(const f32x4*)hp, h1 = *(const f32x4*)(hp + 4);
        c[0] = a0.x * c[0] + h0.x; c[1] = a0.y * c[1] + h0.y; c[2] = a0.z * c[2] + h0.z; c[3] = a0.w * c[3] + h0.w; c[4] = a1.x * c[4] + h1.x; c[5] = a1.y * c[5] + h1.y; c[6] = a1.z * c[6] + h1.z; c[7] = a1.w * c[7] + h1.w; }
    const size_t row0 = (size_t)b * SEQ + tile * 64;
#pragma unroll 4
    for (int p = 0; p < 8; ++p) { const size_t row = row0 + 8 * p + tl;
        const u32x4 hl = *(const u32x4*)(XN + row * 1024 + 8 * cg), ac = *(const u32x4*)(XN + row * 1024 + 512 + 8 * cg); bf16* gp = P1 + row * P1W + C_GB + 8 * cg; const u32x4 gg = *(const u32x4*)gp;
        u32x4 o;
        o.x = pk2(bflo(gg.x) * (bflo(hl.x) + bflo(ac.x) * c[0]), bfhi(gg.x) * (bfhi(hl.x) + bfhi(ac.x) * c[1])); o.y = pk2(bflo(gg.y) * (bflo(hl.y) + bflo(ac.y) * c[2]), bfhi(gg.y) * (bfhi(hl.y) + bfhi(ac.y) * c[3]));
        o.z = pk2(bflo(gg.z) * (bflo(hl.z) + bflo(ac.z) * c[4]), bfhi(gg.z) * (bfhi(hl.z) + bfhi(ac.z) * c[5])); o.w = pk2(bflo(gg.w) * (bflo(hl.w) + bflo(ac.w) * c[6]), bfhi(gg.w) * (bfhi(hl.w) + bfhi(ac.w) * c[7]));
        GST(*(u32x4*)gp = o); }
}

typedef float f32x16 __attribute__((ext_vector_type(16)));
typedef short s16x4 __attribute__((ext_vector_type(4)));
typedef __bf16 bf16x2_t __attribute__((ext_vector_type(2)));
constexpr int AT_KB = 8320, AT_VB = 8192;
constexpr int AT_K0 = 0, AT_V0 = 2 * AT_KB, AT_IMP = AT_V0 + 2 * AT_VB, AT_SEL = AT_IMP + 16384, AT_SELU = AT_SEL + 512;
constexpr float AT_C2 = 0.125f * 1.4426950408889634f;
__device__ __forceinline__ unsigned cvtpk_bf16(float lo, float hi) { f32x2 v = {lo, hi}; bf16x2_t b = __builtin_convertvector(v, bf16x2_t); return __builtin_bit_cast(unsigned, b); }
__device__ __forceinline__ int crow(int r, int h) { return (r & 3) + 8 * (r >> 2) + 4 * h; }
struct AtRegs { u32x4 k, v; };
__device__ __forceinline__ AtRegs at_load_bf16(const bf16* kp, const bf16* vp, int tid) {
    AtRegs r; const int key = tid >> 3, c = tid & 7;
    r.k = *(const u32x4*)(kp + (size_t)key * P1W + 8 * c); r.v = *(const u32x4*)(vp + (size_t)key * P1W + 8 * c); return r;
}
__device__ __forceinline__ AtRegs at_load_f32(const float* kp, const float* vp, int n0, int tid) {
    AtRegs r; const int key = tid >> 3, c = tid & 7; const int n = n0 + key;
    if (n < 255) { const f32x4 a0 = *(const f32x4*)(kp + (size_t)n * 64 + 8 * c), a1 = *(const f32x4*)(kp + (size_t)n * 64 + 8 * c + 4), b0 = *(const f32x4*)(vp + (size_t)n * 64 + 8 * c), b1 = *(const f32x4*)(vp + (size_t)n * 64 + 8 * c + 4);
        r.k = (u32x4){pk2(a0.x, a0.y), pk2(a0.z, a0.w), pk2(a1.x, a1.y), pk2(a1.z, a1.w)}; r.v = (u32x4){pk2(b0.x, b0.y), pk2(b0.z, b0.w), pk2(b1.x, b1.y), pk2(b1.z, b1.w)}; }
    else { r.k = (u32x4){0u, 0u, 0u, 0u}; r.v = (u32x4){0u, 0u, 0u, 0u}; }
    return r;
}
__device__ __forceinline__ void at_store(LAS unsigned char* lds, int buf, const AtRegs& r, int tid) {
    const int key = tid >> 3, c = tid & 7;
    *(LAS u32x4*)(lds + AT_K0 + buf * AT_KB + c * 1040 + key * 16) = r.k;
    *(LAS u32x4*)(lds + AT_V0 + buf * AT_VB + (c >> 2) * 4096 + key * 64 + (c & 3) * 16) = r.v;
}
__device__ __forceinline__ void at_qk(f32x16& p0, f32x16& p1, const LAS unsigned char* kb, const bf16x8 (&qr)[4], int r32, int h) {
    const f32x16 z = {0.f, 0.f, 0.f, 0.f, 0.f, 0.f, 0.f, 0.f, 0.f, 0.f, 0.f, 0.f, 0.f, 0.f, 0.f, 0.f};
    p0 = z; p1 = z;
#pragma unroll
    for (int d0 = 0; d0 < 4; ++d0) {
        const bf16x8 k0 = *(const LAS bf16x8*)(kb + (2 * d0 + h) * 1040 + r32 * 16);
        const bf16x8 k1 = *(const LAS bf16x8*)(kb + (2 * d0 + h) * 1040 + (32 + r32) * 16);
        p0 = __builtin_amdgcn_mfma_f32_32x32x16_bf16(k0, qr[d0], p0, 0, 0, 0);
        p1 = __builtin_amdgcn_mfma_f32_32x32x16_bf16(k1, qr[d0], p1, 0, 0, 0);
    }
}
__device__ __forceinline__ void at_step(const LAS unsigned char* lds, int buf, const bf16x8 (&qr)[4], f32x16 (&o)[2], float& m, float& l, u64 vm, int lane) {
    if (!__any(vm != 0ull)) return;
    const int r32 = lane & 31, h = lane >> 5;
    f32x16 p0, p1;
    at_qk(p0, p1, lds + AT_K0 + buf * AT_KB, qr, r32, h);
    const bool full = __all(vm == ~0ull);
    const unsigned vlo = (unsigned)vm, vhi = (unsigned)(vm >> 32);
    float rm = -INFINITY;
#pragma unroll
    for (int r = 0; r < 16; ++r) {
        float a = p0[r] * AT_C2, b = p1[r] * AT_C2;
        if (!full) { const int kx = crow(r, h); a = ((vlo >> kx) & 1u) ? a : -INFINITY; b = ((vhi >> kx) & 1u) ? b : -INFINITY; }
        p0[r] = a; p1[r] = b; rm = fmaxf(rm, fmaxf(a, b));
    }
    rm = fmaxf(rm, __shfl_xor(rm, 32));
    const float mn = fmaxf(m, rm); const float f = __builtin_amdgcn_exp2f(m - mn); m = mn;
    float ls = 0.f;
#pragma unroll
    for (int r = 0; r < 16; ++r) { p0[r] = __builtin_amdgcn_exp2f(p0[r] - mn); p1[r] = __builtin_amdgcn_exp2f(p1[r] - mn); ls += p0[r] + p1[r]; }
    l = l * f + ls;
#pragma unroll
    for (int r = 0; r < 16; ++r) { o[0][r] *= f; o[1][r] *= f; }
    const LAS unsigned char* vb = lds + AT_V0 + buf * AT_VB + ((lane >> 4) & 1) * 32 + (lane & 3) * 8 + (4 * h + ((lane & 15) >> 2)) * 64;
#pragma unroll
    for (int ks = 0; ks < 4; ++ks) {
        u32x4 pw;
        if (ks == 0) pw = (u32x4){cvtpk_bf16(p0[0], p0[1]), cvtpk_bf16(p0[2], p0[3]), cvtpk_bf16(p0[4], p0[5]), cvtpk_bf16(p0[6], p0[7])};
        else if (ks == 1) pw = (u32x4){cvtpk_bf16(p0[8], p0[9]), cvtpk_bf16(p0[10], p0[11]), cvtpk_bf16(p0[12], p0[13]), cvtpk_bf16(p0[14], p0[15])};
        else if (ks == 2) pw = (u32x4){cvtpk_bf16(p1[0], p1[1]), cvtpk_bf16(p1[2], p1[3]), cvtpk_bf16(p1[4], p1[5]), cvtpk_bf16(p1[6], p1[7])};
        else pw = (u32x4){cvtpk_bf16(p1[8], p1[9]), cvtpk_bf16(p1[10], p1[11]), cvtpk_bf16(p1[12], p1[13]), cvtpk_bf16(p1[14], p1[15])};
        const bf16x8 pf = __builtin_bit_cast(bf16x8, pw);
#pragma unroll
        for (int db = 0; db < 2; ++db) {
            const s16x4 lo = __builtin_bit_cast(s16x4, __builtin_amdgcn_ds_read_tr16_b64_v4i16((LAS s16x4*)(vb + db * 4096 + ks * 1024)));
            const s16x4 hi = __builtin_bit_cast(s16x4, __builtin_amdgcn_ds_read_tr16_b64_v4i16((LAS s16x4*)(vb + db * 4096 + ks * 1024 + 512)));
            const bf16x8 vf = (bf16x8){lo[0], lo[1], lo[2], lo[3], hi[0], hi[1], hi[2], hi[3]};
            o[db] = __builtin_amdgcn_mfma_f32_32x32x16_bf16(vf, pf, o[db], 0, 0, 0);
        }
    }
}
__device__ __forceinline__ void at_fold(f32x16 (&ot)[2], f32x16 (&o)[2], float& m, float& l, float gate, bool valid) {
    const float lt = l + __shfl_xor(l, 32); const float inv = (valid && lt > 0.f) ? gate / lt : 0.f;
#pragma unroll
    for (int r = 0; r < 16; ++r) { ot[0][r] += o[0][r] * inv; ot[1][r] += o[1][r] * inv; o[0][r] = 0.f; o[1][r] = 0.f; }
    m = -1e30f; l = 0.f;
}
__device__ __forceinline__ void attn_unit_mfma(LAS unsigned char* lds, bf16* P1, const float* KC, int unit) {
    const int tid = opaque_tid(); const int lane = tid & 63, w = __builtin_amdgcn_readfirstlane(tid >> 6), r32 = lane & 31, h = lane >> 5;
    const int ti = unit & 63, g = (unit >> 6) & 1, b = unit >> 7;
    const int tq = 8 * w + (r32 >> 2), j = r32 & 3, hd = 4 * g + j; const int ts = 64 * ti + tq;
    const size_t row = (size_t)b * SEQ + ts;
    LAS float* IMP = (LAS float*)(lds + AT_IMP); LAS u64* SEL = (LAS u64*)(lds + AT_SEL); LAS unsigned* SELU = (LAS unsigned*)(lds + AT_SELU);
    __syncthreads();
    for (int e = tid; e < 4096; e += 512) IMP[e] = 0.f;
    if (tid < 2) SELU[tid] = 0u;
    bf16x8 qr[4];
    { const bf16* qp = P1 + row * P1W + C_Q + hd * 64 + 8 * h;
#pragma unroll
      for (int d0 = 0; d0 < 4; ++d0) qr[d0] = *(const bf16x8*)(qp + 16 * d0); }
    const float g0 = bf2f(P1[row * P1W + C_GC + hd * 3 + 0]), g1 = bf2f(P1[row * P1W + C_GC + hd * 3 + 1]), g2 = bf2f(P1[row * P1W + C_GC + hd * 3 + 2]);
    f32x16 o[2], ot[2];
#pragma unroll
    for (int r = 0; r < 16; ++r) { o[0][r] = 0.f; o[1][r] = 0.f; ot[0][r] = 0.f; ot[1][r] = 0.f; }
    float m = -1e30f, l = 0.f;
    const int nv = (ts >= 31) ? ((((ts + 1) >> 4) - 1 > 255) ? 255 : ((ts + 1) >> 4) - 1) : 0;
    const int nkt = (4 * ti + 3 + 63) >> 6;
    const float* kcp = KC + ((((size_t)0 * NB + b) * 2 + g) * 256) * 64; const float* vcp = KC + ((((size_t)1 * NB + b) * 2 + g) * 256) * 64;
    {   AtRegs rg = at_load_f32(kcp, vcp, 0, tid); at_store(lds, 0, rg, tid); __syncthreads();
        for (int kt = 0; kt < nkt; ++kt) {
            if (kt + 1 < nkt) rg = at_load_f32(kcp, vcp, 64 * (kt + 1), tid);
            at_step(lds, kt & 1, qr, o, m, l, mask_lo(nv - 64 * kt), lane);
            if (kt + 1 < nkt) at_store(lds, (kt + 1) & 1, rg, tid);
            __syncthreads();
        }
        const float lt = l + __shfl_xor(l, 32); const float invl = (nv > 0 && lt > 0.f) ? 1.f / lt : 0.f;
        float prevL = 0.f;
        rg = at_load_f32(kcp, vcp, 0, tid); at_store(lds, 0, rg, tid); __syncthreads();
        for (int kt = 0; kt < nkt; ++kt) {
            if (kt + 1 < nkt) rg = at_load_f32(kcp, vcp, 64 * (kt + 1), tid);
            f32x16 p0, p1; at_qk(p0, p1, lds + AT_K0 + (kt & 1) * AT_KB, qr, r32, h);
            const u64 vm = mask_lo(nv - 64 * kt); const unsigned vlo = (unsigned)vm, vhi = (unsigned)(vm >> 32);
#pragma unroll
            for (int r = 0; r < 16; ++r) { const int kx = crow(r, h);
                p0[r] = ((vlo >> kx) & 1u) ? __builtin_amdgcn_exp2f(p0[r] * AT_C2 - m) * invl : 0.f;
                p1[r] = ((vhi >> kx) & 1u) ? __builtin_amdgcn_exp2f(p1[r] * AT_C2 - m) * invl : 0.f; }
#pragma unroll
            for (int hh = 0; hh < 2; ++hh) {
                float G[4], Lp[4];
#pragma unroll
                for (int q4 = 0; q4 < 4; ++q4) { const float a0 = hh ? p1[4 * q4] : p0[4 * q4], a1 = hh ? p1[4 * q4 + 1] : p0[4 * q4 + 1], a2 = hh ? p1[4 * q4 + 2] : p0[4 * q4 + 2], a3 = hh ? p1[4 * q4 + 3] : p0[4 * q4 + 3];
                    G[q4] = (a0 + a1) + (a2 + a3); Lp[q4] = __shfl_xor(a3, 32); }
#pragma unroll
                for (int q4 = 0; q4 < 4; ++q4) {
                    const float carry = h ? Lp[q4] : (q4 == 0 ? prevL : Lp[q4 - 1]);
                    float v = G[q4] + carry; v += __shfl_xor(v, 1); v += __shfl_xor(v, 2);
                    if (j == 0) IMP[tq * 64 + 16 * kt + 8 * hh + 2 * q4 + h] = v;
                }
                prevL = Lp[3];
            }
            if (kt + 1 < nkt) at_store(lds, (kt + 1) & 1, rg, tid);
            __syncthreads();
        }
    }
    at_fold(ot, o, m, l, g0, nv > 0);
    __syncthreads();
    const int cur = ti;
    if (tid < 64) {
        u64 sel = 1ull | (1ull << cur) | (cur >= 1 ? (1ull << (cur - 1)) : 0ull);
        const int npick = (cur - 2) < 5 ? (cur - 2) : 5; const LAS float* ip = IMP + tid * 64;
        for (int pk = 0; pk < npick; ++pk) { float best = -1.f; int bi = 1;
            for (int mm = 1; mm <= cur - 2; ++mm) { const float v = ip[mm]; if (!((sel >> mm) & 1ull) && v > best) { best = v; bi = mm; } }
            sel |= 1ull << bi; }
        SEL[tid] = sel; atomicOr((unsigned*)&SELU[0], (unsigned)sel); atomicOr((unsigned*)&SELU[1], (unsigned)(sel >> 32));
    }
    __syncthreads();
    const u64 sel = SEL[tq];
    const u64 selu = ((u64)SELU[1] << 32) | (u64)SELU[0];
    {   const bf16* kb = P1 + (size_t)b * SEQ * P1W + C_KV + (2 * 2 + g) * 64; const bf16* vbp = P1 + (size_t)b * SEQ * P1W + C_KV + (3 * 2 + g) * 64;
        u64 rem = selu; int mb = __builtin_ctzll(rem); rem &= rem - 1; int it = 0;
        AtRegs rg = at_load_bf16(kb + (size_t)mb * 64 * P1W, vbp + (size_t)mb * 64 * P1W, tid); at_store(lds, 0, rg, tid); __syncthreads();
        for (;;) {
            const bool more = rem != 0ull; int mbn = 0;
            if (more) { mbn = __builtin_ctzll(rem); rem &= rem - 1; rg = at_load_bf16(kb + (size_t)mbn * 64 * P1W, vbp + (size_t)mbn * 64 * P1W, tid); }
            u64 vm = 0ull; if ((sel >> mb) & 1ull) vm = (mb == cur) ? mask_lo((ts & 63) + 1) : ~0ull;
            at_step(lds, it & 1, qr, o, m, l, vm, lane);
            if (more) at_store(lds, (it + 1) & 1, rg, tid);
            __syncthreads();
            if (!more) break;
            mb = mbn; ++it;
        }
    }
    at_fold(ot, o, m, l, g1, true);
    {   const bf16* kb = P1 + (size_t)b * SEQ * P1W + C_KV + (4 * 2 + g) * 64; const bf16* vbp = P1 + (size_t)b * SEQ * P1W + C_KV + (5 * 2 + g) * 64;
        const int mlo = (ti >= 8) ? ti - 8 : 0;
        AtRegs rg = at_load_bf16(kb + (size_t)mlo * 64 * P1W, vbp + (size_t)mlo * 64 * P1W, tid); at_store(lds, 0, rg, tid); __syncthreads();
        for (int mb = mlo; mb <= cur; ++mb) {
            if (mb < cur) rg = at_load_bf16(kb + (size_t)(mb + 1) * 64 * P1W, vbp + (size_t)(mb + 1) * 64 * P1W, tid);
            const int lo = ts - 511 - mb * 64, hi = ts - mb * 64;
            u64 vm = 0ull; if (hi >= 0 && lo <= 63) vm = mask_lo(hi + 1) & ~mask_lo(lo);
            at_step(lds, (mb - mlo) & 1, qr, o, m, l, vm, lane);
            if (mb < cur) at_store(lds, (mb - mlo + 1) & 1, rg, tid);
            __syncthreads();
        }
    }
    at_fold(ot, o, m, l, g2, true);
    {   bf16* op = P1 + row * P1W + C_Q + hd * 64 + 4 * h;
#pragma unroll
        for (int db = 0; db < 2; ++db)
#pragma unroll
            for (int q4 = 0; q4 < 4; ++q4) { u32x2 wv; wv.x = cvtpk_bf16(ot[db][4 * q4], ot[db][4 * q4 + 1]); wv.y = cvtpk_bf16(ot[db][4 * q4 + 2], ot[db][4 * q4 + 3]); GST(*(u32x2*)(op + 32 * db + 8 * q4) = wv); } }
}

__device__ __forceinline__ void set_dry(LAS unsigned char* l, int v) { __syncthreads(); if (threadIdx.x == 0) ((volatile LAS int*)(l + LDS_CTL + 64))[0] = v; __syncthreads(); }
constexpr int NPH = 1 + 9 * NL;
__global__ void __launch_bounds__(512, 2) fwd_kernel(Args args) {
    extern __shared__ __attribute__((aligned(16))) unsigned char lds_raw[];
    LAS unsigned char* ldsl = (LAS unsigned char*)lds_raw;
    float* ldsf = (float*)lds_raw;
    const int G = gridDim.x, bx = blockIdx.x, NGW = G * 8;
#define PHASE_IDS() const int tid = opaque_tid(), lane = tid & 63, wave = __builtin_amdgcn_readfirstlane(tid >> 6), gw = bx * 8 + wave; (void)lane; (void)gw
#define ws ARG_WS()
#define ctl ((unsigned*)(ws + WS_CTL))
#define H ARG_OUT()
#define XN ((bf16*)(ws + WS_XN))
#define P1 ((bf16*)(ws + WS_P1))
#define Rr ((bf16*)(ws + WS_R))
#define WIN ((bf16*)(ws + WS_WIN))
#define WB ((bf16*)(ws + WS_WB))
#define WOUT ((bf16*)(ws + WS_WOUT))
#define WGU ((bf16*)(ws + WS_WGU))
#define WD ((bf16*)(ws + WS_WD))
#define HID ((bf16*)(ws + WS_HID))
#define Y ((bf16*)(ws + WS_Y))
#define KC ((float*)(ws + WS_KC))
#define AGA ((float*)(ws + WS_LRUA))
#define AGH ((float*)(ws + WS_LRUH))
#define LIST ((unsigned*)(ws + WS_LIST))
#define LISTW ((float*)(ws + WS_LISTW))
    { PHASE_IDS(); for (int u = tid; u < (LDS_BYTES - LDS_CTL) / 4; u += 512) ((LAS unsigned*)(ldsl + LDS_CTL))[u] = 0u; }
    __syncthreads();
    XcdBarrier bar; bar.bar = ctl + CW_BAR; bar.x = 0; bar.st = nullptr;
    if (!MK_SPLIT) bar = xcd_barrier_post(ctl + CW_BAR, (volatile LAS unsigned*)(ldsl + LDS_CTL + 32));
    const int lo = args.ph_lo, hi = args.ph_hi;
#define IN(k) (lo <= (k) && (k) < hi)
#if PROBE_PH >= 0
#define PHASE_REP(id) for (int rep_ = 0; rep_ < (((id) == PROBE_PH) ? 2 : 1); ++rep_, set_dry(ldsl, 0)) if (set_dry(ldsl, rep_), true)
#else
#define PHASE_REP(id) if (true)
#endif
#define SEAM(k) do { if (!MK_SPLIT && IN((k) + 1)) { for (int r_ = 0; r_ < ((PROBE_PH == 50) ? 3 : 1); ++r_) xcd_barrier(bar); } } while (0)
    const LAS int* tab = (const LAS int*)(ldsl + LDS_MOE);

    if (IN(0)) PHASE_REP(100) {
        PHASE_IDS();
        float* scr = ldsf + wave * 4096;
        constexpr int IT_WIN = 16 * 249, IT_WB = 8 * 32, IT_WO = 16 * 32;
        constexpr int IT_W1 = 32 * 2, IT_LW = 2, IT_PW = 2 * 4;
        constexpr int NIT = NL * IT_WIN + NL * 4 * IT_WB + NL * IT_WO + NL * 4 * IT_W1 + NL * 16 * IT_LW + NL * 4 * IT_PW;
        for (int it = gw; it < NIT; it += NGW) {
            int r = it;
            if (r < NL * IT_WIN) { const int l = r / IT_WIN; r -= l * IT_WIN; tr_item(ARG_IN(I_WIN) + (size_t)l * D * NIN, D, NIN, WIN + (size_t)l * NPROJ * D, scr, r / 249, r % 249, lane, [](int s) { return win_dst_row(s); }); continue; }
            r -= NL * IT_WIN;
            if (r < NL * 4 * IT_WB) { const int ln = r / IT_WB; r -= ln * IT_WB; tr_item(ARG_IN(I_WBR) + (size_t)ln * 512 * 1024, 512, 1024, WB + (size_t)ln * 1024 * 512, scr, r / 32, r % 32, lane, [](int s) { return s; }); continue; }
            r -= NL * 4 * IT_WB;
            if (r < NL * IT_WO) { const int l = r / IT_WO; r -= l * IT_WO; tr_item(ARG_IN(I_WOUT) + (size_t)l * 1024 * 1024, 1024, 1024, WOUT + (size_t)l * 1024 * 1024, scr, r / 32, r % 32, lane, [](int s) { return s; }); continue; }
            r -= NL * IT_WO;
            if (r < NL * 4 * IT_W1) { const int m = r / IT_W1; r -= m * IT_W1; tr_item(ARG_IN(I_CW1) + (size_t)m * 2048 * 64, 2048, 64, (bf16*)(ws + WS_W1T) + (size_t)m * 64 * 2048, scr, r / 2, r % 2, lane, [](int s) { return s; }); continue; }
            r -= NL * 4 * IT_W1;
            if (r < NL * 16 * IT_LW) { const int m = r / IT_LW; r -= m * IT_LW; const int l = m >> 4, mat = (m >> 3) & 1, hh = m & 7;
                tr_item(ARG_IN(mat ? I_LWX : I_LWA) + ((size_t)l * 8 + hh) * 4096, 64, 64, (bf16*)(ws + WS_LWT) + (size_t)m * 4096, scr, 0, r, lane, [](int s) { return s; }); continue; }
            r -= NL * 16 * IT_LW;
            { const int m = r / IT_PW; r -= m * IT_PW; tr_item(ARG_IN(I_PW) + (size_t)m * 16384, 128, 128, (bf16*)(ws + WS_PWT) + (size_t)m * 16384, scr, r / 4, r % 4, lane, [](int s) { return s; }); }
        }
        for (int e = bx * 512 + tid; e < NL * 232 * 128; e += G * 512) { const int l = e / (232 * 128), rr = (e / 128) % 232, c8 = (e % 128) * 8;
            GST(*(u32x4*)(WIN + ((size_t)l * NPROJ + C_GC + 24 + rr) * D + c8) = (u32x4){0u, 0u, 0u, 0u}); }
        for (int m = gw; m < T; m += NGW) norm_row<0>(ARG_IN(I_X) + (size_t)m * D, H + (size_t)m * D, nullptr, nullptr, ARG_IN(I_N1G), XN + (size_t)m * D, lane);
    }
    SEAM(0);

    for (int l = 0; l < NL; ++l) {
        const int pb = 1 + 9 * l;
        if (IN(pb + 0)) PHASE_REP(0) {
            SchedDense S{XN, WIN + (size_t)l * NPROJ * D, D, D, T / 256, NPROJ / 256, G, bx};
            EpiProj E{P1, Rr};
            pg8::gemm_phase<EpiProj, SchedDense, true>(ldsl, D, S, E);
        }
        SEAM(pb + 0);
        if (IN(pb + 1)) PHASE_REP(1) {
            constexpr int U_LRU = NB * 64, U_GM = 128 * 4, U_CMP = 256;
            for (int u = bx; u < U_LRU + U_GM + U_CMP; u += G) {
                if (u < U_CMP) cmp_unit2(ldsl, P1, KC, ARG_IN(I_PE) + (size_t)l * 2 * 2048, (const bf16*)(ws + WS_W1T) + (size_t)l * 4 * 64 * 2048, ARG_IN(I_CW2) + (size_t)l * 4 * 4096, u);
                else if (u < U_CMP + U_GM) gmlp_unit2(ldsl, P1, ARG_IN(I_GMNG) + l * 512, ARG_IN(I_GMWS) + (size_t)l * 4 * 16384, ARG_IN(I_GMB) + l * 512, u - U_CMP);
                else lru_unit2(ldsl, P1, XN, AGA, AGH, ARG_IN(I_CONVW) + l * 2048, ARG_IN(I_CONVB) + l * 512, (const bf16*)(ws + WS_LWT) + (size_t)(l * 2 + 0) * 8 * 4096, (const bf16*)(ws + WS_LWT) + (size_t)(l * 2 + 1) * 8 * 4096,
                               ARG_IN(I_LBA) + l * 512, ARG_IN(I_LBX) + l * 512, ARG_IN(I_LLAM) + l * 512, u - U_CMP - U_GM);
            }
            __syncthreads();
        }
        SEAM(pb + 1);
        if (IN(pb + 2)) PHASE_REP(2) {
            constexpr int U_AT = NB * 2 * 64, U_PL = NB * 64 * 4, U_FX = NB * 64;
            for (int u = bx; u < U_AT + U_PL + U_FX; u += G) {
                if (u < U_AT) { const int k = u >> 3, bg = u & 7; const int ti = (u < 256) ? 63 - k : k - 32; attn_unit_mfma(ldsl, P1, KC, (bg << 6) | ti); }
                else if (u < U_AT + U_PL) pool_unit2(ldsl, P1, (const bf16*)(ws + WS_PWT) + ((size_t)l * 4 + ((u - U_AT) & 3)) * 16384, ARG_IN(I_PS) + l * 512, u - U_AT);
                else lrufix_unit2(P1, XN, AGA, AGH, u - U_AT - U_PL);
            }
            __syncthreads();
        }
        SEAM(pb + 2);
        if (IN(pb + 3)) PHASE_REP(3) {
            SchedMerge S{P1, WB + (size_t)l * 4 * 1024 * 512, G, bx};
            EpiMerge E{Rr, XN};
            pg8::gemm_phase<EpiMerge, SchedMerge, false>(ldsl, 512, S, E);
        }
        SEAM(pb + 3);
        if (IN(pb + 4)) PHASE_REP(4) {
            SchedDense S{XN, WOUT + (size_t)l * 1024 * 1024, D, D, T / 256, 4, G, bx};
            EpiWout E{H};
            pg8::gemm_phase<EpiWout, SchedDense, false>(ldsl, D, S, E);
        }
        SEAM(pb + 4);
        if (IN(pb + 5)) PHASE_REP(5) {
            PHASE_IDS();
            {   float* scr = ldsf + wave * 4096;
                constexpr int IT_G = 16 * 16, IT_D = 8 * 32;
                for (int it = gw; it < 16 * (2 * IT_G + IT_D); it += NGW) {
                    const int e = it / (2 * IT_G + IT_D); int r = it % (2 * IT_G + IT_D);
                    if (r < IT_G) tr_item(ARG_IN(I_MG) + ((size_t)l * 16 + e) * 1024 * 512, 1024, 512, WGU + (size_t)e * 1024 * 1024, scr, r / 16, r % 16, lane, [](int s) { return 256 * (s >> 7) + (s & 127); });
                    else if (r < 2 * IT_G) { r -= IT_G; tr_item(ARG_IN(I_MU) + ((size_t)l * 16 + e) * 1024 * 512, 1024, 512, WGU + (size_t)e * 1024 * 1024, scr, r / 16, r % 16, lane, [](int s) { return 256 * (s >> 7) + 128 + (s & 127); }); }
                    else { r -= 2 * IT_G; tr_item(ARG_IN(I_MD) + ((size_t)l * 16 + e) * 512 * 1024, 512, 1024, WD + (size_t)e * 1024 * 512, scr, r / 32, r % 32, lane, [](int s) { return s; }); }
                }
            }
            __syncthreads();
            for (int e = tid; e < 1024 * 20; e += 512) { const int k = e / 20, o = e % 20;
                ldsf[o * 1024 + k] = (o < 4) ? ARG_IN(I_RWG)[(size_t)l * 4096 + k * 4 + o] : ARG_IN(I_RWE)[(size_t)l * 16384 + k * 16 + (o - 4)]; }
            __syncthreads();
            const float* g2 = ARG_IN(I_N2G) + l * D; const float* bg = ARG_IN(I_RBG) + l * 4; const float* be = ARG_IN(I_RBE) + l * 16;
            unsigned* cnt = ctl + CW_CNT + 64 * l;
            for (int m = gw; m < T; m += NGW) {
                const float* hr = H + (size_t)m * D; f32x4 v[4]; float ss = 0.f;
#pragma unroll
                for (int jj = 0; jj < 4; ++jj) { v[jj] = *(const f32x4*)(hr + 4 * lane + 256 * jj); ss += (v[jj].x * v[jj].x + v[jj].y * v[jj].y) + (v[jj].z * v[jj].z + v[jj].w * v[jj].w); }
                const float rstd = rsqrtf(wave_sum(ss) * (1.f / D) + EPS);
#pragma unroll
                for (int jj = 0; jj < 4; ++jj) { const f32x4 gg = *(const f32x4*)(g2 + 4 * lane + 256 * jj); v[jj].x *= rstd * gg.x; v[jj].y *= rstd * gg.y; v[jj].z *= rstd * gg.z; v[jj].w *= rstd * gg.w;
                    u32x2 o; o.x = pk2(v[jj].x, v[jj].y); o.y = pk2(v[jj].z, v[jj].w); GST(*(u32x2*)(XN + (size_t)m * D + 4 * lane + 256 * jj) = o); }
                float lg[20];
#pragma unroll
                for (int o = 0; o < 20; ++o) { float a = 0.f;
#pragma unroll
                    for (int jj = 0; jj < 4; ++jj) { const f32x4 wv = *(const f32x4*)(ldsf + o * 1024 + 4 * lane + 256 * jj); a += v[jj].x * wv.x + v[jj].y * wv.y + v[jj].z * wv.z + v[jj].w * wv.w; }
                    lg[o] = wave_sum(a); if ((o & 3) == 3) __builtin_amdgcn_sched_barrier(0); }
                float gl[4]; int grp = 0; float gmx;
#pragma unroll
                for (int k = 0; k < 4; ++k) gl[k] = lg[k] + bg[k];
                gmx = gl[0];
#pragma unroll
                for (int k = 1; k < 4; ++k) if (gl[k] > gmx) { gmx = gl[k]; grp = k; }
                float den = 0.f;
#pragma unroll
                for (int k = 0; k < 4; ++k) den += __expf(gl[k] - gmx);
                const float grpw = 1.f / den;
                float el[4];
#pragma unroll
                for (int k = 0; k < 4; ++k) { float vsel = 0.f;
#pragma unroll
                    for (int gg = 0; gg < 4; ++gg) vsel = (grp == gg) ? (lg[4 + gg * 4 + k] + be[gg * 4 + k]) : vsel;
                    el[k] = vsel; }
                int i1 = 0; float m1 = el[0];
#pragma unroll
                for (int k = 1; k < 4; ++k) if (el[k] > m1) { m1 = el[k]; i1 = k; }
                int i2 = -1; float m2 = 0.f;
#pragma unroll
                for (int k = 0; k < 4; ++k) if (k != i1 && (i2 < 0 || el[k] > m2)) { m2 = el[k]; i2 = k; }
                const float ex = __expf(m2 - m1); const float w1 = grpw / (1.f + ex), w2 = grpw * ex / (1.f + ex);
                if (lane == 0 && !is_dry()) {
                    const int e1 = grp * 4 + i1, e2 = grp * 4 + i2;
                    const unsigned p1 = atomicAdd(&cnt[e1], 1u); LIST[(size_t)e1 * T + p1] = (unsigned)m; LISTW[(size_t)e1 * T + p1] = w1;
                    const unsigned p2 = atomicAdd(&cnt[e2], 1u); LIST[(size_t)e2 * T + p2] = (unsigned)m | (1u << 14); LISTW[(size_t)e2 * T + p2] = w2;
                }
            }
            __syncthreads();
        }
        SEAM(pb + 5);
        if (IN(pb + 6) || IN(pb + 7)) {
            __syncthreads();
            if (threadIdx.x == 0) { LAS int* tw = (LAS int*)(ldsl + LDS_MOE); int acc = 0;
                for (int e = 0; e < 16; ++e) { const int c = (int)__hip_atomic_load(ctl + CW_CNT + 64 * l + e, __ATOMIC_RELAXED, __HIP_MEMORY_SCOPE_AGENT); tw[e] = acc; tw[32 + e] = c; acc += (c + 255) >> 8; }
                tw[16] = acc; }
            __syncthreads();
        }
        if (IN(pb + 6)) PHASE_REP(6) {
            SchedMoe S{XN, WGU, LIST, D, D, 1024, G, bx, true, tab};
            EpiGateUp E{HID, LISTW, tab};
            pg8::gemm_phase<EpiGateUp, SchedMoe, true>(ldsl, D, S, E);
        }
        SEAM(pb + 6);
        if (IN(pb + 7)) PHASE_REP(7) {
            SchedMoe S{HID, WD, LIST, 512, 512, 1024, G, bx, false, tab};
            EpiDown E{Y, LIST, tab};
            pg8::gemm_phase<EpiDown, SchedMoe, true>(ldsl, 512, S, E);
        }
        SEAM(pb + 7);
        if (IN(pb + 8)) PHASE_REP(8) {
            PHASE_IDS();
            if (l + 1 < NL) { for (int m = gw; m < T; m += NGW) norm_row<1>(nullptr, H + (size_t)m * D, Y + (size_t)m * D, Y + ((size_t)T + m) * D, ARG_IN(I_N1G) + (l + 1) * D, XN + (size_t)m * D, lane); }
            else { for (int m = gw; m < T; m += NGW) norm_row<2>(nullptr, H + (size_t)m * D, Y + (size_t)m * D, Y + ((size_t)T + m) * D, ARG_IN(I_FNG), nullptr, lane); }
        }
        if (l + 1 < NL) SEAM(pb + 8);
    }
#undef IN
#undef SEAM
#undef ws
#undef ctl
#undef H
#undef XN
#undef P1
#undef Rr
#undef WIN
#undef WB
#undef WOUT
#undef WGU
#undef WD
#undef HID
#undef Y
#undef KC
#undef AGA
#undef AGH
#undef LIST
#undef LISTW
}

extern "C" void kernel_launch(void* const* d_in, const int* in_sizes, int n_in, void* d_out, int out_size, void* d_ws, size_t ws_size, hipStream_t stream) {
    static int grid = 0;
    if (grid == 0) {
        if (n_in != 29 || in_sizes[0] != T * D || out_size != T * D || ws_size < WS_END) { fprintf(stderr, "kernel_launch: unexpected shapes / workspace (%d inputs, ws %zu < %zu); nothing launched\n", n_in, ws_size, (size_t)WS_END); grid = -1; return; }
        int dev = 0, cus = 0;
        if (hipGetDevice(&dev) != hipSuccess || hipDeviceGetAttribute(&cus, hipDeviceAttributeMultiprocessorCount, dev) != hipSuccess) { grid = -1; return; }
        if (hipFuncSetAttribute((const void*)fwd_kernel, hipFuncAttributeMaxDynamicSharedMemorySize, LDS_BYTES) != hipSuccess) { fprintf(stderr, "kernel_launch: hipFuncSetAttribute failed\n"); grid = -1; return; }
        int per_cu = 0;
        if (hipOccupancyMaxActiveBlocksPerMultiprocessor(&per_cu, (const void*)fwd_kernel, 512, LDS_BYTES) != hipSuccess || per_cu < 1) { fprintf(stderr, "kernel_launch: occupancy query says %d\n", per_cu); }
        (void)hipGetLastError();
        grid = cus;
    }
    if (grid < 0) return;
    if (hipMemsetAsync((char*)d_ws + WS_CTL, 0, CTL_ZERO_BYTES, stream) != hipSuccess) return;
    Args a{};
    for (int i = 0; i < 29; ++i) a.in[i] = (const float*)d_in[i];
    a.out = (float*)d_out; a.ws = (unsigned char*)d_ws;
#if MK_SPLIT
    for (int p = 0; p < NPH; ++p) { a.ph_lo = p; a.ph_hi = p + 1; hipLaunchKernelGGL(fwd_kernel, dim3(grid), dim3(512), LDS_BYTES, stream, a); }
#else
    a.ph_lo = 0; a.ph_hi = NPH;
    hipLaunchKernelGGL(fwd_kernel, dim3(grid), dim3(512), LDS_BYTES, stream, a);
#endif
}
```

```cpp
#include <hip/hip_runtime.h>
#include <cstdio>
#include <cstdint>

#define GAS __attribute__((address_space(1)))
#define LAS __attribute__((address_space(3)))
typedef unsigned short bf16;
typedef unsigned u32x4 __attribute__((ext_vector_type(4)));
typedef unsigned u32x2 __attribute__((ext_vector_type(2)));
typedef float f32x4 __attribute__((ext_vector_type(4)));
typedef float f32x2 __attribute__((ext_vector_type(2)));
typedef short bf16x8 __attribute__((ext_vector_type(8)));
typedef unsigned long long u64;

#ifndef MK_SPLIT
#define MK_SPLIT 0
#endif

constexpr int NB = 4, SEQ = 4096, T = NB * SEQ, D = 1024, MIX = 512, NL = 2;
constexpr int NIN = 7960, NPROJ = 8192, P1W = 3904;
constexpr int C_U = 0, C_V = 512, C_GB = 1024, C_RB = 1536, C_Q = 2048, C_KV = 2560, C_XD = 3328, C_GC = 3840;
constexpr int SRC_GC = 3328, SRC_XD = 3352, SRC_MG = 3864;
constexpr float EPS = 1e-6f;
constexpr int NEXP = 16, DEXP = 512;
constexpr int HID_ROWS = 2 * T + 4096;

constexpr size_t MiB = 1u << 20;
constexpr size_t WS_CTL = 0, CTL_ZERO_BYTES = 1 * MiB;
constexpr size_t WS_KC = 1 * MiB;
constexpr size_t WS_LRUA = 2 * MiB;
constexpr size_t WS_LRUH = 2 * MiB + 512 * 1024;
constexpr size_t WS_LIST = 3 * MiB;
constexpr size_t WS_LISTW = 4 * MiB;
constexpr size_t WS_W1T = 5 * MiB;
constexpr size_t WS_LWT = 7 * MiB;
constexpr size_t WS_PWT = 7 * MiB + 256 * 1024;
constexpr size_t WS_WIN = 8 * MiB;
constexpr size_t WS_WB = 40 * MiB;
constexpr size_t WS_WOUT = 48 * MiB;
constexpr size_t WS_XN = 52 * MiB;
constexpr size_t WS_P1 = 84 * MiB;
constexpr size_t WS_R = 212 * MiB;
constexpr size_t WS_WGU = 84 * MiB;
constexpr size_t WS_WD = 116 * MiB;
constexpr size_t WS_HID = 132 * MiB;
constexpr size_t WS_Y = 168 * MiB;
constexpr size_t WS_END = 340 * MiB;
static_assert(WS_HID + (size_t)HID_ROWS * 512 * 2 <= WS_Y && WS_Y + (size_t)2 * T * 1024 * 2 <= WS_END && WS_P1 + (size_t)T * P1W * 2 <= WS_R && WS_R + (size_t)4 * T * 1024 * 2 <= WS_END, "ws map");

constexpr int CW_BAR = 4096;
constexpr int CW_CNT = 8192;
constexpr int CW_E1 = 16384;
constexpr int CW_G2 = 49152;
constexpr int CW_Q = 8448;

__device__ __forceinline__ unsigned f2bf(float f) { unsigned u = __builtin_bit_cast(unsigned, f); return (u + 0x7fffu + ((u >> 16) & 1u)) >> 16; }
typedef __bf16 bf16x2_hw __attribute__((ext_vector_type(2)));
__device__ __forceinline__ unsigned pk2(float lo, float hi) { f32x2 v = {lo, hi}; bf16x2_hw b = __builtin_convertvector(v, bf16x2_hw); return __builtin_bit_cast(unsigned, b); }
__device__ __forceinline__ float bflo(unsigned u) { return __builtin_bit_cast(float, u << 16); }
__device__ __forceinline__ float bfhi(unsigned u) { return __builtin_bit_cast(float, u & 0xffff0000u); }
__device__ __forceinline__ float bf2f(bf16 h) { return __builtin_bit_cast(float, (unsigned)h << 16); }
__device__ __forceinline__ float sigmoidf_(float x) { return __builtin_amdgcn_rcpf(1.0f + __builtin_amdgcn_exp2f(-1.4426950408889634f * x)); }
__device__ __forceinline__ float gelu_tanh(float x) { const float z = 1.5957691216057308f * (x + 0.044715f * x * x * x); return x * sigmoidf_(z); }
__device__ __forceinline__ float dpp_add_(float v, const int ctrl, const int row_mask) {
    return v;
}
#define DPP_ADD(v, ctrl, rmask) ((v) + __builtin_bit_cast(float, __builtin_amdgcn_update_dpp(0, __builtin_bit_cast(int, (v)), (ctrl), (rmask), 0xf, false)))
__device__ __forceinline__ float wave_sum(float v) {
    v = DPP_ADD(v, 0xB1, 0xf);
    v = DPP_ADD(v, 0x4E, 0xf);
    v = DPP_ADD(v, 0x141, 0xf);
    v = DPP_ADD(v, 0x140, 0xf);
    v = DPP_ADD(v, 0x142, 0xa);
    v = DPP_ADD(v, 0x143, 0xc);
    return __builtin_bit_cast(float, __builtin_amdgcn_readlane(__builtin_bit_cast(int, v), 63));
}
__device__ __forceinline__ u64 mask_lo(int n) { return n >= 64 ? ~0ull : (n <= 0 ? 0ull : ((1ull << n) - 1ull)); }
#define LDS_WAIT() asm volatile("s_waitcnt lgkmcnt(0)" ::: "memory")
#ifndef PROBE_PH
#define PROBE_PH -1
#endif
#ifndef PROBE_T_LO
#define PROBE_T_LO -1
#define PROBE_T_HI -1
#endif
#define PROBE_T_MULT 4
#ifndef ABL
#define ABL 0
#endif
#define ABL_ON(bit) ((ABL & (bit)) && is_dry())
#ifndef PROBE_BLK
#define PROBE_BLK 0
#endif
#ifdef PROBE_SUB
#define SUBT0() const unsigned long long ts0_ = __builtin_amdgcn_s_memrealtime()
#define SUBT1(ty) do { __syncthreads(); if ((ty) == PROBE_SUB) tacc_ += __builtin_amdgcn_s_memrealtime() - ts0_; } while (0)
#else
#define SUBT0() do {} while (0)
#define SUBT1(ty) do {} while (0)
#endif

constexpr int LDS_BYTES = 147456;
constexpr int LDS_CTL = 146432;
constexpr int LDS_MOE = LDS_CTL + 256;
__device__ __forceinline__ bool is_dry() {
#if PROBE_PH >= 0
    extern __shared__ __attribute__((aligned(16))) unsigned char lds_raw_[]; return ((volatile LAS int*)((LAS unsigned char*)lds_raw_ + LDS_CTL + 64))[0] != 0;
#else
    return false;
#endif
}
#define GST(...) do { if (!is_dry()) { __VA_ARGS__; } } while (0)
#ifdef PROBE_FINE
#define FT0(id) unsigned long long ft0_##id = ((id) == PROBE_FINE) ? __builtin_amdgcn_s_memrealtime() : 0ull
#define FT1(id) do { if ((id) == PROBE_FINE && threadIdx.x == 0) { extern __shared__ __attribute__((aligned(16))) unsigned char lds_raw_f[]; volatile LAS unsigned long long* a_ = (volatile LAS unsigned long long*)((LAS unsigned char*)lds_raw_f + LDS_CTL + 128); *a_ = *a_ + (__builtin_amdgcn_s_memrealtime() - ft0_##id); } } while (0)
#else
#define FT0(id) do {} while (0)
#define FT1(id) do {} while (0)
#endif
__device__ __forceinline__ int opaque_tid() { int t = (int)threadIdx.x; asm volatile("" : "+v"(t)); return t; }

namespace pg8 {
constexpr int BM = 256, BK = 64, HALF = 128, HTB = HALF * BK * 2, NXCD = 8, WGM = 8;
__host__ __device__ __forceinline__ int lds_byte(int r, int c) { const int st = (r >> 4) * 2 + (c >> 5), rr = r & 15, cc = c & 31, ob = rr * 64 + cc * 2; return st * 1024 + (ob ^ (((ob >> 9) & 1) << 5)); }
__host__ __device__ __forceinline__ void stage_rc(int b, int& R, int& C) { const int st = b / 1024, sb = b % 1024, swz = sb ^ (((sb >> 9) & 1) << 5); R = (st >> 1) * 16 + swz / 64; C = (st & 1) * 32 + (swz % 64) / 2; }
__host__ __device__ __forceinline__ int perm32(int rho) { const int n = rho >> 4, i = rho & 15; return 8 * (i >> 2) + 4 * n + (i & 3); }

struct Unit { const char* A; const char* B; int pm, pn, sub, e; };

__device__ __forceinline__ bool static_tile(int i, int G, int c, int nM, int nN, int& pm, int& pn) {
    const int nwg = nM * nN; const long L = (long)i * G + c; if (L >= nwg) return false;
    int wgid = (int)L; { const int q = nwg / NXCD, r = nwg % NXCD, xcd = wgid % NXCD, off = wgid / NXCD; wgid = (xcd < r ? xcd * (q + 1) : r * (q + 1) + (xcd - r) * q) + off; }
    const int nig = WGM * nN, gid = wgid / nig, fm = gid * WGM, gsz = (nM - fm) < WGM ? (nM - fm) : WGM;
    pm = fm + ((wgid % nig) % gsz); pn = (wgid % nig) / gsz; return true;
}

template <class Epi, class Sched, bool ALIGN_EPI>
__device__ __forceinline__ void gemm_phase(LAS unsigned char* lds, const int K, const Sched& S, const Epi& E) {
    const int tid = opaque_tid(), wid = __builtin_amdgcn_readfirstlane(tid >> 6), lane = tid & 63, wr = wid >> 2, wc = wid & 3, fr = lane & 15, fq = lane >> 4;
    const int nt = K / BK;
    unsigned voffB[2];
#pragma unroll
    for (int i = 0; i < 2; ++i) { int R, C; stage_rc(tid * 16 + i * 8192, R, C); const int Rb = (R & ~31) + perm32(R & 31); voffB[i] = (unsigned)(Rb * K + C) * 2u; }
    const size_t kstep = (size_t)(BK * 2);
    const size_t hstepB = (size_t)HALF * K * 2;
    const unsigned ldsw = (unsigned)wid * 1024u;
    const int aoff = lds_byte(wr * 64 + fr, fq * 8), boff = lds_byte(wc * 32 + fr, fq * 8);
#define PG8_SA(b, h) (((b) * 2 + (h)) * HTB)
#define PG8_SB(b, h) ((4 + (b) * 2 + (h)) * HTB)
#define PG8_STAGE(bufoff, gbase, voff) do { _Pragma("unroll") for (int _i = 0; _i < 2; ++_i) \
        __builtin_amdgcn_global_load_lds((const unsigned*)((const char*)(gbase) + (voff)[_i]), (LAS unsigned*)(lds + (bufoff) + ldsw + _i * 8192), 16, 0, 0); } while (0)
#define PG8_LDA(dst, b, h) do { _Pragma("unroll") for (int m = 0; m < 4; ++m) _Pragma("unroll") for (int k = 0; k < 2; ++k) dst[m][k] = *(const LAS bf16x8*)(lds + PG8_SA(b, h) + aoff + m * 2048 + k * 1024); } while (0)
#define PG8_LDB(dst, b, h) do { _Pragma("unroll") for (int n = 0; n < 2; ++n) _Pragma("unroll") for (int k = 0; k < 2; ++k) dst[n][k] = *(const LAS bf16x8*)(lds + PG8_SB(b, h) + boff + n * 2048 + k * 1024); } while (0)
#define PG8_MMA(ai, bj, At, Bt) do { __builtin_amdgcn_s_setprio(1); _Pragma("unroll") for (int m = 0; m < 4; ++m) _Pragma("unroll") for (int n = 0; n < 2; ++n) _Pragma("unroll") for (int k = 0; k < 2; ++k) \
        acc[ai][bj][m][n] = __builtin_amdgcn_mfma_f32_16x16x32_bf16(Bt[n][k], At[m][k], acc[ai][bj][m][n], 0, 0, 0); __builtin_amdgcn_s_setprio(0); } while (0)
#define PG8_WAIT_V(n) asm volatile("s_waitcnt vmcnt(" #n ")" ::: "memory")
#define PG8_WAIT_L(n) asm volatile("s_waitcnt lgkmcnt(" #n ")" ::: "memory")
#define PG8_BAR __builtin_amdgcn_s_barrier()
#define PG8_SCHED __builtin_amdgcn_sched_barrier(0)
#define PG8_ZERO() do { _Pragma("unroll") for (int a = 0; a < 2; ++a) _Pragma("unroll") for (int b = 0; b < 2; ++b) _Pragma("unroll") for (int m = 0; m < 4; ++m) _Pragma("unroll") for (int n = 0; n < 2; ++n) acc[a][b][m][n] = (f32x4){0.f, 0.f, 0.f, 0.f}; } while (0)
    Unit cur, nxt; int ui = 0;
    if (!S.next(0, cur)) return;
    f32x4 acc[2][2][4][2];
    PG8_ZERO();
    bf16x8 At[4][2], B0[2][2], B1[2][2];
    unsigned voA[2][2], voN[2][2];
    S.a_off(cur, voA);
    const char* cA = cur.A; const char* cB = cur.B;
    S.a_ready(cur);
    PG8_STAGE(PG8_SB(0, 0), cB, voffB); PG8_STAGE(PG8_SB(0, 1), cB + hstepB, voffB); PG8_STAGE(PG8_SA(0, 0), cA, voA[0]); PG8_STAGE(PG8_SA(0, 1), cA, voA[1]);
    if (wr == 1) PG8_BAR;
    PG8_WAIT_V(2); PG8_BAR;
    PG8_STAGE(PG8_SB(1, 0), cB + kstep, voffB); PG8_STAGE(PG8_SA(1, 0), cA + kstep, voA[0]); PG8_STAGE(PG8_SB(1, 1), cB + hstepB + kstep, voffB);
    PG8_WAIT_V(6); PG8_BAR;
    for (;;) {
        const bool has_next = S.next(ui + 1, nxt);
        if (has_next) S.a_ready(nxt);
        const char* nA = has_next ? nxt.A : cA; const char* nB = has_next ? nxt.B : cB;
        if (has_next) S.a_off(nxt, voN); else { voN[0][0] = voA[0][0]; voN[0][1] = voA[0][1]; voN[1][0] = voA[1][0]; voN[1][1] = voA[1][1]; }
        for (int t = 0; t < nt; t += 2) {
            const bool last = (t == nt - 2);
            const char* a1 = cA + (size_t)(t + 1) * kstep;
            const char* a2 = last ? nA : cA + (size_t)(t + 2) * kstep; const char* b2 = last ? nB : cB + (size_t)(t + 2) * kstep;
            const char* a3 = a2 + kstep; const char* b3 = b2 + kstep;
            PG8_LDB(B0, 0, 0); PG8_LDB(B1, 0, 1); PG8_SCHED; PG8_LDA(At, 0, 0); PG8_STAGE(PG8_SA(1, 1), a1, voA[1]);
            PG8_WAIT_V(8); PG8_WAIT_L(0); PG8_BAR; PG8_MMA(0, 0, At, B0); PG8_MMA(0, 1, At, B1); PG8_BAR; PG8_SCHED;
            if (last) { voA[0][0] = voN[0][0]; voA[0][1] = voN[0][1]; voA[1][0] = voN[1][0]; voA[1][1] = voN[1][1]; }
            PG8_LDA(At, 0, 1); PG8_STAGE(PG8_SB(0, 0), b2, voffB); PG8_STAGE(PG8_SB(0, 1), b2 + hstepB, voffB); PG8_STAGE(PG8_SA(0, 0), a2, voA[0]);
            PG8_WAIT_V(8); PG8_WAIT_L(0); PG8_BAR; PG8_MMA(1, 0, At, B0); PG8_MMA(1, 1, At, B1); PG8_BAR; PG8_SCHED;
            PG8_LDB(B0, 1, 0); PG8_LDB(B1, 1, 1); PG8_SCHED; PG8_LDA(At, 1, 0); PG8_STAGE(PG8_SA(0, 1), a2, voA[1]);
            PG8_WAIT_V(8); PG8_WAIT_L(0); PG8_BAR; PG8_MMA(0, 0, At, B0); PG8_MMA(0, 1, At, B1); PG8_BAR; PG8_SCHED;
            PG8_LDA(At, 1, 1); PG8_STAGE(PG8_SB(1, 0), b3, voffB); PG8_STAGE(PG8_SB(1, 1), b3 + hstepB, voffB); PG8_STAGE(PG8_SA(1, 0), a3, voA[0]);
            PG8_WAIT_V(8); PG8_WAIT_L(0); PG8_BAR; PG8_MMA(1, 0, At, B0); PG8_MMA(1, 1, At, B1); PG8_BAR; PG8_SCHED;
        }
        if constexpr (ALIGN_EPI) { if (wr == 0) PG8_BAR; }
        int tz = lane; asm volatile("" : "+v"(tz));
        const bool z = E(acc, cur, wr, wc, tz & 15, tz >> 4);
        S.done(cur);
        if (!has_next) break;
        if (z) PG8_ZERO();
        cur = nxt; cA = nA; cB = nB; ++ui;
        if constexpr (ALIGN_EPI) { if (wr == 1) PG8_BAR; }
    }
    PG8_WAIT_V(0);
    if constexpr (!ALIGN_EPI) { if (wr == 0) PG8_BAR; }
    PG8_BAR;
#undef PG8_SA
#undef PG8_SB
#undef PG8_STAGE
#undef PG8_LDA
#undef PG8_LDB
#undef PG8_MMA
#undef PG8_WAIT_V
#undef PG8_WAIT_L
#undef PG8_BAR
#undef PG8_SCHED
#undef PG8_ZERO
}
}

#define XB_TMO      128
#define XB_XCNT(j)  (256  + 64 * (j))
#define XB_XSUB(j)  (1280 + 64 * (j))
#define XB_XGEN(j)  (2304 + 64 * (j))
#define XB_TOP      3328
#define XB_TOPGEN   3392
#define XCD_BAR_WORDS 3456
#define XB_SPIN_CAP (1u << 23)
__device__ __forceinline__ unsigned xb_ld(unsigned* p)              { return __hip_atomic_load(p, __ATOMIC_RELAXED, __HIP_MEMORY_SCOPE_AGENT); }
__device__ __forceinline__ unsigned xb_add(unsigned* p, unsigned v) { return __hip_atomic_fetch_add(p, v, __ATOMIC_RELAXED, __HIP_MEMORY_SCOPE_AGENT); }
__device__ __forceinline__ unsigned xb_xcc_id() { return (unsigned)__builtin_amdgcn_s_getreg((3 << 11) | 20) & 0xFu; }
#define XB_SPIN(cond, bar) do { unsigned _sp = 0; while (cond) { __builtin_amdgcn_s_sleep(1); \
    if ((++_sp & 255u) == 0u) { if (xb_ld(&(bar)[XB_TMO])) break; if (_sp > XB_SPIN_CAP) { atomicAdd(&(bar)[XB_TMO], 1u); break; } } } } while (0)
struct XcdBarrier { unsigned* bar; unsigned x; volatile LAS unsigned* st; };
__device__ __forceinline__ XcdBarrier xcd_barrier_post(unsigned* bar, volatile LAS unsigned* st) {
    XcdBarrier b; b.bar = bar; b.x = xb_xcc_id(); b.st = st;
    if (threadIdx.x == 0) (void)xb_add(&bar[XB_XCNT(b.x)], 1u);
    return b;
}
__device__ __forceinline__ void xcd_barrier_complete(unsigned* bar, unsigned x, unsigned& nloc, unsigned& nx) {
    const unsigned G = gridDim.x * gridDim.y * gridDim.z;
    unsigned sum, cnt, mine, sp = 0u;
    for (;;) {
        sum = 0u; cnt = 0u; mine = 0u;
#pragma unroll
        for (unsigned j = 0; j < 16; ++j) { const unsigned c = xb_ld(&bar[XB_XCNT(j)]); sum += c; cnt += (c > 0u) ? 1u : 0u; mine = (j == x) ? c : mine; }
        if (sum == G) break;
        __builtin_amdgcn_s_sleep(1);
        if ((++sp & 255u) == 0u) { if (xb_ld(&bar[XB_TMO])) break; if (sp > XB_SPIN_CAP) { atomicAdd(&bar[XB_TMO], 1u); break; } }
    }
    nloc = mine > 0u ? mine : 1u; nx = cnt > 0u ? cnt : 1u;
}
__device__ __forceinline__ void xcd_barrier(const XcdBarrier& b) {
    asm volatile("s_waitcnt vmcnt(0)" ::: "memory");
    __syncthreads();
    if (threadIdx.x == 0) {
        unsigned* bar = b.bar;
        __builtin_amdgcn_s_waitcnt(0);
        unsigned nloc = b.st[0], nx = b.st[1];
        if (nloc == 0u) { xcd_barrier_complete(bar, b.x, nloc, nx); b.st[0] = nloc; b.st[1] = nx; }
        const unsigned old = xb_add(&bar[XB_XSUB(b.x)], 1u);
        const unsigned gen = old / nloc;
        if (old + 1u == (gen + 1u) * nloc) {
            __builtin_amdgcn_fence(__ATOMIC_RELEASE, "agent");
            asm volatile("s_waitcnt vmcnt(0)" ::: "memory");
            const unsigned og = xb_add(&bar[XB_TOP], 1u);
            const unsigned tg = og / nx;
            if (og + 1u == (tg + 1u) * nx) xb_add(&bar[XB_TOPGEN], 1u);
            else XB_SPIN(xb_ld(&bar[XB_TOPGEN]) == tg, bar);
            __builtin_amdgcn_fence(__ATOMIC_ACQUIRE, "agent");
            xb_add(&bar[XB_XGEN(b.x)], 1u);
            asm volatile("s_waitcnt vmcnt(0)" ::: "memory");
        } else {
            XB_SPIN(xb_ld(&bar[XB_XGEN(b.x)]) == gen, bar);
            __builtin_amdgcn_fence(__ATOMIC_ACQUIRE, "agent");
            asm volatile("s_waitcnt vmcnt(0)" ::: "memory");
        }
    }
    __syncthreads();
}

struct Args { const float* in[29]; float* out; unsigned char* ws; int ph_lo, ph_hi; };
enum { I_X = 0, I_N1G, I_WIN, I_GMNG, I_GMWS, I_GMB, I_CONVW, I_CONVB, I_LWA, I_LBA, I_LWX, I_LBX, I_LLAM, I_PE, I_CW1, I_CW2, I_PW, I_PS, I_WBR, I_WOUT, I_N2G, I_RWG, I_RBG, I_RWE, I_RBE, I_MG, I_MU, I_MD, I_FNG };

#define CAS __attribute__((address_space(4)))
__device__ __forceinline__ unsigned long long karg_u64(int off) { const CAS char* kp = (const CAS char*)__builtin_amdgcn_kernarg_segment_ptr(); asm volatile("" : "+s"(kp)); return *(const CAS unsigned long long*)(kp + off); }
#define ARG_IN(k) ((const float*)(const GAS float*)karg_u64(8 * (k)))
#define ARG_OUT() ((float*)(GAS float*)karg_u64(8 * 29))
#define ARG_WS() ((unsigned char*)(GAS unsigned char*)karg_u64(8 * 30))
__device__ __forceinline__ int win_dst_row(int s) {
    if (s < SRC_GC) return s;
    if (s < SRC_XD) return C_GC + (s - SRC_GC);
    if (s < SRC_MG) return C_XD + (s - SRC_XD);
    const int n = (s - SRC_MG) >> 10, d = (s - SRC_MG) & 1023;
    return 4096 + 256 * (d >> 6) + 128 * (n >> 1) + 32 * ((d >> 4) & 3) + 8 * ((d >> 2) & 3) + 4 * (n & 1) + (d & 3);
}
struct TrItem { const float* W; bf16* WT; int K, N, kb, nb, kind; };
struct TrRegs { f32x4 v[8]; };
__device__ __forceinline__ int tr_dst(int kind, int n) { return kind == 0 ? n : kind == 1 ? win_dst_row(n) : kind == 2 ? 256 * (n >> 7) + (n & 127) : 256 * (n >> 7) + 128 + (n & 127); }
__device__ __forceinline__ TrRegs tr_load(const TrItem& it, int lane) {
    TrRegs r; const int k0 = 64 * it.kb, n4 = 32 * it.nb + (lane & 7) * 4;
#pragma unroll
    for (int i = 0; i < 8; ++i) { const int kk = 8 * i + (lane >> 3); r.v[i] = *(const f32x4*)(it.W + (size_t)(k0 + kk) * it.N + (n4 < it.N ? n4 : 0)); }
    return r;
}
__device__ __forceinline__ void tr_finish(const TrItem& it, const TrRegs& r, float* scr, int lane) {
    const int k0 = 64 * it.kb, n0 = 32 * it.nb;
#pragma unroll
    for (int i = 0; i < 8; ++i) { const int kk = 8 * i + (lane >> 3); float* d = scr + kk * 33 + (lane & 7) * 4; d[0] = r.v[i].x; d[1] = r.v[i].y; d[2] = r.v[i].z; d[3] = r.v[i].w; }
    LDS_WAIT(); asm volatile("" ::: "memory");
    const int c = lane & 7;
#pragma unroll
    for (int j = 0; j < 4; ++j) { const int nl = (lane >> 3) + 8 * j; const int n = n0 + nl; const float* sp = scr + (8 * c) * 33 + nl;
        u32x4 o; o.x = pk2(sp[0 * 33], sp[1 * 33]); o.y = pk2(sp[2 * 33], sp[3 * 33]); o.z = pk2(sp[4 * 33], sp[5 * 33]); o.w = pk2(sp[6 * 33], sp[7 * 33]);
        if (n < it.N) GST(*(u32x4*)(it.WT + (size_t)tr_dst(it.kind, n) * it.K + k0 + 8 * c) = o); }
    LDS_WAIT(); asm volatile("" ::: "memory");
}
template <int MODE>
__device__ __forceinline__ void norm_rows(const float* xbase, float* hbase, const bf16* y0b, const bf16* y1b, const float* g, bf16* xnb, int m0, int m1, bool two, int lane) {
    f32x4 v[2][4]; u32x2 ya[2][4], yb[2][4];
#pragma unroll
    for (int r = 0; r < 2; ++r) { const size_t m = (size_t)(r ? m1 : m0); if (r == 0 || two) {
#pragma unroll
        for (int j = 0; j < 4; ++j) { const int c = 4 * lane + 256 * j; v[r][j] = *(const f32x4*)((MODE == 0 ? xbase : hbase) + m * D + c);
            if (MODE != 0) { ya[r][j] = *(const u32x2*)(y0b + m * D + c); yb[r][j] = *(const u32x2*)(y1b + m * D + c); } } } }
#pragma unroll
    for (int r = 0; r < 2; ++r) { if (r == 1 && !two) break; const size_t m = (size_t)(r ? m1 : m0); float ss = 0.f;
#pragma unroll
        for (int j = 0; j < 4; ++j) {
            if (MODE != 0) { const u32x2 a = ya[r][j], b = yb[r][j];
                v[r][j].x += bflo(a.x) + bflo(b.x); v[r][j].y += bfhi(a.x) + bfhi(b.x); v[r][j].z += bflo(a.y) + bflo(b.y); v[r][j].w += bfhi(a.y) + bfhi(b.y); }
            ss += (v[r][j].x * v[r][j].x + v[r][j].y * v[r][j].y) + (v[r][j].z * v[r][j].z + v[r][j].w * v[r][j].w); }
        const float rstd = rsqrtf(wave_sum(ss) * (1.f / D) + EPS);
#pragma unroll
        for (int j = 0; j < 4; ++j) { const int c = 4 * lane + 256 * j; const f32x4 gg = *(const f32x4*)(g + c); const f32x4 x = v[r][j];
            if (MODE == 2) { GST(*(f32x4*)(hbase + m * D + c) = (f32x4){x.x * rstd * gg.x, x.y * rstd * gg.y, x.z * rstd * gg.z, x.w * rstd * gg.w}); }
            else { if (MODE != 0) GST(*(f32x4*)(hbase + m * D + c) = x);
                u32x2 o; o.x = pk2(x.x * rstd * gg.x, x.y * rstd * gg.y); o.y = pk2(x.z * rstd * gg.z, x.w * rstd * gg.w); GST(*(u32x2*)(xnb + m * D + c) = o); } } }
}

constexpr int IT_WIN_ = 16 * 249, IT_WB_ = 8 * 32, IT_WO_ = 16 * 32, IT_BIG = IT_WIN_ + 4 * IT_WB_ + IT_WO_;
__device__ __forceinline__ TrItem dec_big(int it, int l) {
    unsigned char* wsb = ARG_WS(); int r = it;
    if (r < IT_WIN_) return TrItem{ARG_IN(I_WIN) + (size_t)l * D * NIN, (bf16*)(wsb + WS_WIN) + (size_t)l * NPROJ * D, D, NIN, r / 249, r % 249, 1};
    r -= IT_WIN_;
    if (r < 4 * IT_WB_) { const int n = r / IT_WB_; r -= n * IT_WB_; const int ln = l * 4 + n; return TrItem{ARG_IN(I_WBR) + (size_t)ln * 512 * 1024, (bf16*)(wsb + WS_WB) + (size_t)ln * 1024 * 512, 512, 1024, r / 32, r % 32, 0}; }
    r -= 4 * IT_WB_;
    return TrItem{ARG_IN(I_WOUT) + (size_t)l * 1024 * 1024, (bf16*)(wsb + WS_WOUT) + (size_t)l * 1024 * 1024, 1024, 1024, r / 32, r % 32, 0};
}
__device__ __forceinline__ void conv_unit(float* ldsf, int cu) {
    const int tid = opaque_tid(); const int wv = __builtin_amdgcn_readfirstlane(tid >> 6), lane = tid & 63; const int it = cu * 8 + wv;
    __syncthreads();
    if (it < IT_BIG) { const TrItem ti = dec_big(it, 1); const TrRegs rr = tr_load(ti, lane); tr_finish(ti, rr, ldsf + wv * 4096, lane); }
}
__device__ __forceinline__ void wait_counter(unsigned* cp, unsigned need, unsigned* tmo) {
    if (__builtin_amdgcn_readfirstlane((int)threadIdx.x) < 64) {
        unsigned polls = 0u;
        while ((unsigned)__builtin_amdgcn_readfirstlane(__hip_atomic_load(cp, __ATOMIC_RELAXED, __HIP_MEMORY_SCOPE_AGENT)) < need) {
            if (++polls > (1u << 22)) { __hip_atomic_store(tmo, 1u, __ATOMIC_RELAXED, __HIP_MEMORY_SCOPE_AGENT); break; }
            __builtin_amdgcn_s_sleep(2); }
        __builtin_amdgcn_fence(__ATOMIC_ACQUIRE, "agent");
        asm volatile("s_waitcnt vmcnt(0)" ::: "memory");
    }
    asm volatile("" ::: "memory"); __builtin_amdgcn_s_barrier(); asm volatile("" ::: "memory");
}
struct SchedDense {
    const bf16* A; const bf16* Bt; int lda, K, nM, nN, G, c; unsigned* cnt; unsigned need; unsigned* tmo;
    __device__ __forceinline__ void a_ready(const pg8::Unit& u) const { if (cnt) wait_counter(cnt + 64 * u.pm, need, tmo); }
    __device__ __forceinline__ void done(const pg8::Unit&) const {}
    __device__ __forceinline__ bool next(int i, pg8::Unit& u) const {
        int pm, pn; if (!pg8::static_tile(i, G, c, nM, nN, pm, pn)) return false;
        u.pm = pm; u.pn = pn; u.sub = 0; u.e = 0; u.A = (const char*)(A + (size_t)pm * 256 * lda); u.B = (const char*)(Bt + (size_t)pn * 256 * K); return true;
    }
    __device__ __forceinline__ void a_off(const pg8::Unit&, unsigned (&vo)[2][2]) const {
        const int tz = opaque_tid();
#pragma unroll
        for (int i = 0; i < 2; ++i) { int R, C; pg8::stage_rc(tz * 16 + i * 8192, R, C);
#pragma unroll
            for (int h = 0; h < 2; ++h) vo[h][i] = (unsigned)((h * 128 + R) * lda + C) * 2u; }
    }
};
struct SchedMerge {
    const bf16* P1; const bf16* Wb; int G, c; unsigned* cnt;
    __device__ __forceinline__ void a_ready(const pg8::Unit&) const {}
    __device__ __forceinline__ void done(const pg8::Unit& u) const {
        if (u.sub != 3) return;
        asm volatile("s_waitcnt vmcnt(0)" ::: "memory");
        if ((threadIdx.x & 63) == 0 && !is_dry()) (void)__hip_atomic_fetch_add(cnt + 64 * u.pm, 1u, __ATOMIC_RELAXED, __HIP_MEMORY_SCOPE_AGENT);
    }
    __device__ __forceinline__ bool next(int i, pg8::Unit& u) const {
        const int ti = i >> 2, sub = i & 3; int pm, pn; if (!pg8::static_tile(ti, G, c, T / 256, 4, pm, pn)) return false;
        const int ycol = (sub == 0) ? C_U : (sub == 1) ? C_GB : (sub == 2) ? C_Q : C_V;
        u.pm = pm; u.pn = pn; u.sub = sub; u.e = 0;
        u.A = (const char*)(P1 + (size_t)pm * 256 * P1W + ycol); u.B = (const char*)(Wb + ((size_t)sub * 1024 + (size_t)pn * 256) * 512); return true;
    }
    __device__ __forceinline__ void a_off(const pg8::Unit&, unsigned (&vo)[2][2]) const {
        const int tz = opaque_tid();
#pragma unroll
        for (int i = 0; i < 2; ++i) { int R, C; pg8::stage_rc(tz * 16 + i * 8192, R, C);
#pragma unroll
            for (int h = 0; h < 2; ++h) vo[h][i] = (unsigned)((h * 128 + R) * P1W + C) * 2u; }
    }
};
__device__ __forceinline__ const LAS int* moe_tab() { unsigned a = (unsigned)LDS_MOE; asm volatile("" : "+s"(a)); return (const LAS int*)(uintptr_t)a; }
struct SchedMoe {
    const bf16* A; const bf16* Bt; const unsigned* list; int lda, K, brows  , G, c; bool gather; unsigned* cnt; unsigned* tmo;
    __device__ __forceinline__ bool next(int i, pg8::Unit& u) const {
        const LAS int* tab = moe_tab(); const int L = i * G + (gather ? c : (G - 1 - c)); const int tot = __builtin_amdgcn_readfirstlane(tab[16]); if (L >= 4 * tot) return false;
        const int rtg = L >> 2, pn = L & 3; int e = 0, st = 0;
#pragma unroll
        for (int k = 1; k < 16; ++k) { const int tk = __builtin_amdgcn_readfirstlane(tab[k]); if (rtg >= tk) { e = k; st = tk; } }
        u.e = e; u.pm = rtg; u.sub = rtg - st; u.pn = pn;
        u.A = gather ? (const char*)A : (const char*)(A + (size_t)rtg * 256 * lda);
        u.B = (const char*)(Bt + ((size_t)e * brows + (size_t)pn * 256) * K); return true;
    }
    __device__ __forceinline__ void a_ready(const pg8::Unit& u) const {
        if (gather) return;
        if (__builtin_amdgcn_readfirstlane((int)threadIdx.x) < 64) {
            unsigned* cp = cnt + 64 * u.pm; unsigned polls = 0u;
            while ((unsigned)__builtin_amdgcn_readfirstlane(__hip_atomic_load(cp, __ATOMIC_RELAXED, __HIP_MEMORY_SCOPE_AGENT)) < 32u) {
                if (++polls > (1u << 22)) { __hip_atomic_store(tmo, 1u, __ATOMIC_RELAXED, __HIP_MEMORY_SCOPE_AGENT); break; }
                __builtin_amdgcn_s_sleep(2); }
            __builtin_amdgcn_fence(__ATOMIC_ACQUIRE, "agent");
            asm volatile("s_waitcnt vmcnt(0)" ::: "memory");
        }
        asm volatile("" ::: "memory"); __builtin_amdgcn_s_barrier(); asm volatile("" ::: "memory");
    }
    __device__ __forceinline__ void done(const pg8::Unit& u) const {
        if (!gather) return;
        asm volatile("s_waitcnt vmcnt(0)" ::: "memory");
        if ((threadIdx.x & 63) == 0 && !is_dry()) (void)__hip_atomic_fetch_add(cnt + 64 * u.pm, 1u, __ATOMIC_RELAXED, __HIP_MEMORY_SCOPE_AGENT);
    }
    __device__ __forceinline__ void a_off(const pg8::Unit& u, unsigned (&vo)[2][2]) const {
        const LAS int* tab = moe_tab(); const int cnt = __builtin_amdgcn_readfirstlane(tab[32 + u.e]); const unsigned* le = list + (size_t)u.e * T + u.sub * 256;
        int tz = (int)threadIdx.x; asm volatile("" : "+v"(tz));
#pragma unroll
        for (int i = 0; i < 2; ++i) { int R, C; pg8::stage_rc(tz * 16 + i * 8192, R, C);
#pragma unroll
            for (int h = 0; h < 2; ++h) {
                int row = h * 128 + R;
                if (gather) { row = (u.sub * 256 + row < cnt) ? (int)(le[row] & 0x3fffu) : 0; }
                vo[h][i] = (unsigned)(row * lda + C) * 2u;
            } }
    }
};

struct EpiProj {
    bf16* P1; bf16* Rr;
    __device__ __forceinline__ bool operator()(f32x4 (&acc)[2][2][4][2], const pg8::Unit& u, int wr, int wc, int fr, int fq) const {
        const int row0 = u.pm * 256 + wr * 64 + fr;
        if (u.pn < 16) {
            const int act = (u.pn < 6) ? 1 : (u.pn == 15 ? 2 : 0);
#pragma unroll
            for (int ai = 0; ai < 2; ++ai)
#pragma unroll
                for (int m = 0; m < 4; ++m) { bf16* rowp = P1 + (size_t)(row0 + ai * 128 + m * 16) * P1W + u.pn * 256 + wc * 32 + 8 * fq;
#pragma unroll
                    for (int bj = 0; bj < 2; ++bj) { f32x4 v0 = acc[ai][bj][m][0], v1 = acc[ai][bj][m][1];
                        if (act == 1) { v0 = (f32x4){gelu_tanh(v0.x), gelu_tanh(v0.y), gelu_tanh(v0.z), gelu_tanh(v0.w)}; v1 = (f32x4){gelu_tanh(v1.x), gelu_tanh(v1.y), gelu_tanh(v1.z), gelu_tanh(v1.w)}; }
                        else if (act == 2) { v0 = (f32x4){sigmoidf_(v0.x), sigmoidf_(v0.y), sigmoidf_(v0.z), sigmoidf_(v0.w)}; v1 = (f32x4){sigmoidf_(v1.x), sigmoidf_(v1.y), sigmoidf_(v1.z), sigmoidf_(v1.w)}; }
                        u32x4 w; w.x = pk2(v0.x, v0.y); w.y = pk2(v0.z, v0.w); w.z = pk2(v1.x, v1.y); w.w = pk2(v1.z, v1.w);
                        if (u.pn < 15 || (bj == 0 && wc < 2)) GST(*(u32x4*)(rowp + bj * 128) = w); } }
        } else {
            const int dcol = 64 * (u.pn - 16) + 16 * wc + 4 * fq;
#pragma unroll
            for (int ai = 0; ai < 2; ++ai)
#pragma unroll
                for (int m = 0; m < 4; ++m) { const size_t row = (size_t)(row0 + ai * 128 + m * 16);
                    float r0[4], r1[4], r2[4], r3[4];
#pragma unroll
                    for (int i = 0; i < 4; ++i) {
                        const float d0 = fminf(1.0f + __builtin_amdgcn_exp2f(-1.4426950408889634f * acc[ai][0][m][0][i]), 1e20f), d1 = fminf(1.0f + __builtin_amdgcn_exp2f(-1.4426950408889634f * acc[ai][0][m][1][i]), 1e20f);
                        const float d2 = fminf(1.0f + __builtin_amdgcn_exp2f(-1.4426950408889634f * acc[ai][1][m][0][i]), 1e20f), d3 = fminf(1.0f + __builtin_amdgcn_exp2f(-1.4426950408889634f * acc[ai][1][m][1][i]), 1e20f);
                        const float i0 = __builtin_amdgcn_rcpf(d0), i1 = __builtin_amdgcn_rcpf(d1), i2 = __builtin_amdgcn_rcpf(d2), i3 = __builtin_amdgcn_rcpf(d3);
                        r0[i] = d1 * i0; r1[i] = d2 * i1; r2[i] = d3 * i2; r3[i] = i3; }
                    u32x2 w;
                    w.x = pk2(r0[0], r0[1]); w.y = pk2(r0[2], r0[3]); GST(*(u32x2*)(Rr + ((size_t)0 * T + row) * 1024 + dcol) = w);
                    w.x = pk2(r1[0], r1[1]); w.y = pk2(r1[2], r1[3]); GST(*(u32x2*)(Rr + ((size_t)1 * T + row) * 1024 + dcol) = w);
                    w.x = pk2(r2[0], r2[1]); w.y = pk2(r2[2], r2[3]); GST(*(u32x2*)(Rr + ((size_t)2 * T + row) * 1024 + dcol) = w);
                    w.x = pk2(r3[0], r3[1]); w.y = pk2(r3[2], r3[3]); GST(*(u32x2*)(Rr + ((size_t)3 * T + row) * 1024 + dcol) = w); }
        }
        return true;
    }
};
struct EpiMerge {
    const bf16* Rr; bf16* O;
    __device__ __forceinline__ bool operator()(f32x4 (&acc)[2][2][4][2], const pg8::Unit& u, int wr, int wc, int fr, int fq) const {
        const int row0 = u.pm * 256 + wr * 64 + fr, col0 = u.pn * 256 + wc * 32 + 8 * fq;
        const bf16* Rn = Rr + (size_t)u.sub * T * 1024;
        const __amdgpu_buffer_rsrc_t rs = __builtin_amdgcn_make_buffer_rsrc((void*)O, (short)0, (int)((size_t)T * 1024 * 2), 0x00020000);
        u32x4 rv[2][4][2];
#pragma unroll
        for (int ai = 0; ai < 2; ++ai)
#pragma unroll
            for (int m = 0; m < 4; ++m)
#pragma unroll
                for (int bj = 0; bj < 2; ++bj) rv[ai][m][bj] = *(const u32x4*)(Rn + (size_t)(row0 + ai * 128 + m * 16) * 1024 + col0 + bj * 128);
        __builtin_amdgcn_sched_barrier(0);
#pragma unroll
        for (int ai = 0; ai < 2; ++ai)
#pragma unroll
            for (int m = 0; m < 4; ++m) { const size_t ro = (size_t)(row0 + ai * 128 + m * 16) * 1024 + col0;
#pragma unroll
                for (int bj = 0; bj < 2; ++bj) { const u32x4 r = rv[ai][m][bj];
                    f32x4& v0 = acc[ai][bj][m][0]; f32x4& v1 = acc[ai][bj][m][1];
                    v0.x *= bflo(r.x); v0.y *= bfhi(r.x); v0.z *= bflo(r.y); v0.w *= bfhi(r.y); v1.x *= bflo(r.z); v1.y *= bfhi(r.z); v1.z *= bflo(r.w); v1.w *= bfhi(r.w);
                    if (u.sub == 3) { u32x4 w; w.x = pk2(v0.x, v0.y); w.y = pk2(v0.z, v0.w); w.z = pk2(v1.x, v1.y); w.w = pk2(v1.z, v1.w); GST(__builtin_amdgcn_raw_buffer_store_b128(w, rs, (unsigned)((ro + bj * 128) * 2), 0, 16)); } } }
        return u.sub == 3;
    }
};
struct EpiWout {
    const float* Hin; float* H;
    __device__ __forceinline__ bool operator()(f32x4 (&acc)[2][2][4][2], const pg8::Unit& u, int wr, int wc, int fr, int fq) const {
        const int row0 = u.pm * 256 + wr * 64 + fr, col0 = u.pn * 256 + wc * 32 + 8 * fq;
#pragma unroll
        for (int ai = 0; ai < 2; ++ai)
        {   f32x4 hv[4][2][2];
#pragma unroll
            for (int m = 0; m < 4; ++m)
#pragma unroll
                for (int bj = 0; bj < 2; ++bj)
#pragma unroll
                    for (int n = 0; n < 2; ++n) hv[m][bj][n] = *(const f32x4*)(Hin + (size_t)(row0 + ai * 128 + m * 16) * 1024 + col0 + bj * 128 + 4 * n);
            __builtin_amdgcn_sched_barrier(0);
#pragma unroll
            for (int m = 0; m < 4; ++m)
#pragma unroll
                for (int bj = 0; bj < 2; ++bj)
#pragma unroll
                    for (int n = 0; n < 2; ++n) { const f32x4 h = hv[m][bj][n] + acc[ai][bj][m][n]; GST(*(f32x4*)(H + (size_t)(row0 + ai * 128 + m * 16) * 1024 + col0 + bj * 128 + 4 * n) = h); } }
        return true;
    }
};
struct EpiGateUp {
    bf16* HID; const float* lw;
    __device__ __forceinline__ bool operator()(f32x4 (&acc)[2][2][4][2], const pg8::Unit& u, int wr, int wc, int fr, int fq) const {
        const int cnt = __builtin_amdgcn_readfirstlane(moe_tab()[32 + u.e]);
        const __amdgpu_buffer_rsrc_t rs = __builtin_amdgcn_make_buffer_rsrc((void*)HID, (short)0, (int)((size_t)HID_ROWS * 512 * 2), 0x00020000);
#pragma unroll
        for (int ai = 0; ai < 2; ++ai)
#pragma unroll
            for (int m = 0; m < 4; ++m) { const int rl = ai * 128 + wr * 64 + m * 16 + fr; const int lr = u.sub * 256 + rl;
                const bool ok = lr < cnt; const float w = ok ? lw[(size_t)u.e * T + lr] : 0.f;
                float o[8];
#pragma unroll
                for (int n = 0; n < 2; ++n)
#pragma unroll
                    for (int i = 0; i < 4; ++i) { const float g = acc[ai][0][m][n][i], up = acc[ai][1][m][n][i]; o[4 * n + i] = ok ? g * sigmoidf_(g) * up * w : 0.f; }
                u32x4 wv; wv.x = pk2(o[0], o[1]); wv.y = pk2(o[2], o[3]); wv.z = pk2(o[4], o[5]); wv.w = pk2(o[6], o[7]);
                GST(__builtin_amdgcn_raw_buffer_store_b128(wv, rs, (unsigned)((((size_t)u.pm * 256 + rl) * 512 + u.pn * 128 + wc * 32 + 8 * fq) * 2), 0, 16)); }
        return true;
    }
};
struct EpiDown {
    bf16* Y; const unsigned* list;
    __device__ __forceinline__ bool operator()(f32x4 (&acc)[2][2][4][2], const pg8::Unit& u, int wr, int wc, int fr, int fq) const {
        const int cnt = __builtin_amdgcn_readfirstlane(moe_tab()[32 + u.e]);
        unsigned en[2][4];
#pragma unroll
        for (int ai = 0; ai < 2; ++ai)
#pragma unroll
            for (int m = 0; m < 4; ++m) { const int lr = u.sub * 256 + ai * 128 + wr * 64 + m * 16 + fr; en[ai][m] = list[(size_t)u.e * T + (lr < cnt ? lr : 0)]; }
        __builtin_amdgcn_sched_barrier(0);
#pragma unroll
        for (int ai = 0; ai < 2; ++ai)
#pragma unroll
            for (int m = 0; m < 4; ++m) { const int rl = ai * 128 + wr * 64 + m * 16 + fr; const int lr = u.sub * 256 + rl;
                if (lr < cnt) { const unsigned tok = en[ai][m] & 0x3fffu, slot = en[ai][m] >> 14;
                    bf16* rp = Y + ((size_t)slot * T + tok) * 1024 + u.pn * 256 + wc * 32 + 8 * fq;
#pragma unroll
                    for (int bj = 0; bj < 2; ++bj) { const f32x4 v0 = acc[ai][bj][m][0], v1 = acc[ai][bj][m][1];
                        u32x4 w; w.x = pk2(v0.x, v0.y); w.y = pk2(v0.z, v0.w); w.z = pk2(v1.x, v1.y); w.w = pk2(v1.z, v1.w); GST(*(u32x4*)(rp + bj * 128) = w); } } }
        return true;
    }
};

__device__ __forceinline__ void gmlp_unit(float* lds, bf16* P1, const float* gng, const float* gws, const float* gmb, int unit) {
    const int tid = opaque_tid(); const int c = unit >> 2, g = unit & 3; const size_t t0 = (size_t)c * 128;
    float* Wt = lds; float* Vn = lds + 16384; float* rs = lds + 32768;
    __syncthreads();
    {
        const int tk = tid >> 2, qu = tid & 3; const bf16* vp = P1 + (t0 + tk) * P1W + C_V + qu * 128; float ss = 0.f;
#pragma unroll 4
        for (int i = 0; i < 16; ++i) { const u32x4 w = *(const u32x4*)(vp + 8 * i);
            ss += bflo(w.x) * bflo(w.x) + bfhi(w.x) * bfhi(w.x) + bflo(w.y) * bflo(w.y) + bfhi(w.y) * bfhi(w.y) + bflo(w.z) * bflo(w.z) + bfhi(w.z) * bfhi(w.z) + bflo(w.w) * bflo(w.w) + bfhi(w.w) * bfhi(w.w); }
        ss += __shfl_xor(ss, 1); ss += __shfl_xor(ss, 2);
        if (qu == 0) rs[tk] = rsqrtf(ss * (1.f / 512.f) + EPS);
    }
    for (int e = tid; e < 128 * 128; e += 512) { const int t = e >> 7, s = e & 127; Wt[e] = (s <= t) ? gws[(size_t)g * 16384 + e] : 0.f; }
    __syncthreads();
    for (int e = tid; e < 128 * 16; e += 512) { const int s = e >> 4, c8 = (e & 15) * 8; const u32x4 w = *(const u32x4*)(P1 + (t0 + s) * P1W + C_V + g * 128 + c8);
        const float r = rs[s]; const float* gp = gng + g * 128 + c8; float* o = Vn + s * 128 + c8;
        o[0] = bflo(w.x) * r * gp[0]; o[1] = bfhi(w.x) * r * gp[1]; o[2] = bflo(w.y) * r * gp[2]; o[3] = bfhi(w.y) * r * gp[3];
        o[4] = bflo(w.z) * r * gp[4]; o[5] = bfhi(w.z) * r * gp[5]; o[6] = bflo(w.w) * r * gp[6]; o[7] = bfhi(w.w) * r * gp[7]; }
    __syncthreads();
    const int tg = tid >> 5, c4 = (tid & 31) * 4;
    f32x4 acc[8];
#pragma unroll
    for (int k = 0; k < 8; ++k) acc[k] = (f32x4){0.f, 0.f, 0.f, 0.f};
    const int smax = tg * 8 + 7;
    for (int s = 0; s <= smax; ++s) { const f32x4 v = *(const f32x4*)(Vn + s * 128 + c4);
#pragma unroll
        for (int k = 0; k < 8; ++k) { const float w = Wt[(tg * 8 + k) * 128 + s]; acc[k] = acc[k] + v * w; } }
#pragma unroll
    for (int k = 0; k < 8; ++k) { const int tl = tg * 8 + k; const float bb = gmb[g * 128 + tl];
        bf16* up = P1 + (t0 + tl) * P1W + C_U + g * 128 + c4; const u32x2 uu = *(const u32x2*)up;
        u32x2 o; o.x = pk2(bflo(uu.x) * (acc[k].x + bb), bfhi(uu.x) * (acc[k].y + bb)); o.y = pk2(bflo(uu.y) * (acc[k].z + bb), bfhi(uu.y) * (acc[k].w + bb)); GST(*(u32x2*)up = o); }
}

__device__ __forceinline__ void lru_unit(float* lds, const bf16* P1, bf16* XN, float* AGA, float* AGH, const float* convw, const float* convb, const float* wa, const float* ba, const float* wx, const float* bx, const float* lam, int unit) {
    const int tid = opaque_tid(); const int h = unit & 7, tile = (unit >> 3) & 63, b = unit >> 9; const int ch0 = h * 64;
    const size_t row0 = (size_t)b * SEQ + tile * 64;
    float* xc = lds; float* Wa = lds + 4096; float* Wx = lds + 8192; float* av = lds + 12288; float* bv = lds + 16384;
    __syncthreads();
    {
        const int tt = tid >> 3, c8 = (tid & 7) * 8; const int ts = tile * 64 + tt;
        float o[8];
#pragma unroll
        for (int i = 0; i < 8; ++i) o[i] = convb[ch0 + c8 + i];
#pragma unroll
        for (int k = 0; k < 4; ++k) { const int sp = ts + k - 3; if (sp >= 0) { const u32x4 w = *(const u32x4*)(P1 + ((size_t)b * SEQ + sp) * P1W + C_RB + ch0 + c8); const float* cw = convw + k * 512 + ch0 + c8;
                o[0] += bflo(w.x) * cw[0]; o[1] += bfhi(w.x) * cw[1]; o[2] += bflo(w.y) * cw[2]; o[3] += bfhi(w.y) * cw[3]; o[4] += bflo(w.z) * cw[4]; o[5] += bfhi(w.z) * cw[5]; o[6] += bflo(w.w) * cw[6]; o[7] += bfhi(w.w) * cw[7]; } }
#pragma unroll
        for (int i = 0; i < 8; ++i) xc[tt * 64 + c8 + i] = o[i];
    }
    for (int e = tid; e < 4096; e += 512) { Wa[e] = wa[(size_t)h * 4096 + e]; Wx[e] = wx[(size_t)h * 4096 + e]; }
    __syncthreads();
    {
        const int co = tid & 63, tg = tid >> 6; float ar[8], ai[8];
#pragma unroll
        for (int k = 0; k < 8; ++k) { ar[k] = 0.f; ai[k] = 0.f; }
        for (int ci = 0; ci < 64; ++ci) { const float wav = Wa[ci * 64 + co], wxv = Wx[ci * 64 + co];
#pragma unroll
            for (int k = 0; k < 8; ++k) { const float x = xc[(tg * 8 + k) * 64 + ci]; ar[k] += x * wav; ai[k] += x * wxv; } }
        const float bav = ba[ch0 + co], bxv = bx[ch0 + co]; const float lm = lam[ch0 + co];
        const float sp = (-lm > 20.f) ? -lm : log1pf(__expf(-lm));
#pragma unroll
        for (int k = 0; k < 8; ++k) { const int tt = tg * 8 + k; const float r = sigmoidf_(ar[k] + bav), ig = sigmoidf_(ai[k] + bxv);
            const float la = -8.0f * r * sp; const float a = __expf(la); const float bt = sqrtf(fmaxf(-expm1f(2.0f * la), 0.f)) * (ig * xc[tt * 64 + co]);
            av[tt * 64 + co] = a; bv[tt * 64 + co] = bt; }
    }
    __syncthreads();
    if (tid < 64) { float hr = 0.f, ac = 1.f;
        for (int tt = 0; tt < 64; ++tt) { const float a = av[tt * 64 + tid], bt = bv[tt * 64 + tid]; hr = a * hr + bt; ac *= a; bv[tt * 64 + tid] = hr; av[tt * 64 + tid] = ac; }
        GST(AGA[((size_t)b * 64 + tile) * 512 + ch0 + tid] = ac); GST(AGH[((size_t)b * 64 + tile) * 512 + ch0 + tid] = hr); }
    __syncthreads();
    {   const int tt = tid >> 3, c8 = (tid & 7) * 8; const float* hp = bv + tt * 64 + c8; const float* ap = av + tt * 64 + c8;
        u32x4 w; w.x = pk2(hp[0], hp[1]); w.y = pk2(hp[2], hp[3]); w.z = pk2(hp[4], hp[5]); w.w = pk2(hp[6], hp[7]);
        GST(*(u32x4*)(XN + (row0 + tt) * 1024 + ch0 + c8) = w);
        w.x = pk2(ap[0], ap[1]); w.y = pk2(ap[2], ap[3]); w.z = pk2(ap[4], ap[5]); w.w = pk2(ap[6], ap[7]);
        GST(*(u32x4*)(XN + (row0 + tt) * 1024 + 512 + ch0 + c8) = w); }
}
__device__ __forceinline__ void lrufix_unit(bf16* P1, const bf16* XN, const float* AGA, const float* AGH, int unit) {
    const int ch = opaque_tid(); const int tile = unit & 63, b = unit >> 6;
    float c = 0.f;
    for (int i = 0; i < tile; ++i) { const float a = AGA[((size_t)b * 64 + i) * 512 + ch], hh = AGH[((size_t)b * 64 + i) * 512 + ch]; c = a * c + hh; }
    const size_t row0 = (size_t)b * SEQ + tile * 64;
    for (int tt = 0; tt < 64; ++tt) { const float hl = bf2f(XN[(row0 + tt) * 1024 + ch]), ac = bf2f(XN[(row0 + tt) * 1024 + 512 + ch]);
        bf16* gp = P1 + (row0 + tt) * P1W + C_GB + ch; GST(*gp = (bf16)f2bf(bf2f(*gp) * (hl + ac * c))); }
}
__device__ __forceinline__ void pool_unit(float* lds, bf16* P1, const float* pw, const float* ps, int unit) {
    const int tid = opaque_tid(); const int gi = unit & 3, tile = (unit >> 2) & 63, b = unit >> 8; const int w = 2 << gi;
    float* xs = lds; float* Pw = lds + 10240; float* pl = lds + 26624;
    __syncthreads();
    for (int e = tid; e < 79 * 16; e += 512) { const int r = e >> 4, c8 = (e & 15) * 8; const int sp = tile * 64 + r - 15; float* o = xs + r * 128 + c8;
        if (sp >= 0) { const u32x4 v = *(const u32x4*)(P1 + ((size_t)b * SEQ + sp) * P1W + C_XD + gi * 128 + c8);
            o[0] = bflo(v.x); o[1] = bfhi(v.x); o[2] = bflo(v.y); o[3] = bfhi(v.y); o[4] = bflo(v.z); o[5] = bfhi(v.z); o[6] = bflo(v.w); o[7] = bfhi(v.w); }
        else { o[0] = 0.f; o[1] = 0.f; o[2] = 0.f; o[3] = 0.f; o[4] = 0.f; o[5] = 0.f; o[6] = 0.f; o[7] = 0.f; } }
    for (int e = tid; e < 16384; e += 512) Pw[e] = pw[(size_t)gi * 16384 + e];
    __syncthreads();
    {   const int ci = tid & 127, tq = tid >> 7;
        for (int k = 0; k < 16; ++k) { const int tt = tq * 16 + k; const int ts = tile * 64 + tt; float s = 0.f;
            for (int j = 0; j < w; ++j) s += xs[(tt + 15 - j) * 128 + ci];
            const int cnt = (ts + 1 < w) ? ts + 1 : w;
            pl[tt * 128 + ci] = s / (float)cnt - xs[(tt + 15) * 128 + ci]; } }
    __syncthreads();
    {   const int co = tid & 127, tq = tid >> 7; float acc[16];
#pragma unroll
        for (int k = 0; k < 16; ++k) acc[k] = 0.f;
        for (int ci = 0; ci < 128; ++ci) { const float wv = Pw[ci * 128 + co];
#pragma unroll
            for (int k = 0; k < 16; ++k) acc[k] += pl[(tq * 16 + k) * 128 + ci] * wv; }
        const float sc = ps[gi * 128 + co];
#pragma unroll
        for (int k = 0; k < 16; ++k) GST(P1[((size_t)b * SEQ + tile * 64 + tq * 16 + k) * P1W + C_V + gi * 128 + co] = (bf16)f2bf(acc[k] * sc)); }
}
__device__ __forceinline__ void cmp_unit(float* lds, const bf16* P1, float* KC, const float* pe, const float* w1, const float* w2, int unit) {
    const int tid = opaque_tid(); const int q = unit & 15, g = (unit >> 4) & 1, b = (unit >> 5) & 3, c = unit >> 7;
    float* Fl = lds; float* hid = lds + 32768;
    const float* pec = pe + (size_t)c * 2048; const float* w1c = w1 + ((size_t)c * 2 + g) * 2048 * 64; const float* w2c = w2 + ((size_t)c * 2 + g) * 4096;
    __syncthreads();
    for (int e = tid; e < 16 * 256; e += 512) { const int nl = e >> 8, l = (e >> 3) & 31, c8 = (e & 7) * 8; const int n = q * 16 + nl; float* o = Fl + nl * 2048 + l * 64 + c8;
        if (n < 255) { const u32x4 v = *(const u32x4*)(P1 + ((size_t)b * SEQ + n * 16 + l) * P1W + C_KV + (c * 2 + g) * 64 + c8); const float* pp = pec + l * 64 + c8;
            o[0] = bflo(v.x) + pp[0]; o[1] = bfhi(v.x) + pp[1]; o[2] = bflo(v.y) + pp[2]; o[3] = bfhi(v.y) + pp[3]; o[4] = bflo(v.z) + pp[4]; o[5] = bfhi(v.z) + pp[5]; o[6] = bflo(v.w) + pp[6]; o[7] = bfhi(v.w) + pp[7]; }
        else { o[0] = 0.f; o[1] = 0.f; o[2] = 0.f; o[3] = 0.f; o[4] = 0.f; o[5] = 0.f; o[6] = 0.f; o[7] = 0.f; } }
    __syncthreads();
    {   const int e = tid & 63, ng = tid >> 6; float a0 = 0.f, a1 = 0.f; const float* f0 = Fl + (ng * 2) * 2048; const float* f1 = f0 + 2048;
#pragma unroll 8
        for (int f = 0; f < 2048; ++f) { const float wv = w1c[(size_t)f * 64 + e]; a0 += f0[f] * wv; a1 += f1[f] * wv; }
        hid[(ng * 2) * 64 + e] = gelu_tanh(a0); hid[(ng * 2 + 1) * 64 + e] = gelu_tanh(a1); }
    __syncthreads();
    {   const int d = tid & 63, ng = tid >> 6; float a0 = 0.f, a1 = 0.f;
        for (int e = 0; e < 64; ++e) { const float wv = w2c[e * 64 + d]; a0 += hid[(ng * 2) * 64 + e] * wv; a1 += hid[(ng * 2 + 1) * 64 + e] * wv; }
        const int n0 = q * 16 + ng * 2; float* kp = KC + ((((size_t)c * NB + b) * 2 + g) * 256) * 64;
        if (n0 < 255) GST(kp[(size_t)n0 * 64 + d] = a0);
        if (n0 + 1 < 255) GST(kp[(size_t)(n0 + 1) * 64 + d] = a1); }
}

__device__ __forceinline__ void lru_unit2(LAS unsigned char* lds, const bf16* P1, bf16* XN, float* AGA, float* AGH, const float* convw, const float* convb,
                                          const bf16* WaT, const bf16* WxT, const float* ba, const float* bx, const float* lam, int unit) {
    const int tid = opaque_tid(); const int lane = tid & 63, w = __builtin_amdgcn_readfirstlane(tid >> 6);
    const int tile = unit & 63, b = unit >> 6; const int ch0 = w * 64;
    const size_t row0 = (size_t)b * SEQ + tile * 64;
    LAS unsigned char* wl = lds + w * 17920;
    LAS bf16* xcb = (LAS bf16*)wl; LAS float* AL = (LAS float*)(wl + 9216); LAS float* BL = (LAS float*)(wl + 9216 + 4352);
    __syncthreads();
    FT0(8);
    const int i16 = lane & 15, kb = lane >> 4;
    bf16x8 bfa[4][2], bfx[4][2]; float cba[4], cbx[4], csp[4];
    {
        const int tl = lane >> 3, c8 = (lane & 7) * 8;
        f32x4 cwv[4][2], cbv[2];
#pragma unroll
        for (int k = 0; k < 4; ++k) { cwv[k][0] = *(const f32x4*)(convw + k * 512 + ch0 + c8); cwv[k][1] = *(const f32x4*)(convw + k * 512 + ch0 + c8 + 4); }
        cbv[0] = *(const f32x4*)(convb + ch0 + c8); cbv[1] = *(const f32x4*)(convb + ch0 + c8 + 4);
        u32x4 xa[4][4], xb[4][4];
#pragma unroll
        for (int p = 0; p < 4; ++p)
#pragma unroll
            for (int k = 0; k < 4; ++k) { const int sp = tile * 64 + 8 * p + tl + k - 3; xa[p][k] = *(const u32x4*)(P1 + ((size_t)b * SEQ + (sp < 0 ? 0 : sp)) * P1W + C_RB + ch0 + c8); }
#pragma unroll
        for (int p = 0; p < 4; ++p)
#pragma unroll
            for (int k = 0; k < 4; ++k) { const int sp = tile * 64 + 8 * (p + 4) + tl + k - 3; xb[p][k] = *(const u32x4*)(P1 + ((size_t)b * SEQ + (sp < 0 ? 0 : sp)) * P1W + C_RB + ch0 + c8); }
        __builtin_amdgcn_sched_barrier(0);
#pragma unroll
        for (int hf = 0; hf < 2; ++hf) {
#pragma unroll
            for (int p = 0; p < 4; ++p) { const int tok = 8 * (p + 4 * hf) + tl; const int ts = tile * 64 + tok;
                float o[8] = {cbv[0].x, cbv[0].y, cbv[0].z, cbv[0].w, cbv[1].x, cbv[1].y, cbv[1].z, cbv[1].w};
#pragma unroll
                for (int k = 0; k < 4; ++k) { const u32x4 v = hf ? xb[p][k] : xa[p][k]; const float z = (ts + k - 3 >= 0) ? 1.f : 0.f; const f32x4 w0 = cwv[k][0] * z, w1 = cwv[k][1] * z;
                    o[0] += bflo(v.x) * w0.x; o[1] += bfhi(v.x) * w0.y; o[2] += bflo(v.y) * w0.z; o[3] += bfhi(v.y) * w0.w; o[4] += bflo(v.z) * w1.x; o[5] += bfhi(v.z) * w1.y; o[6] += bflo(v.w) * w1.z; o[7] += bfhi(v.w) * w1.w; }
                *(LAS u32x4*)(xcb + tok * 72 + c8) = (u32x4){pk2(o[0], o[1]), pk2(o[2], o[3]), pk2(o[4], o[5]), pk2(o[6], o[7])}; }
            if (hf == 0) {
#pragma unroll
                for (int n = 0; n < 4; ++n) {
#pragma unroll
                    for (int ks = 0; ks < 2; ++ks) { bfa[n][ks] = *(const bf16x8*)(WaT + ((size_t)ch0 + 16 * n + i16) * 64 + 32 * ks + 8 * kb); bfx[n][ks] = *(const bf16x8*)(WxT + ((size_t)ch0 + 16 * n + i16) * 64 + 32 * ks + 8 * kb); }
                    const int co = ch0 + 16 * n + i16; cba[n] = ba[co]; cbx[n] = bx[co]; csp[n] = lam[co]; }
                __builtin_amdgcn_sched_barrier(0); }
        }
#pragma unroll
        for (int n = 0; n < 4; ++n) { const float lm = csp[n]; csp[n] = 8.0f * ((-lm > 20.f) ? -lm : log1pf(__expf(-lm))); }
    }
    LDS_WAIT(); asm volatile("" ::: "memory");
    FT1(8); FT0(9);
    float hr = 0.f, ac = 1.f;
#pragma unroll 1
    for (int nt = 0; nt < 4; ++nt) {
        bf16x8 af[2];
#pragma unroll
        for (int ks = 0; ks < 2; ++ks) af[ks] = *(const LAS bf16x8*)(xcb + (16 * nt + i16) * 72 + 32 * ks + 8 * kb);
        f32x4 da[4], dx[4];
#pragma unroll
        for (int n = 0; n < 4; ++n) { da[n] = (f32x4){0.f, 0.f, 0.f, 0.f}; dx[n] = da[n];
#pragma unroll
            for (int ks = 0; ks < 2; ++ks) { da[n] = __builtin_amdgcn_mfma_f32_16x16x32_bf16(af[ks], bfa[n][ks], da[n], 0, 0, 0); dx[n] = __builtin_amdgcn_mfma_f32_16x16x32_bf16(af[ks], bfx[n][ks], dx[n], 0, 0, 0); } }
#pragma unroll
        for (int n = 0; n < 4; ++n)
#pragma unroll
            for (int r = 0; r < 4; ++r) { const int tokl = 4 * kb + r, co = 16 * n + i16; const float xcv = bf2f(xcb[(16 * nt + tokl) * 72 + co]);
                const float rg = sigmoidf_(da[n][r] + cba[n]), ig = sigmoidf_(dx[n][r] + cbx[n]); const float a = __expf(-rg * csp[n]);
                AL[tokl * 68 + co] = a; BL[tokl * 68 + co] = sqrtf(fmaxf(1.0f - a * a, 0.f)) * (ig * xcv); }
        LDS_WAIT(); asm volatile("" ::: "memory");
#pragma unroll
        for (int tt = 0; tt < 16; ++tt) { const float a = AL[tt * 68 + lane], bt = BL[tt * 68 + lane]; hr = a * hr + bt; ac *= a; BL[tt * 68 + lane] = hr; AL[tt * 68 + lane] = ac; }
        LDS_WAIT(); asm volatile("" ::: "memory");
        {   const int tk = lane >> 2, pc = (lane & 3) * 16;
            const f32x4 h0 = *(const LAS f32x4*)(BL + tk * 68 + pc), h1 = *(const LAS f32x4*)(BL + tk * 68 + pc + 4), h2 = *(const LAS f32x4*)(BL + tk * 68 + pc + 8), h3 = *(const LAS f32x4*)(BL + tk * 68 + pc + 12);
            const f32x4 a0 = *(const LAS f32x4*)(AL + tk * 68 + pc), a1 = *(const LAS f32x4*)(AL + tk * 68 + pc + 4), a2 = *(const LAS f32x4*)(AL + tk * 68 + pc + 8), a3 = *(const LAS f32x4*)(AL + tk * 68 + pc + 12);
            bf16* hp = XN + (row0 + 16 * nt + tk) * 1024 + ch0 + pc;
            GST(*(u32x4*)hp = (u32x4){pk2(h0.x, h0.y), pk2(h0.z, h0.w), pk2(h1.x, h1.y), pk2(h1.z, h1.w)}); GST(*(u32x4*)(hp + 8) = (u32x4){pk2(h2.x, h2.y), pk2(h2.z, h2.w), pk2(h3.x, h3.y), pk2(h3.z, h3.w)});
            GST(*(u32x4*)(hp + 512) = (u32x4){pk2(a0.x, a0.y), pk2(a0.z, a0.w), pk2(a1.x, a1.y), pk2(a1.z, a1.w)}); GST(*(u32x4*)(hp + 520) = (u32x4){pk2(a2.x, a2.y), pk2(a2.z, a2.w), pk2(a3.x, a3.y), pk2(a3.z, a3.w)}); }
        LDS_WAIT(); asm volatile("" ::: "memory");
    }
    FT1(9);
    GST(AGA[((size_t)b * 64 + tile) * 512 + ch0 + lane] = ac); GST(AGH[((size_t)b * 64 + tile) * 512 + ch0 + lane] = hr);
}
__device__ __forceinline__ void cmp_unit2(LAS unsigned char* lds, const bf16* P1, float* KC, const float* pe, const bf16* W1T, const float* w2, int unit) {
    const int tid = opaque_tid(); const int lane = tid & 63, w = __builtin_amdgcn_readfirstlane(tid >> 6);
    const int q = unit & 15, g = (unit >> 4) & 1, b = (unit >> 5) & 3, c = unit >> 7;
    LAS bf16* Fl = (LAS bf16*)lds;
    LAS float* part = (LAS float*)(lds + 65792);
    LAS float* hid = (LAS float*)(lds + 65792 + 32768);
    const float* pec = pe + (size_t)c * 2048; const bf16* w1t = W1T + ((size_t)c * 2 + g) * 64 * 2048; const float* w2c = w2 + ((size_t)c * 2 + g) * 4096;
    __syncthreads();
    {   u32x4 xv[8]; f32x4 pa[8], pb[8];
#pragma unroll
        for (int k = 0; k < 8; ++k) { const int e = tid + 512 * k; const int nl = e >> 8, l = (e >> 3) & 31, c8 = (e & 7) * 8; const int n = q * 16 + nl; const int nn = n < 255 ? n : 254;
            xv[k] = *(const u32x4*)(P1 + ((size_t)b * SEQ + nn * 16 + l) * P1W + C_KV + (c * 2 + g) * 64 + c8); pa[k] = *(const f32x4*)(pec + l * 64 + c8); pb[k] = *(const f32x4*)(pec + l * 64 + c8 + 4); }
#pragma unroll
        for (int k = 0; k < 8; ++k) { const int e = tid + 512 * k; const int nl = e >> 8, l = (e >> 3) & 31, c8 = (e & 7) * 8; const u32x4 v = xv[k];
            *(LAS u32x4*)(Fl + nl * 2056 + l * 64 + c8) = (u32x4){pk2(bflo(v.x) + pa[k].x, bfhi(v.x) + pa[k].y), pk2(bflo(v.y) + pa[k].z, bfhi(v.y) + pa[k].w), pk2(bflo(v.z) + pb[k].x, bfhi(v.z) + pb[k].y), pk2(bflo(v.w) + pb[k].z, bfhi(v.w) + pb[k].w)}; } }
    __syncthreads();
    {   const int i16 = lane & 15, kb = lane >> 4; f32x4 acc[4];
#pragma unroll
        for (int n = 0; n < 4; ++n) acc[n] = (f32x4){0.f, 0.f, 0.f, 0.f};
        bf16x8 bfr[8][4];
#pragma unroll
        for (int ks = 0; ks < 8; ++ks)
#pragma unroll
            for (int n = 0; n < 4; ++n) bfr[ks][n] = *(const bf16x8*)(w1t + (size_t)(16 * n + i16) * 2048 + 256 * w + 32 * ks + 8 * kb);
        __builtin_amdgcn_sched_barrier(0);
#pragma unroll
        for (int ks = 0; ks < 8; ++ks) { const int f0 = 256 * w + 32 * ks + 8 * kb;
            const bf16x8 af = *(const LAS bf16x8*)(Fl + i16 * 2056 + f0);
#pragma unroll
            for (int n = 0; n < 4; ++n) acc[n] = __builtin_amdgcn_mfma_f32_16x16x32_bf16(af, bfr[ks][n], acc[n], 0, 0, 0); }
#pragma unroll
        for (int n = 0; n < 4; ++n)
#pragma unroll
            for (int r = 0; r < 4; ++r) part[(w * 16 + 4 * kb + r) * 64 + 16 * n + i16] = acc[n][r];
    }
    __syncthreads();
    for (int e = tid; e < 1024; e += 512) { float a = 0.f;
#pragma unroll
        for (int ww = 0; ww < 8; ++ww) a += part[ww * 1024 + e];
        hid[e] = gelu_tanh(a); }
    __syncthreads();
    {   const int d = tid & 63, ng = tid >> 6; float a0 = 0.f, a1 = 0.f;
        for (int e = 0; e < 64; ++e) { const float wv = w2c[e * 64 + d]; a0 += hid[(ng * 2) * 64 + e] * wv; a1 += hid[(ng * 2 + 1) * 64 + e] * wv; }
        const int n0 = q * 16 + ng * 2; float* kp = KC + ((((size_t)c * NB + b) * 2 + g) * 256) * 64;
        if (n0 < 255) GST(kp[(size_t)n0 * 64 + d] = a0);
        if (n0 + 1 < 255) GST(kp[(size_t)(n0 + 1) * 64 + d] = a1); }
}

__device__ __forceinline__ void gmlp_unit2(LAS unsigned char* lds, bf16* P1, const float* gng, const float* gws, const float* gmb, int unit) {
    typedef float f32x16_ __attribute__((ext_vector_type(16))); typedef short s16x4_ __attribute__((ext_vector_type(4)));
    const int tid = opaque_tid(); const int lane = tid & 63, w = __builtin_amdgcn_readfirstlane(tid >> 6), r32 = lane & 31, h = lane >> 5;
    const int c = unit >> 2, g = unit & 3; const size_t t0 = (size_t)c * 128;
    LAS unsigned char* VN = lds; LAS unsigned char* WT = lds + 32768; LAS float* rs = (LAS float*)(lds + 67584);
    __syncthreads();
    {   const int tk = tid >> 2, qu = tid & 3; const bf16* vp = P1 + (t0 + tk) * P1W + C_V + qu * 128; float ss = 0.f;
#pragma unroll 4
        for (int i = 0; i < 16; ++i) { const u32x4 x = *(const u32x4*)(vp + 8 * i);
            ss += bflo(x.x) * bflo(x.x) + bfhi(x.x) * bfhi(x.x) + bflo(x.y) * bflo(x.y) + bfhi(x.y) * bfhi(x.y) + bflo(x.z) * bflo(x.z) + bfhi(x.z) * bfhi(x.z) + bflo(x.w) * bflo(x.w) + bfhi(x.w) * bfhi(x.w); }
        ss += __shfl_xor(ss, 1); ss += __shfl_xor(ss, 2);
        if (qu == 0) rs[tk] = rsqrtf(ss * (1.f / 512.f) + EPS);
    }
#pragma unroll
    for (int k = 0; k < 4; ++k) { const int e = tid + 512 * k; const int t = e >> 4, s8 = (e & 15) * 8; const float* wp = gws + (size_t)g * 16384 + t * 128 + s8;
        const f32x4 a = *(const f32x4*)wp, bq = *(const f32x4*)(wp + 4);
        const float v0 = (s8 + 0 <= t) ? a.x : 0.f, v1 = (s8 + 1 <= t) ? a.y : 0.f, v2 = (s8 + 2 <= t) ? a.z : 0.f, v3 = (s8 + 3 <= t) ? a.w : 0.f;
        const float v4 = (s8 + 4 <= t) ? bq.x : 0.f, v5 = (s8 + 5 <= t) ? bq.y : 0.f, v6 = (s8 + 6 <= t) ? bq.z : 0.f, v7 = (s8 + 7 <= t) ? bq.w : 0.f;
        *(LAS u32x4*)(WT + t * 272 + s8 * 2) = (u32x4){pk2(v0, v1), pk2(v2, v3), pk2(v4, v5), pk2(v6, v7)}; }
    __syncthreads();
#pragma unroll
    for (int k = 0; k < 4; ++k) { const int e = tid + 512 * k; const int sr = e >> 4, c8 = e & 15; const u32x4 x = *(const u32x4*)(P1 + (t0 + sr) * P1W + C_V + g * 128 + 8 * c8);
        const float r = rs[sr]; const float* gp = gng + g * 128 + 8 * c8;
        *(LAS u32x4*)(VN + (c8 >> 2) * 8192 + sr * 64 + (c8 & 3) * 16) = (u32x4){pk2(bflo(x.x) * r * gp[0], bfhi(x.x) * r * gp[1]), pk2(bflo(x.y) * r * gp[2], bfhi(x.y) * r * gp[3]), pk2(bflo(x.z) * r * gp[4], bfhi(x.z) * r * gp[5]), pk2(bflo(x.w) * r * gp[6], bfhi(x.w) * r * gp[7])}; }
    __syncthreads();
    const int cb = w & 3, pr = w >> 2;
    const LAS unsigned char* vb = VN + cb * 8192 + ((lane >> 4) & 1) * 32 + (lane & 3) * 8 + (8 * h + ((lane & 15) >> 2)) * 64;
#pragma unroll
    for (int half = 0; half < 2; ++half) {
        const int tb = pr ? (1 + half) : (3 * half);
        f32x16_ acc;
#pragma unroll
        for (int r = 0; r < 16; ++r) acc[r] = 0.f;
        const LAS unsigned char* wrow = WT + (32 * tb + r32) * 272 + 16 * h;
        for (int ks = 0; ks < 2 * tb + 2; ++ks) {
            const bf16x8 wf = *(const LAS bf16x8*)(wrow + 32 * ks);
            const s16x4_ lo = __builtin_bit_cast(s16x4_, __builtin_amdgcn_ds_read_tr16_b64_v4i16((LAS s16x4_*)(vb + ks * 1024)));
            const s16x4_ hi = __builtin_bit_cast(s16x4_, __builtin_amdgcn_ds_read_tr16_b64_v4i16((LAS s16x4_*)(vb + ks * 1024 + 256)));
            const bf16x8 vf = (bf16x8){lo[0], lo[1], lo[2], lo[3], hi[0], hi[1], hi[2], hi[3]};
            acc = __builtin_amdgcn_mfma_f32_32x32x16_bf16(vf, wf, acc, 0, 0, 0);
        }
        const int tl = 32 * tb + r32; const float bb = gmb[g * 128 + tl];
        bf16* up = P1 + (t0 + tl) * P1W + C_U + g * 128 + 32 * cb + 4 * h;
#pragma unroll
        for (int q4 = 0; q4 < 4; ++q4) { const u32x2 uu = *(const u32x2*)(up + 8 * q4);
            u32x2 o; o.x = pk2(bflo(uu.x) * (acc[4 * q4] + bb), bfhi(uu.x) * (acc[4 * q4 + 1] + bb)); o.y = pk2(bflo(uu.y) * (acc[4 * q4 + 2] + bb), bfhi(uu.y) * (acc[4 * q4 + 3] + bb));
            GST(*(u32x2*)(up + 8 * q4) = o); }
    }
}
__device__ __forceinline__ void gmlp_unit3(LAS unsigned char* lds, bf16* P1, const float* gng, const float* gws, const float* gmb, int unit) {
    typedef float f32x16_ __attribute__((ext_vector_type(16))); typedef short s16x4_ __attribute__((ext_vector_type(4)));
    const int tid = opaque_tid(); const int lane = tid & 63, w = __builtin_amdgcn_readfirstlane(tid >> 6), r32 = lane & 31, h = lane >> 5;
    const int c = unit >> 1, gp = unit & 1; const size_t t0 = (size_t)c * 128;
    LAS unsigned char* VN = lds; LAS unsigned char* WT = lds + 65536; LAS float* rs = (LAS float*)(lds + 135168);
    __syncthreads();
    f32x4 wa[8], wb[8];
#pragma unroll
    for (int k = 0; k < 8; ++k) { const int e = tid + 512 * k; const int gi = e >> 11, t = (e >> 4) & 127, s8 = (e & 15) * 8; const float* wp = gws + (size_t)(2 * gp + gi) * 16384 + t * 128 + s8; wa[k] = *(const f32x4*)wp; wb[k] = *(const f32x4*)(wp + 4); }
    {   const int tk = tid >> 2, qu = tid & 3; const bf16* vp = P1 + (t0 + tk) * P1W + C_V + qu * 128; float ss = 0.f;
#pragma unroll 8
        for (int i = 0; i < 16; ++i) { const u32x4 x = *(const u32x4*)(vp + 8 * i);
            ss += bflo(x.x) * bflo(x.x) + bfhi(x.x) * bfhi(x.x) + bflo(x.y) * bflo(x.y) + bfhi(x.y) * bfhi(x.y) + bflo(x.z) * bflo(x.z) + bfhi(x.z) * bfhi(x.z) + bflo(x.w) * bflo(x.w) + bfhi(x.w) * bfhi(x.w); }
        ss += __shfl_xor(ss, 1); ss += __shfl_xor(ss, 2);
        if (qu == 0) rs[tk] = rsqrtf(ss * (1.f / 512.f) + EPS);
    }
#pragma unroll
    for (int k = 0; k < 8; ++k) { const int e = tid + 512 * k; const int gi = e >> 11, t = (e >> 4) & 127, s8 = (e & 15) * 8; const f32x4 a = wa[k], bq = wb[k];
        const float v0 = (s8 + 0 <= t) ? a.x : 0.f, v1 = (s8 + 1 <= t) ? a.y : 0.f, v2 = (s8 + 2 <= t) ? a.z : 0.f, v3 = (s8 + 3 <= t) ? a.w : 0.f;
        const float v4 = (s8 + 4 <= t) ? bq.x : 0.f, v5 = (s8 + 5 <= t) ? bq.y : 0.f, v6 = (s8 + 6 <= t) ? bq.z : 0.f, v7 = (s8 + 7 <= t) ? bq.w : 0.f;
        *(LAS u32x4*)(WT + gi * 34816 + t * 272 + s8 * 2) = (u32x4){pk2(v0, v1), pk2(v2, v3), pk2(v4, v5), pk2(v6, v7)}; }
    __syncthreads();
    {   u32x4 xv[8];
#pragma unroll
        for (int k = 0; k < 8; ++k) { const int e = tid + 512 * k; const int gi = e >> 11, sr = (e >> 4) & 127, c8 = e & 15; xv[k] = *(const u32x4*)(P1 + (t0 + sr) * P1W + C_V + (2 * gp + gi) * 128 + 8 * c8); }
#pragma unroll
        for (int k = 0; k < 8; ++k) { const int e = tid + 512 * k; const int gi = e >> 11, sr = (e >> 4) & 127, c8 = e & 15; const u32x4 x = xv[k];
            const float r = rs[sr]; const float* gq = gng + (2 * gp + gi) * 128 + 8 * c8;
            *(LAS u32x4*)(VN + gi * 32768 + (c8 >> 2) * 8192 + sr * 64 + (c8 & 3) * 16) = (u32x4){pk2(bflo(x.x) * r * gq[0], bfhi(x.x) * r * gq[1]), pk2(bflo(x.y) * r * gq[2], bfhi(x.y) * r * gq[3]), pk2(bflo(x.z) * r * gq[4], bfhi(x.z) * r * gq[5]), pk2(bflo(x.w) * r * gq[6], bfhi(x.w) * r * gq[7])}; } }
    __syncthreads();
    const int gi = w >> 2, cb = w & 3, g = 2 * gp + gi;
    const LAS unsigned char* vb = VN + gi * 32768 + cb * 8192 + ((lane >> 4) & 1) * 32 + (lane & 3) * 8 + (8 * h + ((lane & 15) >> 2)) * 64;
#pragma unroll 1
    for (int tb = 0; tb < 4; ++tb) {
        f32x16_ acc;
#pragma unroll
        for (int r = 0; r < 16; ++r) acc[r] = 0.f;
        const LAS unsigned char* wrow = WT + gi * 34816 + (32 * tb + r32) * 272 + 16 * h;
        for (int ks = 0; ks < 2 * tb + 2; ++ks) {
            const bf16x8 wf = *(const LAS bf16x8*)(wrow + 32 * ks);
            const s16x4_ lo = __builtin_bit_cast(s16x4_, __builtin_amdgcn_ds_read_tr16_b64_v4i16((LAS s16x4_*)(vb + ks * 1024)));
            const s16x4_ hi = __builtin_bit_cast(s16x4_, __builtin_amdgcn_ds_read_tr16_b64_v4i16((LAS s16x4_*)(vb + ks * 1024 + 256)));
            const bf16x8 vf = (bf16x8){lo[0], lo[1], lo[2], lo[3], hi[0], hi[1], hi[2], hi[3]};
            acc = __builtin_amdgcn_mfma_f32_32x32x16_bf16(vf, wf, acc, 0, 0, 0);
        }
        const int tl = 32 * tb + r32; const float bb = gmb[g * 128 + tl];
        bf16* up = P1 + (t0 + tl) * P1W + C_U + g * 128 + 32 * cb + 4 * h;
        u32x2 uu[4];
#pragma unroll
        for (int q4 = 0; q4 < 4; ++q4) uu[q4] = *(const u32x2*)(up + 8 * q4);
#pragma unroll
        for (int q4 = 0; q4 < 4; ++q4) {
            u32x2 o; o.x = pk2(bflo(uu[q4].x) * (acc[4 * q4] + bb), bfhi(uu[q4].x) * (acc[4 * q4 + 1] + bb)); o.y = pk2(bflo(uu[q4].y) * (acc[4 * q4 + 2] + bb), bfhi(uu[q4].y) * (acc[4 * q4 + 3] + bb));
            GST(*(u32x2*)(up + 8 * q4) = o); }
    }
}
__device__ __forceinline__ void pool_unit2(LAS unsigned char* lds, bf16* P1, const bf16* pwT, const float* ps, int unit) {
    typedef float f32x16_ __attribute__((ext_vector_type(16)));
    const int tid = opaque_tid(); const int lane = tid & 63, w = __builtin_amdgcn_readfirstlane(tid >> 6), r32 = lane & 31, h = lane >> 5;
    const int gi = unit & 3, tile = (unit >> 2) & 63, b = unit >> 8; const int wn = 2 << gi;
    LAS float* xs = (LAS float*)lds; LAS bf16* PL = (LAS bf16*)(lds + 40448);
    __syncthreads();
#pragma unroll
    for (int k = 0; k < 3; ++k) { const int e = tid + 512 * k; if (e < 79 * 16) { const int r = e >> 4, c8 = (e & 15) * 8; const int sp = tile * 64 + r - 15; const float z = sp >= 0 ? 1.f : 0.f;
        const u32x4 v = *(const u32x4*)(P1 + ((size_t)b * SEQ + (sp < 0 ? 0 : sp)) * P1W + C_XD + gi * 128 + c8);
        *(LAS f32x4*)(xs + r * 128 + c8) = (f32x4){bflo(v.x) * z, bfhi(v.x) * z, bflo(v.y) * z, bfhi(v.y) * z}; *(LAS f32x4*)(xs + r * 128 + c8 + 4) = (f32x4){bflo(v.z) * z, bfhi(v.z) * z, bflo(v.w) * z, bfhi(v.w) * z}; } }
    __syncthreads();
    {   const int ci = tid & 127, tq = tid >> 7;
        for (int k = 0; k < 16; ++k) { const int tt = tq * 16 + k; const int ts = tile * 64 + tt; float sacc = 0.f;
            for (int jj = 0; jj < wn; ++jj) sacc += xs[(tt + 15 - jj) * 128 + ci];
            const int cnt = (ts + 1 < wn) ? ts + 1 : wn;
            PL[tt * 136 + ci] = (bf16)f2bf(sacc / (float)cnt - xs[(tt + 15) * 128 + ci]); } }
    __syncthreads();
    {   const int cob = w >> 1, tokb = w & 1; f32x16_ acc;
#pragma unroll
        for (int r = 0; r < 16; ++r) acc[r] = 0.f;
        const bf16* wrow = pwT + (size_t)(32 * cob + r32) * 128 + 8 * h; const LAS bf16* prow = PL + (32 * tokb + r32) * 136 + 8 * h;
#pragma unroll
        for (int ks = 0; ks < 8; ++ks) { const bf16x8 wf = *(const bf16x8*)(wrow + 16 * ks); const bf16x8 pf = *(const LAS bf16x8*)(prow + 16 * ks);
            acc = __builtin_amdgcn_mfma_f32_32x32x16_bf16(wf, pf, acc, 0, 0, 0); }
        bf16* op = P1 + ((size_t)b * SEQ + tile * 64 + 32 * tokb + r32) * P1W + C_V + gi * 128 + 32 * cob + 4 * h; const float* sp = ps + gi * 128 + 32 * cob + 4 * h;
#pragma unroll
        for (int q4 = 0; q4 < 4; ++q4) { const f32x4 sc = *(const f32x4*)(sp + 8 * q4);
            u32x2 o; o.x = pk2(acc[4 * q4] * sc.x, acc[4 * q4 + 1] * sc.y); o.y = pk2(acc[4 * q4 + 2] * sc.z, acc[4 * q4 + 3] * sc.w); GST(*(u32x2*)(op + 8 * q4) = o); }
    }
}
__device__ __forceinline__ void lrufix_unit2(LAS unsigned char* lds, bf16* P1, const bf16* XN, const float* AGA, const float* AGH, int unit) {
    const int tid = opaque_tid(); const int cg = tid & 63, tl = tid >> 6; const int tile = unit & 63, b = unit >> 6;
    LAS float* seg = (LAS float*)lds;
    __syncthreads();
    {   float sa[8], sh[8];
#pragma unroll
        for (int i = 0; i < 8; ++i) { sa[i] = 1.f; sh[i] = 0.f; }
        f32x4 la0[8], la1[8], lh0[8], lh1[8];
#pragma unroll
        for (int k = 0; k < 8; ++k) { const int i = 8 * tl + k; const int ii = i < tile ? i : 0; const float* ap = AGA + ((size_t)b * 64 + ii) * 512 + 8 * cg; const float* hp = AGH + ((size_t)b * 64 + ii) * 512 + 8 * cg;
            la0[k] = *(const f32x4*)ap; la1[k] = *(const f32x4*)(ap + 4); lh0[k] = *(const f32x4*)hp; lh1[k] = *(const f32x4*)(hp + 4); }
#pragma unroll
        for (int k = 0; k < 8; ++k) { const int i = 8 * tl + k; if (i < tile) { const f32x4 a0 = la0[k], a1 = la1[k], h0 = lh0[k], h1 = lh1[k];
                sh[0] = a0.x * sh[0] + h0.x; sh[1] = a0.y * sh[1] + h0.y; sh[2] = a0.z * sh[2] + h0.z; sh[3] = a0.w * sh[3] + h0.w; sh[4] = a1.x * sh[4] + h1.x; sh[5] = a1.y * sh[5] + h1.y; sh[6] = a1.z * sh[6] + h1.z; sh[7] = a1.w * sh[7] + h1.w;
                sa[0] *= a0.x; sa[1] *= a0.y; sa[2] *= a0.z; sa[3] *= a0.w; sa[4] *= a1.x; sa[5] *= a1.y; sa[6] *= a1.z; sa[7] *= a1.w; } }
        LAS float* sp = seg + (tl * 64 + cg) * 16;
        *(LAS f32x4*)sp = (f32x4){sa[0], sa[1], sa[2], sa[3]}; *(LAS f32x4*)(sp + 4) = (f32x4){sa[4], sa[5], sa[6], sa[7]}; *(LAS f32x4*)(sp + 8) = (f32x4){sh[0], sh[1], sh[2], sh[3]}; *(LAS f32x4*)(sp + 12) = (f32x4){sh[4], sh[5], sh[6], sh[7]};
    }
    __syncthreads();
    float c[8];
#pragma unroll
    for (int i = 0; i < 8; ++i) c[i] = 0.f;
#pragma unroll
    for (int sgi = 0; sgi < 8; ++sgi) { const LAS float* sp = seg + (sgi * 64 + cg) * 16; const f32x4 a0 = *(const LAS f32x4*)sp, a1 = *(const LAS f32x4*)(sp + 4), h0 = *(const LAS f32x4*)(sp + 8), h1 = *(const LAS f32x4*)(sp + 12);
        c[0] = a0.x * c[0] + h0.x; c[1] = a0.y * c[1] + h0.y; c[2] = a0.z * c[2] + h0.z; c[3] = a0.w * c[3] + h0.w; c[4] = a1.x * c[4] + h1.x; c[5] = a1.y * c[5] + h1.y; c[6] = a1.z * c[6] + h1.z; c[7] = a1.w * c[7] + h1.w; }
    const size_t row0 = (size_t)b * SEQ + tile * 64;
#pragma unroll 4
    for (int p = 0; p < 8; ++p) { const size_t row = row0 + 8 * p + tl;
        const u32x4 hl = *(const u32x4*)(XN + row * 1024 + 8 * cg), ac = *(const u32x4*)(XN + row * 1024 + 512 + 8 * cg); bf16* gp = P1 + row * P1W + C_GB + 8 * cg; const u32x4 gg = *(const u32x4*)gp;
        u32x4 o;
        o.x = pk2(bflo(gg.x) * (bflo(hl.x) + bflo(ac.x) * c[0]), bfhi(gg.x) * (bfhi(hl.x) + bfhi(ac.x) * c[1])); o.y = pk2(bflo(gg.y) * (bflo(hl.y) + bflo(ac.y) * c[2]), bfhi(gg.y) * (bfhi(hl.y) + bfhi(ac.y) * c[3]));
        o.z = pk2(bflo(gg.z) * (bflo(hl.z) + bflo(ac.z) * c[4]), bfhi(gg.z) * (bfhi(hl.z) + bfhi(ac.z) * c[5])); o.w = pk2(bflo(gg.w) * (bflo(hl.w) + bflo(ac.w) * c[6]), bfhi(gg.w) * (bfhi(hl.w) + bfhi(ac.w) * c[7]));
        GST(*(u32x4*)gp = o); }
}

typedef float f32x16 __attribute__((ext_vector_type(16)));
typedef short s16x4 __attribute__((ext_vector_type(4)));
typedef __bf16 bf16x2_t __attribute__((ext_vector_type(2)));
constexpr int AT_KB = 8320, AT_VB = 8192;
constexpr int AT_TILE = AT_KB + AT_VB, AT_NT = 6, AT_IMP = AT_NT * AT_TILE, AT_SEL = AT_IMP + 16384, AT_SELU = AT_SEL + 512, AT_CNT = AT_SELU + 16;
__device__ __forceinline__ int at_koff(int slot, int sub) { return (2 * slot + sub) * AT_TILE; }
__device__ __forceinline__ int at_voff(int slot, int sub) { return (2 * slot + sub) * AT_TILE + AT_KB; }
__device__ __forceinline__ void ring_wait(LAS unsigned* p, unsigned target) { while (__hip_atomic_load(p, __ATOMIC_ACQUIRE, __HIP_MEMORY_SCOPE_WORKGROUP) < target) __builtin_amdgcn_s_sleep(1); }
__device__ __forceinline__ void ring_signal(LAS unsigned* p, int lane) { if (lane == 0) (void)__hip_atomic_fetch_add(p, 1u, __ATOMIC_RELEASE, __HIP_MEMORY_SCOPE_WORKGROUP); }
constexpr float AT_C2 = 0.125f * 1.4426950408889634f, AT_THR = 6.0f;
__device__ __forceinline__ unsigned cvtpk_bf16(float lo, float hi) { f32x2 v = {lo, hi}; bf16x2_t b = __builtin_convertvector(v, bf16x2_t); return __builtin_bit_cast(unsigned, b); }
__device__ __forceinline__ int crow(int r, int h) { return (r & 3) + 8 * (r >> 2) + 4 * h; }
__device__ __forceinline__ float max3f_(float a, float b, float c) { float r; asm("v_max3_f32 %0, %1, %2, %3" : "=v"(r) : "v"(a), "v"(b), "v"(c)); return r; }
__device__ __forceinline__ float swap32_max(float x) { auto rr = __builtin_amdgcn_permlane32_swap(__builtin_bit_cast(unsigned, x), __builtin_bit_cast(unsigned, x), false, false); float a = __builtin_bit_cast(float, rr[0]), b = __builtin_bit_cast(float, rr[1]); float r; asm("v_max_f32_e32 %0, %1, %2" : "=v"(r) : "v"(a), "v"(b)); return r; }
__device__ __forceinline__ float swap32_sum(float x) { auto rr = __builtin_amdgcn_permlane32_swap(__builtin_bit_cast(unsigned, x), __builtin_bit_cast(unsigned, x), false, false); return __builtin_bit_cast(float, rr[0]) + __builtin_bit_cast(float, rr[1]); }
struct AtRegs { u32x4 k, v; };
__device__ __forceinline__ AtRegs at_load_bf16(const bf16* kp, const bf16* vp, int tid) {
    AtRegs r; const int key = tid >> 3, c = tid & 7;
    if (ABL_ON(8)) { r.k = (u32x4){1u, 2u, 3u, 4u}; r.v = r.k; return r; }
    r.k = *(const u32x4*)(kp + (size_t)key * P1W + 8 * c); r.v = *(const u32x4*)(vp + (size_t)key * P1W + 8 * c); return r;
}
__device__ __forceinline__ AtRegs at_load_f32(const float* kp, const float* vp, int n0, int tid) {
    AtRegs r; const int key = tid >> 3, c = tid & 7; const int n = n0 + key;
    if (n < 255) { const f32x4 a0 = *(const f32x4*)(kp + (size_t)n * 64 + 8 * c), a1 = *(const f32x4*)(kp + (size_t)n * 64 + 8 * c + 4), b0 = *(const f32x4*)(vp + (size_t)n * 64 + 8 * c), b1 = *(const f32x4*)(vp + (size_t)n * 64 + 8 * c + 4);
        r.k = (u32x4){pk2(a0.x, a0.y), pk2(a0.z, a0.w), pk2(a1.x, a1.y), pk2(a1.z, a1.w)}; r.v = (u32x4){pk2(b0.x, b0.y), pk2(b0.z, b0.w), pk2(b1.x, b1.y), pk2(b1.z, b1.w)}; }
    else { r.k = (u32x4){0u, 0u, 0u, 0u}; r.v = (u32x4){0u, 0u, 0u, 0u}; }
    return r;
}
__device__ __forceinline__ void at_store(LAS unsigned char* lds, int slot, int sub, const AtRegs& r, int tid) {
    const int key = tid >> 3, c = tid & 7;
    *(LAS u32x4*)(lds + at_koff(slot, sub) + c * 1040 + key * 16) = r.k;
    *(LAS u32x4*)(lds + at_voff(slot, sub) + (c >> 2) * 4096 + key * 64 + (c & 3) * 16) = r.v;
}
__device__ __forceinline__ void at_qk(f32x16& p0, f32x16& p1, const LAS unsigned char* kb, const bf16x8 (&qr)[4], int r32, int h) {
    const f32x16 z = {0.f, 0.f, 0.f, 0.f, 0.f, 0.f, 0.f, 0.f, 0.f, 0.f, 0.f, 0.f, 0.f, 0.f, 0.f, 0.f};
    bf16x8 kf[8];
#pragma unroll
    for (int d0 = 0; d0 < 4; ++d0) { kf[2 * d0] = *(const LAS bf16x8*)(kb + (2 * d0 + h) * 1040 + r32 * 16); kf[2 * d0 + 1] = *(const LAS bf16x8*)(kb + (2 * d0 + h) * 1040 + (32 + r32) * 16); }
    __builtin_amdgcn_sched_barrier(0);
    p0 = __builtin_amdgcn_mfma_f32_32x32x16_bf16(kf[0], qr[0], z, 0, 0, 0); p1 = __builtin_amdgcn_mfma_f32_32x32x16_bf16(kf[1], qr[0], z, 0, 0, 0);
#pragma unroll
    for (int d0 = 1; d0 < 4; ++d0) { p0 = __builtin_amdgcn_mfma_f32_32x32x16_bf16(kf[2 * d0], qr[d0], p0, 0, 0, 0); p1 = __builtin_amdgcn_mfma_f32_32x32x16_bf16(kf[2 * d0 + 1], qr[d0], p1, 0, 0, 0); }
}
__device__ __forceinline__ void at_step(const LAS unsigned char* lds, int slot, int sub, const bf16x8 (&qr)[4], f32x16 (&o)[2], float& m, float& l, u64 vm, int lane) {
    if (!__any(vm != 0ull)) return;
    const int r32 = lane & 31, h = lane >> 5;
    f32x16 p0, p1;
    if (!ABL_ON(4)) at_qk(p0, p1, lds + at_koff(slot, sub), qr, r32, h); else { for (int r = 0; r < 16; ++r) { p0[r] = 0.f; p1[r] = 0.f; } }
    const LAS unsigned char* vb = lds + at_voff(slot, sub) + ((lane >> 4) & 1) * 32 + (lane & 3) * 8 + (4 * h + ((lane & 15) >> 2)) * 64;
    s16x4 tlo[8], thi[8];
#pragma unroll
    for (int i = 0; i < 8; ++i) { tlo[i] = __builtin_bit_cast(s16x4, __builtin_amdgcn_ds_read_tr16_b64_v4i16((LAS s16x4*)(vb + (i & 1) * 4096 + (i >> 1) * 1024)));
        thi[i] = __builtin_bit_cast(s16x4, __builtin_amdgcn_ds_read_tr16_b64_v4i16((LAS s16x4*)(vb + (i & 1) * 4096 + (i >> 1) * 1024 + 512))); }
    __builtin_amdgcn_sched_barrier(0);
    const bool full = __all(vm == ~0ull);
    const unsigned vlo = (unsigned)vm, vhi = (unsigned)(vm >> 32);
    if (!full && !ABL_ON(16)) {
#pragma unroll
        for (int r = 0; r < 16; ++r) { const int kx = crow(r, h); p0[r] = ((vlo >> kx) & 1u) ? p0[r] : -INFINITY; p1[r] = ((vhi >> kx) & 1u) ? p1[r] : -INFINITY; }
    }
    asm volatile("s_nop 15\n\ts_nop 7" : "+v"(p0), "+v"(p1));
    float rm = max3f_(p0[0], p1[0], p0[1]);
#pragma unroll
    for (int r = 1; r < 15; ++r) rm = max3f_(rm, p1[r], p0[r + 1]);
    rm = max3f_(rm, p1[15], rm);
    rm *= AT_C2;
    rm = fmaxf(rm, __shfl_xor(rm, 32));
    if (__any(rm > m + AT_THR)) { const float mn = fmaxf(m, rm); const float f = __builtin_amdgcn_exp2f(m - mn); m = mn; l *= f;
#pragma unroll
        for (int r = 0; r < 16; ++r) { o[0][r] *= f; o[1][r] *= f; } }
    const float nm = -m; float ls = 0.f;
#pragma unroll
    for (int r = 0; r < 16; ++r) { if (!ABL_ON(1)) { p0[r] = __builtin_amdgcn_exp2f(__builtin_fmaf(p0[r], AT_C2, nm)); p1[r] = __builtin_amdgcn_exp2f(__builtin_fmaf(p1[r], AT_C2, nm)); } ls += p0[r] + p1[r]; }
    l += ls;
    __builtin_amdgcn_sched_barrier(0);
#pragma unroll
    for (int ks = 0; ks < 4; ++ks) {
        u32x4 pw;
        if (ks == 0) pw = (u32x4){cvtpk_bf16(p0[0], p0[1]), cvtpk_bf16(p0[2], p0[3]), cvtpk_bf16(p0[4], p0[5]), cvtpk_bf16(p0[6], p0[7])};
        else if (ks == 1) pw = (u32x4){cvtpk_bf16(p0[8], p0[9]), cvtpk_bf16(p0[10], p0[11]), cvtpk_bf16(p0[12], p0[13]), cvtpk_bf16(p0[14], p0[15])};
        else if (ks == 2) pw = (u32x4){cvtpk_bf16(p1[0], p1[1]), cvtpk_bf16(p1[2], p1[3]), cvtpk_bf16(p1[4], p1[5]), cvtpk_bf16(p1[6], p1[7])};
        else pw = (u32x4){cvtpk_bf16(p1[8], p1[9]), cvtpk_bf16(p1[10], p1[11]), cvtpk_bf16(p1[12], p1[13]), cvtpk_bf16(p1[14], p1[15])};
        const bf16x8 pf = __builtin_bit_cast(bf16x8, pw);
#pragma unroll
        for (int db = 0; db < 2; ++db) { const int i = 2 * ks + db;
            const bf16x8 vf = (bf16x8){tlo[i][0], tlo[i][1], tlo[i][2], tlo[i][3], thi[i][0], thi[i][1], thi[i][2], thi[i][3]};
            if (!ABL_ON(2)) o[db] = __builtin_amdgcn_mfma_f32_32x32x16_bf16(vf, pf, o[db], 0, 0, 0); else asm volatile("" :: "v"(vf), "v"(pf)); }
    }
}
__device__ __forceinline__ void at_fold(f32x16 (&ot)[2], f32x16 (&o)[2], float& m, float& l, float gate, bool valid) {
    const float lt = l + __shfl_xor(l, 32); const float inv = (valid && lt > 0.f) ? gate / lt : 0.f;
#pragma unroll
    for (int r = 0; r < 16; ++r) { ot[0][r] += o[0][r] * inv; ot[1][r] += o[1][r] * inv; o[0][r] = 0.f; o[1][r] = 0.f; }
    m = -1e30f; l = 0.f;
}
__device__ __forceinline__ void attn_unit_mfma(LAS unsigned char* lds, bf16* P1, const float* KC, int unit) {
    const int tid = opaque_tid(); const int lane = tid & 63, w = __builtin_amdgcn_readfirstlane(tid >> 6), r32 = lane & 31, h = lane >> 5;
    const int ti = unit & 63, g = (unit >> 6) & 1, b = unit >> 7;
    const int tq = 8 * w + (r32 >> 2), j = r32 & 3, hd = 4 * g + j; const int ts = 64 * ti + tq;
    const size_t row = (size_t)b * SEQ + ts;
    LAS float* IMP = (LAS float*)(lds + AT_IMP); LAS u64* SEL = (LAS u64*)(lds + AT_SEL); LAS unsigned* SELU = (LAS unsigned*)(lds + AT_SELU);
    __syncthreads();
    for (int e = tid; e < 4096; e += 512) IMP[e] = 0.f;
    if (tid < 2) SELU[tid] = 0u;
    if (tid < 16) ((LAS unsigned*)(lds + AT_CNT))[tid] = 0u;
    bf16x8 qr[4];
    { const bf16* qp = P1 + row * P1W + C_Q + hd * 64 + 8 * h;
#pragma unroll
      for (int d0 = 0; d0 < 4; ++d0) qr[d0] = *(const bf16x8*)(qp + 16 * d0); }
    const float g0 = bf2f(P1[row * P1W + C_GC + hd * 3 + 0]), g1 = bf2f(P1[row * P1W + C_GC + hd * 3 + 1]), g2 = bf2f(P1[row * P1W + C_GC + hd * 3 + 2]);
    f32x16 o[2], ot[2];
#pragma unroll
    for (int r = 0; r < 16; ++r) { o[0][r] = 0.f; o[1][r] = 0.f; ot[0][r] = 0.f; ot[1][r] = 0.f; }
    float m = -1e30f, l = 0.f;
    const int nv = (ts >= 31) ? ((((ts + 1) >> 4) - 1 > 255) ? 255 : ((ts + 1) >> 4) - 1) : 0;
    const int nkt = (4 * ti + 3 + 63) >> 6;
    const float* kcp = KC + ((((size_t)0 * NB + b) * 2 + g) * 256) * 64; const float* vcp = KC + ((((size_t)1 * NB + b) * 2 + g) * 256) * 64;
    {   const int np = (nkt + 1) >> 1;
        AtRegs ra = at_load_f32(kcp, vcp, 0, tid), rb = ra; if (nkt > 1) rb = at_load_f32(kcp, vcp, 64, tid);
        at_store(lds, 0, 0, ra, tid); if (nkt > 1) at_store(lds, 0, 1, rb, tid); __syncthreads();
        for (int pi = 0; pi < np; ++pi) {
            const int k0 = 2 * pi, k2 = 2 * pi + 2;
            if (k2 < nkt) { ra = at_load_f32(kcp, vcp, 64 * k2, tid); if (k2 + 1 < nkt) rb = at_load_f32(kcp, vcp, 64 * (k2 + 1), tid); }
            at_step(lds, pi & 1, 0, qr, o, m, l, mask_lo(nv - 64 * k0), lane);
            if (k0 + 1 < nkt) at_step(lds, pi & 1, 1, qr, o, m, l, mask_lo(nv - 64 * (k0 + 1)), lane);
            if (k2 < nkt) { at_store(lds, (pi + 1) & 1, 0, ra, tid); if (k2 + 1 < nkt) at_store(lds, (pi + 1) & 1, 1, rb, tid); }
            __syncthreads();
        }
        const float lt = l + __shfl_xor(l, 32); const float invl = (nv > 0 && lt > 0.f) ? 1.f / lt : 0.f;
        float prevL = 0.f;
        ra = at_load_f32(kcp, vcp, 0, tid); if (nkt > 1) rb = at_load_f32(kcp, vcp, 64, tid);
        at_store(lds, 0, 0, ra, tid); if (nkt > 1) at_store(lds, 0, 1, rb, tid); __syncthreads();
        for (int pi = 0; pi < np; ++pi) {
            const int k2 = 2 * pi + 2;
            if (k2 < nkt) { ra = at_load_f32(kcp, vcp, 64 * k2, tid); if (k2 + 1 < nkt) rb = at_load_f32(kcp, vcp, 64 * (k2 + 1), tid); }
#pragma unroll 1
            for (int sub = 0; sub < 2; ++sub) {
                const int kt = 2 * pi + sub; if (kt >= nkt) break;
                f32x16 p0, p1; at_qk(p0, p1, lds + at_koff(pi & 1, sub), qr, r32, h);
                const u64 vm = mask_lo(nv - 64 * kt); const unsigned vlo = (unsigned)vm, vhi = (unsigned)(vm >> 32);
#pragma unroll
                for (int r = 0; r < 16; ++r) { const int kx = crow(r, h);
                    p0[r] = ((vlo >> kx) & 1u) ? __builtin_amdgcn_exp2f(p0[r] * AT_C2 - m) * invl : 0.f;
                    p1[r] = ((vhi >> kx) & 1u) ? __builtin_amdgcn_exp2f(p1[r] * AT_C2 - m) * invl : 0.f; }
#pragma unroll
                for (int hh = 0; hh < 2; ++hh) {
                    float G[4], Lp[4];
#pragma unroll
                    for (int q4 = 0; q4 < 4; ++q4) { const float a0 = hh ? p1[4 * q4] : p0[4 * q4], a1 = hh ? p1[4 * q4 + 1] : p0[4 * q4 + 1], a2 = hh ? p1[4 * q4 + 2] : p0[4 * q4 + 2], a3 = hh ? p1[4 * q4 + 3] : p0[4 * q4 + 3];
                        G[q4] = (a0 + a1) + (a2 + a3); Lp[q4] = __shfl_xor(a3, 32); }
#pragma unroll
                    for (int q4 = 0; q4 < 4; ++q4) {
                        const float carry = h ? Lp[q4] : (q4 == 0 ? prevL : Lp[q4 - 1]);
                        float v = G[q4] + carry; v += __shfl_xor(v, 1); v += __shfl_xor(v, 2);
                        if (j == 0) IMP[tq * 64 + 16 * kt + 8 * hh + 2 * q4 + h] = v;
                    }
                    prevL = Lp[3];
                }
            }
            if (k2 < nkt) { at_store(lds, (pi + 1) & 1, 0, ra, tid); if (k2 + 1 < nkt) at_store(lds, (pi + 1) & 1, 1, rb, tid); }
            __syncthreads();
        }
    }
    at_fold(ot, o, m, l, g0, nv > 0);
    __syncthreads();
    const int cur = ti;
    FT0(3);
    {
        const int tok = tid >> 3, j8 = tid & 7; u64 selt = 1ull | (1ull << cur) | (cur >= 1 ? (1ull << (cur - 1)) : 0ull);
        float cv[8];
#pragma unroll
        for (int k = 0; k < 8; ++k) { const int mm = j8 + 8 * k; cv[k] = (mm >= 1 && mm <= cur - 2) ? IMP[tok * 64 + mm] : -1.f; }
        const int npick = (cur - 2) < 5 ? (cur - 2) : 5;
        for (int pk = 0; pk < npick; ++pk) { float best = -1.f; int bi = 64;
#pragma unroll
            for (int k = 0; k < 8; ++k) if (cv[k] > best) { best = cv[k]; bi = j8 + 8 * k; }
#pragma unroll
            for (int off = 1; off < 8; off <<= 1) { const float ov = __shfl_xor(best, off); const int oi = __shfl_xor(bi, off); if (ov > best || (ov == best && oi < bi)) { best = ov; bi = oi; } }
            selt |= 1ull << (bi & 63);
#pragma unroll
            for (int k = 0; k < 8; ++k) if (j8 + 8 * k == bi) cv[k] = -2.f; }
        if (j8 == 0) { SEL[tok] = selt; atomicOr((unsigned*)&SELU[0], (unsigned)selt); atomicOr((unsigned*)&SELU[1], (unsigned)(selt >> 32)); }
    }
    __syncthreads();
    FT1(3);
    const u64 sel = SEL[tq];
    const u64 selu = ((u64)SELU[1] << 32) | (u64)SELU[0];
    {
        const bf16* kb = P1 + (size_t)b * SEQ * P1W + C_KV + (2 * 2 + g) * 64; const bf16* vbp = P1 + (size_t)b * SEQ * P1W + C_KV + (3 * 2 + g) * 64;
        LAS unsigned* FIL = (LAS unsigned*)(lds + AT_CNT); LAS unsigned* DON = FIL + 8;
        const int n = __builtin_popcountll(selu);
        u64 remL = selu, remC = selu;
        {   AtRegs r0, r1, r2; int b0 = __builtin_ctzll(remL); remL &= remL - 1; r0 = at_load_bf16(kb + (size_t)b0 * 64 * P1W, vbp + (size_t)b0 * 64 * P1W, tid); r1 = r0; r2 = r0;
            if (n > 1) { const int b1 = __builtin_ctzll(remL); remL &= remL - 1; r1 = at_load_bf16(kb + (size_t)b1 * 64 * P1W, vbp + (size_t)b1 * 64 * P1W, tid); }
            if (n > 2) { const int b2 = __builtin_ctzll(remL); remL &= remL - 1; r2 = at_load_bf16(kb + (size_t)b2 * 64 * P1W, vbp + (size_t)b2 * 64 * P1W, tid); }
            at_store(lds, 0, 0, r0, tid); ring_signal(FIL + 0, lane);
            if (n > 1) { at_store(lds, 0, 1, r1, tid); ring_signal(FIL + 1, lane); }
            if (n > 2) { at_store(lds, 1, 0, r2, tid); ring_signal(FIL + 2, lane); } }
        AtRegs rg; rg.k = (u32x4){0u, 0u, 0u, 0u}; rg.v = rg.k;
        if (n > 3) { const int b3 = __builtin_ctzll(remL); remL &= remL - 1; rg = at_load_bf16(kb + (size_t)b3 * 64 * P1W, vbp + (size_t)b3 * 64 * P1W, tid); }
        int jc = 0, gc = 1, js = 3, gs = 0;
#pragma unroll 1
        for (int t = 0; t < n; ++t) {
            const int mbc = __builtin_ctzll(remC); remC &= remC - 1;
            if (t + 3 < n) {
                FT0(4); ring_wait(DON + js, 8u * (unsigned)gs); FT1(4);
                FT0(5); at_store(lds, js >> 1, js & 1, rg, tid); ring_signal(FIL + js, lane); FT1(5);
                if (t + 4 < n) { const int bn = __builtin_ctzll(remL); remL &= remL - 1; rg = at_load_bf16(kb + (size_t)bn * 64 * P1W, vbp + (size_t)bn * 64 * P1W, tid); }
            }
            FT0(6); ring_wait(FIL + jc, 8u * (unsigned)gc); FT1(6);
            u64 vm = 0ull; if ((sel >> mbc) & 1ull) vm = (mbc == cur) ? mask_lo((ts & 63) + 1) : ~0ull;
            FT0(7); at_step(lds, jc >> 1, jc & 1, qr, o, m, l, vm, lane); FT1(7);
            ring_signal(DON + jc, lane);
            if (++jc == 6) { jc = 0; ++gc; }
            if (++js == 6) { js = 0; ++gs; }
        }
        __syncthreads();
    }
    at_fold(ot, o, m, l, g1, true);
    {   const bf16* kb = P1 + (size_t)b * SEQ * P1W + C_KV + (4 * 2 + g) * 64; const bf16* vbp = P1 + (size_t)b * SEQ * P1W + C_KV + (5 * 2 + g) * 64;
        const int mlo = (ti >= 8) ? ti - 8 : 0; const int nw = cur - mlo + 1, np = (nw + 1) >> 1;
        AtRegs ra = at_load_bf16(kb + (size_t)mlo * 64 * P1W, vbp + (size_t)mlo * 64 * P1W, tid), rb = ra; if (nw > 1) rb = at_load_bf16(kb + (size_t)(mlo + 1) * 64 * P1W, vbp + (size_t)(mlo + 1) * 64 * P1W, tid);
        at_store(lds, 0, 0, ra, tid); if (nw > 1) at_store(lds, 0, 1, rb, tid); __syncthreads();
        for (int pi = 0; pi < np; ++pi) {
            const int i0 = 2 * pi, i2 = 2 * pi + 2;
            if (i2 < nw) { ra = at_load_bf16(kb + (size_t)(mlo + i2) * 64 * P1W, vbp + (size_t)(mlo + i2) * 64 * P1W, tid); if (i2 + 1 < nw) rb = at_load_bf16(kb + (size_t)(mlo + i2 + 1) * 64 * P1W, vbp + (size_t)(mlo + i2 + 1) * 64 * P1W, tid); }
#pragma unroll 1
            for (int sub = 0; sub < 2; ++sub) { const int mb = mlo + i0 + sub; if (i0 + sub >= nw) break;
                const int lo = ts - 511 - mb * 64, hi = ts - mb * 64;
                u64 vm = 0ull; if (hi >= 0 && lo <= 63) vm = mask_lo(hi + 1) & ~mask_lo(lo);
                at_step(lds, pi & 1, sub, qr, o, m, l, vm, lane); }
            if (i2 < nw) { at_store(lds, (pi + 1) & 1, 0, ra, tid); if (i2 + 1 < nw) at_store(lds, (pi + 1) & 1, 1, rb, tid); }
            __syncthreads();
        }
    }
    at_fold(ot, o, m, l, g2, true);
    {   bf16* op = P1 + row * P1W + C_Q + hd * 64 + 4 * h;
#pragma unroll
        for (int db = 0; db < 2; ++db)
#pragma unroll
            for (int q4 = 0; q4 < 4; ++q4) { u32x2 wv; wv.x = cvtpk_bf16(ot[db][4 * q4], ot[db][4 * q4 + 1]); wv.y = cvtpk_bf16(ot[db][4 * q4 + 2], ot[db][4 * q4 + 3]); GST(*(u32x2*)(op + 32 * db + 8 * q4) = wv); } }
}

__device__ __forceinline__ void set_dry(LAS unsigned char* l, int v) { __syncthreads(); if (threadIdx.x == 0) ((volatile LAS int*)(l + LDS_CTL + 64))[0] = v; __syncthreads(); }
constexpr int NPH = 1 + 9 * NL;
__global__ void __launch_bounds__(512, 2) fwd_kernel(Args args) {
    extern __shared__ __attribute__((aligned(16))) unsigned char lds_raw[];
    LAS unsigned char* ldsl = (LAS unsigned char*)lds_raw;
    float* ldsf = (float*)lds_raw;
    const int G0 = gridDim.x, bx0 = blockIdx.x, G = G0, bx = bx0, NGW = G * 8;
#define PHASE_IDS() const int tid = opaque_tid(), lane = tid & 63, wave = __builtin_amdgcn_readfirstlane(tid >> 6), gw = bx * 8 + wave; (void)lane; (void)gw
#define ws ARG_WS()
#define ctl ((unsigned*)(ws + WS_CTL))
#define H ARG_OUT()
#define XN ((bf16*)(ws + WS_XN))
#define P1 ((bf16*)(ws + WS_P1))
#define Rr ((bf16*)(ws + WS_R))
#define WIN ((bf16*)(ws + WS_WIN))
#define WB ((bf16*)(ws + WS_WB))
#define WOUT ((bf16*)(ws + WS_WOUT))
#define WGU ((bf16*)(ws + WS_WGU))
#define WD ((bf16*)(ws + WS_WD))
#define HID ((bf16*)(ws + WS_HID))
#define Y ((bf16*)(ws + WS_Y))
#define KC ((float*)(ws + WS_KC))
#define AGA ((float*)(ws + WS_LRUA))
#define AGH ((float*)(ws + WS_LRUH))
#define LIST ((unsigned*)(ws + WS_LIST))
#define LISTW ((float*)(ws + WS_LISTW))
    { PHASE_IDS(); for (int u = tid; u < (LDS_BYTES - LDS_CTL) / 4; u += 512) ((LAS unsigned*)(ldsl + LDS_CTL))[u] = 0u; }
    __syncthreads();
    if (!MK_SPLIT) (void)xcd_barrier_post(ctl + CW_BAR, (volatile LAS unsigned*)(ldsl + LDS_CTL + 32));
    const int lo = args.ph_lo, hi = args.ph_hi;
#define IN(k) (lo <= (k) && (k) < hi)
#if PROBE_PH >= 0
#ifndef PROBE_REAL
#define PROBE_REAL 0
#endif
#define PHASE_REP(id) for (int rep_ = 0; rep_ < (((id) == PROBE_PH) ? 2 : 1); ++rep_, set_dry(ldsl, 0)) if (set_dry(ldsl, PROBE_REAL ? 0 : rep_), true)
#else
#define PHASE_REP(id) if (true)
#endif
#define SEAM(k) do { if (!MK_SPLIT && IN((k) + 1)) { XcdBarrier bb_; bb_.bar = ctl + CW_BAR; bb_.x = xb_xcc_id(); bb_.st = (volatile LAS unsigned*)(ldsl + LDS_CTL + 32); \
    for (int r_ = 0; r_ < ((PROBE_PH == 50) ? 3 : 1); ++r_) xcd_barrier(bb_); } } while (0)

    if (IN(0)) PHASE_REP(100) {
        PHASE_IDS();
        float* scr = ldsf + wave * 4096;
        constexpr int IT_W1 = 32 * 2, IT_LW = 2, IT_PW = 2 * 4;
        constexpr int NSMALL = NL * 4 * IT_W1 + NL * 16 * IT_LW + NL * 4 * IT_PW;
        auto dec0 = [&](int it) -> TrItem {
            if (it < IT_BIG) return dec_big(it, 0);
            int r = it - IT_BIG;
            if (r < NL * 4 * IT_W1) { const int m = r / IT_W1; r -= m * IT_W1; return TrItem{ARG_IN(I_CW1) + (size_t)m * 2048 * 64, (bf16*)(ws + WS_W1T) + (size_t)m * 64 * 2048, 2048, 64, r / 2, r % 2, 0}; }
            r -= NL * 4 * IT_W1;
            if (r < NL * 16 * IT_LW) { const int m = r / IT_LW; r -= m * IT_LW; const int l = m >> 4, mat = (m >> 3) & 1, hh = m & 7;
                return TrItem{ARG_IN(mat ? I_LWX : I_LWA) + ((size_t)l * 8 + hh) * 4096, (bf16*)(ws + WS_LWT) + (size_t)m * 4096, 64, 64, 0, r, 0}; }
            r -= NL * 16 * IT_LW;
            { const int m = r / IT_PW; r -= m * IT_PW; return TrItem{ARG_IN(I_PW) + (size_t)m * 16384, (bf16*)(ws + WS_PWT) + (size_t)m * 16384, 128, 128, r / 4, r % 4, 0}; }
        };
        constexpr int NIT0 = IT_BIG + NSMALL;
        if (gw < NIT0) { TrItem cur = dec0(gw); TrRegs rv = tr_load(cur, lane);
            for (int it = gw; it < NIT0; it += NGW) { TrItem nxt = cur; TrRegs rn = rv; const bool more = it + NGW < NIT0;
                if (more) { nxt = dec0(it + NGW); rn = tr_load(nxt, lane); }
                tr_finish(cur, rv, scr, lane); cur = nxt; rv = rn; } }
        for (int e = bx * 512 + tid; e < NL * 232 * 128; e += G * 512) { const int l = e / (232 * 128), rr = (e / 128) % 232, c8 = (e % 128) * 8;
            GST(*(u32x4*)(WIN + ((size_t)l * NPROJ + C_GC + 24 + rr) * D + c8) = (u32x4){0u, 0u, 0u, 0u}); }
        for (int m = gw; m < T; m += 2 * NGW) norm_rows<0>(ARG_IN(I_X), H, nullptr, nullptr, ARG_IN(I_N1G), XN, m, m + NGW, m + NGW < T, lane);
    }
    SEAM(0);

    unsigned long long tacc_ = 0ull, tbeg_ = 0ull; (void)tacc_; (void)tbeg_;
#define TBEG(id) do { if (PROBE_T_LO >= 0 && (id) == PROBE_T_LO) tbeg_ = __builtin_amdgcn_s_memrealtime(); } while (0)
#define TEND(id) do { if (PROBE_T_LO >= 0 && (id) + 1 == PROBE_T_HI) tacc_ += __builtin_amdgcn_s_memrealtime() - tbeg_; } while (0)
    for (int l = 0; l < NL; ++l) {
        const int pb = 1 + 9 * l;
#define OPQ_S(x) ({ int t_ = (x); asm volatile("" : "+s"(t_)); t_; })
#undef bx
#undef G
        TBEG(0);
        if (IN(pb + 0)) PHASE_REP(0) {
            const int bxo = OPQ_S(bx0), Go = OPQ_S(G0); (void)bxo; (void)Go;
#define bx bxo
#define G Go
            SchedDense S{XN, WIN + (size_t)l * NPROJ * D, D, D, T / 256, NPROJ / 256, G, bx, nullptr, 0u, nullptr};
            EpiProj E{P1, Rr};
            pg8::gemm_phase<EpiProj, SchedDense, true>(ldsl, D, S, E);
        }
        SEAM(pb + 0); TEND(0);
#undef bx
#undef G
        TBEG(1);
        if (IN(pb + 1)) PHASE_REP(1) {
            const int bxo = OPQ_S(bx0), Go = OPQ_S(G0); (void)bxo; (void)Go;
#define bx bxo
#define G Go
            constexpr int U_LRU = NB * 64, U_GM = 128 * 2, U_CMP = 256;
            for (int u = bx; u < U_LRU + U_GM + U_CMP; u += G) {
                SUBT0(); const int ty_ = (u < U_CMP) ? 6 : (u < U_CMP + U_GM) ? 7 : 8; (void)ty_;
                if (u < U_CMP) cmp_unit2(ldsl, P1, KC, ARG_IN(I_PE) + (size_t)l * 2 * 2048, (const bf16*)(ws + WS_W1T) + (size_t)l * 4 * 64 * 2048, ARG_IN(I_CW2) + (size_t)l * 4 * 4096, u);
                else if (u < U_CMP + U_GM) gmlp_unit3(ldsl, P1, ARG_IN(I_GMNG) + l * 512, ARG_IN(I_GMWS) + (size_t)l * 4 * 16384, ARG_IN(I_GMB) + l * 512, u - U_CMP);
                else lru_unit2(ldsl, P1, XN, AGA, AGH, ARG_IN(I_CONVW) + l * 2048, ARG_IN(I_CONVB) + l * 512, (const bf16*)(ws + WS_LWT) + (size_t)(l * 2 + 0) * 8 * 4096, (const bf16*)(ws + WS_LWT) + (size_t)(l * 2 + 1) * 8 * 4096,
                               ARG_IN(I_LBA) + l * 512, ARG_IN(I_LBX) + l * 512, ARG_IN(I_LLAM) + l * 512, u - U_CMP - U_GM);
                SUBT1(ty_);
            }
            __syncthreads();
        }
        SEAM(pb + 1); TEND(1);
#undef bx
#undef G
        TBEG(2);
        if (IN(pb + 2)) PHASE_REP(2) {
            const int bxo = OPQ_S(bx0), Go = OPQ_S(G0); (void)bxo; (void)Go;
#define bx bxo
#define G Go
            constexpr int U_AT = NB * 2 * 64, U_PL = NB * 64 * 4, U_FX = NB * 64;
            const int U_CV = (l == 0 && NL > 1) ? (IT_BIG + 7) / 8 : 0;
            for (int u = bx; u < U_AT; u += G) {
                SUBT0(); const int ty_ = 1; (void)ty_;
                { const int k = u >> 3, bg = u & 7; const int ti = (u < 256) ? 63 - k : k - 32; attn_unit_mfma(ldsl, P1, KC, (bg << 6) | ti); }
                SUBT1(ty_);
            }
            {   const int NDYN = U_PL + U_FX + U_CV; unsigned* qctr = ctl + CW_Q + 64 * l; volatile LAS unsigned* qslot = (volatile LAS unsigned*)(ldsl + LDS_CTL + 192);
                unsigned nx = 0u; const bool ldr = (threadIdx.x == 0) && !is_dry();
                if (threadIdx.x == 0) nx = is_dry() ? (unsigned)NDYN : __hip_atomic_fetch_add(qctr, 1u, __ATOMIC_RELAXED, __HIP_MEMORY_SCOPE_AGENT);
                for (;;) {
                    __syncthreads(); if (threadIdx.x == 0) qslot[0] = nx; __syncthreads();
                    const int u = (int)qslot[0]; if (u >= NDYN) break;
                    if (ldr) nx = __hip_atomic_fetch_add(qctr, 1u, __ATOMIC_RELAXED, __HIP_MEMORY_SCOPE_AGENT);
                    SUBT0(); const int ty_ = (u < U_FX) ? 3 : (u < U_FX + U_PL) ? 2 : 4; (void)ty_;
                    if (u < U_FX) lrufix_unit2(ldsl, P1, XN, AGA, AGH, u);
                    else if (u < U_FX + U_PL) pool_unit2(ldsl, P1, (const bf16*)(ws + WS_PWT) + ((size_t)l * 4 + ((u - U_FX) & 3)) * 16384, ARG_IN(I_PS) + l * 512, u - U_FX);
                    else conv_unit(ldsf, u - U_FX - U_PL);
                    SUBT1(ty_);
                }
            }
            __syncthreads();
        }
        SEAM(pb + 2); TEND(2);
#undef bx
#undef G
        TBEG(3);
        if (IN(pb + 3)) PHASE_REP(3) {
            const int bxo = OPQ_S(bx0), Go = OPQ_S(G0); (void)bxo; (void)Go;
#define bx bxo
#define G Go
            SchedMerge S{P1, WB + (size_t)l * 4 * 1024 * 512, G, bx, ctl + CW_G2 + l * 4096};
            EpiMerge E{Rr, XN};
            pg8::gemm_phase<EpiMerge, SchedMerge, true>(ldsl, 512, S, E);
        }
        if (MK_SPLIT) { SEAM(pb + 3); } TEND(3);
#undef bx
#undef G
        TBEG(4);
        if (IN(pb + 4)) PHASE_REP(4) {
            const int bxo = OPQ_S(bx0), Go = OPQ_S(G0); (void)bxo; (void)Go;
#define bx bxo
#define G Go
            SchedDense S{XN, WOUT + (size_t)l * 1024 * 1024, D, D, T / 256, 4, G, bx, MK_SPLIT ? nullptr : ctl + CW_G2 + l * 4096, 32u, ctl};
            EpiWout E{(l == 0) ? ARG_IN(I_X) : (const float*)H, H};
            pg8::gemm_phase<EpiWout, SchedDense, true>(ldsl, D, S, E);
        }
        SEAM(pb + 4); TEND(4);
#undef bx
#undef G
        TBEG(5);
        if (IN(pb + 5)) PHASE_REP(5) {
            const int bxo = OPQ_S(bx0), Go = OPQ_S(G0); (void)bxo; (void)Go;
#define bx bxo
#define G Go
            PHASE_IDS();
            {   SUBT0();
                float* scr = ldsf + wave * 4096;
                constexpr int IT_G = 16 * 16, IT_D = 8 * 32;
                auto dec1 = [&](int it) -> TrItem {
                    const int e = it / (2 * IT_G + IT_D); int r = it % (2 * IT_G + IT_D);
                    if (r < IT_G) return TrItem{ARG_IN(I_MG) + ((size_t)l * 16 + e) * 1024 * 512, WGU + (size_t)e * 1024 * 1024, 1024, 512, r / 16, r % 16, 2};
                    if (r < 2 * IT_G) { r -= IT_G; return TrItem{ARG_IN(I_MU) + ((size_t)l * 16 + e) * 1024 * 512, WGU + (size_t)e * 1024 * 1024, 1024, 512, r / 16, r % 16, 3}; }
                    r -= 2 * IT_G; return TrItem{ARG_IN(I_MD) + ((size_t)l * 16 + e) * 512 * 1024, WD + (size_t)e * 1024 * 512, 512, 1024, r / 32, r % 32, 0};
                };
                constexpr int NIT1 = 16 * (2 * IT_G + IT_D);
                if (gw < NIT1) { TrItem cur = dec1(gw); TrRegs rv = tr_load(cur, lane);
                    for (int it = gw; it < NIT1; it += NGW) { TrItem nxt = cur; TrRegs rn = rv; const bool more = it + NGW < NIT1;
                        if (more) { nxt = dec1(it + NGW); rn = tr_load(nxt, lane); }
                        tr_finish(cur, rv, scr, lane); cur = nxt; rv = rn; } }
                SUBT1(4);
            }
            SUBT0();
            __syncthreads();
            for (int k = tid; k < 1024; k += 512) { const f32x4 wg = *(const f32x4*)(ARG_IN(I_RWG) + (size_t)l * 4096 + k * 4); const float* we = ARG_IN(I_RWE) + (size_t)l * 16384 + k * 16;
                const f32x4 e0 = *(const f32x4*)we, e1 = *(const f32x4*)(we + 4), e2 = *(const f32x4*)(we + 8), e3 = *(const f32x4*)(we + 12);
                ldsf[0 * 1024 + k] = wg.x; ldsf[1 * 1024 + k] = wg.y; ldsf[2 * 1024 + k] = wg.z; ldsf[3 * 1024 + k] = wg.w;
                ldsf[4 * 1024 + k] = e0.x; ldsf[5 * 1024 + k] = e0.y; ldsf[6 * 1024 + k] = e0.z; ldsf[7 * 1024 + k] = e0.w; ldsf[8 * 1024 + k] = e1.x; ldsf[9 * 1024 + k] = e1.y; ldsf[10 * 1024 + k] = e1.z; ldsf[11 * 1024 + k] = e1.w;
                ldsf[12 * 1024 + k] = e2.x; ldsf[13 * 1024 + k] = e2.y; ldsf[14 * 1024 + k] = e2.z; ldsf[15 * 1024 + k] = e2.w; ldsf[16 * 1024 + k] = e3.x; ldsf[17 * 1024 + k] = e3.y; ldsf[18 * 1024 + k] = e3.z; ldsf[19 * 1024 + k] = e3.w; }
            __syncthreads();
            const float* g2 = ARG_IN(I_N2G) + l * D; const float* bg = ARG_IN(I_RBG) + l * 4; const float* be = ARG_IN(I_RBE) + l * 16;
            unsigned* cnt = ctl + CW_CNT + 64 * l;
            LAS unsigned* hist = (LAS unsigned*)(ldsl + 81920); LAS unsigned* baseL = hist + 16; LAS unsigned* rinfo = hist + 32;
            for (int ck = bx; ck < T / 64; ck += G) {
              if (tid < 16) hist[tid] = 0u;
              __syncthreads();
              f32x4 vnx[2][4];
#pragma unroll
              for (int rr = 0; rr < 2; ++rr) { const float* hr0 = H + (size_t)(ck * 64 + wave * 8 + rr) * D;
#pragma unroll
                for (int jj = 0; jj < 4; ++jj) vnx[rr][jj] = *(const f32x4*)(hr0 + 4 * lane + 256 * jj); }
#pragma unroll 1
              for (int ri = 0; ri < 8; ri += 2) { const int rl = wave * 8 + ri; const int m = ck * 64 + rl;
                f32x4 v[2][4];
#pragma unroll
                for (int rr = 0; rr < 2; ++rr)
#pragma unroll
                    for (int jj = 0; jj < 4; ++jj) v[rr][jj] = vnx[rr][jj];
                if (ri + 2 < 8) {
#pragma unroll
                    for (int rr = 0; rr < 2; ++rr) { const float* hr1 = H + (size_t)(m + 2 + rr) * D;
#pragma unroll
                        for (int jj = 0; jj < 4; ++jj) vnx[rr][jj] = *(const f32x4*)(hr1 + 4 * lane + 256 * jj); } }
#pragma unroll
                for (int rr = 0; rr < 2; ++rr) { float ss = 0.f;
#pragma unroll
                    for (int jj = 0; jj < 4; ++jj) ss += (v[rr][jj].x * v[rr][jj].x + v[rr][jj].y * v[rr][jj].y) + (v[rr][jj].z * v[rr][jj].z + v[rr][jj].w * v[rr][jj].w);
                    const float rstd = rsqrtf(wave_sum(ss) * (1.f / D) + EPS);
#pragma unroll
                    for (int jj = 0; jj < 4; ++jj) { const f32x4 gg = *(const f32x4*)(g2 + 4 * lane + 256 * jj); v[rr][jj].x *= rstd * gg.x; v[rr][jj].y *= rstd * gg.y; v[rr][jj].z *= rstd * gg.z; v[rr][jj].w *= rstd * gg.w;
                        u32x2 o; o.x = pk2(v[rr][jj].x, v[rr][jj].y); o.y = pk2(v[rr][jj].z, v[rr][jj].w); GST(*(u32x2*)(XN + (size_t)(m + rr) * D + 4 * lane + 256 * jj) = o); } }
                float lg[2][20];
#pragma unroll
                for (int o = 0; o < 20; ++o) { float a0 = 0.f, a1 = 0.f;
#pragma unroll
                    for (int jj = 0; jj < 4; ++jj) { const f32x4 wv = *(const f32x4*)(ldsf + o * 1024 + 4 * lane + 256 * jj);
                        a0 += v[0][jj].x * wv.x + v[0][jj].y * wv.y + v[0][jj].z * wv.z + v[0][jj].w * wv.w; a1 += v[1][jj].x * wv.x + v[1][jj].y * wv.y + v[1][jj].z * wv.z + v[1][jj].w * wv.w; }
                    lg[0][o] = wave_sum(a0); lg[1][o] = wave_sum(a1); if ((o & 3) == 3) __builtin_amdgcn_sched_barrier(0); }
#pragma unroll
                for (int rr = 0; rr < 2; ++rr) {
                float gl[4]; int grp = 0; float gmx;
#pragma unroll
                for (int k = 0; k < 4; ++k) gl[k] = lg[rr][k] + bg[k];
                gmx = gl[0];
#pragma unroll
                for (int k = 1; k < 4; ++k) if (gl[k] > gmx) { gmx = gl[k]; grp = k; }
                float den = 0.f;
#pragma unroll
                for (int k = 0; k < 4; ++k) den += __expf(gl[k] - gmx);
                const float grpw = 1.f / den;
                float el[4];
#pragma unroll
                for (int k = 0; k < 4; ++k) { float vsel = 0.f;
#pragma unroll
                    for (int gg = 0; gg < 4; ++gg) vsel = (grp == gg) ? (lg[rr][4 + gg * 4 + k] + be[gg * 4 + k]) : vsel;
                    el[k] = vsel; }
                int i1 = 0; float m1 = el[0];
#pragma unroll
                for (int k = 1; k < 4; ++k) if (el[k] > m1) { m1 = el[k]; i1 = k; }
                int i2 = -1; float m2 = 0.f;
#pragma unroll
                for (int k = 0; k < 4; ++k) if (k != i1 && (i2 < 0 || el[k] > m2)) { m2 = el[k]; i2 = k; }
                const float ex = __expf(m2 - m1); const float w1 = grpw / (1.f + ex), w2 = grpw * ex / (1.f + ex);
                if (lane == 0) {
                    const int e1 = grp * 4 + i1, e2 = grp * 4 + i2; const int rq = rl + rr;
                    const unsigned p1 = atomicAdd((unsigned*)&hist[e1], 1u), p2 = atomicAdd((unsigned*)&hist[e2], 1u);
                    rinfo[rq * 4 + 0] = (unsigned)e1 | ((unsigned)e2 << 8); rinfo[rq * 4 + 1] = p1 | (p2 << 16); rinfo[rq * 4 + 2] = __builtin_bit_cast(unsigned, w1); rinfo[rq * 4 + 3] = __builtin_bit_cast(unsigned, w2);
                }
                }
              }
              __syncthreads();
              if (tid < 16) { const unsigned hc = hist[tid]; baseL[tid] = (hc && !is_dry()) ? atomicAdd(&cnt[tid], hc) : 0u; }
              __syncthreads();
              if (tid < 64 && !is_dry()) { const unsigned ee = rinfo[tid * 4 + 0], pp = rinfo[tid * 4 + 1]; const unsigned e1 = ee & 255u, e2 = ee >> 8; const unsigned m = (unsigned)(ck * 64 + tid);
                  const size_t q1 = (size_t)e1 * T + baseL[e1] + (pp & 0xffffu), q2 = (size_t)e2 * T + baseL[e2] + (pp >> 16);
                  LIST[q1] = m; LISTW[q1] = __builtin_bit_cast(float, rinfo[tid * 4 + 2]); LIST[q2] = m | (1u << 14); LISTW[q2] = __builtin_bit_cast(float, rinfo[tid * 4 + 3]); }
              __syncthreads();
            }
            SUBT1(5);
        }
        SEAM(pb + 5); TEND(5);
#undef bx
#undef G
        TBEG(6);
        if (IN(pb + 6) || IN(pb + 7)) {
            __syncthreads();
            if (threadIdx.x == 0) { LAS int* tw = (LAS int*)(ldsl + LDS_MOE); int acc = 0;
                for (int e = 0; e < 16; ++e) { const int c = (int)__hip_atomic_load(ctl + CW_CNT + 64 * l + e, __ATOMIC_RELAXED, __HIP_MEMORY_SCOPE_AGENT); tw[e] = acc; tw[32 + e] = c; acc += (c + 255) >> 8; }
                tw[16] = acc; }
            __syncthreads();
        }
        if (IN(pb + 6)) PHASE_REP(6) {
            const int bxo = OPQ_S(bx0), Go = OPQ_S(G0); (void)bxo; (void)Go;
#define bx bxo
#define G Go
            SchedMoe S{XN, WGU, LIST, D, D, 1024, G, bx, true, ctl + CW_E1 + l * 16384, ctl};
            EpiGateUp E{HID, LISTW};
            pg8::gemm_phase<EpiGateUp, SchedMoe, true>(ldsl, D, S, E);
        }
        if (MK_SPLIT) { SEAM(pb + 6); } TEND(6);
#undef bx
#undef G
        TBEG(7);
        if (IN(pb + 7)) PHASE_REP(7) {
            const int bxo = OPQ_S(bx0), Go = OPQ_S(G0); (void)bxo; (void)Go;
#define bx bxo
#define G Go
            SchedMoe S{HID, WD, LIST, 512, 512, 1024, G, bx, false, ctl + CW_E1 + l * 16384, ctl};
            EpiDown E{Y, LIST};
            pg8::gemm_phase<EpiDown, SchedMoe, true>(ldsl, 512, S, E);
        }
        SEAM(pb + 7); TEND(7);
#undef bx
#undef G
        TBEG(8);
        if (IN(pb + 8)) PHASE_REP(8) {
            const int bxo = OPQ_S(bx0), Go = OPQ_S(G0); (void)bxo; (void)Go;
#define bx bxo
#define G Go
            PHASE_IDS();
            if (l + 1 < NL) { for (int m = gw; m < T; m += 2 * NGW) norm_rows<1>(nullptr, H, Y, Y + (size_t)T * D, ARG_IN(I_N1G) + (l + 1) * D, XN, m, m + NGW, m + NGW < T, lane); }
            else { for (int m = gw; m < T; m += 2 * NGW) norm_rows<2>(nullptr, H, Y, Y + (size_t)T * D, ARG_IN(I_FNG), nullptr, m, m + NGW, m + NGW < T, lane); }
        }
        if (l + 1 < NL) SEAM(pb + 8);
        TEND(8);
    }
#undef bx
#undef G
#ifdef PROBE_FINE
    tacc_ += *(volatile LAS unsigned long long*)(ldsl + LDS_CTL + 128);
#endif
    if (PROBE_T_LO >= 0 && bx == PROBE_BLK) { const unsigned long long tgt = __builtin_amdgcn_s_memrealtime() + PROBE_T_MULT * tacc_; while (__builtin_amdgcn_s_memrealtime() < tgt) __builtin_amdgcn_s_sleep(16); }
#undef IN
#undef SEAM
#undef ws
#undef ctl
#undef H
#undef XN
#undef P1
#undef Rr
#undef WIN
#undef WB
#undef WOUT
#undef WGU
#undef WD
#undef HID
#undef Y
#undef KC
#undef AGA
#undef AGH
#undef LIST
#undef LISTW
}

extern "C" void kernel_launch(void* const* d_in, const int* in_sizes, int n_in, void* d_out, int out_size, void* d_ws, size_t ws_size, hipStream_t stream) {
    static int grid = 0;
    if (grid == 0) {
        if (n_in != 29 || in_sizes[0] != T * D || out_size != T * D || ws_size < WS_END) { fprintf(stderr, "kernel_launch: unexpected shapes / workspace (%d inputs, ws %zu < %zu); nothing launched\n", n_in, ws_size, (size_t)WS_END); grid = -1; return; }
        int dev = 0, cus = 0;
        if (hipGetDevice(&dev) != hipSuccess || hipDeviceGetAttribute(&cus, hipDeviceAttributeMultiprocessorCount, dev) != hipSuccess) { grid = -1; return; }
        if (hipFuncSetAttribute((const void*)fwd_kernel, hipFuncAttributeMaxDynamicSharedMemorySize, LDS_BYTES) != hipSuccess) { fprintf(stderr, "kernel_launch: hipFuncSetAttribute failed\n"); grid = -1; return; }
        int per_cu = 0;
        if (hipOccupancyMaxActiveBlocksPerMultiprocessor(&per_cu, (const void*)fwd_kernel, 512, LDS_BYTES) != hipSuccess || per_cu < 1) { fprintf(stderr, "kernel_launch: occupancy query says %d\n", per_cu); }
        (void)hipGetLastError();
        grid = cus;
    }
    if (grid < 0) return;
    if (hipMemsetAsync((char*)d_ws + WS_CTL, 0, CTL_ZERO_BYTES, stream) != hipSuccess) return;
    Args a{};
    for (int i = 0; i < 29; ++i) a.in[i] = (const float*)d_in[i];
    a.out = (float*)d_out; a.ws = (unsigned char*)d_ws;
#if MK_SPLIT
    for (int p = 0; p < NPH; ++p) { a.ph_lo = p; a.ph_hi = p + 1; hipLaunchKernelGGL(fwd_kernel, dim3(grid), dim3(512), LDS_BYTES, stream, a); }
#else
    a.ph_lo = 0; a.ph_hi = NPH;
    hipLaunchKernelGGL(fwd_kernel, dim3(grid), dim3(512), LDS_BYTES, stream, a);
#endif
}
```

```cpp
#include <hip/hip_runtime.h>
#include <cstdio>
#include <cstdint>

#define GAS __attribute__((address_space(1)))
#define LAS __attribute__((address_space(3)))
typedef unsigned short bf16;
typedef unsigned u32x4 __attribute__((ext_vector_type(4)));
typedef unsigned u32x2 __attribute__((ext_vector_type(2)));
typedef float f32x4 __attribute__((ext_vector_type(4)));
typedef float f32x2 __attribute__((ext_vector_type(2)));
typedef short bf16x8 __attribute__((ext_vector_type(8)));
typedef unsigned long long u64;

#ifndef MK_SPLIT
#define MK_SPLIT 0
#endif

constexpr int NB = 4, SEQ = 4096, T = NB * SEQ, D = 1024, MIX = 512, NL = 2;
constexpr int NIN = 7960, NPROJ = 8192, P1W = 3904;
constexpr int C_U = 0, C_V = 512, C_GB = 1024, C_RB = 1536, C_Q = 2048, C_KV = 2560, C_XD = 3328, C_GC = 3840;
constexpr int SRC_GC = 3328, SRC_XD = 3352, SRC_MG = 3864;
constexpr float EPS = 1e-6f;
constexpr int NEXP = 16, DEXP = 512;
constexpr int HID_ROWS = 2 * T + 4096;

constexpr size_t MiB = 1u << 20;
constexpr size_t WS_CTL = 0, CTL_ZERO_BYTES = 1 * MiB;
constexpr size_t WS_KC = 1 * MiB;
constexpr size_t WS_LRUA = 2 * MiB;
constexpr size_t WS_LRUH = 2 * MiB + 512 * 1024;
constexpr size_t WS_LIST = 3 * MiB;
constexpr size_t WS_LISTW = 4 * MiB;
constexpr size_t WS_W1T = 5 * MiB;
constexpr size_t WS_LWT = 7 * MiB;
constexpr size_t WS_PWT = 7 * MiB + 256 * 1024;
constexpr size_t WS_WIN = 8 * MiB;
constexpr size_t WS_WB = 40 * MiB;
constexpr size_t WS_WOUT = 48 * MiB;
constexpr size_t WS_XN = 52 * MiB;
constexpr size_t WS_P1 = 84 * MiB;
constexpr size_t WS_R = 206 * MiB;
constexpr size_t WS_WGU = 84 * MiB;
constexpr size_t WS_WD = 116 * MiB;
constexpr size_t WS_HID = 132 * MiB;
constexpr size_t WS_Y = 168 * MiB;
constexpr size_t WS_END = 334 * MiB;
static_assert(WS_HID + (size_t)HID_ROWS * 512 * 2 <= WS_Y && WS_Y + (size_t)2 * T * 1024 * 2 <= WS_END && WS_P1 + (size_t)T * P1W * 2 <= WS_R && WS_R + (size_t)4 * T * 1024 * 2 <= WS_END, "ws map");

constexpr int CW_BAR = 4096;
constexpr int CW_CNT = 8192;
constexpr int CW_E1 = 16384;
constexpr int CW_G2 = 49152;
constexpr int CW_Q = 8448;

__device__ __forceinline__ unsigned f2bf(float f) { unsigned u = __builtin_bit_cast(unsigned, f); return (u + 0x7fffu + ((u >> 16) & 1u)) >> 16; }
typedef __bf16 bf16x2_hw __attribute__((ext_vector_type(2)));
__device__ __forceinline__ unsigned pk2(float lo, float hi) { f32x2 v = {lo, hi}; bf16x2_hw b = __builtin_convertvector(v, bf16x2_hw); return __builtin_bit_cast(unsigned, b); }
__device__ __forceinline__ float bflo(unsigned u) { return __builtin_bit_cast(float, u << 16); }
__device__ __forceinline__ float bfhi(unsigned u) { return __builtin_bit_cast(float, u & 0xffff0000u); }
__device__ __forceinline__ float bf2f(bf16 h) { return __builtin_bit_cast(float, (unsigned)h << 16); }
__device__ __forceinline__ float sigmoidf_(float x) { return __builtin_amdgcn_rcpf(1.0f + __builtin_amdgcn_exp2f(-1.4426950408889634f * x)); }
__device__ __forceinline__ float gelu_tanh(float x) { const float z = 1.5957691216057308f * (x + 0.044715f * x * x * x); return x * sigmoidf_(z); }
__device__ __forceinline__ float dpp_add_(float v, const int ctrl, const int row_mask) {
    return v;
}
#define DPP_ADD(v, ctrl, rmask) ((v) + __builtin_bit_cast(float, __builtin_amdgcn_update_dpp(0, __builtin_bit_cast(int, (v)), (ctrl), (rmask), 0xf, false)))
__device__ __forceinline__ float wave_sum(float v) {
    v = DPP_ADD(v, 0xB1, 0xf);
    v = DPP_ADD(v, 0x4E, 0xf);
    v = DPP_ADD(v, 0x141, 0xf);
    v = DPP_ADD(v, 0x140, 0xf);
    v = DPP_ADD(v, 0x142, 0xa);
    v = DPP_ADD(v, 0x143, 0xc);
    return __builtin_bit_cast(float, __builtin_amdgcn_readlane(__builtin_bit_cast(int, v), 63));
}
__device__ __forceinline__ u64 mask_lo(int n) { return n >= 64 ? ~0ull : (n <= 0 ? 0ull : ((1ull << n) - 1ull)); }
#define LDS_WAIT() asm volatile("s_waitcnt lgkmcnt(0)" ::: "memory")
#ifndef PROBE_PH
#define PROBE_PH -1
#endif
#ifndef PROBE_T_LO
#define PROBE_T_LO -1
#define PROBE_T_HI -1
#endif
#define PROBE_T_MULT 4
#ifndef ABL
#define ABL 0
#endif
#define ABL_ON(bit) ((ABL & (bit)) && is_dry())
#ifndef PROBE_BLK
#define PROBE_BLK 0
#endif
#ifdef PROBE_SUB
#define SUBT0() const unsigned long long ts0_ = __builtin_amdgcn_s_memrealtime()
#define SUBT1(ty) do { __syncthreads(); if ((ty) == PROBE_SUB) tacc_ += __builtin_amdgcn_s_memrealtime() - ts0_; } while (0)
#else
#define SUBT0() do {} while (0)
#define SUBT1(ty) do {} while (0)
#endif

constexpr int LDS_BYTES = 147456;
constexpr int LDS_CTL = 146432;
constexpr int LDS_MOE = LDS_CTL + 256;
__device__ __forceinline__ bool is_dry() {
#if PROBE_PH >= 0
    extern __shared__ __attribute__((aligned(16))) unsigned char lds_raw_[]; return ((volatile LAS int*)((LAS unsigned char*)lds_raw_ + LDS_CTL + 64))[0] != 0;
#else
    return false;
#endif
}
#define GST(...) do { if (!is_dry()) { __VA_ARGS__; } } while (0)
#ifdef PROBE_FINE
#define FT0(id) unsigned long long ft0_##id = ((id) == PROBE_FINE) ? __builtin_amdgcn_s_memrealtime() : 0ull
#define FT1(id) do { if ((id) == PROBE_FINE && threadIdx.x == 0) { extern __shared__ __attribute__((aligned(16))) unsigned char lds_raw_f[]; volatile LAS unsigned long long* a_ = (volatile LAS unsigned long long*)((LAS unsigned char*)lds_raw_f + LDS_CTL + 128); *a_ = *a_ + (__builtin_amdgcn_s_memrealtime() - ft0_##id); } } while (0)
#else
#define FT0(id) do {} while (0)
#define FT1(id) do {} while (0)
#endif
__device__ __forceinline__ int opaque_tid() { int t = (int)threadIdx.x; asm volatile("" : "+v"(t)); return t; }

namespace pg8 {
constexpr int BM = 256, BK = 64, HALF = 128, HTB = HALF * BK * 2, NXCD = 8, WGM = 8;
__host__ __device__ __forceinline__ int lds_byte(int r, int c) { const int st = (r >> 4) * 2 + (c >> 5), rr = r & 15, cc = c & 31, ob = rr * 64 + cc * 2; return st * 1024 + (ob ^ (((ob >> 9) & 1) << 5)); }
__host__ __device__ __forceinline__ void stage_rc(int b, int& R, int& C) { const int st = b / 1024, sb = b % 1024, swz = sb ^ (((sb >> 9) & 1) << 5); R = (st >> 1) * 16 + swz / 64; C = (st & 1) * 32 + (swz % 64) / 2; }
__host__ __device__ __forceinline__ int perm32(int rho) { const int n = rho >> 4, i = rho & 15; return 8 * (i >> 2) + 4 * n + (i & 3); }

struct Unit { const char* A; const char* B; int pm, pn, sub, e; };

__device__ __forceinline__ bool static_tile(int i, int G, int c, int nM, int nN, int& pm, int& pn) {
    const int nwg = nM * nN; const long L = (long)i * G + c; if (L >= nwg) return false;
    int wgid = (int)L; { const int q = nwg / NXCD, r = nwg % NXCD, xcd = wgid % NXCD, off = wgid / NXCD; wgid = (xcd < r ? xcd * (q + 1) : r * (q + 1) + (xcd - r) * q) + off; }
    const int nig = WGM * nN, gid = wgid / nig, fm = gid * WGM, gsz = (nM - fm) < WGM ? (nM - fm) : WGM;
    pm = fm + ((wgid % nig) % gsz); pn = (wgid % nig) / gsz; return true;
}

template <class Epi, class Sched, bool ALIGN_EPI>
__device__ __forceinline__ void gemm_phase(LAS unsigned char* lds, const int K, const Sched& S, const Epi& E) {
    const int tid = opaque_tid(), wid = __builtin_amdgcn_readfirstlane(tid >> 6), lane = tid & 63, wr = wid >> 2, wc = wid & 3, fr = lane & 15, fq = lane >> 4;
    const int nt = K / BK;
    unsigned voffB[2];
#pragma unroll
    for (int i = 0; i < 2; ++i) { int R, C; stage_rc(tid * 16 + i * 8192, R, C); const int Rb = (R & ~31) + perm32(R & 31); voffB[i] = (unsigned)(Rb * K + C) * 2u; }
    const size_t kstep = (size_t)(BK * 2);
    const size_t hstepB = (size_t)HALF * K * 2;
    const unsigned ldsw = (unsigned)wid * 1024u;
    const int aoff = lds_byte(wr * 64 + fr, fq * 8), boff = lds_byte(wc * 32 + fr, fq * 8);
#define PG8_SA(b, h) (((b) * 2 + (h)) * HTB)
#define PG8_SB(b, h) ((4 + (b) * 2 + (h)) * HTB)
#define PG8_STAGE(bufoff, gbase, voff) do { _Pragma("unroll") for (int _i = 0; _i < 2; ++_i) \
        __builtin_amdgcn_global_load_lds((const unsigned*)((const char*)(gbase) + (voff)[_i]), (LAS unsigned*)(lds + (bufoff) + ldsw + _i * 8192), 16, 0, 0); } while (0)
#define PG8_LDA(dst, b, h) do { _Pragma("unroll") for (int m = 0; m < 4; ++m) _Pragma("unroll") for (int k = 0; k < 2; ++k) dst[m][k] = *(const LAS bf16x8*)(lds + PG8_SA(b, h) + aoff + m * 2048 + k * 1024); } while (0)
#define PG8_LDB(dst, b, h) do { _Pragma("unroll") for (int n = 0; n < 2; ++n) _Pragma("unroll") for (int k = 0; k < 2; ++k) dst[n][k] = *(const LAS bf16x8*)(lds + PG8_SB(b, h) + boff + n * 2048 + k * 1024); } while (0)
#define PG8_MMA(ai, bj, At, Bt) do { __builtin_amdgcn_s_setprio(1); _Pragma("unroll") for (int m = 0; m < 4; ++m) _Pragma("unroll") for (int n = 0; n < 2; ++n) _Pragma("unroll") for (int k = 0; k < 2; ++k) \
        acc[ai][bj][m][n] = __builtin_amdgcn_mfma_f32_16x16x32_bf16(Bt[n][k], At[m][k], acc[ai][bj][m][n], 0, 0, 0); __builtin_amdgcn_s_setprio(0); } while (0)
#define PG8_WAIT_V(n) asm volatile("s_waitcnt vmcnt(" #n ")" ::: "memory")
#define PG8_WAIT_L(n) asm volatile("s_waitcnt lgkmcnt(" #n ")" ::: "memory")
#define PG8_BAR __builtin_amdgcn_s_barrier()
#define PG8_SCHED __builtin_amdgcn_sched_barrier(0)
#define PG8_ZERO() do { _Pragma("unroll") for (int a = 0; a < 2; ++a) _Pragma("unroll") for (int b = 0; b < 2; ++b) _Pragma("unroll") for (int m = 0; m < 4; ++m) _Pragma("unroll") for (int n = 0; n < 2; ++n) acc[a][b][m][n] = (f32x4){0.f, 0.f, 0.f, 0.f}; } while (0)
    Unit cur, nxt; int ui = 0;
    if (!S.next(0, cur)) return;
    f32x4 acc[2][2][4][2];
    PG8_ZERO();
    bf16x8 At[4][2], B0[2][2], B1[2][2];
    unsigned voA[2][2], voN[2][2];
    S.a_off(cur, voA);
    const char* cA = cur.A; const char* cB = cur.B;
    S.a_ready(cur);
    PG8_STAGE(PG8_SB(0, 0), cB, voffB); PG8_STAGE(PG8_SB(0, 1), cB + hstepB, voffB); PG8_STAGE(PG8_SA(0, 0), cA, voA[0]); PG8_STAGE(PG8_SA(0, 1), cA, voA[1]);
    if (wr == 1) PG8_BAR;
    PG8_WAIT_V(2); PG8_BAR;
    PG8_STAGE(PG8_SB(1, 0), cB + kstep, voffB); PG8_STAGE(PG8_SA(1, 0), cA + kstep, voA[0]); PG8_STAGE(PG8_SB(1, 1), cB + hstepB + kstep, voffB);
    PG8_WAIT_V(6); PG8_BAR;
    for (;;) {
        const bool has_next = S.next(ui + 1, nxt);
        if (has_next) S.a_ready(nxt);
        const char* nA = has_next ? nxt.A : cA; const char* nB = has_next ? nxt.B : cB;
        if (has_next) S.a_off(nxt, voN); else { voN[0][0] = voA[0][0]; voN[0][1] = voA[0][1]; voN[1][0] = voA[1][0]; voN[1][1] = voA[1][1]; }
        for (int t = 0; t < nt; t += 2) {
            const bool last = (t == nt - 2);
            const char* a1 = cA + (size_t)(t + 1) * kstep;
            const char* a2 = last ? nA : cA + (size_t)(t + 2) * kstep; const char* b2 = last ? nB : cB + (size_t)(t + 2) * kstep;
            const char* a3 = a2 + kstep; const char* b3 = b2 + kstep;
            PG8_LDB(B0, 0, 0); PG8_LDB(B1, 0, 1); PG8_SCHED; PG8_LDA(At, 0, 0); PG8_STAGE(PG8_SA(1, 1), a1, voA[1]);
            PG8_WAIT_V(8); PG8_WAIT_L(0); PG8_BAR; PG8_MMA(0, 0, At, B0); PG8_MMA(0, 1, At, B1); PG8_BAR; PG8_SCHED;
            if (last) { voA[0][0] = voN[0][0]; voA[0][1] = voN[0][1]; voA[1][0] = voN[1][0]; voA[1][1] = voN[1][1]; }
            PG8_LDA(At, 0, 1); PG8_STAGE(PG8_SB(0, 0), b2, voffB); PG8_STAGE(PG8_SB(0, 1), b2 + hstepB, voffB); PG8_STAGE(PG8_SA(0, 0), a2, voA[0]);
            PG8_WAIT_V(8); PG8_WAIT_L(0); PG8_BAR; PG8_MMA(1, 0, At, B0); PG8_MMA(1, 1, At, B1); PG8_BAR; PG8_SCHED;
            PG8_LDB(B0, 1, 0); PG8_LDB(B1, 1, 1); PG8_SCHED; PG8_LDA(At, 1, 0); PG8_STAGE(PG8_SA(0, 1), a2, voA[1]);
            PG8_WAIT_V(8); PG8_WAIT_L(0); PG8_BAR; PG8_MMA(0, 0, At, B0); PG8_MMA(0, 1, At, B1); PG8_BAR; PG8_SCHED;
            PG8_LDA(At, 1, 1); PG8_STAGE(PG8_SB(1, 0), b3, voffB); PG8_STAGE(PG8_SB(1, 1), b3 + hstepB, voffB); PG8_STAGE(PG8_SA(1, 0), a3, voA[0]);
            PG8_WAIT_V(8); PG8_WAIT_L(0); PG8_BAR; PG8_MMA(1, 0, At, B0); PG8_MMA(1, 1, At, B1); PG8_BAR; PG8_SCHED;
        }
        if constexpr (ALIGN_EPI) { if (wr == 0) PG8_BAR; }
        int tz = lane; asm volatile("" : "+v"(tz));
        const bool z = E(acc, cur, wr, wc, tz & 15, tz >> 4);
        S.done(cur);
        if (!has_next) break;
        if (z) PG8_ZERO();
        cur = nxt; cA = nA; cB = nB; ++ui;
        if constexpr (ALIGN_EPI) { if (wr == 1) PG8_BAR; }
    }
    PG8_WAIT_V(0);
    if constexpr (!ALIGN_EPI) { if (wr == 0) PG8_BAR; }
    PG8_BAR;
#undef PG8_SA
#undef PG8_SB
#undef PG8_STAGE
#undef PG8_LDA
#undef PG8_LDB
#undef PG8_MMA
#undef PG8_WAIT_V
#undef PG8_WAIT_L
#undef PG8_BAR
#undef PG8_SCHED
#undef PG8_ZERO
}
}

#define XB_TMO      128
#define XB_XCNT(j)  (256  + 64 * (j))
#define XB_XSUB(j)  (1280 + 64 * (j))
#define XB_XGEN(j)  (2304 + 64 * (j))
#define XB_TOP      3328
#define XB_TOPGEN   3392
#define XCD_BAR_WORDS 3456
#define XB_SPIN_CAP (1u << 23)
__device__ __forceinline__ unsigned xb_ld(unsigned* p)              { return __hip_atomic_load(p, __ATOMIC_RELAXED, __HIP_MEMORY_SCOPE_AGENT); }
__device__ __forceinline__ unsigned xb_add(unsigned* p, unsigned v) { return __hip_atomic_fetch_add(p, v, __ATOMIC_RELAXED, __HIP_MEMORY_SCOPE_AGENT); }
__device__ __forceinline__ unsigned xb_xcc_id() { return (unsigned)__builtin_amdgcn_s_getreg((3 << 11) | 20) & 0xFu; }
#define XB_SPIN(cond, bar) do { unsigned _sp = 0; while (cond) { __builtin_amdgcn_s_sleep(1); \
    if ((++_sp & 255u) == 0u) { if (xb_ld(&(bar)[XB_TMO])) break; if (_sp > XB_SPIN_CAP) { atomicAdd(&(bar)[XB_TMO], 1u); break; } } } } while (0)
struct XcdBarrier { unsigned* bar; unsigned x; volatile LAS unsigned* st; };
__device__ __forceinline__ XcdBarrier xcd_barrier_post(unsigned* bar, volatile LAS unsigned* st) {
    XcdBarrier b; b.bar = bar; b.x = xb_xcc_id(); b.st = st;
    if (threadIdx.x == 0) (void)xb_add(&bar[XB_XCNT(b.x)], 1u);
    return b;
}
__device__ __forceinline__ void xcd_barrier_complete(unsigned* bar, unsigned x, unsigned& nloc, unsigned& nx) {
    const unsigned G = gridDim.x * gridDim.y * gridDim.z;
    unsigned sum, cnt, mine, sp = 0u;
    for (;;) {
        sum = 0u; cnt = 0u; mine = 0u;
#pragma unroll
        for (unsigned j = 0; j < 16; ++j) { const unsigned c = xb_ld(&bar[XB_XCNT(j)]); sum += c; cnt += (c > 0u) ? 1u : 0u; mine = (j == x) ? c : mine; }
        if (sum == G) break;
        __builtin_amdgcn_s_sleep(1);
        if ((++sp & 255u) == 0u) { if (xb_ld(&bar[XB_TMO])) break; if (sp > XB_SPIN_CAP) { atomicAdd(&bar[XB_TMO], 1u); break; } }
    }
    nloc = mine > 0u ? mine : 1u; nx = cnt > 0u ? cnt : 1u;
}
__device__ __forceinline__ void xcd_barrier(const XcdBarrier& b) {
    asm volatile("s_waitcnt vmcnt(0)" ::: "memory");
    __syncthreads();
    if (threadIdx.x == 0) {
        unsigned* bar = b.bar;
        __builtin_amdgcn_s_waitcnt(0);
        unsigned nloc = b.st[0], nx = b.st[1];
        if (nloc == 0u) { xcd_barrier_complete(bar, b.x, nloc, nx); b.st[0] = nloc; b.st[1] = nx; }
        const unsigned old = xb_add(&bar[XB_XSUB(b.x)], 1u);
        const unsigned gen = old / nloc;
        if (old + 1u == (gen + 1u) * nloc) {
            __builtin_amdgcn_fence(__ATOMIC_RELEASE, "agent");
            asm volatile("s_waitcnt vmcnt(0)" ::: "memory");
            const unsigned og = xb_add(&bar[XB_TOP], 1u);
            const unsigned tg = og / nx;
            if (og + 1u == (tg + 1u) * nx) xb_add(&bar[XB_TOPGEN], 1u);
            else XB_SPIN(xb_ld(&bar[XB_TOPGEN]) == tg, bar);
            __builtin_amdgcn_fence(__ATOMIC_ACQUIRE, "agent");
            xb_add(&bar[XB_XGEN(b.x)], 1u);
            asm volatile("s_waitcnt vmcnt(0)" ::: "memory");
        } else {
            XB_SPIN(xb_ld(&bar[XB_XGEN(b.x)]) == gen, bar);
            __builtin_amdgcn_fence(__ATOMIC_ACQUIRE, "agent");
            asm volatile("s_waitcnt vmcnt(0)" ::: "memory");
        }
    }
    __syncthreads();
}

struct Args { const float* in[29]; float* out; unsigned char* ws; int ph_lo, ph_hi; };
enum { I_X = 0, I_N1G, I_WIN, I_GMNG, I_GMWS, I_GMB, I_CONVW, I_CONVB, I_LWA, I_LBA, I_LWX, I_LBX, I_LLAM, I_PE, I_CW1, I_CW2, I_PW, I_PS, I_WBR, I_WOUT, I_N2G, I_RWG, I_RBG, I_RWE, I_RBE, I_MG, I_MU, I_MD, I_FNG };

#define CAS __attribute__((address_space(4)))
__device__ __forceinline__ unsigned long long karg_u64(int off) { const CAS char* kp = (const CAS char*)__builtin_amdgcn_kernarg_segment_ptr(); asm volatile("" : "+s"(kp)); return *(const CAS unsigned long long*)(kp + off); }
#define ARG_IN(k) ((const float*)(const GAS float*)karg_u64(8 * (k)))
#define ARG_OUT() ((float*)(GAS float*)karg_u64(8 * 29))
#define ARG_WS() ((unsigned char*)(GAS unsigned char*)karg_u64(8 * 30))
__device__ __forceinline__ int win_dst_row(int s) {
    if (s < SRC_GC) return s;
    if (s < SRC_XD) return C_GC + (s - SRC_GC);
    if (s < SRC_MG) return C_XD + (s - SRC_XD);
    const int n = (s - SRC_MG) >> 10, d = (s - SRC_MG) & 1023;
    return 4096 + 256 * (d >> 6) + 128 * (n >> 1) + 32 * ((d >> 4) & 3) + 8 * ((d >> 2) & 3) + 4 * (n & 1) + (d & 3);
}
struct TrItem { const float* W; bf16* WT; int K, N, kb, nb, kind; };
struct TrRegs { f32x4 v[8]; };
__device__ __forceinline__ int tr_dst(int kind, int n) { return kind == 0 ? n : kind == 1 ? win_dst_row(n) : kind == 2 ? 256 * (n >> 7) + (n & 127) : 256 * (n >> 7) + 128 + (n & 127); }
__device__ __forceinline__ TrRegs tr_load(const TrItem& it, int lane) {
    TrRegs r; const int k0 = 64 * it.kb, n4 = 32 * it.nb + (lane & 7) * 4;
#pragma unroll
    for (int i = 0; i < 8; ++i) { const int kk = 8 * i + (lane >> 3); r.v[i] = *(const f32x4*)(it.W + (size_t)(k0 + kk) * it.N + (n4 < it.N ? n4 : 0)); }
    return r;
}
__device__ __forceinline__ void tr_finish(const TrItem& it, const TrRegs& r, float* scr, int lane) {
    const int k0 = 64 * it.kb, n0 = 32 * it.nb;
#pragma unroll
    for (int i = 0; i < 8; ++i) { const int kk = 8 * i + (lane >> 3); float* d = scr + kk * 33 + (lane & 7) * 4; d[0] = r.v[i].x; d[1] = r.v[i].y; d[2] = r.v[i].z; d[3] = r.v[i].w; }
    LDS_WAIT(); asm volatile("" ::: "memory");
    const int c = lane & 7;
#pragma unroll
    for (int j = 0; j < 4; ++j) { const int nl = (lane >> 3) + 8 * j; const int n = n0 + nl; const float* sp = scr + (8 * c) * 33 + nl;
        u32x4 o; o.x = pk2(sp[0 * 33], sp[1 * 33]); o.y = pk2(sp[2 * 33], sp[3 * 33]); o.z = pk2(sp[4 * 33], sp[5 * 33]); o.w = pk2(sp[6 * 33], sp[7 * 33]);
        if (n < it.N) GST(*(u32x4*)(it.WT + (size_t)tr_dst(it.kind, n) * it.K + k0 + 8 * c) = o); }
    LDS_WAIT(); asm volatile("" ::: "memory");
}
template <int MODE>
__device__ __forceinline__ void norm_rows(const float* xbase, float* hbase, const bf16* y0b, const bf16* y1b, const float* g, bf16* xnb, int m0, int m1, bool two, int lane) {
    f32x4 v[2][4]; u32x2 ya[2][4], yb[2][4];
#pragma unroll
    for (int r = 0; r < 2; ++r) { const size_t m = (size_t)(r ? m1 : m0); if (r == 0 || two) {
#pragma unroll
        for (int j = 0; j < 4; ++j) { const int c = 4 * lane + 256 * j; v[r][j] = *(const f32x4*)((MODE == 0 ? xbase : hbase) + m * D + c);
            if (MODE != 0) { ya[r][j] = *(const u32x2*)(y0b + m * D + c); yb[r][j] = *(const u32x2*)(y1b + m * D + c); } } } }
#pragma unroll
    for (int r = 0; r < 2; ++r) { if (r == 1 && !two) break; const size_t m = (size_t)(r ? m1 : m0); float ss = 0.f;
#pragma unroll
        for (int j = 0; j < 4; ++j) {
            if (MODE != 0) { const u32x2 a = ya[r][j], b = yb[r][j];
                v[r][j].x += bflo(a.x) + bflo(b.x); v[r][j].y += bfhi(a.x) + bfhi(b.x); v[r][j].z += bflo(a.y) + bflo(b.y); v[r][j].w += bfhi(a.y) + bfhi(b.y); }
            ss += (v[r][j].x * v[r][j].x + v[r][j].y * v[r][j].y) + (v[r][j].z * v[r][j].z + v[r][j].w * v[r][j].w); }
        const float rstd = rsqrtf(wave_sum(ss) * (1.f / D) + EPS);
#pragma unroll
        for (int j = 0; j < 4; ++j) { const int c = 4 * lane + 256 * j; const f32x4 gg = *(const f32x4*)(g + c); const f32x4 x = v[r][j];
            if (MODE == 2) { GST(*(f32x4*)(hbase + m * D + c) = (f32x4){x.x * rstd * gg.x, x.y * rstd * gg.y, x.z * rstd * gg.z, x.w * rstd * gg.w}); }
            else { if (MODE != 0) GST(*(f32x4*)(hbase + m * D + c) = x);
                u32x2 o; o.x = pk2(x.x * rstd * gg.x, x.y * rstd * gg.y); o.y = pk2(x.z * rstd * gg.z, x.w * rstd * gg.w); GST(*(u32x2*)(xnb + m * D + c) = o); } } }
}

constexpr int IT_WIN_ = 16 * 249, IT_WB_ = 8 * 32, IT_WO_ = 16 * 32, IT_BIG = IT_WIN_ + 4 * IT_WB_ + IT_WO_;
__device__ __forceinline__ TrItem dec_big(int it, int l) {
    unsigned char* wsb = ARG_WS(); int r = it;
    if (r < IT_WIN_) return TrItem{ARG_IN(I_WIN) + (size_t)l * D * NIN, (bf16*)(wsb + WS_WIN) + (size_t)l * NPROJ * D, D, NIN, r / 249, r % 249, 1};
    r -= IT_WIN_;
    if (r < 4 * IT_WB_) { const int n = r / IT_WB_; r -= n * IT_WB_; const int ln = l * 4 + n; return TrItem{ARG_IN(I_WBR) + (size_t)ln * 512 * 1024, (bf16*)(wsb + WS_WB) + (size_t)ln * 1024 * 512, 512, 1024, r / 32, r % 32, 0}; }
    r -= 4 * IT_WB_;
    return TrItem{ARG_IN(I_WOUT) + (size_t)l * 1024 * 1024, (bf16*)(wsb + WS_WOUT) + (size_t)l * 1024 * 1024, 1024, 1024, r / 32, r % 32, 0};
}
__device__ __forceinline__ void conv_unit(float* ldsf, int cu) {
    const int tid = opaque_tid(); const int wv = __builtin_amdgcn_readfirstlane(tid >> 6), lane = tid & 63; const int it = cu * 8 + wv;
    __syncthreads();
    if (it < IT_BIG) { const TrItem ti = dec_big(it, 1); const TrRegs rr = tr_load(ti, lane); tr_finish(ti, rr, ldsf + wv * 4096, lane); }
}
__device__ __forceinline__ void wait_counter(unsigned* cp, unsigned need, unsigned* tmo) {
    if (__builtin_amdgcn_readfirstlane((int)threadIdx.x) < 64) {
        unsigned polls = 0u;
        while ((unsigned)__builtin_amdgcn_readfirstlane(__hip_atomic_load(cp, __ATOMIC_RELAXED, __HIP_MEMORY_SCOPE_AGENT)) < need) {
            if (++polls > (1u << 22)) { __hip_atomic_store(tmo, 1u, __ATOMIC_RELAXED, __HIP_MEMORY_SCOPE_AGENT); break; }
            __builtin_amdgcn_s_sleep(2); }
        __builtin_amdgcn_fence(__ATOMIC_ACQUIRE, "agent");
        asm volatile("s_waitcnt vmcnt(0)" ::: "memory");
    }
    asm volatile("" ::: "memory"); __builtin_amdgcn_s_barrier(); asm volatile("" ::: "memory");
}
struct SchedDense {
    const bf16* A; const bf16* Bt; int lda, K, nM, nN, G, c; unsigned* cnt; unsigned need; unsigned* tmo;
    __device__ __forceinline__ void a_ready(const pg8::Unit& u) const { if (cnt) wait_counter(cnt + 64 * u.pm, need, tmo); }
    __device__ __forceinline__ void done(const pg8::Unit&) const {}
    __device__ __forceinline__ bool next(int i, pg8::Unit& u) const {
        int pm, pn; if (!pg8::static_tile(i, G, c, nM, nN, pm, pn)) return false;
        u.pm = pm; u.pn = pn; u.sub = 0; u.e = 0; u.A = (const char*)(A + (size_t)pm * 256 * lda); u.B = (const char*)(Bt + (size_t)pn * 256 * K); return true;
    }
    __device__ __forceinline__ void a_off(const pg8::Unit&, unsigned (&vo)[2][2]) const {
        const int tz = opaque_tid();
#pragma unroll
        for (int i = 0; i < 2; ++i) { int R, C; pg8::stage_rc(tz * 16 + i * 8192, R, C);
#pragma unroll
            for (int h = 0; h < 2; ++h) vo[h][i] = (unsigned)((h * 128 + R) * lda + C) * 2u; }
    }
};
struct SchedMerge {
    const bf16* P1; const bf16* Wb; int G, c; unsigned* cnt;
    __device__ __forceinline__ void a_ready(const pg8::Unit&) const {}
    __device__ __forceinline__ void done(const pg8::Unit& u) const {
        if (u.sub != 3) return;
        asm volatile("s_waitcnt vmcnt(0)" ::: "memory");
        if ((threadIdx.x & 63) == 0 && !is_dry()) (void)__hip_atomic_fetch_add(cnt + 64 * u.pm, 1u, __ATOMIC_RELAXED, __HIP_MEMORY_SCOPE_AGENT);
    }
    __device__ __forceinline__ bool next(int i, pg8::Unit& u) const {
        const int ti = i >> 2, sub = i & 3; int pm, pn; if (!pg8::static_tile(ti, G, c, T / 256, 4, pm, pn)) return false;
        const int ycol = (sub == 0) ? C_U : (sub == 1) ? C_GB : (sub == 2) ? C_Q : C_V;
        u.pm = pm; u.pn = pn; u.sub = sub; u.e = 0;
        u.A = (const char*)(P1 + (size_t)pm * 256 * P1W + ycol); u.B = (const char*)(Wb + ((size_t)sub * 1024 + (size_t)pn * 256) * 512); return true;
    }
    __device__ __forceinline__ void a_off(const pg8::Unit&, unsigned (&vo)[2][2]) const {
        const int tz = opaque_tid();
#pragma unroll
        for (int i = 0; i < 2; ++i) { int R, C; pg8::stage_rc(tz * 16 + i * 8192, R, C);
#pragma unroll
            for (int h = 0; h < 2; ++h) vo[h][i] = (unsigned)((h * 128 + R) * P1W + C) * 2u; }
    }
};
__device__ __forceinline__ const LAS int* moe_tab() { unsigned a = (unsigned)LDS_MOE; asm volatile("" : "+s"(a)); return (const LAS int*)(uintptr_t)a; }
struct SchedMoe {
    const bf16* A; const bf16* Bt; const unsigned* list; int lda, K, brows  , G, c; bool gather; unsigned* cnt; unsigned* tmo;
    __device__ __forceinline__ bool next(int i, pg8::Unit& u) const {
        const LAS int* tab = moe_tab(); const int L = i * G + (gather ? c : (G - 1 - c)); const int tot = __builtin_amdgcn_readfirstlane(tab[16]); if (L >= 4 * tot) return false;
        const int rtg = L >> 2, pn = L & 3; int e = 0, st = 0;
#pragma unroll
        for (int k = 1; k < 16; ++k) { const int tk = __builtin_amdgcn_readfirstlane(tab[k]); if (rtg >= tk) { e = k; st = tk; } }
        u.e = e; u.pm = rtg; u.sub = rtg - st; u.pn = pn;
        u.A = gather ? (const char*)A : (const char*)(A + (size_t)rtg * 256 * lda);
        u.B = (const char*)(Bt + ((size_t)e * brows + (size_t)pn * 256) * K); return true;
    }
    __device__ __forceinline__ void a_ready(const pg8::Unit& u) const {
        if (gather) return;
        if (__builtin_amdgcn_readfirstlane((int)threadIdx.x) < 64) {
            unsigned* cp = cnt + 64 * u.pm; unsigned polls = 0u;
            while ((unsigned)__builtin_amdgcn_readfirstlane(__hip_atomic_load(cp, __ATOMIC_RELAXED, __HIP_MEMORY_SCOPE_AGENT)) < 32u) {
                if (++polls > (1u << 22)) { __hip_atomic_store(tmo, 1u, __ATOMIC_RELAXED, __HIP_MEMORY_SCOPE_AGENT); break; }
                __builtin_amdgcn_s_sleep(2); }
            __builtin_amdgcn_fence(__ATOMIC_ACQUIRE, "agent");
            asm volatile("s_waitcnt vmcnt(0)" ::: "memory");
        }
        asm volatile("" ::: "memory"); __builtin_amdgcn_s_barrier(); asm volatile("" ::: "memory");
    }
    __device__ __forceinline__ void done(const pg8::Unit& u) const {
        if (!gather) return;
        asm volatile("s_waitcnt vmcnt(0)" ::: "memory");
        if ((threadIdx.x & 63) == 0 && !is_dry()) (void)__hip_atomic_fetch_add(cnt + 64 * u.pm, 1u, __ATOMIC_RELAXED, __HIP_MEMORY_SCOPE_AGENT);
    }
    __device__ __forceinline__ void a_off(const pg8::Unit& u, unsigned (&vo)[2][2]) const {
        const LAS int* tab = moe_tab(); const int cnt = __builtin_amdgcn_readfirstlane(tab[32 + u.e]); const unsigned* le = list + (size_t)u.e * T + u.sub * 256;
        int tz = (int)threadIdx.x; asm volatile("" : "+v"(tz));
#pragma unroll
        for (int i = 0; i < 2; ++i) { int R, C; pg8::stage_rc(tz * 16 + i * 8192, R, C);
#pragma unroll
            for (int h = 0; h < 2; ++h) {
                int row = h * 128 + R;
                if (gather) { row = (u.sub * 256 + row < cnt) ? (int)(le[row] & 0x3fffu) : 0; }
                vo[h][i] = (unsigned)(row * lda + C) * 2u;
            } }
    }
};

struct EpiProj {
    bf16* P1; bf16* Rr;
    __device__ __forceinline__ bool operator()(f32x4 (&acc)[2][2][4][2], const pg8::Unit& u, int wr, int wc, int fr, int fq) const {
        const int row0 = u.pm * 256 + wr * 64 + fr;
        if (u.pn < 16) {
            const int act = (u.pn < 6) ? 1 : (u.pn == 15 ? 2 : 0);
#pragma unroll
            for (int ai = 0; ai < 2; ++ai)
#pragma unroll
                for (int m = 0; m < 4; ++m) { bf16* rowp = P1 + (size_t)(row0 + ai * 128 + m * 16) * P1W + u.pn * 256 + wc * 32 + 8 * fq;
#pragma unroll
                    for (int bj = 0; bj < 2; ++bj) { f32x4 v0 = acc[ai][bj][m][0], v1 = acc[ai][bj][m][1];
                        if (act == 1) { v0 = (f32x4){gelu_tanh(v0.x), gelu_tanh(v0.y), gelu_tanh(v0.z), gelu_tanh(v0.w)}; v1 = (f32x4){gelu_tanh(v1.x), gelu_tanh(v1.y), gelu_tanh(v1.z), gelu_tanh(v1.w)}; }
                        else if (act == 2) { v0 = (f32x4){sigmoidf_(v0.x), sigmoidf_(v0.y), sigmoidf_(v0.z), sigmoidf_(v0.w)}; v1 = (f32x4){sigmoidf_(v1.x), sigmoidf_(v1.y), sigmoidf_(v1.z), sigmoidf_(v1.w)}; }
                        u32x4 w; w.x = pk2(v0.x, v0.y); w.y = pk2(v0.z, v0.w); w.z = pk2(v1.x, v1.y); w.w = pk2(v1.z, v1.w);
                        if (u.pn < 15 || (bj == 0 && wc < 2)) GST(*(u32x4*)(rowp + bj * 128) = w); } }
        } else {
            const int dcol = 64 * (u.pn - 16) + 16 * wc + 4 * fq;
#pragma unroll
            for (int ai = 0; ai < 2; ++ai)
#pragma unroll
                for (int m = 0; m < 4; ++m) { const size_t row = (size_t)(row0 + ai * 128 + m * 16);
                    float r0[4], r1[4], r2[4], r3[4];
#pragma unroll
                    for (int i = 0; i < 4; ++i) {
                        const float d0 = fminf(1.0f + __builtin_amdgcn_exp2f(-1.4426950408889634f * acc[ai][0][m][0][i]), 1e20f), d1 = fminf(1.0f + __builtin_amdgcn_exp2f(-1.4426950408889634f * acc[ai][0][m][1][i]), 1e20f);
                        const float d2 = fminf(1.0f + __builtin_amdgcn_exp2f(-1.4426950408889634f * acc[ai][1][m][0][i]), 1e20f), d3 = fminf(1.0f + __builtin_amdgcn_exp2f(-1.4426950408889634f * acc[ai][1][m][1][i]), 1e20f);
                        const float i0 = __builtin_amdgcn_rcpf(d0), i1 = __builtin_amdgcn_rcpf(d1), i2 = __builtin_amdgcn_rcpf(d2), i3 = __builtin_amdgcn_rcpf(d3);
                        r0[i] = d1 * i0; r1[i] = d2 * i1; r2[i] = d3 * i2; r3[i] = i3; }
                    u32x2 w;
                    w.x = pk2(r0[0], r0[1]); w.y = pk2(r0[2], r0[3]); GST(*(u32x2*)(Rr + ((size_t)0 * T + row) * 1024 + dcol) = w);
                    w.x = pk2(r1[0], r1[1]); w.y = pk2(r1[2], r1[3]); GST(*(u32x2*)(Rr + ((size_t)1 * T + row) * 1024 + dcol) = w);
                    w.x = pk2(r2[0], r2[1]); w.y = pk2(r2[2], r2[3]); GST(*(u32x2*)(Rr + ((size_t)2 * T + row) * 1024 + dcol) = w);
                    w.x = pk2(r3[0], r3[1]); w.y = pk2(r3[2], r3[3]); GST(*(u32x2*)(Rr + ((size_t)3 * T + row) * 1024 + dcol) = w); }
        }
        return true;
    }
};
struct EpiMerge {
    const bf16* Rr; bf16* O;
    __device__ __forceinline__ bool operator()(f32x4 (&acc)[2][2][4][2], const pg8::Unit& u, int wr, int wc, int fr, int fq) const {
        const int row0 = u.pm * 256 + wr * 64 + fr, col0 = u.pn * 256 + wc * 32 + 8 * fq;
        const bf16* Rn = Rr + (size_t)u.sub * T * 1024;
        const __amdgpu_buffer_rsrc_t rs = __builtin_amdgcn_make_buffer_rsrc((void*)O, (short)0, (int)((size_t)T * 1024 * 2), 0x00020000);
        u32x4 rv[2][4][2];
#pragma unroll
        for (int ai = 0; ai < 2; ++ai)
#pragma unroll
            for (int m = 0; m < 4; ++m)
#pragma unroll
                for (int bj = 0; bj < 2; ++bj) rv[ai][m][bj] = *(const u32x4*)(Rn + (size_t)(row0 + ai * 128 + m * 16) * 1024 + col0 + bj * 128);
        __builtin_amdgcn_sched_barrier(0);
#pragma unroll
        for (int ai = 0; ai < 2; ++ai)
#pragma unroll
            for (int m = 0; m < 4; ++m) { const size_t ro = (size_t)(row0 + ai * 128 + m * 16) * 1024 + col0;
#pragma unroll
                for (int bj = 0; bj < 2; ++bj) { const u32x4 r = rv[ai][m][bj];
                    f32x4& v0 = acc[ai][bj][m][0]; f32x4& v1 = acc[ai][bj][m][1];
                    v0.x *= bflo(r.x); v0.y *= bfhi(r.x); v0.z *= bflo(r.y); v0.w *= bfhi(r.y); v1.x *= bflo(r.z); v1.y *= bfhi(r.z); v1.z *= bflo(r.w); v1.w *= bfhi(r.w);
                    if (u.sub == 3) { u32x4 w; w.x = pk2(v0.x, v0.y); w.y = pk2(v0.z, v0.w); w.z = pk2(v1.x, v1.y); w.w = pk2(v1.z, v1.w); GST(__builtin_amdgcn_raw_buffer_store_b128(w, rs, (unsigned)((ro + bj * 128) * 2), 0, 16)); } } }
        return u.sub == 3;
    }
};
struct EpiWout {
    const float* Hin; float* H;
    __device__ __forceinline__ bool operator()(f32x4 (&acc)[2][2][4][2], const pg8::Unit& u, int wr, int wc, int fr, int fq) const {
        const int row0 = u.pm * 256 + wr * 64 + fr, col0 = u.pn * 256 + wc * 32 + 8 * fq;
#pragma unroll
        for (int ai = 0; ai < 2; ++ai)
        {   f32x4 hv[4][2][2];
#pragma unroll
            for (int m = 0; m < 4; ++m)
#pragma unroll
                for (int bj = 0; bj < 2; ++bj)
#pragma unroll
                    for (int n = 0; n < 2; ++n) hv[m][bj][n] = *(const f32x4*)(Hin + (size_t)(row0 + ai * 128 + m * 16) * 1024 + col0 + bj * 128 + 4 * n);
            __builtin_amdgcn_sched_barrier(0);
#pragma unroll
            for (int m = 0; m < 4; ++m)
#pragma unroll
                for (int bj = 0; bj < 2; ++bj)
#pragma unroll
                    for (int n = 0; n < 2; ++n) { const f32x4 h = hv[m][bj][n] + acc[ai][bj][m][n]; GST(*(f32x4*)(H + (size_t)(row0 + ai * 128 + m * 16) * 1024 + col0 + bj * 128 + 4 * n) = h); } }
        return true;
    }
};
struct EpiGateUp {
    bf16* HID; const float* lw;
    __device__ __forceinline__ bool operator()(f32x4 (&acc)[2][2][4][2], const pg8::Unit& u, int wr, int wc, int fr, int fq) const {
        const int cnt = __builtin_amdgcn_readfirstlane(moe_tab()[32 + u.e]);
        const __amdgpu_buffer_rsrc_t rs = __builtin_amdgcn_make_buffer_rsrc((void*)HID, (short)0, (int)((size_t)HID_ROWS * 512 * 2), 0x00020000);
#pragma unroll
        for (int ai = 0; ai < 2; ++ai)
#pragma unroll
            for (int m = 0; m < 4; ++m) { const int rl = ai * 128 + wr * 64 + m * 16 + fr; const int lr = u.sub * 256 + rl;
                const bool ok = lr < cnt; const float w = ok ? lw[(size_t)u.e * T + lr] : 0.f;
                float o[8];
#pragma unroll
                for (int n = 0; n < 2; ++n)
#pragma unroll
                    for (int i = 0; i < 4; ++i) { const float g = acc[ai][0][m][n][i], up = acc[ai][1][m][n][i]; o[4 * n + i] = ok ? g * sigmoidf_(g) * up * w : 0.f; }
                u32x4 wv; wv.x = pk2(o[0], o[1]); wv.y = pk2(o[2], o[3]); wv.z = pk2(o[4], o[5]); wv.w = pk2(o[6], o[7]);
                GST(__builtin_amdgcn_raw_buffer_store_b128(wv, rs, (unsigned)((((size_t)u.pm * 256 + rl) * 512 + u.pn * 128 + wc * 32 + 8 * fq) * 2), 0, 16)); }
        return true;
    }
};
struct EpiDown {
    bf16* Y; const unsigned* list;
    __device__ __forceinline__ bool operator()(f32x4 (&acc)[2][2][4][2], const pg8::Unit& u, int wr, int wc, int fr, int fq) const {
        const int cnt = __builtin_amdgcn_readfirstlane(moe_tab()[32 + u.e]);
        unsigned en[2][4];
#pragma unroll
        for (int ai = 0; ai < 2; ++ai)
#pragma unroll
            for (int m = 0; m < 4; ++m) { const int lr = u.sub * 256 + ai * 128 + wr * 64 + m * 16 + fr; en[ai][m] = list[(size_t)u.e * T + (lr < cnt ? lr : 0)]; }
        __builtin_amdgcn_sched_barrier(0);
#pragma unroll
        for (int ai = 0; ai < 2; ++ai)
#pragma unroll
            for (int m = 0; m < 4; ++m) { const int rl = ai * 128 + wr * 64 + m * 16 + fr; const int lr = u.sub * 256 + rl;
                if (lr < cnt) { const unsigned tok = en[ai][m] & 0x3fffu, slot = en[ai][m] >> 14;
                    bf16* rp = Y + ((size_t)slot * T + tok) * 1024 + u.pn * 256 + wc * 32 + 8 * fq;
#pragma unroll
                    for (int bj = 0; bj < 2; ++bj) { const f32x4 v0 = acc[ai][bj][m][0], v1 = acc[ai][bj][m][1];
                        u32x4 w; w.x = pk2(v0.x, v0.y); w.y = pk2(v0.z, v0.w); w.z = pk2(v1.x, v1.y); w.w = pk2(v1.z, v1.w); GST(*(u32x4*)(rp + bj * 128) = w); } } }
        return true;
    }
};


__device__ __forceinline__ void lru_unit2(LAS unsigned char* lds, const bf16* P1, bf16* XN, float* AGA, float* AGH, const float* convw, const float* convb,
                                          const bf16* WaT, const bf16* WxT, const float* ba, const float* bx, const float* lam, int unit) {
    const int tid = opaque_tid(); const int lane = tid & 63, w = __builtin_amdgcn_readfirstlane(tid >> 6);
    const int tile = unit & 63, b = unit >> 6; const int ch0 = w * 64;
    const size_t row0 = (size_t)b * SEQ + tile * 64;
    LAS unsigned char* wl = lds + w * 17920;
    LAS bf16* xcb = (LAS bf16*)wl; LAS float* AL = (LAS float*)(wl + 9216); LAS float* BL = (LAS float*)(wl + 9216 + 4352);
    __syncthreads();
    FT0(8);
    const int i16 = lane & 15, kb = lane >> 4;
    bf16x8 bfa[4][2], bfx[4][2]; float cba[4], cbx[4], csp[4];
    {
        const int tl = lane >> 3, c8 = (lane & 7) * 8;
        f32x4 cwv[4][2], cbv[2];
#pragma unroll
        for (int k = 0; k < 4; ++k) { cwv[k][0] = *(const f32x4*)(convw + k * 512 + ch0 + c8); cwv[k][1] = *(const f32x4*)(convw + k * 512 + ch0 + c8 + 4); }
        cbv[0] = *(const f32x4*)(convb + ch0 + c8); cbv[1] = *(const f32x4*)(convb + ch0 + c8 + 4);
        u32x4 xa[4][4], xb[4][4];
#pragma unroll
        for (int p = 0; p < 4; ++p)
#pragma unroll
            for (int k = 0; k < 4; ++k) { const int sp = tile * 64 + 8 * p + tl + k - 3; xa[p][k] = *(const u32x4*)(P1 + ((size_t)b * SEQ + (sp < 0 ? 0 : sp)) * P1W + C_RB + ch0 + c8); }
#pragma unroll
        for (int p = 0; p < 4; ++p)
#pragma unroll
            for (int k = 0; k < 4; ++k) { const int sp = tile * 64 + 8 * (p + 4) + tl + k - 3; xb[p][k] = *(const u32x4*)(P1 + ((size_t)b * SEQ + (sp < 0 ? 0 : sp)) * P1W + C_RB + ch0 + c8); }
        __builtin_amdgcn_sched_barrier(0);
#pragma unroll
        for (int hf = 0; hf < 2; ++hf) {
#pragma unroll
            for (int p = 0; p < 4; ++p) { const int tok = 8 * (p + 4 * hf) + tl; const int ts = tile * 64 + tok;
                float o[8] = {cbv[0].x, cbv[0].y, cbv[0].z, cbv[0].w, cbv[1].x, cbv[1].y, cbv[1].z, cbv[1].w};
#pragma unroll
                for (int k = 0; k < 4; ++k) { const u32x4 v = hf ? xb[p][k] : xa[p][k]; const float z = (ts + k - 3 >= 0) ? 1.f : 0.f; const f32x4 w0 = cwv[k][0] * z, w1 = cwv[k][1] * z;
                    o[0] += bflo(v.x) * w0.x; o[1] += bfhi(v.x) * w0.y; o[2] += bflo(v.y) * w0.z; o[3] += bfhi(v.y) * w0.w; o[4] += bflo(v.z) * w1.x; o[5] += bfhi(v.z) * w1.y; o[6] += bflo(v.w) * w1.z; o[7] += bfhi(v.w) * w1.w; }
                *(LAS u32x4*)(xcb + tok * 72 + c8) = (u32x4){pk2(o[0], o[1]), pk2(o[2], o[3]), pk2(o[4], o[5]), pk2(o[6], o[7])}; }
            if (hf == 0) {
#pragma unroll
                for (int n = 0; n < 4; ++n) {
#pragma unroll
                    for (int ks = 0; ks < 2; ++ks) { bfa[n][ks] = *(const bf16x8*)(WaT + ((size_t)ch0 + 16 * n + i16) * 64 + 32 * ks + 8 * kb); bfx[n][ks] = *(const bf16x8*)(WxT + ((size_t)ch0 + 16 * n + i16) * 64 + 32 * ks + 8 * kb); }
                    const int co = ch0 + 16 * n + i16; cba[n] = ba[co]; cbx[n] = bx[co]; csp[n] = lam[co]; }
                __builtin_amdgcn_sched_barrier(0); }
        }
#pragma unroll
        for (int n = 0; n < 4; ++n) { const float lm = csp[n]; csp[n] = 8.0f * ((-lm > 20.f) ? -lm : log1pf(__expf(-lm))); }
    }
    LDS_WAIT(); asm volatile("" ::: "memory");
    FT1(8); FT0(9);
    float hr = 0.f, ac = 1.f;
#pragma unroll 1
    for (int nt = 0; nt < 4; ++nt) {
        bf16x8 af[2];
#pragma unroll
        for (int ks = 0; ks < 2; ++ks) af[ks] = *(const LAS bf16x8*)(xcb + (16 * nt + i16) * 72 + 32 * ks + 8 * kb);
        f32x4 da[4], dx[4];
#pragma unroll
        for (int n = 0; n < 4; ++n) { da[n] = (f32x4){0.f, 0.f, 0.f, 0.f}; dx[n] = da[n];
#pragma unroll
            for (int ks = 0; ks < 2; ++ks) { da[n] = __builtin_amdgcn_mfma_f32_16x16x32_bf16(af[ks], bfa[n][ks], da[n], 0, 0, 0); dx[n] = __builtin_amdgcn_mfma_f32_16x16x32_bf16(af[ks], bfx[n][ks], dx[n], 0, 0, 0); } }
#pragma unroll
        for (int n = 0; n < 4; ++n)
#pragma unroll
            for (int r = 0; r < 4; ++r) { const int tokl = 4 * kb + r, co = 16 * n + i16; const float xcv = bf2f(xcb[(16 * nt + tokl) * 72 + co]);
                const float rg = sigmoidf_(da[n][r] + cba[n]), ig = sigmoidf_(dx[n][r] + cbx[n]); const float a = __expf(-rg * csp[n]);
                AL[tokl * 68 + co] = a; BL[tokl * 68 + co] = sqrtf(fmaxf(1.0f - a * a, 0.f)) * (ig * xcv); }
        LDS_WAIT(); asm volatile("" ::: "memory");
#pragma unroll
        for (int tt = 0; tt < 16; ++tt) { const float a = AL[tt * 68 + lane], bt = BL[tt * 68 + lane]; hr = a * hr + bt; ac *= a; BL[tt * 68 + lane] = hr; AL[tt * 68 + lane] = ac; }
        LDS_WAIT(); asm volatile("" ::: "memory");
        {   const int tk = lane >> 2, pc = (lane & 3) * 16;
            const f32x4 h0 = *(const LAS f32x4*)(BL + tk * 68 + pc), h1 = *(const LAS f32x4*)(BL + tk * 68 + pc + 4), h2 = *(const LAS f32x4*)(BL + tk * 68 + pc + 8), h3 = *(const LAS f32x4*)(BL + tk * 68 + pc + 12);
            const f32x4 a0 = *(const LAS f32x4*)(AL + tk * 68 + pc), a1 = *(const LAS f32x4*)(AL + tk * 68 + pc + 4), a2 = *(const LAS f32x4*)(AL + tk * 68 + pc + 8), a3 = *(const LAS f32x4*)(AL + tk * 68 + pc + 12);
            bf16* hp = XN + (row0 + 16 * nt + tk) * 1024 + ch0 + pc;
            GST(*(u32x4*)hp = (u32x4){pk2(h0.x, h0.y), pk2(h0.z, h0.w), pk2(h1.x, h1.y), pk2(h1.z, h1.w)}); GST(*(u32x4*)(hp + 8) = (u32x4){pk2(h2.x, h2.y), pk2(h2.z, h2.w), pk2(h3.x, h3.y), pk2(h3.z, h3.w)});
            GST(*(u32x4*)(hp + 512) = (u32x4){pk2(a0.x, a0.y), pk2(a0.z, a0.w), pk2(a1.x, a1.y), pk2(a1.z, a1.w)}); GST(*(u32x4*)(hp + 520) = (u32x4){pk2(a2.x, a2.y), pk2(a2.z, a2.w), pk2(a3.x, a3.y), pk2(a3.z, a3.w)}); }
        LDS_WAIT(); asm volatile("" ::: "memory");
    }
    FT1(9);
    GST(AGA[((size_t)b * 64 + tile) * 512 + ch0 + lane] = ac); GST(AGH[((size_t)b * 64 + tile) * 512 + ch0 + lane] = hr);
}
__device__ __forceinline__ void cmp_unit2(LAS unsigned char* lds, const bf16* P1, float* KC, const float* pe, const bf16* W1T, const float* w2, int unit) {
    const int tid = opaque_tid(); const int lane = tid & 63, w = __builtin_amdgcn_readfirstlane(tid >> 6);
    const int q = unit & 15, g = (unit >> 4) & 1, b = (unit >> 5) & 3, c = unit >> 7;
    LAS bf16* Fl = (LAS bf16*)lds;
    LAS float* part = (LAS float*)(lds + 65792);
    LAS float* hid = (LAS float*)(lds + 65792 + 32768);
    const float* pec = pe + (size_t)c * 2048; const bf16* w1t = W1T + ((size_t)c * 2 + g) * 64 * 2048; const float* w2c = w2 + ((size_t)c * 2 + g) * 4096;
    __syncthreads();
    {   u32x4 xv[8]; f32x4 pa[8], pb[8];
#pragma unroll
        for (int k = 0; k < 8; ++k) { const int e = tid + 512 * k; const int nl = e >> 8, l = (e >> 3) & 31, c8 = (e & 7) * 8; const int n = q * 16 + nl; const int nn = n < 255 ? n : 254;
            xv[k] = *(const u32x4*)(P1 + ((size_t)b * SEQ + nn * 16 + l) * P1W + C_KV + (c * 2 + g) * 64 + c8); pa[k] = *(const f32x4*)(pec + l * 64 + c8); pb[k] = *(const f32x4*)(pec + l * 64 + c8 + 4); }
#pragma unroll
        for (int k = 0; k < 8; ++k) { const int e = tid + 512 * k; const int nl = e >> 8, l = (e >> 3) & 31, c8 = (e & 7) * 8; const u32x4 v = xv[k];
            *(LAS u32x4*)(Fl + nl * 2056 + l * 64 + c8) = (u32x4){pk2(bflo(v.x) + pa[k].x, bfhi(v.x) + pa[k].y), pk2(bflo(v.y) + pa[k].z, bfhi(v.y) + pa[k].w), pk2(bflo(v.z) + pb[k].x, bfhi(v.z) + pb[k].y), pk2(bflo(v.w) + pb[k].z, bfhi(v.w) + pb[k].w)}; } }
    __syncthreads();
    {   const int i16 = lane & 15, kb = lane >> 4; f32x4 acc[4];
#pragma unroll
        for (int n = 0; n < 4; ++n) acc[n] = (f32x4){0.f, 0.f, 0.f, 0.f};
        bf16x8 bfr[8][4];
#pragma unroll
        for (int ks = 0; ks < 8; ++ks)
#pragma unroll
            for (int n = 0; n < 4; ++n) bfr[ks][n] = *(const bf16x8*)(w1t + (size_t)(16 * n + i16) * 2048 + 256 * w + 32 * ks + 8 * kb);
        __builtin_amdgcn_sched_barrier(0);
#pragma unroll
        for (int ks = 0; ks < 8; ++ks) { const int f0 = 256 * w + 32 * ks + 8 * kb;
            const bf16x8 af = *(const LAS bf16x8*)(Fl + i16 * 2056 + f0);
#pragma unroll
            for (int n = 0; n < 4; ++n) acc[n] = __builtin_amdgcn_mfma_f32_16x16x32_bf16(af, bfr[ks][n], acc[n], 0, 0, 0); }
#pragma unroll
        for (int n = 0; n < 4; ++n)
#pragma unroll
            for (int r = 0; r < 4; ++r) part[(w * 16 + 4 * kb + r) * 64 + 16 * n + i16] = acc[n][r];
    }
    __syncthreads();
    for (int e = tid; e < 1024; e += 512) { float a = 0.f;
#pragma unroll
        for (int ww = 0; ww < 8; ++ww) a += part[ww * 1024 + e];
        hid[e] = gelu_tanh(a); }
    __syncthreads();
    {   const int d = tid & 63, ng = tid >> 6; float a0 = 0.f, a1 = 0.f;
        for (int e = 0; e < 64; ++e) { const float wv = w2c[e * 64 + d]; a0 += hid[(ng * 2) * 64 + e] * wv; a1 += hid[(ng * 2 + 1) * 64 + e] * wv; }
        const int n0 = q * 16 + ng * 2; float* kp = KC + ((((size_t)c * NB + b) * 2 + g) * 256) * 64;
        if (n0 < 255) GST(kp[(size_t)n0 * 64 + d] = a0);
        if (n0 + 1 < 255) GST(kp[(size_t)(n0 + 1) * 64 + d] = a1); }
}
__device__ __forceinline__ void gmlp_unit3(LAS unsigned char* lds, bf16* P1, const float* gng, const float* gws, const float* gmb, int unit) {
    typedef float f32x16_ __attribute__((ext_vector_type(16))); typedef short s16x4_ __attribute__((ext_vector_type(4)));
    const int tid = opaque_tid(); const int lane = tid & 63, w = __builtin_amdgcn_readfirstlane(tid >> 6), r32 = lane & 31, h = lane >> 5;
    const int c = unit >> 1, gp = unit & 1; const size_t t0 = (size_t)c * 128;
    LAS unsigned char* VN = lds; LAS unsigned char* WT = lds + 65536; LAS float* rs = (LAS float*)(lds + 135168);
    __syncthreads();
    f32x4 wa[8], wb[8];
#pragma unroll
    for (int k = 0; k < 8; ++k) { const int e = tid + 512 * k; const int gi = e >> 11, t = (e >> 4) & 127, s8 = (e & 15) * 8; const float* wp = gws + (size_t)(2 * gp + gi) * 16384 + t * 128 + s8; wa[k] = *(const f32x4*)wp; wb[k] = *(const f32x4*)(wp + 4); }
    {   const int tk = tid >> 2, qu = tid & 3; const bf16* vp = P1 + (t0 + tk) * P1W + C_V + qu * 128; float ss = 0.f;
#pragma unroll 8
        for (int i = 0; i < 16; ++i) { const u32x4 x = *(const u32x4*)(vp + 8 * i);
            ss += bflo(x.x) * bflo(x.x) + bfhi(x.x) * bfhi(x.x) + bflo(x.y) * bflo(x.y) + bfhi(x.y) * bfhi(x.y) + bflo(x.z) * bflo(x.z) + bfhi(x.z) * bfhi(x.z) + bflo(x.w) * bflo(x.w) + bfhi(x.w) * bfhi(x.w); }
        ss += __shfl_xor(ss, 1); ss += __shfl_xor(ss, 2);
        if (qu == 0) rs[tk] = rsqrtf(ss * (1.f / 512.f) + EPS);
    }
#pragma unroll
    for (int k = 0; k < 8; ++k) { const int e = tid + 512 * k; const int gi = e >> 11, t = (e >> 4) & 127, s8 = (e & 15) * 8; const f32x4 a = wa[k], bq = wb[k];
        const float v0 = (s8 + 0 <= t) ? a.x : 0.f, v1 = (s8 + 1 <= t) ? a.y : 0.f, v2 = (s8 + 2 <= t) ? a.z : 0.f, v3 = (s8 + 3 <= t) ? a.w : 0.f;
        const float v4 = (s8 + 4 <= t) ? bq.x : 0.f, v5 = (s8 + 5 <= t) ? bq.y : 0.f, v6 = (s8 + 6 <= t) ? bq.z : 0.f, v7 = (s8 + 7 <= t) ? bq.w : 0.f;
        *(LAS u32x4*)(WT + gi * 34816 + t * 272 + s8 * 2) = (u32x4){pk2(v0, v1), pk2(v2, v3), pk2(v4, v5), pk2(v6, v7)}; }
    __syncthreads();
    {   u32x4 xv[8];
#pragma unroll
        for (int k = 0; k < 8; ++k) { const int e = tid + 512 * k; const int gi = e >> 11, sr = (e >> 4) & 127, c8 = e & 15; xv[k] = *(const u32x4*)(P1 + (t0 + sr) * P1W + C_V + (2 * gp + gi) * 128 + 8 * c8); }
#pragma unroll
        for (int k = 0; k < 8; ++k) { const int e = tid + 512 * k; const int gi = e >> 11, sr = (e >> 4) & 127, c8 = e & 15; const u32x4 x = xv[k];
            const float r = rs[sr]; const float* gq = gng + (2 * gp + gi) * 128 + 8 * c8;
            *(LAS u32x4*)(VN + gi * 32768 + (c8 >> 2) * 8192 + sr * 64 + (c8 & 3) * 16) = (u32x4){pk2(bflo(x.x) * r * gq[0], bfhi(x.x) * r * gq[1]), pk2(bflo(x.y) * r * gq[2], bfhi(x.y) * r * gq[3]), pk2(bflo(x.z) * r * gq[4], bfhi(x.z) * r * gq[5]), pk2(bflo(x.w) * r * gq[6], bfhi(x.w) * r * gq[7])}; } }
    __syncthreads();
    const int gi = w >> 2, cb = w & 3, g = 2 * gp + gi;
    const LAS unsigned char* vb = VN + gi * 32768 + cb * 8192 + ((lane >> 4) & 1) * 32 + (lane & 3) * 8 + (8 * h + ((lane & 15) >> 2)) * 64;
#pragma unroll 1
    for (int tb = 0; tb < 4; ++tb) {
        f32x16_ acc;
#pragma unroll
        for (int r = 0; r < 16; ++r) acc[r] = 0.f;
        const LAS unsigned char* wrow = WT + gi * 34816 + (32 * tb + r32) * 272 + 16 * h;
        for (int ks = 0; ks < 2 * tb + 2; ++ks) {
            const bf16x8 wf = *(const LAS bf16x8*)(wrow + 32 * ks);
            const s16x4_ lo = __builtin_bit_cast(s16x4_, __builtin_amdgcn_ds_read_tr16_b64_v4i16((LAS s16x4_*)(vb + ks * 1024)));
            const s16x4_ hi = __builtin_bit_cast(s16x4_, __builtin_amdgcn_ds_read_tr16_b64_v4i16((LAS s16x4_*)(vb + ks * 1024 + 256)));
            const bf16x8 vf = (bf16x8){lo[0], lo[1], lo[2], lo[3], hi[0], hi[1], hi[2], hi[3]};
            acc = __builtin_amdgcn_mfma_f32_32x32x16_bf16(vf, wf, acc, 0, 0, 0);
        }
        const int tl = 32 * tb + r32; const float bb = gmb[g * 128 + tl];
        bf16* up = P1 + (t0 + tl) * P1W + C_U + g * 128 + 32 * cb + 4 * h;
        u32x2 uu[4];
#pragma unroll
        for (int q4 = 0; q4 < 4; ++q4) uu[q4] = *(const u32x2*)(up + 8 * q4);
#pragma unroll
        for (int q4 = 0; q4 < 4; ++q4) {
            u32x2 o; o.x = pk2(bflo(uu[q4].x) * (acc[4 * q4] + bb), bfhi(uu[q4].x) * (acc[4 * q4 + 1] + bb)); o.y = pk2(bflo(uu[q4].y) * (acc[4 * q4 + 2] + bb), bfhi(uu[q4].y) * (acc[4 * q4 + 3] + bb));
            GST(*(u32x2*)(up + 8 * q4) = o); }
    }
}
__device__ __forceinline__ void pool_unit2(LAS unsigned char* lds, bf16* P1, const bf16* pwT, const float* ps, int unit) {
    typedef float f32x16_ __attribute__((ext_vector_type(16)));
    const int tid = opaque_tid(); const int lane = tid & 63, w = __builtin_amdgcn_readfirstlane(tid >> 6), r32 = lane & 31, h = lane >> 5;
    const int gi = unit & 3, tile = (unit >> 2) & 63, b = unit >> 8; const int wn = 2 << gi;
    LAS float* xs = (LAS float*)lds; LAS bf16* PL = (LAS bf16*)(lds + 40448);
    __syncthreads();
#pragma unroll
    for (int k = 0; k < 3; ++k) { const int e = tid + 512 * k; if (e < 79 * 16) { const int r = e >> 4, c8 = (e & 15) * 8; const int sp = tile * 64 + r - 15; const float z = sp >= 0 ? 1.f : 0.f;
        const u32x4 v = *(const u32x4*)(P1 + ((size_t)b * SEQ + (sp < 0 ? 0 : sp)) * P1W + C_XD + gi * 128 + c8);
        *(LAS f32x4*)(xs + r * 128 + c8) = (f32x4){bflo(v.x) * z, bfhi(v.x) * z, bflo(v.y) * z, bfhi(v.y) * z}; *(LAS f32x4*)(xs + r * 128 + c8 + 4) = (f32x4){bflo(v.z) * z, bfhi(v.z) * z, bflo(v.w) * z, bfhi(v.w) * z}; } }
    __syncthreads();
    {   const int ci = tid & 127, tq = tid >> 7;
        for (int k = 0; k < 16; ++k) { const int tt = tq * 16 + k; const int ts = tile * 64 + tt; float sacc = 0.f;
            for (int jj = 0; jj < wn; ++jj) sacc += xs[(tt + 15 - jj) * 128 + ci];
            const int cnt = (ts + 1 < wn) ? ts + 1 : wn;
            PL[tt * 136 + ci] = (bf16)f2bf(sacc / (float)cnt - xs[(tt + 15) * 128 + ci]); } }
    __syncthreads();
    {   const int cob = w >> 1, tokb = w & 1; f32x16_ acc;
#pragma unroll
        for (int r = 0; r < 16; ++r) acc[r] = 0.f;
        const bf16* wrow = pwT + (size_t)(32 * cob + r32) * 128 + 8 * h; const LAS bf16* prow = PL + (32 * tokb + r32) * 136 + 8 * h;
#pragma unroll
        for (int ks = 0; ks < 8; ++ks) { const bf16x8 wf = *(const bf16x8*)(wrow + 16 * ks); const bf16x8 pf = *(const LAS bf16x8*)(prow + 16 * ks);
            acc = __builtin_amdgcn_mfma_f32_32x32x16_bf16(wf, pf, acc, 0, 0, 0); }
        bf16* op = P1 + ((size_t)b * SEQ + tile * 64 + 32 * tokb + r32) * P1W + C_V + gi * 128 + 32 * cob + 4 * h; const float* sp = ps + gi * 128 + 32 * cob + 4 * h;
#pragma unroll
        for (int q4 = 0; q4 < 4; ++q4) { const f32x4 sc = *(const f32x4*)(sp + 8 * q4);
            u32x2 o; o.x = pk2(acc[4 * q4] * sc.x, acc[4 * q4 + 1] * sc.y); o.y = pk2(acc[4 * q4 + 2] * sc.z, acc[4 * q4 + 3] * sc.w); GST(*(u32x2*)(op + 8 * q4) = o); }
    }
}
__device__ __forceinline__ void lrufix_unit2(LAS unsigned char* lds, bf16* P1, const bf16* XN, const float* AGA, const float* AGH, int unit) {
    const int tid = opaque_tid(); const int cg = tid & 63, tl = tid >> 6; const int tile = unit & 63, b = unit >> 6;
    LAS float* seg = (LAS float*)lds;
    __syncthreads();
    {   float sa[8], sh[8];
#pragma unroll
        for (int i = 0; i < 8; ++i) { sa[i] = 1.f; sh[i] = 0.f; }
        f32x4 la0[8], la1[8], lh0[8], lh1[8];
#pragma unroll
        for (int k = 0; k < 8; ++k) { const int i = 8 * tl + k; const int ii = i < tile ? i : 0; const float* ap = AGA + ((size_t)b * 64 + ii) * 512 + 8 * cg; const float* hp = AGH + ((size_t)b * 64 + ii) * 512 + 8 * cg;
            la0[k] = *(const f32x4*)ap; la1[k] = *(const f32x4*)(ap + 4); lh0[k] = *(const f32x4*)hp; lh1[k] = *(const f32x4*)(hp + 4); }
#pragma unroll
        for (int k = 0; k < 8; ++k) { const int i = 8 * tl + k; if (i < tile) { const f32x4 a0 = la0[k], a1 = la1[k], h0 = lh0[k], h1 = lh1[k];
                sh[0] = a0.x * sh[0] + h0.x; sh[1] = a0.y * sh[1] + h0.y; sh[2] = a0.z * sh[2] + h0.z; sh[3] = a0.w * sh[3] + h0.w; sh[4] = a1.x * sh[4] + h1.x; sh[5] = a1.y * sh[5] + h1.y; sh[6] = a1.z * sh[6] + h1.z; sh[7] = a1.w * sh[7] + h1.w;
                sa[0] *= a0.x; sa[1] *= a0.y; sa[2] *= a0.z; sa[3] *= a0.w; sa[4] *= a1.x; sa[5] *= a1.y; sa[6] *= a1.z; sa[7] *= a1.w; } }
        LAS float* sp = seg + (tl * 64 + cg) * 16;
        *(LAS f32x4*)sp = (f32x4){sa[0], sa[1], sa[2], sa[3]}; *(LAS f32x4*)(sp + 4) = (f32x4){sa[4], sa[5], sa[6], sa[7]}; *(LAS f32x4*)(sp + 8) = (f32x4){sh[0], sh[1], sh[2], sh[3]}; *(LAS f32x4*)(sp + 12) = (f32x4){sh[4], sh[5], sh[6], sh[7]};
    }
    __syncthreads();
    float c[8];
#pragma unroll
    for (int i = 0; i < 8; ++i) c[i] = 0.f;
#pragma unroll
    for (int sgi = 0; sgi < 8; ++sgi) { const LAS float* sp = seg + (sgi * 64 + cg) * 16; const f32x4 a0 = *(const LAS f32x4*)sp, a1 = *(const LAS f32x4*)(sp + 4), h0 = *(const LAS f32x4*)(sp + 8), h1 = *(const LAS f32x4*)(sp + 12);
        c[0] = a0.x * c[0] + h0.x; c[1] = a0.y * c[1] + h0.y; c[2] = a0.z * c[2] + h0.z; c[3] = a0.w * c[3] + h0.w; c[4] = a1.x * c[4] + h1.x; c[5] = a1.y * c[5] + h1.y; c[6] = a1.z * c[6] + h1.z; c[7] = a1.w * c[7] + h1.w; }
    const size_t row0 = (size_t)b * SEQ + tile * 64;
#pragma unroll 4
    for (int p = 0; p < 8; ++p) { const size_t row = row0 + 8 * p + tl;
        const u32x4 hl = *(const u32x4*)(XN + row * 1024 + 8 * cg), ac = *(const u32x4*)(XN + row * 1024 + 512 + 8 * cg); bf16* gp = P1 + row * P1W + C_GB + 8 * cg; const u32x4 gg = *(const u32x4*)gp;
        u32x4 o;
        o.x = pk2(bflo(gg.x) * (bflo(hl.x) + bflo(ac.x) * c[0]), bfhi(gg.x) * (bfhi(hl.x) + bfhi(ac.x) * c[1])); o.y = pk2(bflo(gg.y) * (bflo(hl.y) + bflo(ac.y) * c[2]), bfhi(gg.y) * (bfhi(hl.y) + bfhi(ac.y) * c[3]));
        o.z = pk2(bflo(gg.z) * (bflo(hl.z) + bflo(ac.z) * c[4]), bfhi(gg.z) * (bfhi(hl.z) + bfhi(ac.z) * c[5])); o.w = pk2(bflo(gg.w) * (bflo(hl.w) + bflo(ac.w) * c[6]), bfhi(gg.w) * (bfhi(hl.w) + bfhi(ac.w) * c[7]));
        GST(*(u32x4*)gp = o); }
}

typedef float f32x16 __attribute__((ext_vector_type(16)));
typedef short s16x4 __attribute__((ext_vector_type(4)));
typedef __bf16 bf16x2_t __attribute__((ext_vector_type(2)));
constexpr int AT_KB = 8320, AT_VB = 8192;
constexpr int AT_TILE = AT_KB + AT_VB, AT_NT = 6, AT_IMP = AT_NT * AT_TILE, AT_SEL = AT_IMP + 16384, AT_SELU = AT_SEL + 512, AT_CNT = AT_SELU + 16;
__device__ __forceinline__ int at_koff(int slot, int sub) { return (2 * slot + sub) * AT_TILE; }
__device__ __forceinline__ int at_voff(int slot, int sub) { return (2 * slot + sub) * AT_TILE + AT_KB; }
__device__ __forceinline__ void ring_wait(LAS unsigned* p, unsigned target) { while (__hip_atomic_load(p, __ATOMIC_ACQUIRE, __HIP_MEMORY_SCOPE_WORKGROUP) < target) __builtin_amdgcn_s_sleep(1); }
__device__ __forceinline__ void ring_signal(LAS unsigned* p, int lane) { if (lane == 0) (void)__hip_atomic_fetch_add(p, 1u, __ATOMIC_RELEASE, __HIP_MEMORY_SCOPE_WORKGROUP); }
constexpr float AT_C2 = 0.125f * 1.4426950408889634f, AT_THR = 6.0f;
__device__ __forceinline__ unsigned cvtpk_bf16(float lo, float hi) { f32x2 v = {lo, hi}; bf16x2_t b = __builtin_convertvector(v, bf16x2_t); return __builtin_bit_cast(unsigned, b); }
__device__ __forceinline__ int crow(int r, int h) { return (r & 3) + 8 * (r >> 2) + 4 * h; }
__device__ __forceinline__ float max3f_(float a, float b, float c) { float r; asm("v_max3_f32 %0, %1, %2, %3" : "=v"(r) : "v"(a), "v"(b), "v"(c)); return r; }
__device__ __forceinline__ float swap32_max(float x) { auto rr = __builtin_amdgcn_permlane32_swap(__builtin_bit_cast(unsigned, x), __builtin_bit_cast(unsigned, x), false, false); float a = __builtin_bit_cast(float, rr[0]), b = __builtin_bit_cast(float, rr[1]); float r; asm("v_max_f32_e32 %0, %1, %2" : "=v"(r) : "v"(a), "v"(b)); return r; }
__device__ __forceinline__ float swap32_sum(float x) { auto rr = __builtin_amdgcn_permlane32_swap(__builtin_bit_cast(unsigned, x), __builtin_bit_cast(unsigned, x), false, false); return __builtin_bit_cast(float, rr[0]) + __builtin_bit_cast(float, rr[1]); }
struct AtRegs { u32x4 k, v; };
__device__ __forceinline__ AtRegs at_load_bf16(const bf16* kp, const bf16* vp, int tid) {
    AtRegs r; const int key = tid >> 3, c = tid & 7;
    if (ABL_ON(8)) { r.k = (u32x4){1u, 2u, 3u, 4u}; r.v = r.k; return r; }
    r.k = *(const u32x4*)(kp + (size_t)key * P1W + 8 * c); r.v = *(const u32x4*)(vp + (size_t)key * P1W + 8 * c); return r;
}
__device__ __forceinline__ AtRegs at_load_f32(const float* kp, const float* vp, int n0, int tid) {
    AtRegs r; const int key = tid >> 3, c = tid & 7; const int n = n0 + key;
    if (n < 255) { const f32x4 a0 = *(const f32x4*)(kp + (size_t)n * 64 + 8 * c), a1 = *(const f32x4*)(kp + (size_t)n * 64 + 8 * c + 4), b0 = *(const f32x4*)(vp + (size_t)n * 64 + 8 * c), b1 = *(const f32x4*)(vp + (size_t)n * 64 + 8 * c + 4);
        r.k = (u32x4){pk2(a0.x, a0.y), pk2(a0.z, a0.w), pk2(a1.x, a1.y), pk2(a1.z, a1.w)}; r.v = (u32x4){pk2(b0.x, b0.y), pk2(b0.z, b0.w), pk2(b1.x, b1.y), pk2(b1.z, b1.w)}; }
    else { r.k = (u32x4){0u, 0u, 0u, 0u}; r.v = (u32x4){0u, 0u, 0u, 0u}; }
    return r;
}
__device__ __forceinline__ void at_store(LAS unsigned char* lds, int slot, int sub, const AtRegs& r, int tid) {
    const int key = tid >> 3, c = tid & 7;
    *(LAS u32x4*)(lds + at_koff(slot, sub) + c * 1040 + key * 16) = r.k;
    *(LAS u32x4*)(lds + at_voff(slot, sub) + (c >> 2) * 4096 + key * 64 + (c & 3) * 16) = r.v;
}
__device__ __forceinline__ void at_qk(f32x16& p0, f32x16& p1, const LAS unsigned char* kb, const bf16x8 (&qr)[4], int r32, int h) {
    const f32x16 z = {0.f, 0.f, 0.f, 0.f, 0.f, 0.f, 0.f, 0.f, 0.f, 0.f, 0.f, 0.f, 0.f, 0.f, 0.f, 0.f};
    bf16x8 kf[8];
#pragma unroll
    for (int d0 = 0; d0 < 4; ++d0) { kf[2 * d0] = *(const LAS bf16x8*)(kb + (2 * d0 + h) * 1040 + r32 * 16); kf[2 * d0 + 1] = *(const LAS bf16x8*)(kb + (2 * d0 + h) * 1040 + (32 + r32) * 16); }
    __builtin_amdgcn_sched_barrier(0);
    p0 = __builtin_amdgcn_mfma_f32_32x32x16_bf16(kf[0], qr[0], z, 0, 0, 0); p1 = __builtin_amdgcn_mfma_f32_32x32x16_bf16(kf[1], qr[0], z, 0, 0, 0);
#pragma unroll
    for (int d0 = 1; d0 < 4; ++d0) { p0 = __builtin_amdgcn_mfma_f32_32x32x16_bf16(kf[2 * d0], qr[d0], p0, 0, 0, 0); p1 = __builtin_amdgcn_mfma_f32_32x32x16_bf16(kf[2 * d0 + 1], qr[d0], p1, 0, 0, 0); }
}
__device__ __forceinline__ void at_step(const LAS unsigned char* lds, int slot, int sub, const bf16x8 (&qr)[4], f32x16 (&o)[2], float& m, float& l, u64 vm, int lane) {
    if (!__any(vm != 0ull)) return;
    const int r32 = lane & 31, h = lane >> 5;
    f32x16 p0, p1;
    if (!ABL_ON(4)) at_qk(p0, p1, lds + at_koff(slot, sub), qr, r32, h); else { for (int r = 0; r < 16; ++r) { p0[r] = 0.f; p1[r] = 0.f; } }
    const LAS unsigned char* vb = lds + at_voff(slot, sub) + ((lane >> 4) & 1) * 32 + (lane & 3) * 8 + (4 * h + ((lane & 15) >> 2)) * 64;
    s16x4 tlo[8], thi[8];
#pragma unroll
    for (int i = 0; i < 8; ++i) { tlo[i] = __builtin_bit_cast(s16x4, __builtin_amdgcn_ds_read_tr16_b64_v4i16((LAS s16x4*)(vb + (i & 1) * 4096 + (i >> 1) * 1024)));
        thi[i] = __builtin_bit_cast(s16x4, __builtin_amdgcn_ds_read_tr16_b64_v4i16((LAS s16x4*)(vb + (i & 1) * 4096 + (i >> 1) * 1024 + 512))); }
    __builtin_amdgcn_sched_barrier(0);
    const bool full = __all(vm == ~0ull);
    const unsigned vlo = (unsigned)vm, vhi = (unsigned)(vm >> 32);
    if (!full && !ABL_ON(16)) {
#pragma unroll
        for (int r = 0; r < 16; ++r) { const int kx = crow(r, h); p0[r] = ((vlo >> kx) & 1u) ? p0[r] : -INFINITY; p1[r] = ((vhi >> kx) & 1u) ? p1[r] : -INFINITY; }
    }
    float rm = fmaxf(p0[0], p1[0]);
#pragma unroll
    for (int r = 1; r < 16; ++r) rm = fmaxf(rm, fmaxf(p0[r], p1[r]));
    rm *= AT_C2;
    rm = fmaxf(rm, __shfl_xor(rm, 32));
    if (__any(rm > m + AT_THR)) { const float mn = fmaxf(m, rm); const float f = __builtin_amdgcn_exp2f(m - mn); m = mn; l *= f;
#pragma unroll
        for (int r = 0; r < 16; ++r) { o[0][r] *= f; o[1][r] *= f; } }
    const float nm = -m; float ls = 0.f;
#pragma unroll
    for (int r = 0; r < 16; ++r) { if (!ABL_ON(1)) { p0[r] = __builtin_amdgcn_exp2f(__builtin_fmaf(p0[r], AT_C2, nm)); p1[r] = __builtin_amdgcn_exp2f(__builtin_fmaf(p1[r], AT_C2, nm)); } ls += p0[r] + p1[r]; }
    l += ls;
    __builtin_amdgcn_sched_barrier(0);
#pragma unroll
    for (int ks = 0; ks < 4; ++ks) {
        u32x4 pw;
        if (ks == 0) pw = (u32x4){cvtpk_bf16(p0[0], p0[1]), cvtpk_bf16(p0[2], p0[3]), cvtpk_bf16(p0[4], p0[5]), cvtpk_bf16(p0[6], p0[7])};
        else if (ks == 1) pw = (u32x4){cvtpk_bf16(p0[8], p0[9]), cvtpk_bf16(p0[10], p0[11]), cvtpk_bf16(p0[12], p0[13]), cvtpk_bf16(p0[14], p0[15])};
        else if (ks == 2) pw = (u32x4){cvtpk_bf16(p1[0], p1[1]), cvtpk_bf16(p1[2], p1[3]), cvtpk_bf16(p1[4], p1[5]), cvtpk_bf16(p1[6], p1[7])};
        else pw = (u32x4){cvtpk_bf16(p1[8], p1[9]), cvtpk_bf16(p1[10], p1[11]), cvtpk_bf16(p1[12], p1[13]), cvtpk_bf16(p1[14], p1[15])};
        const bf16x8 pf = __builtin_bit_cast(bf16x8, pw);
#pragma unroll
        for (int db = 0; db < 2; ++db) { const int i = 2 * ks + db;
            const bf16x8 vf = (bf16x8){tlo[i][0], tlo[i][1], tlo[i][2], tlo[i][3], thi[i][0], thi[i][1], thi[i][2], thi[i][3]};
            if (!ABL_ON(2)) o[db] = __builtin_amdgcn_mfma_f32_32x32x16_bf16(vf, pf, o[db], 0, 0, 0); else asm volatile("" :: "v"(vf), "v"(pf)); }
    }
}
__device__ __forceinline__ void at_fold(f32x16 (&ot)[2], f32x16 (&o)[2], float& m, float& l, float gate, bool valid) {
    const float lt = l + __shfl_xor(l, 32); const float inv = (valid && lt > 0.f) ? gate / lt : 0.f;
#pragma unroll
    for (int r = 0; r < 16; ++r) { ot[0][r] += o[0][r] * inv; ot[1][r] += o[1][r] * inv; o[0][r] = 0.f; o[1][r] = 0.f; }
    m = -1e30f; l = 0.f;
}
__device__ __forceinline__ void attn_unit_mfma(LAS unsigned char* lds, bf16* P1, const float* KC, int unit) {
    const int tid = opaque_tid(); const int lane = tid & 63, w = __builtin_amdgcn_readfirstlane(tid >> 6), r32 = lane & 31, h = lane >> 5;
    const int ti = unit & 63, g = (unit >> 6) & 1, b = unit >> 7;
    const int tq = 8 * w + (r32 >> 2), j = r32 & 3, hd = 4 * g + j; const int ts = 64 * ti + tq;
    const size_t row = (size_t)b * SEQ + ts;
    LAS float* IMP = (LAS float*)(lds + AT_IMP); LAS u64* SEL = (LAS u64*)(lds + AT_SEL); LAS unsigned* SELU = (LAS unsigned*)(lds + AT_SELU);
    __syncthreads();
    for (int e = tid; e < 4096; e += 512) IMP[e] = 0.f;
    if (tid < 2) SELU[tid] = 0u;
    if (tid < 16) ((LAS unsigned*)(lds + AT_CNT))[tid] = 0u;
    bf16x8 qr[4];
    { const bf16* qp = P1 + row * P1W + C_Q + hd * 64 + 8 * h;
#pragma unroll
      for (int d0 = 0; d0 < 4; ++d0) qr[d0] = *(const bf16x8*)(qp + 16 * d0); }
    const float g0 = bf2f(P1[row * P1W + C_GC + hd * 3 + 0]), g1 = bf2f(P1[row * P1W + C_GC + hd * 3 + 1]), g2 = bf2f(P1[row * P1W + C_GC + hd * 3 + 2]);
    f32x16 o[2], ot[2];
#pragma unroll
    for (int r = 0; r < 16; ++r) { o[0][r] = 0.f; o[1][r] = 0.f; ot[0][r] = 0.f; ot[1][r] = 0.f; }
    float m = -1e30f, l = 0.f;
    const int nv = (ts >= 31) ? ((((ts + 1) >> 4) - 1 > 255) ? 255 : ((ts + 1) >> 4) - 1) : 0;
    const int nkt = (4 * ti + 3 + 63) >> 6;
    const float* kcp = KC + ((((size_t)0 * NB + b) * 2 + g) * 256) * 64; const float* vcp = KC + ((((size_t)1 * NB + b) * 2 + g) * 256) * 64;
    {   const int np = (nkt + 1) >> 1;
        AtRegs ra = at_load_f32(kcp, vcp, 0, tid), rb = ra; if (nkt > 1) rb = at_load_f32(kcp, vcp, 64, tid);
        at_store(lds, 0, 0, ra, tid); if (nkt > 1) at_store(lds, 0, 1, rb, tid); __syncthreads();
        for (int pi = 0; pi < np; ++pi) {
            const int k0 = 2 * pi, k2 = 2 * pi + 2;
            if (k2 < nkt) { ra = at_load_f32(kcp, vcp, 64 * k2, tid); if (k2 + 1 < nkt) rb = at_load_f32(kcp, vcp, 64 * (k2 + 1), tid); }
            at_step(lds, pi & 1, 0, qr, o, m, l, mask_lo(nv - 64 * k0), lane);
            if (k0 + 1 < nkt) at_step(lds, pi & 1, 1, qr, o, m, l, mask_lo(nv - 64 * (k0 + 1)), lane);
            if (k2 < nkt) { at_store(lds, (pi + 1) & 1, 0, ra, tid); if (k2 + 1 < nkt) at_store(lds, (pi + 1) & 1, 1, rb, tid); }
            __syncthreads();
        }
        const float lt = l + __shfl_xor(l, 32); const float invl = (nv > 0 && lt > 0.f) ? 1.f / lt : 0.f;
        float prevL = 0.f;
        ra = at_load_f32(kcp, vcp, 0, tid); if (nkt > 1) rb = at_load_f32(kcp, vcp, 64, tid);
        at_store(lds, 0, 0, ra, tid); if (nkt > 1) at_store(lds, 0, 1, rb, tid); __syncthreads();
        for (int pi = 0; pi < np; ++pi) {
            const int k2 = 2 * pi + 2;
            if (k2 < nkt) { ra = at_load_f32(kcp, vcp, 64 * k2, tid); if (k2 + 1 < nkt) rb = at_load_f32(kcp, vcp, 64 * (k2 + 1), tid); }
#pragma unroll 1
            for (int sub = 0; sub < 2; ++sub) {
                const int kt = 2 * pi + sub; if (kt >= nkt) break;
                f32x16 p0, p1; at_qk(p0, p1, lds + at_koff(pi & 1, sub), qr, r32, h);
                const u64 vm = mask_lo(nv - 64 * kt); const unsigned vlo = (unsigned)vm, vhi = (unsigned)(vm >> 32);
#pragma unroll
                for (int r = 0; r < 16; ++r) { const int kx = crow(r, h);
                    p0[r] = ((vlo >> kx) & 1u) ? __builtin_amdgcn_exp2f(p0[r] * AT_C2 - m) * invl : 0.f;
                    p1[r] = ((vhi >> kx) & 1u) ? __builtin_amdgcn_exp2f(p1[r] * AT_C2 - m) * invl : 0.f; }
#pragma unroll
                for (int hh = 0; hh < 2; ++hh) {
                    float G[4], Lp[4];
#pragma unroll
                    for (int q4 = 0; q4 < 4; ++q4) { const float a0 = hh ? p1[4 * q4] : p0[4 * q4], a1 = hh ? p1[4 * q4 + 1] : p0[4 * q4 + 1], a2 = hh ? p1[4 * q4 + 2] : p0[4 * q4 + 2], a3 = hh ? p1[4 * q4 + 3] : p0[4 * q4 + 3];
                        G[q4] = (a0 + a1) + (a2 + a3); Lp[q4] = __shfl_xor(a3, 32); }
#pragma unroll
                    for (int q4 = 0; q4 < 4; ++q4) {
                        const float carry = h ? Lp[q4] : (q4 == 0 ? prevL : Lp[q4 - 1]);
                        float v = G[q4] + carry; v += __shfl_xor(v, 1); v += __shfl_xor(v, 2);
                        if (j == 0) IMP[tq * 64 + 16 * kt + 8 * hh + 2 * q4 + h] = v;
                    }
                    prevL = Lp[3];
                }
            }
            if (k2 < nkt) { at_store(lds, (pi + 1) & 1, 0, ra, tid); if (k2 + 1 < nkt) at_store(lds, (pi + 1) & 1, 1, rb, tid); }
            __syncthreads();
        }
    }
    at_fold(ot, o, m, l, g0, nv > 0);
    __syncthreads();
    const int cur = ti;
    FT0(3);
    {
        const int tok = tid >> 3, j8 = tid & 7; u64 selt = 1ull | (1ull << cur) | (cur >= 1 ? (1ull << (cur - 1)) : 0ull);
        float cv[8];
#pragma unroll
        for (int k = 0; k < 8; ++k) { const int mm = j8 + 8 * k; cv[k] = (mm >= 1 && mm <= cur - 2) ? IMP[tok * 64 + mm] : -1.f; }
        const int npick = (cur - 2) < 5 ? (cur - 2) : 5;
        for (int pk = 0; pk < npick; ++pk) { float best = -1.f; int bi = 64;
#pragma unroll
            for (int k = 0; k < 8; ++k) if (cv[k] > best) { best = cv[k]; bi = j8 + 8 * k; }
#pragma unroll
            for (int off = 1; off < 8; off <<= 1) { const float ov = __shfl_xor(best, off); const int oi = __shfl_xor(bi, off); if (ov > best || (ov == best && oi < bi)) { best = ov; bi = oi; } }
            selt |= 1ull << (bi & 63);
#pragma unroll
            for (int k = 0; k < 8; ++k) if (j8 + 8 * k == bi) cv[k] = -2.f; }
        if (j8 == 0) { SEL[tok] = selt; atomicOr((unsigned*)&SELU[0], (unsigned)selt); atomicOr((unsigned*)&SELU[1], (unsigned)(selt >> 32)); }
    }
    __syncthreads();
    FT1(3);
    const u64 sel = SEL[tq];
    const u64 selu = ((u64)SELU[1] << 32) | (u64)SELU[0];
    {
        const bf16* kb = P1 + (size_t)b * SEQ * P1W + C_KV + (2 * 2 + g) * 64; const bf16* vbp = P1 + (size_t)b * SEQ * P1W + C_KV + (3 * 2 + g) * 64;
        LAS unsigned* FIL = (LAS unsigned*)(lds + AT_CNT); LAS unsigned* DON = FIL + 8;
        const int n = __builtin_popcountll(selu);
        u64 remL = selu, remC = selu;
        {   AtRegs r0, r1, r2; int b0 = __builtin_ctzll(remL); remL &= remL - 1; r0 = at_load_bf16(kb + (size_t)b0 * 64 * P1W, vbp + (size_t)b0 * 64 * P1W, tid); r1 = r0; r2 = r0;
            if (n > 1) { const int b1 = __builtin_ctzll(remL); remL &= remL - 1; r1 = at_load_bf16(kb + (size_t)b1 * 64 * P1W, vbp + (size_t)b1 * 64 * P1W, tid); }
            if (n > 2) { const int b2 = __builtin_ctzll(remL); remL &= remL - 1; r2 = at_load_bf16(kb + (size_t)b2 * 64 * P1W, vbp + (size_t)b2 * 64 * P1W, tid); }
            at_store(lds, 0, 0, r0, tid); ring_signal(FIL + 0, lane);
            if (n > 1) { at_store(lds, 0, 1, r1, tid); ring_signal(FIL + 1, lane); }
            if (n > 2) { at_store(lds, 1, 0, r2, tid); ring_signal(FIL + 2, lane); } }
        AtRegs rg; rg.k = (u32x4){0u, 0u, 0u, 0u}; rg.v = rg.k;
        if (n > 3) { const int b3 = __builtin_ctzll(remL); remL &= remL - 1; rg = at_load_bf16(kb + (size_t)b3 * 64 * P1W, vbp + (size_t)b3 * 64 * P1W, tid); }
        int jc = 0, gc = 1, js = 3, gs = 0;
#pragma unroll 1
        for (int t = 0; t < n; ++t) {
            const int mbc = __builtin_ctzll(remC); remC &= remC - 1;
            if (t + 3 < n) {
                FT0(4); ring_wait(DON + js, 8u * (unsigned)gs); FT1(4);
                FT0(5); at_store(lds, js >> 1, js & 1, rg, tid); ring_signal(FIL + js, lane); FT1(5);
                if (t + 4 < n) { const int bn = __builtin_ctzll(remL); remL &= remL - 1; rg = at_load_bf16(kb + (size_t)bn * 64 * P1W, vbp + (size_t)bn * 64 * P1W, tid); }
            }
            FT0(6); ring_wait(FIL + jc, 8u * (unsigned)gc); FT1(6);
            u64 vm = 0ull; if ((sel >> mbc) & 1ull) vm = (mbc == cur) ? mask_lo((ts & 63) + 1) : ~0ull;
            FT0(7); at_step(lds, jc >> 1, jc & 1, qr, o, m, l, vm, lane); FT1(7);
            ring_signal(DON + jc, lane);
            if (++jc == 6) { jc = 0; ++gc; }
            if (++js == 6) { js = 0; ++gs; }
        }
        __syncthreads();
    }
    at_fold(ot, o, m, l, g1, true);
    {   const bf16* kb = P1 + (size_t)b * SEQ * P1W + C_KV + (4 * 2 + g) * 64; const bf16* vbp = P1 + (size_t)b * SEQ * P1W + C_KV + (5 * 2 + g) * 64;
        const int mlo = (ti >= 8) ? ti - 8 : 0; const int nw = cur - mlo + 1, np = (nw + 1) >> 1;
        AtRegs ra = at_load_bf16(kb + (size_t)mlo * 64 * P1W, vbp + (size_t)mlo * 64 * P1W, tid), rb = ra; if (nw > 1) rb = at_load_bf16(kb + (size_t)(mlo + 1) * 64 * P1W, vbp + (size_t)(mlo + 1) * 64 * P1W, tid);
        at_store(lds, 0, 0, ra, tid); if (nw > 1) at_store(lds, 0, 1, rb, tid); __syncthreads();
        for (int pi = 0; pi < np; ++pi) {
            const int i0 = 2 * pi, i2 = 2 * pi + 2;
            if (i2 < nw) { ra = at_load_bf16(kb + (size_t)(mlo + i2) * 64 * P1W, vbp + (size_t)(mlo + i2) * 64 * P1W, tid); if (i2 + 1 < nw) rb = at_load_bf16(kb + (size_t)(mlo + i2 + 1) * 64 * P1W, vbp + (size_t)(mlo + i2 + 1) * 64 * P1W, tid); }
#pragma unroll 1
            for (int sub = 0; sub < 2; ++sub) { const int mb = mlo + i0 + sub; if (i0 + sub >= nw) break;
                const int lo = ts - 511 - mb * 64, hi = ts - mb * 64;
                u64 vm = 0ull; if (hi >= 0 && lo <= 63) vm = mask_lo(hi + 1) & ~mask_lo(lo);
                at_step(lds, pi & 1, sub, qr, o, m, l, vm, lane); }
            if (i2 < nw) { at_store(lds, (pi + 1) & 1, 0, ra, tid); if (i2 + 1 < nw) at_store(lds, (pi + 1) & 1, 1, rb, tid); }
            __syncthreads();
        }
    }
    at_fold(ot, o, m, l, g2, true);
    {   bf16* op = P1 + row * P1W + C_Q + hd * 64 + 4 * h;
#pragma unroll
        for (int db = 0; db < 2; ++db)
#pragma unroll
            for (int q4 = 0; q4 < 4; ++q4) { u32x2 wv; wv.x = cvtpk_bf16(ot[db][4 * q4], ot[db][4 * q4 + 1]); wv.y = cvtpk_bf16(ot[db][4 * q4 + 2], ot[db][4 * q4 + 3]); GST(*(u32x2*)(op + 32 * db + 8 * q4) = wv); } }
}

__device__ __forceinline__ void set_dry(LAS unsigned char* l, int v) { __syncthreads(); if (threadIdx.x == 0) ((volatile LAS int*)(l + LDS_CTL + 64))[0] = v; __syncthreads(); }
constexpr int NPH = 1 + 9 * NL;
__global__ void __launch_bounds__(512, 2) fwd_kernel(Args args) {
    extern __shared__ __attribute__((aligned(16))) unsigned char lds_raw[];
    LAS unsigned char* ldsl = (LAS unsigned char*)lds_raw;
    float* ldsf = (float*)lds_raw;
    const int G0 = gridDim.x, bx0 = blockIdx.x, G = G0, bx = bx0, NGW = G * 8;
#define PHASE_IDS() const int tid = opaque_tid(), lane = tid & 63, wave = __builtin_amdgcn_readfirstlane(tid >> 6), gw = bx * 8 + wave; (void)lane; (void)gw
#define ws ARG_WS()
#define ctl ((unsigned*)(ws + WS_CTL))
#define H ARG_OUT()
#define XN ((bf16*)(ws + WS_XN))
#define P1 ((bf16*)(ws + WS_P1))
#define Rr ((bf16*)(ws + WS_R))
#define WIN ((bf16*)(ws + WS_WIN))
#define WB ((bf16*)(ws + WS_WB))
#define WOUT ((bf16*)(ws + WS_WOUT))
#define WGU ((bf16*)(ws + WS_WGU))
#define WD ((bf16*)(ws + WS_WD))
#define HID ((bf16*)(ws + WS_HID))
#define Y ((bf16*)(ws + WS_Y))
#define KC ((float*)(ws + WS_KC))
#define AGA ((float*)(ws + WS_LRUA))
#define AGH ((float*)(ws + WS_LRUH))
#define LIST ((unsigned*)(ws + WS_LIST))
#define LISTW ((float*)(ws + WS_LISTW))
    { PHASE_IDS(); for (int u = tid; u < (LDS_BYTES - LDS_CTL) / 4; u += 512) ((LAS unsigned*)(ldsl + LDS_CTL))[u] = 0u; }
    __syncthreads();
    if (!MK_SPLIT) (void)xcd_barrier_post(ctl + CW_BAR, (volatile LAS unsigned*)(ldsl + LDS_CTL + 32));
    const int lo = args.ph_lo, hi = args.ph_hi;
#define IN(k) (lo <= (k) && (k) < hi)
#if PROBE_PH >= 0
#ifndef PROBE_REAL
#define PROBE_REAL 0
#endif
#define PHASE_REP(id) for (int rep_ = 0; rep_ < (((id) == PROBE_PH) ? 2 : 1); ++rep_, set_dry(ldsl, 0)) if (set_dry(ldsl, PROBE_REAL ? 0 : rep_), true)
#else
#define PHASE_REP(id) if (true)
#endif
#define SEAM(k) do { if (!MK_SPLIT && IN((k) + 1)) { XcdBarrier bb_; bb_.bar = ctl + CW_BAR; bb_.x = xb_xcc_id(); bb_.st = (volatile LAS unsigned*)(ldsl + LDS_CTL + 32); \
    for (int r_ = 0; r_ < ((PROBE_PH == 50) ? 3 : 1); ++r_) xcd_barrier(bb_); } } while (0)

    if (IN(0)) PHASE_REP(100) {
        PHASE_IDS();
        float* scr = ldsf + wave * 4096;
        constexpr int IT_W1 = 32 * 2, IT_LW = 2, IT_PW = 2 * 4;
        constexpr int NSMALL = NL * 4 * IT_W1 + NL * 16 * IT_LW + NL * 4 * IT_PW;
        auto dec0 = [&](int it) -> TrItem {
            if (it < IT_BIG) return dec_big(it, 0);
            int r = it - IT_BIG;
            if (r < NL * 4 * IT_W1) { const int m = r / IT_W1; r -= m * IT_W1; return TrItem{ARG_IN(I_CW1) + (size_t)m * 2048 * 64, (bf16*)(ws + WS_W1T) + (size_t)m * 64 * 2048, 2048, 64, r / 2, r % 2, 0}; }
            r -= NL * 4 * IT_W1;
            if (r < NL * 16 * IT_LW) { const int m = r / IT_LW; r -= m * IT_LW; const int l = m >> 4, mat = (m >> 3) & 1, hh = m & 7;
                return TrItem{ARG_IN(mat ? I_LWX : I_LWA) + ((size_t)l * 8 + hh) * 4096, (bf16*)(ws + WS_LWT) + (size_t)m * 4096, 64, 64, 0, r, 0}; }
            r -= NL * 16 * IT_LW;
            { const int m = r / IT_PW; r -= m * IT_PW; return TrItem{ARG_IN(I_PW) + (size_t)m * 16384, (bf16*)(ws + WS_PWT) + (size_t)m * 16384, 128, 128, r / 4, r % 4, 0}; }
        };
        constexpr int NIT0 = IT_BIG + NSMALL;
        if (gw < NIT0) { TrItem cur = dec0(gw); TrRegs rv = tr_load(cur, lane);
            for (int it = gw; it < NIT0; it += NGW) { TrItem nxt = cur; TrRegs rn = rv; const bool more = it + NGW < NIT0;
                if (more) { nxt = dec0(it + NGW); rn = tr_load(nxt, lane); }
                tr_finish(cur, rv, scr, lane); cur = nxt; rv = rn; } }
        for (int e = bx * 512 + tid; e < NL * 232 * 128; e += G * 512) { const int l = e / (232 * 128), rr = (e / 128) % 232, c8 = (e % 128) * 8;
            GST(*(u32x4*)(WIN + ((size_t)l * NPROJ + C_GC + 24 + rr) * D + c8) = (u32x4){0u, 0u, 0u, 0u}); }
        for (int m = gw; m < T; m += 2 * NGW) norm_rows<0>(ARG_IN(I_X), H, nullptr, nullptr, ARG_IN(I_N1G), XN, m, m + NGW, m + NGW < T, lane);
    }
    SEAM(0);

    unsigned long long tacc_ = 0ull, tbeg_ = 0ull; (void)tacc_; (void)tbeg_;
#define TBEG(id) do { if (PROBE_T_LO >= 0 && (id) == PROBE_T_LO) tbeg_ = __builtin_amdgcn_s_memrealtime(); } while (0)
#define TEND(id) do { if (PROBE_T_LO >= 0 && (id) + 1 == PROBE_T_HI) tacc_ += __builtin_amdgcn_s_memrealtime() - tbeg_; } while (0)
    for (int l = 0; l < NL; ++l) {
        const int pb = 1 + 9 * l;
#define OPQ_S(x) ({ int t_ = (x); asm volatile("" : "+s"(t_)); t_; })
#undef bx
#undef G
        TBEG(0);
        if (IN(pb + 0)) PHASE_REP(0) {
            const int bxo = OPQ_S(bx0), Go = OPQ_S(G0); (void)bxo; (void)Go;
#define bx bxo
#define G Go
            SchedDense S{XN, WIN + (size_t)l * NPROJ * D, D, D, T / 256, NPROJ / 256, G, bx, nullptr, 0u, nullptr};
            EpiProj E{P1, Rr};
            pg8::gemm_phase<EpiProj, SchedDense, true>(ldsl, D, S, E);
        }
        SEAM(pb + 0); TEND(0);
#undef bx
#undef G
        TBEG(1);
        if (IN(pb + 1)) PHASE_REP(1) {
            const int bxo = OPQ_S(bx0), Go = OPQ_S(G0); (void)bxo; (void)Go;
#define bx bxo
#define G Go
            constexpr int U_LRU = NB * 64, U_GM = 128 * 2, U_CMP = 256;
            for (int u = bx; u < U_LRU + U_GM + U_CMP; u += G) {
                SUBT0(); const int ty_ = (u < U_CMP) ? 6 : (u < U_CMP + U_GM) ? 7 : 8; (void)ty_;
                if (u < U_CMP) cmp_unit2(ldsl, P1, KC, ARG_IN(I_PE) + (size_t)l * 2 * 2048, (const bf16*)(ws + WS_W1T) + (size_t)l * 4 * 64 * 2048, ARG_IN(I_CW2) + (size_t)l * 4 * 4096, u);
                else if (u < U_CMP + U_GM) gmlp_unit3(ldsl, P1, ARG_IN(I_GMNG) + l * 512, ARG_IN(I_GMWS) + (size_t)l * 4 * 16384, ARG_IN(I_GMB) + l * 512, u - U_CMP);
                else lru_unit2(ldsl, P1, XN, AGA, AGH, ARG_IN(I_CONVW) + l * 2048, ARG_IN(I_CONVB) + l * 512, (const bf16*)(ws + WS_LWT) + (size_t)(l * 2 + 0) * 8 * 4096, (const bf16*)(ws + WS_LWT) + (size_t)(l * 2 + 1) * 8 * 4096,
                               ARG_IN(I_LBA) + l * 512, ARG_IN(I_LBX) + l * 512, ARG_IN(I_LLAM) + l * 512, u - U_CMP - U_GM);
                SUBT1(ty_);
            }
            __syncthreads();
        }
        SEAM(pb + 1); TEND(1);
#undef bx
#undef G
        TBEG(2);
        if (IN(pb + 2)) PHASE_REP(2) {
            const int bxo = OPQ_S(bx0), Go = OPQ_S(G0); (void)bxo; (void)Go;
#define bx bxo
#define G Go
            constexpr int U_AT = NB * 2 * 64, U_PL = NB * 64 * 4, U_FX = NB * 64;
            const int U_CV = (l == 0 && NL > 1) ? (IT_BIG + 7) / 8 : 0;
            for (int u = bx; u < U_AT; u += G) {
                SUBT0(); const int ty_ = 1; (void)ty_;
                { const int k = u >> 3, bg = u & 7; const int ti = (u < 256) ? 63 - k : k - 32; attn_unit_mfma(ldsl, P1, KC, (bg << 6) | ti); }
                SUBT1(ty_);
            }
            {   const int NDYN = U_PL + U_FX + U_CV; unsigned* qctr = ctl + CW_Q + 64 * l; volatile LAS unsigned* qslot = (volatile LAS unsigned*)(ldsl + LDS_CTL + 192);
                unsigned nx = 0u; const bool ldr = (threadIdx.x == 0) && !is_dry();
                if (threadIdx.x == 0) nx = is_dry() ? (unsigned)NDYN : __hip_atomic_fetch_add(qctr, 1u, __ATOMIC_RELAXED, __HIP_MEMORY_SCOPE_AGENT);
                for (;;) {
                    __syncthreads(); if (threadIdx.x == 0) qslot[0] = nx; __syncthreads();
                    const int u = (int)qslot[0]; if (u >= NDYN) break;
                    if (ldr) nx = __hip_atomic_fetch_add(qctr, 1u, __ATOMIC_RELAXED, __HIP_MEMORY_SCOPE_AGENT);
                    SUBT0(); const int ty_ = (u < U_FX) ? 3 : (u < U_FX + U_PL) ? 2 : 4; (void)ty_;
                    if (u < U_FX) lrufix_unit2(ldsl, P1, XN, AGA, AGH, u);
                    else if (u < U_FX + U_PL) pool_unit2(ldsl, P1, (const bf16*)(ws + WS_PWT) + ((size_t)l * 4 + ((u - U_FX) & 3)) * 16384, ARG_IN(I_PS) + l * 512, u - U_FX);
                    else conv_unit(ldsf, u - U_FX - U_PL);
                    SUBT1(ty_);
                }
            }
            __syncthreads();
        }
        SEAM(pb + 2); TEND(2);
#undef bx
#undef G
        TBEG(3);
        if (IN(pb + 3)) PHASE_REP(3) {
            const int bxo = OPQ_S(bx0), Go = OPQ_S(G0); (void)bxo; (void)Go;
#define bx bxo
#define G Go
            SchedMerge S{P1, WB + (size_t)l * 4 * 1024 * 512, G, bx, ctl + CW_G2 + l * 4096};
            EpiMerge E{Rr, XN};
            pg8::gemm_phase<EpiMerge, SchedMerge, true>(ldsl, 512, S, E);
        }
        if (MK_SPLIT) { SEAM(pb + 3); } TEND(3);
#undef bx
#undef G
        TBEG(4);
        if (IN(pb + 4)) PHASE_REP(4) {
            const int bxo = OPQ_S(bx0), Go = OPQ_S(G0); (void)bxo; (void)Go;
#define bx bxo
#define G Go
            SchedDense S{XN, WOUT + (size_t)l * 1024 * 1024, D, D, T / 256, 4, G, bx, MK_SPLIT ? nullptr : ctl + CW_G2 + l * 4096, 32u, ctl};
            EpiWout E{(l == 0) ? ARG_IN(I_X) : (const float*)H, H};
            pg8::gemm_phase<EpiWout, SchedDense, true>(ldsl, D, S, E);
        }
        SEAM(pb + 4); TEND(4);
#undef bx
#undef G
        TBEG(5);
        if (IN(pb + 5)) PHASE_REP(5) {
            const int bxo = OPQ_S(bx0), Go = OPQ_S(G0); (void)bxo; (void)Go;
#define bx bxo
#define G Go
            PHASE_IDS();
            {   SUBT0();
                float* scr = ldsf + wave * 4096;
                constexpr int IT_G = 16 * 16, IT_D = 8 * 32;
                auto dec1 = [&](int it) -> TrItem {
                    const int e = it / (2 * IT_G + IT_D); int r = it % (2 * IT_G + IT_D);
                    if (r < IT_G) return TrItem{ARG_IN(I_MG) + ((size_t)l * 16 + e) * 1024 * 512, WGU + (size_t)e * 1024 * 1024, 1024, 512, r / 16, r % 16, 2};
                    if (r < 2 * IT_G) { r -= IT_G; return TrItem{ARG_IN(I_MU) + ((size_t)l * 16 + e) * 1024 * 512, WGU + (size_t)e * 1024 * 1024, 1024, 512, r / 16, r % 16, 3}; }
                    r -= 2 * IT_G; return TrItem{ARG_IN(I_MD) + ((size_t)l * 16 + e) * 512 * 1024, WD + (size_t)e * 1024 * 512, 512, 1024, r / 32, r % 32, 0};
                };
                constexpr int NIT1 = 16 * (2 * IT_G + IT_D);
                if (gw < NIT1) { TrItem cur = dec1(gw); TrRegs rv = tr_load(cur, lane);
                    for (int it = gw; it < NIT1; it += NGW) { TrItem nxt = cur; TrRegs rn = rv; const bool more = it + NGW < NIT1;
                        if (more) { nxt = dec1(it + NGW); rn = tr_load(nxt, lane); }
                        tr_finish(cur, rv, scr, lane); cur = nxt; rv = rn; } }
                SUBT1(4);
            }
            SUBT0();
            __syncthreads();
            for (int k = tid; k < 1024; k += 512) { const f32x4 wg = *(const f32x4*)(ARG_IN(I_RWG) + (size_t)l * 4096 + k * 4); const float* we = ARG_IN(I_RWE) + (size_t)l * 16384 + k * 16;
                const f32x4 e0 = *(const f32x4*)we, e1 = *(const f32x4*)(we + 4), e2 = *(const f32x4*)(we + 8), e3 = *(const f32x4*)(we + 12);
                ldsf[0 * 1024 + k] = wg.x; ldsf[1 * 1024 + k] = wg.y; ldsf[2 * 1024 + k] = wg.z; ldsf[3 * 1024 + k] = wg.w;
                ldsf[4 * 1024 + k] = e0.x; ldsf[5 * 1024 + k] = e0.y; ldsf[6 * 1024 + k] = e0.z; ldsf[7 * 1024 + k] = e0.w; ldsf[8 * 1024 + k] = e1.x; ldsf[9 * 1024 + k] = e1.y; ldsf[10 * 1024 + k] = e1.z; ldsf[11 * 1024 + k] = e1.w;
                ldsf[12 * 1024 + k] = e2.x; ldsf[13 * 1024 + k] = e2.y; ldsf[14 * 1024 + k] = e2.z; ldsf[15 * 1024 + k] = e2.w; ldsf[16 * 1024 + k] = e3.x; ldsf[17 * 1024 + k] = e3.y; ldsf[18 * 1024 + k] = e3.z; ldsf[19 * 1024 + k] = e3.w; }
            __syncthreads();
            const float* g2 = ARG_IN(I_N2G) + l * D; const float* bg = ARG_IN(I_RBG) + l * 4; const float* be = ARG_IN(I_RBE) + l * 16;
            unsigned* cnt = ctl + CW_CNT + 64 * l;
            LAS unsigned* hist = (LAS unsigned*)(ldsl + 81920); LAS unsigned* baseL = hist + 16; LAS unsigned* rinfo = hist + 32;
            for (int ck = bx; ck < T / 64; ck += G) {
              if (tid < 16) hist[tid] = 0u;
              __syncthreads();
              f32x4 vnx[2][4];
#pragma unroll
              for (int rr = 0; rr < 2; ++rr) { const float* hr0 = H + (size_t)(ck * 64 + wave * 8 + rr) * D;
#pragma unroll
                for (int jj = 0; jj < 4; ++jj) vnx[rr][jj] = *(const f32x4*)(hr0 + 4 * lane + 256 * jj); }
#pragma unroll 1
              for (int ri = 0; ri < 8; ri += 2) { const int rl = wave * 8 + ri; const int m = ck * 64 + rl;
                f32x4 v[2][4];
#pragma unroll
                for (int rr = 0; rr < 2; ++rr)
#pragma unroll
                    for (int jj = 0; jj < 4; ++jj) v[rr][jj] = vnx[rr][jj];
                if (ri + 2 < 8) {
#pragma unroll
                    for (int rr = 0; rr < 2; ++rr) { const float* hr1 = H + (size_t)(m + 2 + rr) * D;
#pragma unroll
                        for (int jj = 0; jj < 4; ++jj) vnx[rr][jj] = *(const f32x4*)(hr1 + 4 * lane + 256 * jj); } }
#pragma unroll
                for (int rr = 0; rr < 2; ++rr) { float ss = 0.f;
#pragma unroll
                    for (int jj = 0; jj < 4; ++jj) ss += (v[rr][jj].x * v[rr][jj].x + v[rr][jj].y * v[rr][jj].y) + (v[rr][jj].z * v[rr][jj].z + v[rr][jj].w * v[rr][jj].w);
                    const float rstd = rsqrtf(wave_sum(ss) * (1.f / D) + EPS);
#pragma unroll
                    for (int jj = 0; jj < 4; ++jj) { const f32x4 gg = *(const f32x4*)(g2 + 4 * lane + 256 * jj); v[rr][jj].x *= rstd * gg.x; v[rr][jj].y *= rstd * gg.y; v[rr][jj].z *= rstd * gg.z; v[rr][jj].w *= rstd * gg.w;
                        u32x2 o; o.x = pk2(v[rr][jj].x, v[rr][jj].y); o.y = pk2(v[rr][jj].z, v[rr][jj].w); GST(*(u32x2*)(XN + (size_t)(m + rr) * D + 4 * lane + 256 * jj) = o); } }
                float lg[2][20];
#pragma unroll
                for (int o = 0; o < 20; ++o) { float a0 = 0.f, a1 = 0.f;
#pragma unroll
                    for (int jj = 0; jj < 4; ++jj) { const f32x4 wv = *(const f32x4*)(ldsf + o * 1024 + 4 * lane + 256 * jj);
                        a0 += v[0][jj].x * wv.x + v[0][jj].y * wv.y + v[0][jj].z * wv.z + v[0][jj].w * wv.w; a1 += v[1][jj].x * wv.x + v[1][jj].y * wv.y + v[1][jj].z * wv.z + v[1][jj].w * wv.w; }
                    lg[0][o] = wave_sum(a0); lg[1][o] = wave_sum(a1); if ((o & 3) == 3) __builtin_amdgcn_sched_barrier(0); }
#pragma unroll
                for (int rr = 0; rr < 2; ++rr) {
                float gl[4]; int grp = 0; float gmx;
#pragma unroll
                for (int k = 0; k < 4; ++k) gl[k] = lg[rr][k] + bg[k];
                gmx = gl[0];
#pragma unroll
                for (int k = 1; k < 4; ++k) if (gl[k] > gmx) { gmx = gl[k]; grp = k; }
                float den = 0.f;
#pragma unroll
                for (int k = 0; k < 4; ++k) den += __expf(gl[k] - gmx);
                const float grpw = 1.f / den;
                float el[4];
#pragma unroll
                for (int k = 0; k < 4; ++k) { float vsel = 0.f;
#pragma unroll
                    for (int gg = 0; gg < 4; ++gg) vsel = (grp == gg) ? (lg[rr][4 + gg * 4 + k] + be[gg * 4 + k]) : vsel;
                    el[k] = vsel; }
                int i1 = 0; float m1 = el[0];
#pragma unroll
                for (int k = 1; k < 4; ++k) if (el[k] > m1) { m1 = el[k]; i1 = k; }
                int i2 = -1; float m2 = 0.f;
#pragma unroll
                for (int k = 0; k < 4; ++k) if (k != i1 && (i2 < 0 || el[k] > m2)) { m2 = el[k]; i2 = k; }
                const float ex = __expf(m2 - m1); const float w1 = grpw / (1.f + ex), w2 = grpw * ex / (1.f + ex);
                if (lane == 0) {
                    const int e1 = grp * 4 + i1, e2 = grp * 4 + i2; const int rq = rl + rr;
                    const unsigned p1 = atomicAdd((unsigned*)&hist[e1], 1u), p2 = atomicAdd((unsigned*)&hist[e2], 1u);
                    rinfo[rq * 4 + 0] = (unsigned)e1 | ((unsigned)e2 << 8); rinfo[rq * 4 + 1] = p1 | (p2 << 16); rinfo[rq * 4 + 2] = __builtin_bit_cast(unsigned, w1); rinfo[rq * 4 + 3] = __builtin_bit_cast(unsigned, w2);
                }
                }
              }
              __syncthreads();
              if (tid < 16) { const unsigned hc = hist[tid]; baseL[tid] = (hc && !is_dry()) ? atomicAdd(&cnt[tid], hc) : 0u; }
              __syncthreads();
              if (tid < 64 && !is_dry()) { const unsigned ee = rinfo[tid * 4 + 0], pp = rinfo[tid * 4 + 1]; const unsigned e1 = ee & 255u, e2 = ee >> 8; const unsigned m = (unsigned)(ck * 64 + tid);
                  const size_t q1 = (size_t)e1 * T + baseL[e1] + (pp & 0xffffu), q2 = (size_t)e2 * T + baseL[e2] + (pp >> 16);
                  LIST[q1] = m; LISTW[q1] = __builtin_bit_cast(float, rinfo[tid * 4 + 2]); LIST[q2] = m | (1u << 14); LISTW[q2] = __builtin_bit_cast(float, rinfo[tid * 4 + 3]); }
              __syncthreads();
            }
            SUBT1(5);
        }
        SEAM(pb + 5); TEND(5);
#undef bx
#undef G
        TBEG(6);
        if (IN(pb + 6) || IN(pb + 7)) {
            __syncthreads();
            if (threadIdx.x == 0) { LAS int* tw = (LAS int*)(ldsl + LDS_MOE); int acc = 0;
                for (int e = 0; e < 16; ++e) { const int c = (int)__hip_atomic_load(ctl + CW_CNT + 64 * l + e, __ATOMIC_RELAXED, __HIP_MEMORY_SCOPE_AGENT); tw[e] = acc; tw[32 + e] = c; acc += (c + 255) >> 8; }
                tw[16] = acc; }
            __syncthreads();
        }
        if (IN(pb + 6)) PHASE_REP(6) {
            const int bxo = OPQ_S(bx0), Go = OPQ_S(G0); (void)bxo; (void)Go;
#define bx bxo
#define G Go
            SchedMoe S{XN, WGU, LIST, D, D, 1024, G, bx, true, ctl + CW_E1 + l * 16384, ctl};
            EpiGateUp E{HID, LISTW};
            pg8::gemm_phase<EpiGateUp, SchedMoe, true>(ldsl, D, S, E);
        }
        if (MK_SPLIT) { SEAM(pb + 6); } TEND(6);
#undef bx
#undef G
        TBEG(7);
        if (IN(pb + 7)) PHASE_REP(7) {
            const int bxo = OPQ_S(bx0), Go = OPQ_S(G0); (void)bxo; (void)Go;
#define bx bxo
#define G Go
            SchedMoe S{HID, WD, LIST, 512, 512, 1024, G, bx, false, ctl + CW_E1 + l * 16384, ctl};
            EpiDown E{Y, LIST};
            pg8::gemm_phase<EpiDown, SchedMoe, true>(ldsl, 512, S, E);
        }
        SEAM(pb + 7); TEND(7);
#undef bx
#undef G
        TBEG(8);
        if (IN(pb + 8)) PHASE_REP(8) {
            const int bxo = OPQ_S(bx0), Go = OPQ_S(G0); (void)bxo; (void)Go;
#define bx bxo
#define G Go
            PHASE_IDS();
            if (l + 1 < NL) { for (int m = gw; m < T; m += 2 * NGW) norm_rows<1>(nullptr, H, Y, Y + (size_t)T * D, ARG_IN(I_N1G) + (l + 1) * D, XN, m, m + NGW, m + NGW < T, lane); }
            else { for (int m = gw; m < T; m += 2 * NGW) norm_rows<2>(nullptr, H, Y, Y + (size_t)T * D, ARG_IN(I_FNG), nullptr, m, m + NGW, m + NGW < T, lane); }
        }
        if (l + 1 < NL) SEAM(pb + 8);
        TEND(8);
    }
#undef bx
#undef G
#ifdef PROBE_FINE
    tacc_ += *(volatile LAS unsigned long long*)(ldsl + LDS_CTL + 128);
#endif
    if (PROBE_T_LO >= 0 && bx == PROBE_BLK) { const unsigned long long tgt = __builtin_amdgcn_s_memrealtime() + PROBE_T_MULT * tacc_; while (__builtin_amdgcn_s_memrealtime() < tgt) __builtin_amdgcn_s_sleep(16); }
#undef IN
#undef SEAM
#undef ws
#undef ctl
#undef H
#undef XN
#undef P1
#undef Rr
#undef WIN
#undef WB
#undef WOUT
#undef WGU
#undef WD
#undef HID
#undef Y
#undef KC
#undef AGA
#undef AGH
#undef LIST
#undef LISTW
}

extern "C" void kernel_launch(void* const* d_in, const int* in_sizes, int n_in, void* d_out, int out_size, void* d_ws, size_t ws_size, hipStream_t stream) {
    static int grid = 0;
    if (grid == 0) {
        if (n_in != 29 || in_sizes[0] != T * D || out_size != T * D || ws_size < WS_END) { fprintf(stderr, "kernel_launch: unexpected shapes / workspace (%d inputs, ws %zu < %zu); nothing launched\n", n_in, ws_size, (size_t)WS_END); grid = -1; return; }
        int dev = 0, cus = 0;
        if (hipGetDevice(&dev) != hipSuccess || hipDeviceGetAttribute(&cus, hipDeviceAttributeMultiprocessorCount, dev) != hipSuccess) { grid = -1; return; }
        if (hipFuncSetAttribute((const void*)fwd_kernel, hipFuncAttributeMaxDynamicSharedMemorySize, LDS_BYTES) != hipSuccess) { fprintf(stderr, "kernel_launch: hipFuncSetAttribute failed\n"); grid = -1; return; }
        int per_cu = 0;
        if (hipOccupancyMaxActiveBlocksPerMultiprocessor(&per_cu, (const void*)fwd_kernel, 512, LDS_BYTES) != hipSuccess || per_cu < 1) { fprintf(stderr, "kernel_launch: occupancy query says %d\n", per_cu); }
        (void)hipGetLastError();
        grid = cus;
    }
    if (grid < 0) return;
    if (hipMemsetAsync((char*)d_ws + WS_CTL, 0, CTL_ZERO_BYTES, stream) != hipSuccess) return;
    Args a{};
    for (int i = 0; i < 29; ++i) a.in[i] = (const float*)d_in[i];
    a.out = (float*)d_out; a.ws = (unsigned char*)d_ws;
#if MK_SPLIT
    for (int p = 0; p < NPH; ++p) { a.ph_lo = p; a.ph_hi = p + 1; hipLaunchKernelGGL(fwd_kernel, dim3(grid), dim3(512), LDS_BYTES, stream, a); }
#else
    a.ph_lo = 0; a.ph_hi = NPH;
    hipLaunchKernelGGL(fwd_kernel, dim3(grid), dim3(512), LDS_BYTES, stream, a);
#endif
}
```

```cpp
#include <hip/hip_runtime.h>
#include <cstdio>
#include <cstdint>

#define GAS __attribute__((address_space(1)))
#define LAS __attribute__((address_space(3)))
typedef unsigned short bf16;
typedef unsigned u32x4 __attribute__((ext_vector_type(4)));
typedef unsigned u32x2 __attribute__((ext_vector_type(2)));
typedef float f32x4 __attribute__((ext_vector_type(4)));
typedef float f32x2 __attribute__((ext_vector_type(2)));
typedef short bf16x8 __attribute__((ext_vector_type(8)));
typedef unsigned long long u64;

#ifndef MK_SPLIT
#define MK_SPLIT 0
#endif

constexpr int NB = 4, SEQ = 4096, T = NB * SEQ, D = 1024, MIX = 512, NL = 2;
constexpr int NIN = 7960, NPROJ = 8192, P1W = 3904;
constexpr int C_U = 0, C_V = 512, C_GB = 1024, C_RB = 1536, C_Q = 2048, C_KV = 2560, C_XD = 3328, C_GC = 3840;
constexpr int SRC_GC = 3328, SRC_XD = 3352, SRC_MG = 3864;
constexpr float EPS = 1e-6f;
constexpr int NEXP = 16, DEXP = 512;
constexpr int HID_ROWS = 2 * T + 4096;

constexpr size_t MiB = 1u << 20;
constexpr size_t WS_CTL = 0, CTL_ZERO_BYTES = 1 * MiB;
constexpr size_t WS_KC = 1 * MiB;
constexpr size_t WS_LRUA = 2 * MiB;
constexpr size_t WS_LRUH = 2 * MiB + 512 * 1024;
constexpr size_t WS_LIST = 3 * MiB;
constexpr size_t WS_LISTW = 4 * MiB;
constexpr size_t WS_W1T = 5 * MiB;
constexpr size_t WS_LWT = 7 * MiB;
constexpr size_t WS_PWT = 7 * MiB + 256 * 1024;
constexpr size_t WS_WIN = 8 * MiB;
constexpr size_t WS_WB = 40 * MiB;
constexpr size_t WS_WOUT = 48 * MiB;
constexpr size_t WS_XN = 52 * MiB;
constexpr size_t WS_P1 = 84 * MiB;
constexpr size_t WS_R = 206 * MiB;
constexpr size_t WS_WGU = 84 * MiB;
constexpr size_t WS_WD = 116 * MiB;
constexpr size_t WS_HID = 132 * MiB;
constexpr size_t WS_Y = 168 * MiB;
constexpr size_t WS_END = 334 * MiB;
static_assert(WS_HID + (size_t)HID_ROWS * 512 * 2 <= WS_Y && WS_Y + (size_t)2 * T * 1024 * 2 <= WS_END && WS_P1 + (size_t)T * P1W * 2 <= WS_R && WS_R + (size_t)4 * T * 1024 * 2 <= WS_END, "ws map");

constexpr int CW_BAR = 4096;
constexpr int CW_CNT = 8192;
constexpr int CW_E1 = 16384;
constexpr int CW_G2 = 49152;
constexpr int CW_Q = 8448;

__device__ __forceinline__ unsigned f2bf(float f) { unsigned u = __builtin_bit_cast(unsigned, f); return (u + 0x7fffu + ((u >> 16) & 1u)) >> 16; }
typedef __bf16 bf16x2_hw __attribute__((ext_vector_type(2)));
__device__ __forceinline__ unsigned pk2(float lo, float hi) { f32x2 v = {lo, hi}; bf16x2_hw b = __builtin_convertvector(v, bf16x2_hw); return __builtin_bit_cast(unsigned, b); }
__device__ __forceinline__ float bflo(unsigned u) { return __builtin_bit_cast(float, u << 16); }
__device__ __forceinline__ float bfhi(unsigned u) { return __builtin_bit_cast(float, u & 0xffff0000u); }
__device__ __forceinline__ float bf2f(bf16 h) { return __builtin_bit_cast(float, (unsigned)h << 16); }
__device__ __forceinline__ float sigmoidf_(float x) { return __builtin_amdgcn_rcpf(1.0f + __builtin_amdgcn_exp2f(-1.4426950408889634f * x)); }
__device__ __forceinline__ float gelu_tanh(float x) { const float z = 1.5957691216057308f * (x + 0.044715f * x * x * x); return x * sigmoidf_(z); }
__device__ __forceinline__ float dpp_add_(float v, const int ctrl, const int row_mask) {
    return v;
}
#define DPP_ADD(v, ctrl, rmask) ((v) + __builtin_bit_cast(float, __builtin_amdgcn_update_dpp(0, __builtin_bit_cast(int, (v)), (ctrl), (rmask), 0xf, false)))
__device__ __forceinline__ float wave_sum(float v) {
    v = DPP_ADD(v, 0xB1, 0xf);
    v = DPP_ADD(v, 0x4E, 0xf);
    v = DPP_ADD(v, 0x141, 0xf);
    v = DPP_ADD(v, 0x140, 0xf);
    v = DPP_ADD(v, 0x142, 0xa);
    v = DPP_ADD(v, 0x143, 0xc);
    return __builtin_bit_cast(float, __builtin_amdgcn_readlane(__builtin_bit_cast(int, v), 63));
}
__device__ __forceinline__ u64 mask_lo(int n) { return n >= 64 ? ~0ull : (n <= 0 ? 0ull : ((1ull << n) - 1ull)); }
#define LDS_WAIT() asm volatile("s_waitcnt lgkmcnt(0)" ::: "memory")
#ifndef PROBE_PH
#define PROBE_PH -1
#endif
#ifndef PROBE_T_LO
#define PROBE_T_LO -1
#define PROBE_T_HI -1
#endif
#define PROBE_T_MULT 4
#ifndef ABL
#define ABL 0
#endif
#define ABL_ON(bit) ((ABL & (bit)) && is_dry())
#ifndef PROBE_BLK
#define PROBE_BLK 0
#endif
#ifdef PROBE_SUB
#define SUBT0() const unsigned long long ts0_ = __builtin_amdgcn_s_memrealtime()
#define SUBT1(ty) do { __syncthreads(); if ((ty) == PROBE_SUB) tacc_ += __builtin_amdgcn_s_memrealtime() - ts0_; } while (0)
#else
#define SUBT0() do {} while (0)
#define SUBT1(ty) do {} while (0)
#endif

constexpr int LDS_BYTES = 147456;
constexpr int LDS_CTL = 146432;
constexpr int LDS_MOE = LDS_CTL + 256;
__device__ __forceinline__ bool is_dry() {
#if PROBE_PH >= 0
    extern __shared__ __attribute__((aligned(16))) unsigned char lds_raw_[]; return ((volatile LAS int*)((LAS unsigned char*)lds_raw_ + LDS_CTL + 64))[0] != 0;
#else
    return false;
#endif
}
#define GST(...) do { if (!is_dry()) { __VA_ARGS__; } } while (0)
#ifdef PROBE_FINE
#define FT0(id) unsigned long long ft0_##id = ((id) == PROBE_FINE) ? __builtin_amdgcn_s_memrealtime() : 0ull
#define FT1(id) do { if ((id) == PROBE_FINE && threadIdx.x == 0) { extern __shared__ __attribute__((aligned(16))) unsigned char lds_raw_f[]; volatile LAS unsigned long long* a_ = (volatile LAS unsigned long long*)((LAS unsigned char*)lds_raw_f + LDS_CTL + 128); *a_ = *a_ + (__builtin_amdgcn_s_memrealtime() - ft0_##id); } } while (0)
#else
#define FT0(id) do {} while (0)
#define FT1(id) do {} while (0)
#endif
__device__ __forceinline__ int opaque_tid() { int t = (int)threadIdx.x; asm volatile("" : "+v"(t)); return t; }

namespace pg8 {
constexpr int BM = 256, BK = 64, HALF = 128, HTB = HALF * BK * 2, NXCD = 8, WGM = 8;
__host__ __device__ __forceinline__ int lds_byte(int r, int c) { const int st = (r >> 4) * 2 + (c >> 5), rr = r & 15, cc = c & 31, ob = rr * 64 + cc * 2; return st * 1024 + (ob ^ (((ob >> 9) & 1) << 5)); }
__host__ __device__ __forceinline__ void stage_rc(int b, int& R, int& C) { const int st = b / 1024, sb = b % 1024, swz = sb ^ (((sb >> 9) & 1) << 5); R = (st >> 1) * 16 + swz / 64; C = (st & 1) * 32 + (swz % 64) / 2; }
__host__ __device__ __forceinline__ int perm32(int rho) { const int n = rho >> 4, i = rho & 15; return 8 * (i >> 2) + 4 * n + (i & 3); }

struct Unit { const char* A; const char* B; int pm, pn, sub, e; };

__device__ __forceinline__ bool static_tile(int i, int G, int c, int nM, int nN, int& pm, int& pn) {
    const int nwg = nM * nN; const long L = (long)i * G + c; if (L >= nwg) return false;
    int wgid = (int)L; { const int q = nwg / NXCD, r = nwg % NXCD, xcd = wgid % NXCD, off = wgid / NXCD; wgid = (xcd < r ? xcd * (q + 1) : r * (q + 1) + (xcd - r) * q) + off; }
    const int nig = WGM * nN, gid = wgid / nig, fm = gid * WGM, gsz = (nM - fm) < WGM ? (nM - fm) : WGM;
    pm = fm + ((wgid % nig) % gsz); pn = (wgid % nig) / gsz; return true;
}

template <class Epi, class Sched, bool ALIGN_EPI>
__device__ __forceinline__ void gemm_phase(LAS unsigned char* lds, const int K, const Sched& S, const Epi& E) {
    const int tid = opaque_tid(), wid = __builtin_amdgcn_readfirstlane(tid >> 6), lane = tid & 63, wr = wid >> 2, wc = wid & 3, fr = lane & 15, fq = lane >> 4;
    const int nt = K / BK;
    unsigned voffB[2];
#pragma unroll
    for (int i = 0; i < 2; ++i) { int R, C; stage_rc(tid * 16 + i * 8192, R, C); const int Rb = (R & ~31) + perm32(R & 31); voffB[i] = (unsigned)(Rb * K + C) * 2u; }
    const size_t kstep = (size_t)(BK * 2);
    const size_t hstepB = (size_t)HALF * K * 2;
    const unsigned ldsw = (unsigned)wid * 1024u;
    const int aoff = lds_byte(wr * 64 + fr, fq * 8), boff = lds_byte(wc * 32 + fr, fq * 8);
#define PG8_SA(b, h) (((b) * 2 + (h)) * HTB)
#define PG8_SB(b, h) ((4 + (b) * 2 + (h)) * HTB)
#define PG8_STAGE(bufoff, gbase, voff) do { _Pragma("unroll") for (int _i = 0; _i < 2; ++_i) \
        __builtin_amdgcn_global_load_lds((const unsigned*)((const char*)(gbase) + (voff)[_i]), (LAS unsigned*)(lds + (bufoff) + ldsw + _i * 8192), 16, 0, 0); } while (0)
#define PG8_LDA(dst, b, h) do { _Pragma("unroll") for (int m = 0; m < 4; ++m) _Pragma("unroll") for (int k = 0; k < 2; ++k) dst[m][k] = *(const LAS bf16x8*)(lds + PG8_SA(b, h) + aoff + m * 2048 + k * 1024); } while (0)
#define PG8_LDB(dst, b, h) do { _Pragma("unroll") for (int n = 0; n < 2; ++n) _Pragma("unroll") for (int k = 0; k < 2; ++k) dst[n][k] = *(const LAS bf16x8*)(lds + PG8_SB(b, h) + boff + n * 2048 + k * 1024); } while (0)
#define PG8_MMA(ai, bj, At, Bt) do { __builtin_amdgcn_s_setprio(1); _Pragma("unroll") for (int m = 0; m < 4; ++m) _Pragma("unroll") for (int n = 0; n < 2; ++n) _Pragma("unroll") for (int k = 0; k < 2; ++k) \
        acc[ai][bj][m][n] = __builtin_amdgcn_mfma_f32_16x16x32_bf16(Bt[n][k], At[m][k], acc[ai][bj][m][n], 0, 0, 0); __builtin_amdgcn_s_setprio(0); } while (0)
#define PG8_WAIT_V(n) asm volatile("s_waitcnt vmcnt(" #n ")" ::: "memory")
#define PG8_WAIT_L(n) asm volatile("s_waitcnt lgkmcnt(" #n ")" ::: "memory")
#define PG8_BAR __builtin_amdgcn_s_barrier()
#define PG8_SCHED __builtin_amdgcn_sched_barrier(0)
#define PG8_ZERO() do { _Pragma("unroll") for (int a = 0; a < 2; ++a) _Pragma("unroll") for (int b = 0; b < 2; ++b) _Pragma("unroll") for (int m = 0; m < 4; ++m) _Pragma("unroll") for (int n = 0; n < 2; ++n) acc[a][b][m][n] = (f32x4){0.f, 0.f, 0.f, 0.f}; } while (0)
    Unit cur, nxt; int ui = 0;
    if (!S.next(0, cur)) return;
    f32x4 acc[2][2][4][2];
    PG8_ZERO();
    bf16x8 At[4][2], B0[2][2], B1[2][2];
    unsigned voA[2][2], voN[2][2];
    S.a_off(cur, voA);
    const char* cA = cur.A; const char* cB = cur.B;
    S.a_ready(cur);
    PG8_STAGE(PG8_SB(0, 0), cB, voffB); PG8_STAGE(PG8_SB(0, 1), cB + hstepB, voffB); PG8_STAGE(PG8_SA(0, 0), cA, voA[0]); PG8_STAGE(PG8_SA(0, 1), cA, voA[1]);
    if (wr == 1) PG8_BAR;
    PG8_WAIT_V(2); PG8_BAR;
    PG8_STAGE(PG8_SB(1, 0), cB + kstep, voffB); PG8_STAGE(PG8_SA(1, 0), cA + kstep, voA[0]); PG8_STAGE(PG8_SB(1, 1), cB + hstepB + kstep, voffB);
    PG8_WAIT_V(6); PG8_BAR;
    for (;;) {
        const bool has_next = S.next(ui + 1, nxt);
        if (has_next) S.a_ready(nxt);
        const char* nA = has_next ? nxt.A : cA; const char* nB = has_next ? nxt.B : cB;
        if (has_next) S.a_off(nxt, voN); else { voN[0][0] = voA[0][0]; voN[0][1] = voA[0][1]; voN[1][0] = voA[1][0]; voN[1][1] = voA[1][1]; }
        for (int t = 0; t < nt; t += 2) {
            const bool last = (t == nt - 2);
            const char* a1 = cA + (size_t)(t + 1) * kstep;
            const char* a2 = last ? nA : cA + (size_t)(t + 2) * kstep; const char* b2 = last ? nB : cB + (size_t)(t + 2) * kstep;
            const char* a3 = a2 + kstep; const char* b3 = b2 + kstep;
            PG8_LDB(B0, 0, 0); PG8_LDB(B1, 0, 1); PG8_SCHED; PG8_LDA(At, 0, 0); PG8_STAGE(PG8_SA(1, 1), a1, voA[1]);
            PG8_WAIT_V(8); PG8_WAIT_L(0); PG8_BAR; PG8_MMA(0, 0, At, B0); PG8_MMA(0, 1, At, B1); PG8_BAR; PG8_SCHED;
            if (last) { voA[0][0] = voN[0][0]; voA[0][1] = voN[0][1]; voA[1][0] = voN[1][0]; voA[1][1] = voN[1][1]; }
            PG8_LDA(At, 0, 1); PG8_STAGE(PG8_SB(0, 0), b2, voffB); PG8_STAGE(PG8_SB(0, 1), b2 + hstepB, voffB); PG8_STAGE(PG8_SA(0, 0), a2, voA[0]);
            PG8_WAIT_V(8); PG8_WAIT_L(0); PG8_BAR; PG8_MMA(1, 0, At, B0); PG8_MMA(1, 1, At, B1); PG8_BAR; PG8_SCHED;
            PG8_LDB(B0, 1, 0); PG8_LDB(B1, 1, 1); PG8_SCHED; PG8_LDA(At, 1, 0); PG8_STAGE(PG8_SA(0, 1), a2, voA[1]);
            PG8_WAIT_V(8); PG8_WAIT_L(0); PG8_BAR; PG8_MMA(0, 0, At, B0); PG8_MMA(0, 1, At, B1); PG8_BAR; PG8_SCHED;
            PG8_LDA(At, 1, 1); PG8_STAGE(PG8_SB(1, 0), b3, voffB); PG8_STAGE(PG8_SB(1, 1), b3 + hstepB, voffB); PG8_STAGE(PG8_SA(1, 0), a3, voA[0]);
            PG8_WAIT_V(8); PG8_WAIT_L(0); PG8_BAR; PG8_MMA(1, 0, At, B0); PG8_MMA(1, 1, At, B1); PG8_BAR; PG8_SCHED;
        }
        if constexpr (ALIGN_EPI) { if (wr == 0) PG8_BAR; }
        int tz = lane; asm volatile("" : "+v"(tz));
        const bool z = E(acc, cur, wr, wc, tz & 15, tz >> 4);
        S.done(cur);
        if (!has_next) break;
        if (z) PG8_ZERO();
        cur = nxt; cA = nA; cB = nB; ++ui;
        if constexpr (ALIGN_EPI) { if (wr == 1) PG8_BAR; }
    }
    PG8_WAIT_V(0);
    if constexpr (!ALIGN_EPI) { if (wr == 0) PG8_BAR; }
    PG8_BAR;
#undef PG8_SA
#undef PG8_SB
#undef PG8_STAGE
#undef PG8_LDA
#undef PG8_LDB
#undef PG8_MMA
#undef PG8_WAIT_V
#undef PG8_WAIT_L
#undef PG8_BAR
#undef PG8_SCHED
#undef PG8_ZERO
}
}

#define XB_TMO      128
#define XB_XCNT(j)  (256  + 64 * (j))
#define XB_XSUB(j)  (1280 + 64 * (j))
#define XB_XGEN(j)  (2304 + 64 * (j))
#define XB_TOP      3328
#define XB_TOPGEN   3392
#define XCD_BAR_WORDS 3456
#define XB_SPIN_CAP (1u << 23)
__device__ __forceinline__ unsigned xb_ld(unsigned* p)              { return __hip_atomic_load(p, __ATOMIC_RELAXED, __HIP_MEMORY_SCOPE_AGENT); }
__device__ __forceinline__ unsigned xb_add(unsigned* p, unsigned v) { return __hip_atomic_fetch_add(p, v, __ATOMIC_RELAXED, __HIP_MEMORY_SCOPE_AGENT); }
__device__ __forceinline__ unsigned xb_xcc_id() { return (unsigned)__builtin_amdgcn_s_getreg((3 << 11) | 20) & 0xFu; }
#define XB_SPIN(cond, bar) do { unsigned _sp = 0; while (cond) { __builtin_amdgcn_s_sleep(1); \
    if ((++_sp & 255u) == 0u) { if (xb_ld(&(bar)[XB_TMO])) break; if (_sp > XB_SPIN_CAP) { atomicAdd(&(bar)[XB_TMO], 1u); break; } } } } while (0)
struct XcdBarrier { unsigned* bar; unsigned x; volatile LAS unsigned* st; };
__device__ __forceinline__ XcdBarrier xcd_barrier_post(unsigned* bar, volatile LAS unsigned* st) {
    XcdBarrier b; b.bar = bar; b.x = xb_xcc_id(); b.st = st;
    if (threadIdx.x == 0) (void)xb_add(&bar[XB_XCNT(b.x)], 1u);
    return b;
}
__device__ __forceinline__ void xcd_barrier_complete(unsigned* bar, unsigned x, unsigned& nloc, unsigned& nx) {
    const unsigned G = gridDim.x * gridDim.y * gridDim.z;
    unsigned sum, cnt, mine, sp = 0u;
    for (;;) {
        sum = 0u; cnt = 0u; mine = 0u;
#pragma unroll
        for (unsigned j = 0; j < 16; ++j) { const unsigned c = xb_ld(&bar[XB_XCNT(j)]); sum += c; cnt += (c > 0u) ? 1u : 0u; mine = (j == x) ? c : mine; }
        if (sum == G) break;
        __builtin_amdgcn_s_sleep(1);
        if ((++sp & 255u) == 0u) { if (xb_ld(&bar[XB_TMO])) break; if (sp > XB_SPIN_CAP) { atomicAdd(&bar[XB_TMO], 1u); break; } }
    }
    nloc = mine > 0u ? mine : 1u; nx = cnt > 0u ? cnt : 1u;
}
__device__ __forceinline__ void xcd_barrier(const XcdBarrier& b) {
    asm volatile("s_waitcnt vmcnt(0)" ::: "memory");
    __syncthreads();
    if (threadIdx.x == 0) {
        unsigned* bar = b.bar;
        __builtin_amdgcn_s_waitcnt(0);
        unsigned nloc = b.st[0], nx = b.st[1];
        if (nloc == 0u) { xcd_barrier_complete(bar, b.x, nloc, nx); b.st[0] = nloc; b.st[1] = nx; }
        const unsigned old = xb_add(&bar[XB_XSUB(b.x)], 1u);
        const unsigned gen = old / nloc;
        if (old + 1u == (gen + 1u) * nloc) {
            __builtin_amdgcn_fence(__ATOMIC_RELEASE, "agent");
            asm volatile("s_waitcnt vmcnt(0)" ::: "memory");
            const unsigned og = xb_add(&bar[XB_TOP], 1u);
            const unsigned tg = og / nx;
            if (og + 1u == (tg + 1u) * nx) xb_add(&bar[XB_TOPGEN], 1u);
            else XB_SPIN(xb_ld(&bar[XB_TOPGEN]) == tg, bar);
            __builtin_amdgcn_fence(__ATOMIC_ACQUIRE, "agent");
            xb_add(&bar[XB_XGEN(b.x)], 1u);
            asm volatile("s_waitcnt vmcnt(0)" ::: "memory");
        } else {
            XB_SPIN(xb_ld(&bar[XB_XGEN(b.x)]) == gen, bar);
            __builtin_amdgcn_fence(__ATOMIC_ACQUIRE, "agent");
            asm volatile("s_waitcnt vmcnt(0)" ::: "memory");
        }
    }
    __syncthreads();
}

struct Args { const float* in[29]; float* out; unsigned char* ws; int ph_lo, ph_hi; };
enum { I_X = 0, I_N1G, I_WIN, I_GMNG, I_GMWS, I_GMB, I_CONVW, I_CONVB, I_LWA, I_LBA, I_LWX, I_LBX, I_LLAM, I_PE, I_CW1, I_CW2, I_PW, I_PS, I_WBR, I_WOUT, I_N2G, I_RWG, I_RBG, I_RWE, I_RBE, I_MG, I_MU, I_MD, I_FNG };

#define CAS __attribute__((address_space(4)))
__device__ __forceinline__ unsigned long long karg_u64(int off) { const CAS char* kp = (const CAS char*)__builtin_amdgcn_kernarg_segment_ptr(); asm volatile("" : "+s"(kp)); return *(const CAS unsigned long long*)(kp + off); }
#define ARG_IN(k) ((const float*)(const GAS float*)karg_u64(8 * (k)))
#define ARG_OUT() ((float*)(GAS float*)karg_u64(8 * 29))
#define ARG_WS() ((unsigned char*)(GAS unsigned char*)karg_u64(8 * 30))
__device__ __forceinline__ int win_dst_row(int s) {
    if (s < SRC_GC) return s;
    if (s < SRC_XD) return C_GC + (s - SRC_GC);
    if (s < SRC_MG) return C_XD + (s - SRC_XD);
    const int n = (s - SRC_MG) >> 10, d = (s - SRC_MG) & 1023;
    return 4096 + 256 * (d >> 6) + 128 * (n >> 1) + 32 * ((d >> 4) & 3) + 8 * ((d >> 2) & 3) + 4 * (n & 1) + (d & 3);
}
struct TrItem { const float* W; bf16* WT; int K, N, kb, nb, kind; };
struct TrRegs { f32x4 v[8]; };
__device__ __forceinline__ int tr_dst(int kind, int n) { return kind == 0 ? n : kind == 1 ? win_dst_row(n) : kind == 2 ? 256 * (n >> 7) + (n & 127) : 256 * (n >> 7) + 128 + (n & 127); }
__device__ __forceinline__ TrRegs tr_load(const TrItem& it, int lane) {
    TrRegs r; const int k0 = 64 * it.kb, n4 = 32 * it.nb + (lane & 7) * 4;
#pragma unroll
    for (int i = 0; i < 8; ++i) { const int kk = 8 * i + (lane >> 3); r.v[i] = *(const f32x4*)(it.W + (size_t)(k0 + kk) * it.N + (n4 < it.N ? n4 : 0)); }
    return r;
}
__device__ __forceinline__ void tr_finish(const TrItem& it, const TrRegs& r, float* scr, int lane) {
    const int k0 = 64 * it.kb, n0 = 32 * it.nb;
#pragma unroll
    for (int i = 0; i < 8; ++i) { const int kk = 8 * i + (lane >> 3); float* d = scr + kk * 33 + (lane & 7) * 4; d[0] = r.v[i].x; d[1] = r.v[i].y; d[2] = r.v[i].z; d[3] = r.v[i].w; }
    LDS_WAIT(); asm volatile("" ::: "memory");
    const int c = lane & 7;
#pragma unroll
    for (int j = 0; j < 4; ++j) { const int nl = (lane >> 3) + 8 * j; const int n = n0 + nl; const float* sp = scr + (8 * c) * 33 + nl;
        u32x4 o; o.x = pk2(sp[0 * 33], sp[1 * 33]); o.y = pk2(sp[2 * 33], sp[3 * 33]); o.z = pk2(sp[4 * 33], sp[5 * 33]); o.w = pk2(sp[6 * 33], sp[7 * 33]);
        if (n < it.N) GST(*(u32x4*)(it.WT + (size_t)tr_dst(it.kind, n) * it.K + k0 + 8 * c) = o); }
    LDS_WAIT(); asm volatile("" ::: "memory");
}
template <int MODE>
__device__ __forceinline__ void norm_rows(const float* xbase, float* hbase, const bf16* y0b, const bf16* y1b, const float* g, bf16* xnb, int m0, int m1, bool two, int lane) {
    f32x4 v[2][4]; u32x2 ya[2][4], yb[2][4];
#pragma unroll
    for (int r = 0; r < 2; ++r) { const size_t m = (size_t)(r ? m1 : m0); if (r == 0 || two) {
#pragma unroll
        for (int j = 0; j < 4; ++j) { const int c = 4 * lane + 256 * j; v[r][j] = *(const f32x4*)((MODE == 0 ? xbase : hbase) + m * D + c);
            if (MODE != 0) { ya[r][j] = *(const u32x2*)(y0b + m * D + c); yb[r][j] = *(const u32x2*)(y1b + m * D + c); } } } }
#pragma unroll
    for (int r = 0; r < 2; ++r) { if (r == 1 && !two) break; const size_t m = (size_t)(r ? m1 : m0); float ss = 0.f;
#pragma unroll
        for (int j = 0; j < 4; ++j) {
            if (MODE != 0) { const u32x2 a = ya[r][j], b = yb[r][j];
                v[r][j].x += bflo(a.x) + bflo(b.x); v[r][j].y += bfhi(a.x) + bfhi(b.x); v[r][j].z += bflo(a.y) + bflo(b.y); v[r][j].w += bfhi(a.y) + bfhi(b.y); }
            ss += (v[r][j].x * v[r][j].x + v[r][j].y * v[r][j].y) + (v[r][j].z * v[r][j].z + v[r][j].w * v[r][j].w); }
        const float rstd = rsqrtf(wave_sum(ss) * (1.f / D) + EPS);
#pragma unroll
        for (int j = 0; j < 4; ++j) { const int c = 4 * lane + 256 * j; const f32x4 gg = *(const f32x4*)(g + c); const f32x4 x = v[r][j];
            if (MODE == 2) { GST(*(f32x4*)(hbase + m * D + c) = (f32x4){x.x * rstd * gg.x, x.y * rstd * gg.y, x.z * rstd * gg.z, x.w * rstd * gg.w}); }
            else { if (MODE != 0) GST(*(f32x4*)(hbase + m * D + c) = x);
                u32x2 o; o.x = pk2(x.x * rstd * gg.x, x.y * rstd * gg.y); o.y = pk2(x.z * rstd * gg.z, x.w * rstd * gg.w); GST(*(u32x2*)(xnb + m * D + c) = o); } } }
}

constexpr int IT_WIN_ = 16 * 249, IT_WB_ = 8 * 32, IT_WO_ = 16 * 32, IT_BIG = IT_WIN_ + 4 * IT_WB_ + IT_WO_;
__device__ __forceinline__ TrItem dec_big(int it, int l) {
    unsigned char* wsb = ARG_WS(); int r = it;
    if (r < IT_WIN_) return TrItem{ARG_IN(I_WIN) + (size_t)l * D * NIN, (bf16*)(wsb + WS_WIN) + (size_t)l * NPROJ * D, D, NIN, r / 249, r % 249, 1};
    r -= IT_WIN_;
    if (r < 4 * IT_WB_) { const int n = r / IT_WB_; r -= n * IT_WB_; const int ln = l * 4 + n; return TrItem{ARG_IN(I_WBR) + (size_t)ln * 512 * 1024, (bf16*)(wsb + WS_WB) + (size_t)ln * 1024 * 512, 512, 1024, r / 32, r % 32, 0}; }
    r -= 4 * IT_WB_;
    return TrItem{ARG_IN(I_WOUT) + (size_t)l * 1024 * 1024, (bf16*)(wsb + WS_WOUT) + (size_t)l * 1024 * 1024, 1024, 1024, r / 32, r % 32, 0};
}
__device__ __forceinline__ void conv_unit(float* ldsf, int cu) {
    const int tid = opaque_tid(); const int wv = __builtin_amdgcn_readfirstlane(tid >> 6), lane = tid & 63; const int it = cu * 8 + wv;
    __syncthreads();
    if (it < IT_BIG) { const TrItem ti = dec_big(it, 1); const TrRegs rr = tr_load(ti, lane); tr_finish(ti, rr, ldsf + wv * 4096, lane); }
}
__device__ __forceinline__ void wait_counter(unsigned* cp, unsigned need, unsigned* tmo) {
    if (__builtin_amdgcn_readfirstlane((int)threadIdx.x) < 64) {
        unsigned polls = 0u;
        while ((unsigned)__builtin_amdgcn_readfirstlane(__hip_atomic_load(cp, __ATOMIC_RELAXED, __HIP_MEMORY_SCOPE_AGENT)) < need) {
            if (++polls > (1u << 22)) { __hip_atomic_store(tmo, 1u, __ATOMIC_RELAXED, __HIP_MEMORY_SCOPE_AGENT); break; }
            __builtin_amdgcn_s_sleep(2); }
        __builtin_amdgcn_fence(__ATOMIC_ACQUIRE, "agent");
        asm volatile("s_waitcnt vmcnt(0)" ::: "memory");
    }
    asm volatile("" ::: "memory"); __builtin_amdgcn_s_barrier(); asm volatile("" ::: "memory");
}
struct SchedDense {
    const bf16* A; const bf16* Bt; int lda, K, nM, nN, G, c; unsigned* cnt; unsigned need; unsigned* tmo; int pnrot;
    __device__ __forceinline__ void a_ready(const pg8::Unit& u) const { if (cnt) wait_counter(cnt + 64 * u.pm, need, tmo); }
    __device__ __forceinline__ void done(const pg8::Unit&) const {}
    __device__ __forceinline__ bool next(int i, pg8::Unit& u) const {
        int pm, pn; if (!pg8::static_tile(i, G, c, nM, nN, pm, pn)) return false;
        pn += pnrot; if (pn >= nN) pn -= nN;
        u.pm = pm; u.pn = pn; u.sub = 0; u.e = 0; u.A = (const char*)(A + (size_t)pm * 256 * lda); u.B = (const char*)(Bt + (size_t)pn * 256 * K); return true;
    }
    __device__ __forceinline__ void a_off(const pg8::Unit&, unsigned (&vo)[2][2]) const {
        const int tz = opaque_tid();
#pragma unroll
        for (int i = 0; i < 2; ++i) { int R, C; pg8::stage_rc(tz * 16 + i * 8192, R, C);
#pragma unroll
            for (int h = 0; h < 2; ++h) vo[h][i] = (unsigned)((h * 128 + R) * lda + C) * 2u; }
    }
};
struct SchedMerge {
    const bf16* P1; const bf16* Wb; int G, c; unsigned* cnt;
    __device__ __forceinline__ void a_ready(const pg8::Unit&) const {}
    __device__ __forceinline__ void done(const pg8::Unit& u) const {
        if (u.sub != 3) return;
        asm volatile("s_waitcnt vmcnt(0)" ::: "memory");
        if ((threadIdx.x & 63) == 0 && !is_dry()) (void)__hip_atomic_fetch_add(cnt + 64 * u.pm, 1u, __ATOMIC_RELAXED, __HIP_MEMORY_SCOPE_AGENT);
    }
    __device__ __forceinline__ bool next(int i, pg8::Unit& u) const {
        const int ti = i >> 2, sub = i & 3; int pm, pn; if (!pg8::static_tile(ti, G, c, T / 256, 4, pm, pn)) return false;
        const int ycol = (sub == 0) ? C_U : (sub == 1) ? C_GB : (sub == 2) ? C_Q : C_V;
        u.pm = pm; u.pn = pn; u.sub = sub; u.e = 0;
        u.A = (const char*)(P1 + (size_t)pm * 256 * P1W + ycol); u.B = (const char*)(Wb + ((size_t)sub * 1024 + (size_t)pn * 256) * 512); return true;
    }
    __device__ __forceinline__ void a_off(const pg8::Unit&, unsigned (&vo)[2][2]) const {
        const int tz = opaque_tid();
#pragma unroll
        for (int i = 0; i < 2; ++i) { int R, C; pg8::stage_rc(tz * 16 + i * 8192, R, C);
#pragma unroll
            for (int h = 0; h < 2; ++h) vo[h][i] = (unsigned)((h * 128 + R) * P1W + C) * 2u; }
    }
};
__device__ __forceinline__ const LAS int* moe_tab() { unsigned a = (unsigned)LDS_MOE; asm volatile("" : "+s"(a)); return (const LAS int*)(uintptr_t)a; }
struct SchedMoe {
    const bf16* A; const bf16* Bt; const unsigned* list; int lda, K, brows  , G, c; bool gather; unsigned* cnt; unsigned* tmo;
    __device__ __forceinline__ bool next(int i, pg8::Unit& u) const {
        const LAS int* tab = moe_tab(); const int L = i * G + (gather ? c : (G - 1 - c)); const int tot = __builtin_amdgcn_readfirstlane(tab[16]); if (L >= 4 * tot) return false;
        const int rtg = L >> 2, pn = L & 3; int e = 0, st = 0;
#pragma unroll
        for (int k = 1; k < 16; ++k) { const int tk = __builtin_amdgcn_readfirstlane(tab[k]); if (rtg >= tk) { e = k; st = tk; } }
        u.e = e; u.pm = rtg; u.sub = rtg - st; u.pn = pn;
        u.A = gather ? (const char*)A : (const char*)(A + (size_t)rtg * 256 * lda);
        u.B = (const char*)(Bt + ((size_t)e * brows + (size_t)pn * 256) * K); return true;
    }
    __device__ __forceinline__ void a_ready(const pg8::Unit& u) const {
        if (gather) return;
        if (__builtin_amdgcn_readfirstlane((int)threadIdx.x) < 64) {
            unsigned* cp = cnt + 64 * u.pm; unsigned polls = 0u;
            while ((unsigned)__builtin_amdgcn_readfirstlane(__hip_atomic_load(cp, __ATOMIC_RELAXED, __HIP_MEMORY_SCOPE_AGENT)) < 32u) {
                if (++polls > (1u << 22)) { __hip_atomic_store(tmo, 1u, __ATOMIC_RELAXED, __HIP_MEMORY_SCOPE_AGENT); break; }
                __builtin_amdgcn_s_sleep(2); }
            __builtin_amdgcn_fence(__ATOMIC_ACQUIRE, "agent");
            asm volatile("s_waitcnt vmcnt(0)" ::: "memory");
        }
        asm volatile("" ::: "memory"); __builtin_amdgcn_s_barrier(); asm volatile("" ::: "memory");
    }
    __device__ __forceinline__ void done(const pg8::Unit& u) const {
        if (!gather) return;
        asm volatile("s_waitcnt vmcnt(0)" ::: "memory");
        if ((threadIdx.x & 63) == 0 && !is_dry()) (void)__hip_atomic_fetch_add(cnt + 64 * u.pm, 1u, __ATOMIC_RELAXED, __HIP_MEMORY_SCOPE_AGENT);
    }
    __device__ __forceinline__ void a_off(const pg8::Unit& u, unsigned (&vo)[2][2]) const {
        const LAS int* tab = moe_tab(); const int cnt = __builtin_amdgcn_readfirstlane(tab[32 + u.e]); const unsigned* le = list + (size_t)u.e * T + u.sub * 256;
        int tz = (int)threadIdx.x; asm volatile("" : "+v"(tz));
#pragma unroll
        for (int i = 0; i < 2; ++i) { int R, C; pg8::stage_rc(tz * 16 + i * 8192, R, C);
#pragma unroll
            for (int h = 0; h < 2; ++h) {
                int row = h * 128 + R;
                if (gather) { row = (u.sub * 256 + row < cnt) ? (int)(le[row] & 0x3fffu) : 0; }
                vo[h][i] = (unsigned)(row * lda + C) * 2u;
            } }
    }
};

struct EpiProj {
    bf16* P1; bf16* Rr;
    __device__ __forceinline__ bool operator()(f32x4 (&acc)[2][2][4][2], const pg8::Unit& u, int wr, int wc, int fr, int fq) const {
        const int row0 = u.pm * 256 + wr * 64 + fr;
        if (u.pn < 16) {
            const int act = (u.pn < 6) ? 1 : (u.pn == 15 ? 2 : 0);
#pragma unroll
            for (int ai = 0; ai < 2; ++ai)
#pragma unroll
                for (int m = 0; m < 4; ++m) { bf16* rowp = P1 + (size_t)(row0 + ai * 128 + m * 16) * P1W + u.pn * 256 + wc * 32 + 8 * fq;
#pragma unroll
                    for (int bj = 0; bj < 2; ++bj) { f32x4 v0 = acc[ai][bj][m][0], v1 = acc[ai][bj][m][1];
                        if (act == 1) { v0 = (f32x4){gelu_tanh(v0.x), gelu_tanh(v0.y), gelu_tanh(v0.z), gelu_tanh(v0.w)}; v1 = (f32x4){gelu_tanh(v1.x), gelu_tanh(v1.y), gelu_tanh(v1.z), gelu_tanh(v1.w)}; }
                        else if (act == 2) { v0 = (f32x4){sigmoidf_(v0.x), sigmoidf_(v0.y), sigmoidf_(v0.z), sigmoidf_(v0.w)}; v1 = (f32x4){sigmoidf_(v1.x), sigmoidf_(v1.y), sigmoidf_(v1.z), sigmoidf_(v1.w)}; }
                        u32x4 w; w.x = pk2(v0.x, v0.y); w.y = pk2(v0.z, v0.w); w.z = pk2(v1.x, v1.y); w.w = pk2(v1.z, v1.w);
                        if (u.pn < 15 || (bj == 0 && wc < 2)) GST(*(u32x4*)(rowp + bj * 128) = w); } }
        } else {
            const int dcol = 64 * (u.pn - 16) + 16 * wc + 4 * fq;
#pragma unroll
            for (int ai = 0; ai < 2; ++ai)
#pragma unroll
                for (int m = 0; m < 4; ++m) { const size_t row = (size_t)(row0 + ai * 128 + m * 16);
                    float r0[4], r1[4], r2[4], r3[4];
#pragma unroll
                    for (int i = 0; i < 4; ++i) {
                        const float d0 = fminf(1.0f + __builtin_amdgcn_exp2f(-1.4426950408889634f * acc[ai][0][m][0][i]), 1e20f), d1 = fminf(1.0f + __builtin_amdgcn_exp2f(-1.4426950408889634f * acc[ai][0][m][1][i]), 1e20f);
                        const float d2 = fminf(1.0f + __builtin_amdgcn_exp2f(-1.4426950408889634f * acc[ai][1][m][0][i]), 1e20f), d3 = fminf(1.0f + __builtin_amdgcn_exp2f(-1.4426950408889634f * acc[ai][1][m][1][i]), 1e20f);
                        const float i0 = __builtin_amdgcn_rcpf(d0), i1 = __builtin_amdgcn_rcpf(d1), i2 = __builtin_amdgcn_rcpf(d2), i3 = __builtin_amdgcn_rcpf(d3);
                        r0[i] = d1 * i0; r1[i] = d2 * i1; r2[i] = d3 * i2; r3[i] = i3; }
                    u32x2 w;
                    w.x = pk2(r0[0], r0[1]); w.y = pk2(r0[2], r0[3]); GST(*(u32x2*)(Rr + ((size_t)0 * T + row) * 1024 + dcol) = w);
                    w.x = pk2(r1[0], r1[1]); w.y = pk2(r1[2], r1[3]); GST(*(u32x2*)(Rr + ((size_t)1 * T + row) * 1024 + dcol) = w);
                    w.x = pk2(r2[0], r2[1]); w.y = pk2(r2[2], r2[3]); GST(*(u32x2*)(Rr + ((size_t)2 * T + row) * 1024 + dcol) = w);
                    w.x = pk2(r3[0], r3[1]); w.y = pk2(r3[2], r3[3]); GST(*(u32x2*)(Rr + ((size_t)3 * T + row) * 1024 + dcol) = w); }
        }
        return true;
    }
};
struct EpiMerge {
    const bf16* Rr; bf16* O;
    __device__ __forceinline__ bool operator()(f32x4 (&acc)[2][2][4][2], const pg8::Unit& u, int wr, int wc, int fr, int fq) const {
        const int row0 = u.pm * 256 + wr * 64 + fr, col0 = u.pn * 256 + wc * 32 + 8 * fq;
        const bf16* Rn = Rr + (size_t)u.sub * T * 1024;
        const __amdgpu_buffer_rsrc_t rs = __builtin_amdgcn_make_buffer_rsrc((void*)O, (short)0, (int)((size_t)T * 1024 * 2), 0x00020000);
        u32x4 rv[2][4][2];
#pragma unroll
        for (int ai = 0; ai < 2; ++ai)
#pragma unroll
            for (int m = 0; m < 4; ++m)
#pragma unroll
                for (int bj = 0; bj < 2; ++bj) rv[ai][m][bj] = *(const u32x4*)(Rn + (size_t)(row0 + ai * 128 + m * 16) * 1024 + col0 + bj * 128);
        __builtin_amdgcn_sched_barrier(0);
#pragma unroll
        for (int ai = 0; ai < 2; ++ai)
#pragma unroll
            for (int m = 0; m < 4; ++m) { const size_t ro = (size_t)(row0 + ai * 128 + m * 16) * 1024 + col0;
#pragma unroll
                for (int bj = 0; bj < 2; ++bj) { const u32x4 r = rv[ai][m][bj];
                    f32x4& v0 = acc[ai][bj][m][0]; f32x4& v1 = acc[ai][bj][m][1];
                    v0.x *= bflo(r.x); v0.y *= bfhi(r.x); v0.z *= bflo(r.y); v0.w *= bfhi(r.y); v1.x *= bflo(r.z); v1.y *= bfhi(r.z); v1.z *= bflo(r.w); v1.w *= bfhi(r.w);
                    if (u.sub == 3) { u32x4 w; w.x = pk2(v0.x, v0.y); w.y = pk2(v0.z, v0.w); w.z = pk2(v1.x, v1.y); w.w = pk2(v1.z, v1.w); GST(__builtin_amdgcn_raw_buffer_store_b128(w, rs, (unsigned)((ro + bj * 128) * 2), 0, 16)); } } }
        return u.sub == 3;
    }
};
struct EpiWout {
    const float* Hin; float* H;
    __device__ __forceinline__ bool operator()(f32x4 (&acc)[2][2][4][2], const pg8::Unit& u, int wr, int wc, int fr, int fq) const {
        const int row0 = u.pm * 256 + wr * 64 + fr, col0 = u.pn * 256 + wc * 32 + 8 * fq;
#pragma unroll
        for (int ai = 0; ai < 2; ++ai)
        {   f32x4 hv[4][2][2];
#pragma unroll
            for (int m = 0; m < 4; ++m)
#pragma unroll
                for (int bj = 0; bj < 2; ++bj)
#pragma unroll
                    for (int n = 0; n < 2; ++n) hv[m][bj][n] = *(const f32x4*)(Hin + (size_t)(row0 + ai * 128 + m * 16) * 1024 + col0 + bj * 128 + 4 * n);
            __builtin_amdgcn_sched_barrier(0);
#pragma unroll
            for (int m = 0; m < 4; ++m)
#pragma unroll
                for (int bj = 0; bj < 2; ++bj)
#pragma unroll
                    for (int n = 0; n < 2; ++n) { const f32x4 h = hv[m][bj][n] + acc[ai][bj][m][n]; GST(*(f32x4*)(H + (size_t)(row0 + ai * 128 + m * 16) * 1024 + col0 + bj * 128 + 4 * n) = h); } }
        return true;
    }
};
struct EpiGateUp {
    bf16* HID; const float* lw;
    __device__ __forceinline__ bool operator()(f32x4 (&acc)[2][2][4][2], const pg8::Unit& u, int wr, int wc, int fr, int fq) const {
        const int cnt = __builtin_amdgcn_readfirstlane(moe_tab()[32 + u.e]);
        const __amdgpu_buffer_rsrc_t rs = __builtin_amdgcn_make_buffer_rsrc((void*)HID, (short)0, (int)((size_t)HID_ROWS * 512 * 2), 0x00020000);
#pragma unroll
        for (int ai = 0; ai < 2; ++ai)
#pragma unroll
            for (int m = 0; m < 4; ++m) { const int rl = ai * 128 + wr * 64 + m * 16 + fr; const int lr = u.sub * 256 + rl;
                const bool ok = lr < cnt; const float w = ok ? lw[(size_t)u.e * T + lr] : 0.f;
                float o[8];
#pragma unroll
                for (int n = 0; n < 2; ++n)
#pragma unroll
                    for (int i = 0; i < 4; ++i) { const float g = acc[ai][0][m][n][i], up = acc[ai][1][m][n][i]; o[4 * n + i] = ok ? g * sigmoidf_(g) * up * w : 0.f; }
                u32x4 wv; wv.x = pk2(o[0], o[1]); wv.y = pk2(o[2], o[3]); wv.z = pk2(o[4], o[5]); wv.w = pk2(o[6], o[7]);
                GST(__builtin_amdgcn_raw_buffer_store_b128(wv, rs, (unsigned)((((size_t)u.pm * 256 + rl) * 512 + u.pn * 128 + wc * 32 + 8 * fq) * 2), 0, 16)); }
        return true;
    }
};
struct EpiDown {
    bf16* Y; const unsigned* list;
    __device__ __forceinline__ bool operator()(f32x4 (&acc)[2][2][4][2], const pg8::Unit& u, int wr, int wc, int fr, int fq) const {
        const int cnt = __builtin_amdgcn_readfirstlane(moe_tab()[32 + u.e]);
        unsigned en[2][4];
#pragma unroll
        for (int ai = 0; ai < 2; ++ai)
#pragma unroll
            for (int m = 0; m < 4; ++m) { const int lr = u.sub * 256 + ai * 128 + wr * 64 + m * 16 + fr; en[ai][m] = list[(size_t)u.e * T + (lr < cnt ? lr : 0)]; }
        __builtin_amdgcn_sched_barrier(0);
#pragma unroll
        for (int ai = 0; ai < 2; ++ai)
#pragma unroll
            for (int m = 0; m < 4; ++m) { const int rl = ai * 128 + wr * 64 + m * 16 + fr; const int lr = u.sub * 256 + rl;
                if (lr < cnt) { const unsigned tok = en[ai][m] & 0x3fffu, slot = en[ai][m] >> 14;
                    bf16* rp = Y + ((size_t)slot * T + tok) * 1024 + u.pn * 256 + wc * 32 + 8 * fq;
#pragma unroll
                    for (int bj = 0; bj < 2; ++bj) { const f32x4 v0 = acc[ai][bj][m][0], v1 = acc[ai][bj][m][1];
                        u32x4 w; w.x = pk2(v0.x, v0.y); w.y = pk2(v0.z, v0.w); w.z = pk2(v1.x, v1.y); w.w = pk2(v1.z, v1.w); GST(*(u32x4*)(rp + bj * 128) = w); } } }
        return true;
    }
};


__device__ __forceinline__ void lru_unit2(LAS unsigned char* lds, const bf16* P1, bf16* XN, float* AGA, float* AGH, const float* convw, const float* convb,
                                          const bf16* WaT, const bf16* WxT, const float* ba, const float* bx, const float* lam, int unit) {
    const int tid = opaque_tid(); const int lane = tid & 63, w = __builtin_amdgcn_readfirstlane(tid >> 6);
    const int tile = unit & 63, b = unit >> 6; const int ch0 = w * 64;
    const size_t row0 = (size_t)b * SEQ + tile * 64;
    LAS unsigned char* wl = lds + w * 17920;
    LAS bf16* xcb = (LAS bf16*)wl; LAS float* AL = (LAS float*)(wl + 9216); LAS float* BL = (LAS float*)(wl + 9216 + 4352);
    __syncthreads();
    FT0(8);
    const int i16 = lane & 15, kb = lane >> 4;
    bf16x8 bfa[4][2], bfx[4][2]; float cba[4], cbx[4], csp[4];
    {
        const int tl = lane >> 3, c8 = (lane & 7) * 8;
        f32x4 cwv[4][2], cbv[2];
#pragma unroll
        for (int k = 0; k < 4; ++k) { cwv[k][0] = *(const f32x4*)(convw + k * 512 + ch0 + c8); cwv[k][1] = *(const f32x4*)(convw + k * 512 + ch0 + c8 + 4); }
        cbv[0] = *(const f32x4*)(convb + ch0 + c8); cbv[1] = *(const f32x4*)(convb + ch0 + c8 + 4);
        u32x4 xa[4][4], xb[4][4];
#pragma unroll
        for (int p = 0; p < 4; ++p)
#pragma unroll
            for (int k = 0; k < 4; ++k) { const int sp = tile * 64 + 8 * p + tl + k - 3; xa[p][k] = *(const u32x4*)(P1 + ((size_t)b * SEQ + (sp < 0 ? 0 : sp)) * P1W + C_RB + ch0 + c8); }
#pragma unroll
        for (int p = 0; p < 4; ++p)
#pragma unroll
            for (int k = 0; k < 4; ++k) { const int sp = tile * 64 + 8 * (p + 4) + tl + k - 3; xb[p][k] = *(const u32x4*)(P1 + ((size_t)b * SEQ + (sp < 0 ? 0 : sp)) * P1W + C_RB + ch0 + c8); }
        __builtin_amdgcn_sched_barrier(0);
#pragma unroll
        for (int hf = 0; hf < 2; ++hf) {
#pragma unroll
            for (int p = 0; p < 4; ++p) { const int tok = 8 * (p + 4 * hf) + tl; const int ts = tile * 64 + tok;
                float o[8] = {cbv[0].x, cbv[0].y, cbv[0].z, cbv[0].w, cbv[1].x, cbv[1].y, cbv[1].z, cbv[1].w};
#pragma unroll
                for (int k = 0; k < 4; ++k) { const u32x4 v = hf ? xb[p][k] : xa[p][k]; const float z = (ts + k - 3 >= 0) ? 1.f : 0.f; const f32x4 w0 = cwv[k][0] * z, w1 = cwv[k][1] * z;
                    o[0] += bflo(v.x) * w0.x; o[1] += bfhi(v.x) * w0.y; o[2] += bflo(v.y) * w0.z; o[3] += bfhi(v.y) * w0.w; o[4] += bflo(v.z) * w1.x; o[5] += bfhi(v.z) * w1.y; o[6] += bflo(v.w) * w1.z; o[7] += bfhi(v.w) * w1.w; }
                *(LAS u32x4*)(xcb + tok * 72 + c8) = (u32x4){pk2(o[0], o[1]), pk2(o[2], o[3]), pk2(o[4], o[5]), pk2(o[6], o[7])}; }
            if (hf == 0) {
#pragma unroll
                for (int n = 0; n < 4; ++n) {
#pragma unroll
                    for (int ks = 0; ks < 2; ++ks) { bfa[n][ks] = *(const bf16x8*)(WaT + ((size_t)ch0 + 16 * n + i16) * 64 + 32 * ks + 8 * kb); bfx[n][ks] = *(const bf16x8*)(WxT + ((size_t)ch0 + 16 * n + i16) * 64 + 32 * ks + 8 * kb); }
                    const int co = ch0 + 16 * n + i16; cba[n] = ba[co]; cbx[n] = bx[co]; csp[n] = lam[co]; }
                __builtin_amdgcn_sched_barrier(0); }
        }
#pragma unroll
        for (int n = 0; n < 4; ++n) { const float lm = csp[n]; csp[n] = 8.0f * ((-lm > 20.f) ? -lm : log1pf(__expf(-lm))); }
    }
    LDS_WAIT(); asm volatile("" ::: "memory");
    FT1(8); FT0(9);
    float hr = 0.f, ac = 1.f;
#pragma unroll 1
    for (int nt = 0; nt < 4; ++nt) {
        bf16x8 af[2];
#pragma unroll
        for (int ks = 0; ks < 2; ++ks) af[ks] = *(const LAS bf16x8*)(xcb + (16 * nt + i16) * 72 + 32 * ks + 8 * kb);
        f32x4 da[4], dx[4];
#pragma unroll
        for (int n = 0; n < 4; ++n) { da[n] = (f32x4){0.f, 0.f, 0.f, 0.f}; dx[n] = da[n];
#pragma unroll
            for (int ks = 0; ks < 2; ++ks) { da[n] = __builtin_amdgcn_mfma_f32_16x16x32_bf16(af[ks], bfa[n][ks], da[n], 0, 0, 0); dx[n] = __builtin_amdgcn_mfma_f32_16x16x32_bf16(af[ks], bfx[n][ks], dx[n], 0, 0, 0); } }
#pragma unroll
        for (int n = 0; n < 4; ++n)
#pragma unroll
            for (int r = 0; r < 4; ++r) { const int tokl = 4 * kb + r, co = 16 * n + i16; const float xcv = bf2f(xcb[(16 * nt + tokl) * 72 + co]);
                const float rg = sigmoidf_(da[n][r] + cba[n]), ig = sigmoidf_(dx[n][r] + cbx[n]); const float a = __expf(-rg * csp[n]);
                AL[tokl * 68 + co] = a; BL[tokl * 68 + co] = sqrtf(fmaxf(1.0f - a * a, 0.f)) * (ig * xcv); }
        LDS_WAIT(); asm volatile("" ::: "memory");
#pragma unroll
        for (int tt = 0; tt < 16; ++tt) { const float a = AL[tt * 68 + lane], bt = BL[tt * 68 + lane]; hr = a * hr + bt; ac *= a; BL[tt * 68 + lane] = hr; AL[tt * 68 + lane] = ac; }
        LDS_WAIT(); asm volatile("" ::: "memory");
        {   const int tk = lane >> 2, pc = (lane & 3) * 16;
            const f32x4 h0 = *(const LAS f32x4*)(BL + tk * 68 + pc), h1 = *(const LAS f32x4*)(BL + tk * 68 + pc + 4), h2 = *(const LAS f32x4*)(BL + tk * 68 + pc + 8), h3 = *(const LAS f32x4*)(BL + tk * 68 + pc + 12);
            const f32x4 a0 = *(const LAS f32x4*)(AL + tk * 68 + pc), a1 = *(const LAS f32x4*)(AL + tk * 68 + pc + 4), a2 = *(const LAS f32x4*)(AL + tk * 68 + pc + 8), a3 = *(const LAS f32x4*)(AL + tk * 68 + pc + 12);
            bf16* hp = XN + (row0 + 16 * nt + tk) * 1024 + ch0 + pc;
            GST(*(u32x4*)hp = (u32x4){pk2(h0.x, h0.y), pk2(h0.z, h0.w), pk2(h1.x, h1.y), pk2(h1.z, h1.w)}); GST(*(u32x4*)(hp + 8) = (u32x4){pk2(h2.x, h2.y), pk2(h2.z, h2.w), pk2(h3.x, h3.y), pk2(h3.z, h3.w)});
            GST(*(u32x4*)(hp + 512) = (u32x4){pk2(a0.x, a0.y), pk2(a0.z, a0.w), pk2(a1.x, a1.y), pk2(a1.z, a1.w)}); GST(*(u32x4*)(hp + 520) = (u32x4){pk2(a2.x, a2.y), pk2(a2.z, a2.w), pk2(a3.x, a3.y), pk2(a3.z, a3.w)}); }
        LDS_WAIT(); asm volatile("" ::: "memory");
    }
    FT1(9);
    GST(AGA[((size_t)b * 64 + tile) * 512 + ch0 + lane] = ac); GST(AGH[((size_t)b * 64 + tile) * 512 + ch0 + lane] = hr);
}
__device__ __forceinline__ void cmp_unit2(LAS unsigned char* lds, const bf16* P1, float* KC, const float* pe, const bf16* W1T, const float* w2, int unit) {
    const int tid = opaque_tid(); const int lane = tid & 63, w = __builtin_amdgcn_readfirstlane(tid >> 6);
    const int q = unit & 15, g = (unit >> 4) & 1, b = (unit >> 5) & 3, c = unit >> 7;
    LAS bf16* Fl = (LAS bf16*)lds;
    LAS float* part = (LAS float*)(lds + 65792);
    LAS float* hid = (LAS float*)(lds + 65792 + 32768);
    const float* pec = pe + (size_t)c * 2048; const bf16* w1t = W1T + ((size_t)c * 2 + g) * 64 * 2048; const float* w2c = w2 + ((size_t)c * 2 + g) * 4096;
    __syncthreads();
    {   u32x4 xv[8]; f32x4 pa[8], pb[8];
#pragma unroll
        for (int k = 0; k < 8; ++k) { const int e = tid + 512 * k; const int nl = e >> 8, l = (e >> 3) & 31, c8 = (e & 7) * 8; const int n = q * 16 + nl; const int nn = n < 255 ? n : 254;
            xv[k] = *(const u32x4*)(P1 + ((size_t)b * SEQ + nn * 16 + l) * P1W + C_KV + (c * 2 + g) * 64 + c8); pa[k] = *(const f32x4*)(pec + l * 64 + c8); pb[k] = *(const f32x4*)(pec + l * 64 + c8 + 4); }
#pragma unroll
        for (int k = 0; k < 8; ++k) { const int e = tid + 512 * k; const int nl = e >> 8, l = (e >> 3) & 31, c8 = (e & 7) * 8; const u32x4 v = xv[k];
            *(LAS u32x4*)(Fl + nl * 2056 + l * 64 + c8) = (u32x4){pk2(bflo(v.x) + pa[k].x, bfhi(v.x) + pa[k].y), pk2(bflo(v.y) + pa[k].z, bfhi(v.y) + pa[k].w), pk2(bflo(v.z) + pb[k].x, bfhi(v.z) + pb[k].y), pk2(bflo(v.w) + pb[k].z, bfhi(v.w) + pb[k].w)}; } }
    __syncthreads();
    {   const int i16 = lane & 15, kb = lane >> 4; f32x4 acc[4];
#pragma unroll
        for (int n = 0; n < 4; ++n) acc[n] = (f32x4){0.f, 0.f, 0.f, 0.f};
        bf16x8 bfr[8][4];
#pragma unroll
        for (int ks = 0; ks < 8; ++ks)
#pragma unroll
            for (int n = 0; n < 4; ++n) bfr[ks][n] = *(const bf16x8*)(w1t + (size_t)(16 * n + i16) * 2048 + 256 * w + 32 * ks + 8 * kb);
        __builtin_amdgcn_sched_barrier(0);
#pragma unroll
        for (int ks = 0; ks < 8; ++ks) { const int f0 = 256 * w + 32 * ks + 8 * kb;
            const bf16x8 af = *(const LAS bf16x8*)(Fl + i16 * 2056 + f0);
#pragma unroll
            for (int n = 0; n < 4; ++n) acc[n] = __builtin_amdgcn_mfma_f32_16x16x32_bf16(af, bfr[ks][n], acc[n], 0, 0, 0); }
#pragma unroll
        for (int n = 0; n < 4; ++n)
#pragma unroll
            for (int r = 0; r < 4; ++r) part[(w * 16 + 4 * kb + r) * 64 + 16 * n + i16] = acc[n][r];
    }
    __syncthreads();
    for (int e = tid; e < 1024; e += 512) { float a = 0.f;
#pragma unroll
        for (int ww = 0; ww < 8; ++ww) a += part[ww * 1024 + e];
        hid[e] = gelu_tanh(a); }
    __syncthreads();
    {   const int d = tid & 63, ng = tid >> 6; float a0 = 0.f, a1 = 0.f;
        for (int e = 0; e < 64; ++e) { const float wv = w2c[e * 64 + d]; a0 += hid[(ng * 2) * 64 + e] * wv; a1 += hid[(ng * 2 + 1) * 64 + e] * wv; }
        const int n0 = q * 16 + ng * 2; float* kp = KC + ((((size_t)c * NB + b) * 2 + g) * 256) * 64;
        if (n0 < 255) GST(kp[(size_t)n0 * 64 + d] = a0);
        if (n0 + 1 < 255) GST(kp[(size_t)(n0 + 1) * 64 + d] = a1); }
}
__device__ __forceinline__ void gmlp_unit3(LAS unsigned char* lds, bf16* P1, const float* gng, const float* gws, const float* gmb, int unit) {
    typedef float f32x16_ __attribute__((ext_vector_type(16))); typedef short s16x4_ __attribute__((ext_vector_type(4)));
    const int tid = opaque_tid(); const int lane = tid & 63, w = __builtin_amdgcn_readfirstlane(tid >> 6), r32 = lane & 31, h = lane >> 5;
    const int c = unit >> 1, gp = unit & 1; const size_t t0 = (size_t)c * 128;
    LAS unsigned char* VN = lds; LAS unsigned char* WT = lds + 65536; LAS float* rs = (LAS float*)(lds + 135168);
    __syncthreads();
    f32x4 wa[8], wb[8];
#pragma unroll
    for (int k = 0; k < 8; ++k) { const int e = tid + 512 * k; const int gi = e >> 11, t = (e >> 4) & 127, s8 = (e & 15) * 8; const float* wp = gws + (size_t)(2 * gp + gi) * 16384 + t * 128 + s8; wa[k] = *(const f32x4*)wp; wb[k] = *(const f32x4*)(wp + 4); }
    {   const int tk = tid >> 2, qu = tid & 3; const bf16* vp = P1 + (t0 + tk) * P1W + C_V + qu * 128; float ss = 0.f;
#pragma unroll 8
        for (int i = 0; i < 16; ++i) { const u32x4 x = *(const u32x4*)(vp + 8 * i);
            ss += bflo(x.x) * bflo(x.x) + bfhi(x.x) * bfhi(x.x) + bflo(x.y) * bflo(x.y) + bfhi(x.y) * bfhi(x.y) + bflo(x.z) * bflo(x.z) + bfhi(x.z) * bfhi(x.z) + bflo(x.w) * bflo(x.w) + bfhi(x.w) * bfhi(x.w); }
        ss += __shfl_xor(ss, 1); ss += __shfl_xor(ss, 2);
        if (qu == 0) rs[tk] = rsqrtf(ss * (1.f / 512.f) + EPS);
    }
#pragma unroll
    for (int k = 0; k < 8; ++k) { const int e = tid + 512 * k; const int gi = e >> 11, t = (e >> 4) & 127, s8 = (e & 15) * 8; const f32x4 a = wa[k], bq = wb[k];
        const float v0 = (s8 + 0 <= t) ? a.x : 0.f, v1 = (s8 + 1 <= t) ? a.y : 0.f, v2 = (s8 + 2 <= t) ? a.z : 0.f, v3 = (s8 + 3 <= t) ? a.w : 0.f;
        const float v4 = (s8 + 4 <= t) ? bq.x : 0.f, v5 = (s8 + 5 <= t) ? bq.y : 0.f, v6 = (s8 + 6 <= t) ? bq.z : 0.f, v7 = (s8 + 7 <= t) ? bq.w : 0.f;
        *(LAS u32x4*)(WT + gi * 34816 + t * 272 + s8 * 2) = (u32x4){pk2(v0, v1), pk2(v2, v3), pk2(v4, v5), pk2(v6, v7)}; }
    __syncthreads();
    {   u32x4 xv[8];
#pragma unroll
        for (int k = 0; k < 8; ++k) { const int e = tid + 512 * k; const int gi = e >> 11, sr = (e >> 4) & 127, c8 = e & 15; xv[k] = *(const u32x4*)(P1 + (t0 + sr) * P1W + C_V + (2 * gp + gi) * 128 + 8 * c8); }
#pragma unroll
        for (int k = 0; k < 8; ++k) { const int e = tid + 512 * k; const int gi = e >> 11, sr = (e >> 4) & 127, c8 = e & 15; const u32x4 x = xv[k];
            const float r = rs[sr]; const float* gq = gng + (2 * gp + gi) * 128 + 8 * c8;
            *(LAS u32x4*)(VN + gi * 32768 + (c8 >> 2) * 8192 + sr * 64 + (c8 & 3) * 16) = (u32x4){pk2(bflo(x.x) * r * gq[0], bfhi(x.x) * r * gq[1]), pk2(bflo(x.y) * r * gq[2], bfhi(x.y) * r * gq[3]), pk2(bflo(x.z) * r * gq[4], bfhi(x.z) * r * gq[5]), pk2(bflo(x.w) * r * gq[6], bfhi(x.w) * r * gq[7])}; } }
    __syncthreads();
    const int gi = w >> 2, cb = w & 3, g = 2 * gp + gi;
    const LAS unsigned char* vb = VN + gi * 32768 + cb * 8192 + ((lane >> 4) & 1) * 32 + (lane & 3) * 8 + (8 * h + ((lane & 15) >> 2)) * 64;
#pragma unroll 1
    for (int tb = 0; tb < 4; ++tb) {
        f32x16_ acc;
#pragma unroll
        for (int r = 0; r < 16; ++r) acc[r] = 0.f;
        const LAS unsigned char* wrow = WT + gi * 34816 + (32 * tb + r32) * 272 + 16 * h;
        for (int ks = 0; ks < 2 * tb + 2; ++ks) {
            const bf16x8 wf = *(const LAS bf16x8*)(wrow + 32 * ks);
            const s16x4_ lo = __builtin_bit_cast(s16x4_, __builtin_amdgcn_ds_read_tr16_b64_v4i16((LAS s16x4_*)(vb + ks * 1024)));
            const s16x4_ hi = __builtin_bit_cast(s16x4_, __builtin_amdgcn_ds_read_tr16_b64_v4i16((LAS s16x4_*)(vb + ks * 1024 + 256)));
            const bf16x8 vf = (bf16x8){lo[0], lo[1], lo[2], lo[3], hi[0], hi[1], hi[2], hi[3]};
            acc = __builtin_amdgcn_mfma_f32_32x32x16_bf16(vf, wf, acc, 0, 0, 0);
        }
        const int tl = 32 * tb + r32; const float bb = gmb[g * 128 + tl];
        bf16* up = P1 + (t0 + tl) * P1W + C_U + g * 128 + 32 * cb + 4 * h;
        u32x2 uu[4];
#pragma unroll
        for (int q4 = 0; q4 < 4; ++q4) uu[q4] = *(const u32x2*)(up + 8 * q4);
#pragma unroll
        for (int q4 = 0; q4 < 4; ++q4) {
            u32x2 o; o.x = pk2(bflo(uu[q4].x) * (acc[4 * q4] + bb), bfhi(uu[q4].x) * (acc[4 * q4 + 1] + bb)); o.y = pk2(bflo(uu[q4].y) * (acc[4 * q4 + 2] + bb), bfhi(uu[q4].y) * (acc[4 * q4 + 3] + bb));
            GST(*(u32x2*)(up + 8 * q4) = o); }
    }
}
__device__ __forceinline__ void pool_unit2(LAS unsigned char* lds, bf16* P1, const bf16* pwT, const float* ps, int unit) {
    typedef float f32x16_ __attribute__((ext_vector_type(16)));
    const int tid = opaque_tid(); const int lane = tid & 63, w = __builtin_amdgcn_readfirstlane(tid >> 6), r32 = lane & 31, h = lane >> 5;
    const int gi = unit & 3, tile = (unit >> 2) & 63, b = unit >> 8; const int wn = 2 << gi;
    LAS float* xs = (LAS float*)lds; LAS bf16* PL = (LAS bf16*)(lds + 40448);
    __syncthreads();
#pragma unroll
    for (int k = 0; k < 3; ++k) { const int e = tid + 512 * k; if (e < 79 * 16) { const int r = e >> 4, c8 = (e & 15) * 8; const int sp = tile * 64 + r - 15; const float z = sp >= 0 ? 1.f : 0.f;
        const u32x4 v = *(const u32x4*)(P1 + ((size_t)b * SEQ + (sp < 0 ? 0 : sp)) * P1W + C_XD + gi * 128 + c8);
        *(LAS f32x4*)(xs + r * 128 + c8) = (f32x4){bflo(v.x) * z, bfhi(v.x) * z, bflo(v.y) * z, bfhi(v.y) * z}; *(LAS f32x4*)(xs + r * 128 + c8 + 4) = (f32x4){bflo(v.z) * z, bfhi(v.z) * z, bflo(v.w) * z, bfhi(v.w) * z}; } }
    __syncthreads();
    {   const int ci = tid & 127, tq = tid >> 7;
        for (int k = 0; k < 16; ++k) { const int tt = tq * 16 + k; const int ts = tile * 64 + tt; float sacc = 0.f;
            for (int jj = 0; jj < wn; ++jj) sacc += xs[(tt + 15 - jj) * 128 + ci];
            const int cnt = (ts + 1 < wn) ? ts + 1 : wn;
            PL[tt * 136 + ci] = (bf16)f2bf(sacc / (float)cnt - xs[(tt + 15) * 128 + ci]); } }
    __syncthreads();
    {   const int cob = w >> 1, tokb = w & 1; f32x16_ acc;
#pragma unroll
        for (int r = 0; r < 16; ++r) acc[r] = 0.f;
        const bf16* wrow = pwT + (size_t)(32 * cob + r32) * 128 + 8 * h; const LAS bf16* prow = PL + (32 * tokb + r32) * 136 + 8 * h;
#pragma unroll
        for (int ks = 0; ks < 8; ++ks) { const bf16x8 wf = *(const bf16x8*)(wrow + 16 * ks); const bf16x8 pf = *(const LAS bf16x8*)(prow + 16 * ks);
            acc = __builtin_amdgcn_mfma_f32_32x32x16_bf16(wf, pf, acc, 0, 0, 0); }
        bf16* op = P1 + ((size_t)b * SEQ + tile * 64 + 32 * tokb + r32) * P1W + C_V + gi * 128 + 32 * cob + 4 * h; const float* sp = ps + gi * 128 + 32 * cob + 4 * h;
#pragma unroll
        for (int q4 = 0; q4 < 4; ++q4) { const f32x4 sc = *(const f32x4*)(sp + 8 * q4);
            u32x2 o; o.x = pk2(acc[4 * q4] * sc.x, acc[4 * q4 + 1] * sc.y); o.y = pk2(acc[4 * q4 + 2] * sc.z, acc[4 * q4 + 3] * sc.w); GST(*(u32x2*)(op + 8 * q4) = o); }
    }
}
__device__ __forceinline__ void lrufix_unit2(LAS unsigned char* lds, bf16* P1, const bf16* XN, const float* AGA, const float* AGH, int unit) {
    const int tid = opaque_tid(); const int cg = tid & 63, tl = tid >> 6; const int tile = unit & 63, b = unit >> 6;
    LAS float* seg = (LAS float*)lds;
    __syncthreads();
    {   float sa[8], sh[8];
#pragma unroll
        for (int i = 0; i < 8; ++i) { sa[i] = 1.f; sh[i] = 0.f; }
        f32x4 la0[8], la1[8], lh0[8], lh1[8];
#pragma unroll
        for (int k = 0; k < 8; ++k) { const int i = 8 * tl + k; const int ii = i < tile ? i : 0; const float* ap = AGA + ((size_t)b * 64 + ii) * 512 + 8 * cg; const float* hp = AGH + ((size_t)b * 64 + ii) * 512 + 8 * cg;
            la0[k] = *(const f32x4*)ap; la1[k] = *(const f32x4*)(ap + 4); lh0[k] = *(const f32x4*)hp; lh1[k] = *(const f32x4*)(hp + 4); }
#pragma unroll
        for (int k = 0; k < 8; ++k) { const int i = 8 * tl + k; if (i < tile) { const f32x4 a0 = la0[k], a1 = la1[k], h0 = lh0[k], h1 = lh1[k];
                sh[0] = a0.x * sh[0] + h0.x; sh[1] = a0.y * sh[1] + h0.y; sh[2] = a0.z * sh[2] + h0.z; sh[3] = a0.w * sh[3] + h0.w; sh[4] = a1.x * sh[4] + h1.x; sh[5] = a1.y * sh[5] + h1.y; sh[6] = a1.z * sh[6] + h1.z; sh[7] = a1.w * sh[7] + h1.w;
                sa[0] *= a0.x; sa[1] *= a0.y; sa[2] *= a0.z; sa[3] *= a0.w; sa[4] *= a1.x; sa[5] *= a1.y; sa[6] *= a1.z; sa[7] *= a1.w; } }
        LAS float* sp = seg + (tl * 64 + cg) * 16;
        *(LAS f32x4*)sp = (f32x4){sa[0], sa[1], sa[2], sa[3]}; *(LAS f32x4*)(sp + 4) = (f32x4){sa[4], sa[5], sa[6], sa[7]}; *(LAS f32x4*)(sp + 8) = (f32x4){sh[0], sh[1], sh[2], sh[3]}; *(LAS f32x4*)(sp + 12) = (f32x4){sh[4], sh[5], sh[6], sh[7]};
    }
    __syncthreads();
    float c[8];
#pragma unroll
    for (int i = 0; i < 8; ++i) c[i] = 0.f;
#pragma unroll
    for (int sgi = 0; sgi < 8; ++sgi) { const LAS float* sp = seg + (sgi * 64 + cg) * 16; const f32x4 a0 = *(const LAS f32x4*)sp, a1 = *(const LAS f32x4*)(sp + 4), h0 = *(const LAS f32x4*)(sp + 8), h1 = *(const LAS f32x4*)(sp + 12);
        c[0] = a0.x * c[0] + h0.x; c[1] = a0.y * c[1] + h0.y; c[2] = a0.z * c[2] + h0.z; c[3] = a0.w * c[3] + h0.w; c[4] = a1.x * c[4] + h1.x; c[5] = a1.y * c[5] + h1.y; c[6] = a1.z * c[6] + h1.z; c[7] = a1.w * c[7] + h1.w; }
    const size_t row0 = (size_t)b * SEQ + tile * 64;
#pragma unroll 4
    for (int p = 0; p < 8; ++p) { const size_t row = row0 + 8 * p + tl;
        const u32x4 hl = *(const u32x4*)(XN + row * 1024 + 8 * cg), ac = *(const u32x4*)(XN + row * 1024 + 512 + 8 * cg); bf16* gp = P1 + row * P1W + C_GB + 8 * cg; const u32x4 gg = *(const u32x4*)gp;
        u32x4 o;
        o.x = pk2(bflo(gg.x) * (bflo(hl.x) + bflo(ac.x) * c[0]), bfhi(gg.x) * (bfhi(hl.x) + bfhi(ac.x) * c[1])); o.y = pk2(bflo(gg.y) * (bflo(hl.y) + bflo(ac.y) * c[2]), bfhi(gg.y) * (bfhi(hl.y) + bfhi(ac.y) * c[3]));
        o.z = pk2(bflo(gg.z) * (bflo(hl.z) + bflo(ac.z) * c[4]), bfhi(gg.z) * (bfhi(hl.z) + bfhi(ac.z) * c[5])); o.w = pk2(bflo(gg.w) * (bflo(hl.w) + bflo(ac.w) * c[6]), bfhi(gg.w) * (bfhi(hl.w) + bfhi(ac.w) * c[7]));
        GST(*(u32x4*)gp = o); }
}

typedef float f32x16 __attribute__((ext_vector_type(16)));
typedef short s16x4 __attribute__((ext_vector_type(4)));
typedef __bf16 bf16x2_t __attribute__((ext_vector_type(2)));
constexpr int AT_KB = 8320, AT_VB = 8192;
constexpr int AT_TILE = AT_KB + AT_VB, AT_NT = 6, AT_IMP = AT_NT * AT_TILE, AT_SEL = AT_IMP + 16384, AT_SELU = AT_SEL + 512, AT_CNT = AT_SELU + 16;
__device__ __forceinline__ int at_koff(int slot, int sub) { return (2 * slot + sub) * AT_TILE; }
__device__ __forceinline__ int at_voff(int slot, int sub) { return (2 * slot + sub) * AT_TILE + AT_KB; }
__device__ __forceinline__ void ring_wait(LAS unsigned* p, unsigned target) { while (__hip_atomic_load(p, __ATOMIC_ACQUIRE, __HIP_MEMORY_SCOPE_WORKGROUP) < target) __builtin_amdgcn_s_sleep(1); }
__device__ __forceinline__ void ring_signal(LAS unsigned* p, int lane) { if (lane == 0) (void)__hip_atomic_fetch_add(p, 1u, __ATOMIC_RELEASE, __HIP_MEMORY_SCOPE_WORKGROUP); }
constexpr float AT_C2 = 0.125f * 1.4426950408889634f, AT_THR = 6.0f;
__device__ __forceinline__ unsigned cvtpk_bf16(float lo, float hi) { f32x2 v = {lo, hi}; bf16x2_t b = __builtin_convertvector(v, bf16x2_t); return __builtin_bit_cast(unsigned, b); }
__device__ __forceinline__ int crow(int r, int h) { return (r & 3) + 8 * (r >> 2) + 4 * h; }
__device__ __forceinline__ float max3f_(float a, float b, float c) { float r; asm("v_max3_f32 %0, %1, %2, %3" : "=v"(r) : "v"(a), "v"(b), "v"(c)); return r; }
__device__ __forceinline__ float swap32_max(float x) { auto rr = __builtin_amdgcn_permlane32_swap(__builtin_bit_cast(unsigned, x), __builtin_bit_cast(unsigned, x), false, false); float a = __builtin_bit_cast(float, rr[0]), b = __builtin_bit_cast(float, rr[1]); float r; asm("v_max_f32_e32 %0, %1, %2" : "=v"(r) : "v"(a), "v"(b)); return r; }
__device__ __forceinline__ float swap32_sum(float x) { auto rr = __builtin_amdgcn_permlane32_swap(__builtin_bit_cast(unsigned, x), __builtin_bit_cast(unsigned, x), false, false); return __builtin_bit_cast(float, rr[0]) + __builtin_bit_cast(float, rr[1]); }
struct AtRegs { u32x4 k, v; };
__device__ __forceinline__ AtRegs at_load_bf16(const bf16* kp, const bf16* vp, int tid) {
    AtRegs r; const int key = tid >> 3, c = tid & 7;
    if (ABL_ON(8)) { r.k = (u32x4){1u, 2u, 3u, 4u}; r.v = r.k; return r; }
    r.k = *(const u32x4*)(kp + (size_t)key * P1W + 8 * c); r.v = *(const u32x4*)(vp + (size_t)key * P1W + 8 * c); return r;
}
__device__ __forceinline__ AtRegs at_load_f32(const float* kp, const float* vp, int n0, int tid) {
    AtRegs r; const int key = tid >> 3, c = tid & 7; const int n = n0 + key;
    if (n < 255) { const f32x4 a0 = *(const f32x4*)(kp + (size_t)n * 64 + 8 * c), a1 = *(const f32x4*)(kp + (size_t)n * 64 + 8 * c + 4), b0 = *(const f32x4*)(vp + (size_t)n * 64 + 8 * c), b1 = *(const f32x4*)(vp + (size_t)n * 64 + 8 * c + 4);
        r.k = (u32x4){pk2(a0.x, a0.y), pk2(a0.z, a0.w), pk2(a1.x, a1.y), pk2(a1.z, a1.w)}; r.v = (u32x4){pk2(b0.x, b0.y), pk2(b0.z, b0.w), pk2(b1.x, b1.y), pk2(b1.z, b1.w)}; }
    else { r.k = (u32x4){0u, 0u, 0u, 0u}; r.v = (u32x4){0u, 0u, 0u, 0u}; }
    return r;
}
__device__ __forceinline__ void at_store(LAS unsigned char* lds, int slot, int sub, const AtRegs& r, int tid) {
    const int key = tid >> 3, c = tid & 7;
    *(LAS u32x4*)(lds + at_koff(slot, sub) + c * 1040 + key * 16) = r.k;
    *(LAS u32x4*)(lds + at_voff(slot, sub) + (c >> 2) * 4096 + key * 64 + (c & 3) * 16) = r.v;
}
__device__ __forceinline__ void at_qk(f32x16& p0, f32x16& p1, const LAS unsigned char* kb, const bf16x8 (&qr)[4], int r32, int h) {
    const f32x16 z = {0.f, 0.f, 0.f, 0.f, 0.f, 0.f, 0.f, 0.f, 0.f, 0.f, 0.f, 0.f, 0.f, 0.f, 0.f, 0.f};
    bf16x8 kf[8];
#pragma unroll
    for (int d0 = 0; d0 < 4; ++d0) { kf[2 * d0] = *(const LAS bf16x8*)(kb + (2 * d0 + h) * 1040 + r32 * 16); kf[2 * d0 + 1] = *(const LAS bf16x8*)(kb + (2 * d0 + h) * 1040 + (32 + r32) * 16); }
    __builtin_amdgcn_sched_barrier(0);
    p0 = __builtin_amdgcn_mfma_f32_32x32x16_bf16(kf[0], qr[0], z, 0, 0, 0); p1 = __builtin_amdgcn_mfma_f32_32x32x16_bf16(kf[1], qr[0], z, 0, 0, 0);
#pragma unroll
    for (int d0 = 1; d0 < 4; ++d0) { p0 = __builtin_amdgcn_mfma_f32_32x32x16_bf16(kf[2 * d0], qr[d0], p0, 0, 0, 0); p1 = __builtin_amdgcn_mfma_f32_32x32x16_bf16(kf[2 * d0 + 1], qr[d0], p1, 0, 0, 0); }
}
__device__ __forceinline__ void at_step(const LAS unsigned char* lds, int slot, int sub, const bf16x8 (&qr)[4], f32x16 (&o)[2], float& m, float& l, u64 vm, int lane) {
    if (!__any(vm != 0ull)) return;
    const int r32 = lane & 31, h = lane >> 5;
    f32x16 p0, p1;
    if (!ABL_ON(4)) at_qk(p0, p1, lds + at_koff(slot, sub), qr, r32, h); else { for (int r = 0; r < 16; ++r) { p0[r] = 0.f; p1[r] = 0.f; } }
    const LAS unsigned char* vb = lds + at_voff(slot, sub) + ((lane >> 4) & 1) * 32 + (lane & 3) * 8 + (4 * h + ((lane & 15) >> 2)) * 64;
    s16x4 tlo[8], thi[8];
#pragma unroll
    for (int i = 0; i < 8; ++i) { tlo[i] = __builtin_bit_cast(s16x4, __builtin_amdgcn_ds_read_tr16_b64_v4i16((LAS s16x4*)(vb + (i & 1) * 4096 + (i >> 1) * 1024)));
        thi[i] = __builtin_bit_cast(s16x4, __builtin_amdgcn_ds_read_tr16_b64_v4i16((LAS s16x4*)(vb + (i & 1) * 4096 + (i >> 1) * 1024 + 512))); }
    __builtin_amdgcn_sched_barrier(0);
    const bool full = __all(vm == ~0ull);
    const unsigned vlo = (unsigned)vm, vhi = (unsigned)(vm >> 32);
    if (!full && !ABL_ON(16)) {
#pragma unroll
        for (int r = 0; r < 16; ++r) { const int kx = crow(r, h); p0[r] = ((vlo >> kx) & 1u) ? p0[r] : -INFINITY; p1[r] = ((vhi >> kx) & 1u) ? p1[r] : -INFINITY; }
    }
    float rm = fmaxf(p0[0], p1[0]);
#pragma unroll
    for (int r = 1; r < 16; ++r) rm = fmaxf(rm, fmaxf(p0[r], p1[r]));
    rm *= AT_C2;
    rm = fmaxf(rm, __shfl_xor(rm, 32));
    if (__any(rm > m + AT_THR)) { const float mn = fmaxf(m, rm); const float f = __builtin_amdgcn_exp2f(m - mn); m = mn; l *= f;
#pragma unroll
        for (int r = 0; r < 16; ++r) { o[0][r] *= f; o[1][r] *= f; } }
    const float nm = -m; float ls = 0.f;
#pragma unroll
    for (int r = 0; r < 16; ++r) { if (!ABL_ON(1)) { p0[r] = __builtin_amdgcn_exp2f(__builtin_fmaf(p0[r], AT_C2, nm)); p1[r] = __builtin_amdgcn_exp2f(__builtin_fmaf(p1[r], AT_C2, nm)); } ls += p0[r] + p1[r]; }
    l += ls;
    __builtin_amdgcn_sched_barrier(0);
#pragma unroll
    for (int ks = 0; ks < 4; ++ks) {
        u32x4 pw;
        if (ks == 0) pw = (u32x4){cvtpk_bf16(p0[0], p0[1]), cvtpk_bf16(p0[2], p0[3]), cvtpk_bf16(p0[4], p0[5]), cvtpk_bf16(p0[6], p0[7])};
        else if (ks == 1) pw = (u32x4){cvtpk_bf16(p0[8], p0[9]), cvtpk_bf16(p0[10], p0[11]), cvtpk_bf16(p0[12], p0[13]), cvtpk_bf16(p0[14], p0[15])};
        else if (ks == 2) pw = (u32x4){cvtpk_bf16(p1[0], p1[1]), cvtpk_bf16(p1[2], p1[3]), cvtpk_bf16(p1[4], p1[5]), cvtpk_bf16(p1[6], p1[7])};
        else pw = (u32x4){cvtpk_bf16(p1[8], p1[9]), cvtpk_bf16(p1[10], p1[11]), cvtpk_bf16(p1[12], p1[13]), cvtpk_bf16(p1[14], p1[15])};
        const bf16x8 pf = __builtin_bit_cast(bf16x8, pw);
#pragma unroll
        for (int db = 0; db < 2; ++db) { const int i = 2 * ks + db;
            const bf16x8 vf = (bf16x8){tlo[i][0], tlo[i][1], tlo[i][2], tlo[i][3], thi[i][0], thi[i][1], thi[i][2], thi[i][3]};
            if (!ABL_ON(2)) o[db] = __builtin_amdgcn_mfma_f32_32x32x16_bf16(vf, pf, o[db], 0, 0, 0); else asm volatile("" :: "v"(vf), "v"(pf)); }
    }
}
__device__ __forceinline__ void at_fold(f32x16 (&ot)[2], f32x16 (&o)[2], float& m, float& l, float gate, bool valid) {
    const float lt = l + __shfl_xor(l, 32); const float inv = (valid && lt > 0.f) ? gate / lt : 0.f;
#pragma unroll
    for (int r = 0; r < 16; ++r) { ot[0][r] += o[0][r] * inv; ot[1][r] += o[1][r] * inv; o[0][r] = 0.f; o[1][r] = 0.f; }
    m = -1e30f; l = 0.f;
}
__device__ __forceinline__ void attn_unit_mfma(LAS unsigned char* lds, bf16* P1, const float* KC, int unit) {
    const int tid = opaque_tid(); const int lane = tid & 63, w = __builtin_amdgcn_readfirstlane(tid >> 6), r32 = lane & 31, h = lane >> 5;
    const int ti = unit & 63, g = (unit >> 6) & 1, b = unit >> 7;
    const int tq = 8 * w + (r32 >> 2), j = r32 & 3, hd = 4 * g + j; const int ts = 64 * ti + tq;
    const size_t row = (size_t)b * SEQ + ts;
    LAS float* IMP = (LAS float*)(lds + AT_IMP); LAS u64* SEL = (LAS u64*)(lds + AT_SEL); LAS unsigned* SELU = (LAS unsigned*)(lds + AT_SELU);
    __syncthreads();
    for (int e = tid; e < 4096; e += 512) IMP[e] = 0.f;
    if (tid < 2) SELU[tid] = 0u;
    if (tid < 16) ((LAS unsigned*)(lds + AT_CNT))[tid] = 0u;
    bf16x8 qr[4];
    { const bf16* qp = P1 + row * P1W + C_Q + hd * 64 + 8 * h;
#pragma unroll
      for (int d0 = 0; d0 < 4; ++d0) qr[d0] = *(const bf16x8*)(qp + 16 * d0); }
    const float g0 = bf2f(P1[row * P1W + C_GC + hd * 3 + 0]), g1 = bf2f(P1[row * P1W + C_GC + hd * 3 + 1]), g2 = bf2f(P1[row * P1W + C_GC + hd * 3 + 2]);
    f32x16 o[2], ot[2];
#pragma unroll
    for (int r = 0; r < 16; ++r) { o[0][r] = 0.f; o[1][r] = 0.f; ot[0][r] = 0.f; ot[1][r] = 0.f; }
    float m = -1e30f, l = 0.f;
    const int nv = (ts >= 31) ? ((((ts + 1) >> 4) - 1 > 255) ? 255 : ((ts + 1) >> 4) - 1) : 0;
    const int nkt = (4 * ti + 3 + 63) >> 6;
    const float* kcp = KC + ((((size_t)0 * NB + b) * 2 + g) * 256) * 64; const float* vcp = KC + ((((size_t)1 * NB + b) * 2 + g) * 256) * 64;
    {   const int np = (nkt + 1) >> 1;
        AtRegs ra = at_load_f32(kcp, vcp, 0, tid), rb = ra; if (nkt > 1) rb = at_load_f32(kcp, vcp, 64, tid);
        at_store(lds, 0, 0, ra, tid); if (nkt > 1) at_store(lds, 0, 1, rb, tid); __syncthreads();
        for (int pi = 0; pi < np; ++pi) {
            const int k0 = 2 * pi, k2 = 2 * pi + 2;
            if (k2 < nkt) { ra = at_load_f32(kcp, vcp, 64 * k2, tid); if (k2 + 1 < nkt) rb = at_load_f32(kcp, vcp, 64 * (k2 + 1), tid); }
            at_step(lds, pi & 1, 0, qr, o, m, l, mask_lo(nv - 64 * k0), lane);
            if (k0 + 1 < nkt) at_step(lds, pi & 1, 1, qr, o, m, l, mask_lo(nv - 64 * (k0 + 1)), lane);
            if (k2 < nkt) { at_store(lds, (pi + 1) & 1, 0, ra, tid); if (k2 + 1 < nkt) at_store(lds, (pi + 1) & 1, 1, rb, tid); }
            __syncthreads();
        }
        const float lt = l + __shfl_xor(l, 32); const float invl = (nv > 0 && lt > 0.f) ? 1.f / lt : 0.f;
        float prevL = 0.f;
        ra = at_load_f32(kcp, vcp, 0, tid); if (nkt > 1) rb = at_load_f32(kcp, vcp, 64, tid);
        at_store(lds, 0, 0, ra, tid); if (nkt > 1) at_store(lds, 0, 1, rb, tid); __syncthreads();
        for (int pi = 0; pi < np; ++pi) {
            const int k2 = 2 * pi + 2;
            if (k2 < nkt) { ra = at_load_f32(kcp, vcp, 64 * k2, tid); if (k2 + 1 < nkt) rb = at_load_f32(kcp, vcp, 64 * (k2 + 1), tid); }
#pragma unroll 1
            for (int sub = 0; sub < 2; ++sub) {
                const int kt = 2 * pi + sub; if (kt >= nkt) break;
                f32x16 p0, p1; at_qk(p0, p1, lds + at_koff(pi & 1, sub), qr, r32, h);
                const u64 vm = mask_lo(nv - 64 * kt); const unsigned vlo = (unsigned)vm, vhi = (unsigned)(vm >> 32);
#pragma unroll
                for (int r = 0; r < 16; ++r) { const int kx = crow(r, h);
                    p0[r] = ((vlo >> kx) & 1u) ? __builtin_amdgcn_exp2f(p0[r] * AT_C2 - m) * invl : 0.f;
                    p1[r] = ((vhi >> kx) & 1u) ? __builtin_amdgcn_exp2f(p1[r] * AT_C2 - m) * invl : 0.f; }
#pragma unroll
                for (int hh = 0; hh < 2; ++hh) {
                    float G[4], Lp[4];
#pragma unroll
                    for (int q4 = 0; q4 < 4; ++q4) { const float a0 = hh ? p1[4 * q4] : p0[4 * q4], a1 = hh ? p1[4 * q4 + 1] : p0[4 * q4 + 1], a2 = hh ? p1[4 * q4 + 2] : p0[4 * q4 + 2], a3 = hh ? p1[4 * q4 + 3] : p0[4 * q4 + 3];
                        G[q4] = (a0 + a1) + (a2 + a3); Lp[q4] = __shfl_xor(a3, 32); }
#pragma unroll
                    for (int q4 = 0; q4 < 4; ++q4) {
                        const float carry = h ? Lp[q4] : (q4 == 0 ? prevL : Lp[q4 - 1]);
                        float v = G[q4] + carry; v += __shfl_xor(v, 1); v += __shfl_xor(v, 2);
                        if (j == 0) IMP[tq * 64 + 16 * kt + 8 * hh + 2 * q4 + h] = v;
                    }
                    prevL = Lp[3];
                }
            }
            if (k2 < nkt) { at_store(lds, (pi + 1) & 1, 0, ra, tid); if (k2 + 1 < nkt) at_store(lds, (pi + 1) & 1, 1, rb, tid); }
            __syncthreads();
        }
    }
    at_fold(ot, o, m, l, g0, nv > 0);
    __syncthreads();
    const int cur = ti;
    FT0(3);
    {
        const int tok = tid >> 3, j8 = tid & 7; u64 selt = 1ull | (1ull << cur) | (cur >= 1 ? (1ull << (cur - 1)) : 0ull);
        float cv[8];
#pragma unroll
        for (int k = 0; k < 8; ++k) { const int mm = j8 + 8 * k; cv[k] = (mm >= 1 && mm <= cur - 2) ? IMP[tok * 64 + mm] : -1.f; }
        const int npick = (cur - 2) < 5 ? (cur - 2) : 5;
        for (int pk = 0; pk < npick; ++pk) { float best = -1.f; int bi = 64;
#pragma unroll
            for (int k = 0; k < 8; ++k) if (cv[k] > best) { best = cv[k]; bi = j8 + 8 * k; }
#pragma unroll
            for (int off = 1; off < 8; off <<= 1) { const float ov = __shfl_xor(best, off); const int oi = __shfl_xor(bi, off); if (ov > best || (ov == best && oi < bi)) { best = ov; bi = oi; } }
            selt |= 1ull << (bi & 63);
#pragma unroll
            for (int k = 0; k < 8; ++k) if (j8 + 8 * k == bi) cv[k] = -2.f; }
        if (j8 == 0) { SEL[tok] = selt; atomicOr((unsigned*)&SELU[0], (unsigned)selt); atomicOr((unsigned*)&SELU[1], (unsigned)(selt >> 32)); }
    }
    __syncthreads();
    FT1(3);
    const u64 sel = SEL[tq];
    const u64 selu = ((u64)SELU[1] << 32) | (u64)SELU[0];
    {
        const bf16* kb = P1 + (size_t)b * SEQ * P1W + C_KV + (2 * 2 + g) * 64; const bf16* vbp = P1 + (size_t)b * SEQ * P1W + C_KV + (3 * 2 + g) * 64;
        LAS unsigned* FIL = (LAS unsigned*)(lds + AT_CNT); LAS unsigned* DON = FIL + 8;
        const int n = __builtin_popcountll(selu);
        u64 remL = selu, remC = selu;
        {   AtRegs r0, r1, r2; int b0 = __builtin_ctzll(remL); remL &= remL - 1; r0 = at_load_bf16(kb + (size_t)b0 * 64 * P1W, vbp + (size_t)b0 * 64 * P1W, tid); r1 = r0; r2 = r0;
            if (n > 1) { const int b1 = __builtin_ctzll(remL); remL &= remL - 1; r1 = at_load_bf16(kb + (size_t)b1 * 64 * P1W, vbp + (size_t)b1 * 64 * P1W, tid); }
            if (n > 2) { const int b2 = __builtin_ctzll(remL); remL &= remL - 1; r2 = at_load_bf16(kb + (size_t)b2 * 64 * P1W, vbp + (size_t)b2 * 64 * P1W, tid); }
            at_store(lds, 0, 0, r0, tid); ring_signal(FIL + 0, lane);
            if (n > 1) { at_store(lds, 0, 1, r1, tid); ring_signal(FIL + 1, lane); }
            if (n > 2) { at_store(lds, 1, 0, r2, tid); ring_signal(FIL + 2, lane); } }
        AtRegs rg; rg.k = (u32x4){0u, 0u, 0u, 0u}; rg.v = rg.k;
        if (n > 3) { const int b3 = __builtin_ctzll(remL); remL &= remL - 1; rg = at_load_bf16(kb + (size_t)b3 * 64 * P1W, vbp + (size_t)b3 * 64 * P1W, tid); }
        int jc = 0, gc = 1, js = 3, gs = 0;
#pragma unroll 1
        for (int t = 0; t < n; ++t) {
            const int mbc = __builtin_ctzll(remC); remC &= remC - 1;
            if (t + 3 < n) {
                FT0(4); ring_wait(DON + js, 8u * (unsigned)gs); FT1(4);
                FT0(5); at_store(lds, js >> 1, js & 1, rg, tid); ring_signal(FIL + js, lane); FT1(5);
                if (t + 4 < n) { const int bn = __builtin_ctzll(remL); remL &= remL - 1; rg = at_load_bf16(kb + (size_t)bn * 64 * P1W, vbp + (size_t)bn * 64 * P1W, tid); }
            }
            FT0(6); ring_wait(FIL + jc, 8u * (unsigned)gc); FT1(6);
            u64 vm = 0ull; if ((sel >> mbc) & 1ull) vm = (mbc == cur) ? mask_lo((ts & 63) + 1) : ~0ull;
            FT0(7); at_step(lds, jc >> 1, jc & 1, qr, o, m, l, vm, lane); FT1(7);
            ring_signal(DON + jc, lane);
            if (++jc == 6) { jc = 0; ++gc; }
            if (++js == 6) { js = 0; ++gs; }
        }
        __syncthreads();
    }
    at_fold(ot, o, m, l, g1, true);
    {   const bf16* kb = P1 + (size_t)b * SEQ * P1W + C_KV + (4 * 2 + g) * 64; const bf16* vbp = P1 + (size_t)b * SEQ * P1W + C_KV + (5 * 2 + g) * 64;
        const int mlo = (ti >= 8) ? ti - 8 : 0; const int nw = cur - mlo + 1, np = (nw + 1) >> 1;
        AtRegs ra = at_load_bf16(kb + (size_t)mlo * 64 * P1W, vbp + (size_t)mlo * 64 * P1W, tid), rb = ra; if (nw > 1) rb = at_load_bf16(kb + (size_t)(mlo + 1) * 64 * P1W, vbp + (size_t)(mlo + 1) * 64 * P1W, tid);
        at_store(lds, 0, 0, ra, tid); if (nw > 1) at_store(lds, 0, 1, rb, tid); __syncthreads();
        for (int pi = 0; pi < np; ++pi) {
            const int i0 = 2 * pi, i2 = 2 * pi + 2;
            if (i2 < nw) { ra = at_load_bf16(kb + (size_t)(mlo + i2) * 64 * P1W, vbp + (size_t)(mlo + i2) * 64 * P1W, tid); if (i2 + 1 < nw) rb = at_load_bf16(kb + (size_t)(mlo + i2 + 1) * 64 * P1W, vbp + (size_t)(mlo + i2 + 1) * 64 * P1W, tid); }
#pragma unroll 1
            for (int sub = 0; sub < 2; ++sub) { const int mb = mlo + i0 + sub; if (i0 + sub >= nw) break;
                const int lo = ts - 511 - mb * 64, hi = ts - mb * 64;
                u64 vm = 0ull; if (hi >= 0 && lo <= 63) vm = mask_lo(hi + 1) & ~mask_lo(lo);
                at_step(lds, pi & 1, sub, qr, o, m, l, vm, lane); }
            if (i2 < nw) { at_store(lds, (pi + 1) & 1, 0, ra, tid); if (i2 + 1 < nw) at_store(lds, (pi + 1) & 1, 1, rb, tid); }
            __syncthreads();
        }
    }
    at_fold(ot, o, m, l, g2, true);
    {   bf16* op = P1 + row * P1W + C_Q + hd * 64 + 4 * h;
#pragma unroll
        for (int db = 0; db < 2; ++db)
#pragma unroll
            for (int q4 = 0; q4 < 4; ++q4) { u32x2 wv; wv.x = cvtpk_bf16(ot[db][4 * q4], ot[db][4 * q4 + 1]); wv.y = cvtpk_bf16(ot[db][4 * q4 + 2], ot[db][4 * q4 + 3]); GST(*(u32x2*)(op + 32 * db + 8 * q4) = wv); } }
}

__device__ __forceinline__ void set_dry(LAS unsigned char* l, int v) { __syncthreads(); if (threadIdx.x == 0) ((volatile LAS int*)(l + LDS_CTL + 64))[0] = v; __syncthreads(); }
constexpr int NPH = 1 + 9 * NL;
__global__ void __launch_bounds__(512, 2) fwd_kernel(Args args) {
    extern __shared__ __attribute__((aligned(16))) unsigned char lds_raw[];
    LAS unsigned char* ldsl = (LAS unsigned char*)lds_raw;
    float* ldsf = (float*)lds_raw;
    const int G0 = gridDim.x, bx0 = blockIdx.x, G = G0, bx = bx0, NGW = G * 8;
#define PHASE_IDS() const int tid = opaque_tid(), lane = tid & 63, wave = __builtin_amdgcn_readfirstlane(tid >> 6), gw = bx * 8 + wave; (void)lane; (void)gw
#define ws ARG_WS()
#define ctl ((unsigned*)(ws + WS_CTL))
#define H ARG_OUT()
#define XN ((bf16*)(ws + WS_XN))
#define P1 ((bf16*)(ws + WS_P1))
#define Rr ((bf16*)(ws + WS_R))
#define WIN ((bf16*)(ws + WS_WIN))
#define WB ((bf16*)(ws + WS_WB))
#define WOUT ((bf16*)(ws + WS_WOUT))
#define WGU ((bf16*)(ws + WS_WGU))
#define WD ((bf16*)(ws + WS_WD))
#define HID ((bf16*)(ws + WS_HID))
#define Y ((bf16*)(ws + WS_Y))
#define KC ((float*)(ws + WS_KC))
#define AGA ((float*)(ws + WS_LRUA))
#define AGH ((float*)(ws + WS_LRUH))
#define LIST ((unsigned*)(ws + WS_LIST))
#define LISTW ((float*)(ws + WS_LISTW))
    { PHASE_IDS(); for (int u = tid; u < (LDS_BYTES - LDS_CTL) / 4; u += 512) ((LAS unsigned*)(ldsl + LDS_CTL))[u] = 0u; }
    __syncthreads();
    if (!MK_SPLIT) (void)xcd_barrier_post(ctl + CW_BAR, (volatile LAS unsigned*)(ldsl + LDS_CTL + 32));
    const int lo = args.ph_lo, hi = args.ph_hi;
#define IN(k) (lo <= (k) && (k) < hi)
#if PROBE_PH >= 0
#ifndef PROBE_REAL
#define PROBE_REAL 0
#endif
#define PHASE_REP(id) for (int rep_ = 0; rep_ < (((id) == PROBE_PH) ? 2 : 1); ++rep_, set_dry(ldsl, 0)) if (set_dry(ldsl, PROBE_REAL ? 0 : rep_), true)
#else
#define PHASE_REP(id) if (true)
#endif
#define SEAM(k) do { if (!MK_SPLIT && IN((k) + 1)) { XcdBarrier bb_; bb_.bar = ctl + CW_BAR; bb_.x = xb_xcc_id(); bb_.st = (volatile LAS unsigned*)(ldsl + LDS_CTL + 32); \
    for (int r_ = 0; r_ < ((PROBE_PH == 50) ? 3 : 1); ++r_) xcd_barrier(bb_); } } while (0)

    if (IN(0)) PHASE_REP(100) {
        PHASE_IDS();
        float* scr = ldsf + wave * 4096;
        constexpr int IT_W1 = 32 * 2, IT_LW = 2, IT_PW = 2 * 4;
        constexpr int NSMALL = NL * 4 * IT_W1 + NL * 16 * IT_LW + NL * 4 * IT_PW;
        auto dec0 = [&](int it) -> TrItem {
            if (it < IT_BIG) return dec_big(it, 0);
            int r = it - IT_BIG;
            if (r < NL * 4 * IT_W1) { const int m = r / IT_W1; r -= m * IT_W1; return TrItem{ARG_IN(I_CW1) + (size_t)m * 2048 * 64, (bf16*)(ws + WS_W1T) + (size_t)m * 64 * 2048, 2048, 64, r / 2, r % 2, 0}; }
            r -= NL * 4 * IT_W1;
            if (r < NL * 16 * IT_LW) { const int m = r / IT_LW; r -= m * IT_LW; const int l = m >> 4, mat = (m >> 3) & 1, hh = m & 7;
                return TrItem{ARG_IN(mat ? I_LWX : I_LWA) + ((size_t)l * 8 + hh) * 4096, (bf16*)(ws + WS_LWT) + (size_t)m * 4096, 64, 64, 0, r, 0}; }
            r -= NL * 16 * IT_LW;
            { const int m = r / IT_PW; r -= m * IT_PW; return TrItem{ARG_IN(I_PW) + (size_t)m * 16384, (bf16*)(ws + WS_PWT) + (size_t)m * 16384, 128, 128, r / 4, r % 4, 0}; }
        };
        constexpr int NIT0 = IT_BIG + NSMALL;
        if (gw < NIT0) { TrItem cur = dec0(gw); TrRegs rv = tr_load(cur, lane);
            for (int it = gw; it < NIT0; it += NGW) { TrItem nxt = cur; TrRegs rn = rv; const bool more = it + NGW < NIT0;
                if (more) { nxt = dec0(it + NGW); rn = tr_load(nxt, lane); }
                tr_finish(cur, rv, scr, lane); cur = nxt; rv = rn; } }
        for (int e = bx * 512 + tid; e < NL * 232 * 128; e += G * 512) { const int l = e / (232 * 128), rr = (e / 128) % 232, c8 = (e % 128) * 8;
            GST(*(u32x4*)(WIN + ((size_t)l * NPROJ + C_GC + 24 + rr) * D + c8) = (u32x4){0u, 0u, 0u, 0u}); }
        for (int m = gw; m < T; m += 2 * NGW) norm_rows<0>(ARG_IN(I_X), H, nullptr, nullptr, ARG_IN(I_N1G), XN, m, m + NGW, m + NGW < T, lane);
    }
    SEAM(0);

    unsigned long long tacc_ = 0ull, tbeg_ = 0ull; (void)tacc_; (void)tbeg_;
#define TBEG(id) do { if (PROBE_T_LO >= 0 && (id) == PROBE_T_LO) tbeg_ = __builtin_amdgcn_s_memrealtime(); } while (0)
#define TEND(id) do { if (PROBE_T_LO >= 0 && (id) + 1 == PROBE_T_HI) tacc_ += __builtin_amdgcn_s_memrealtime() - tbeg_; } while (0)
    for (int l = 0; l < NL; ++l) {
        const int pb = 1 + 9 * l;
#define OPQ_S(x) ({ int t_ = (x); asm volatile("" : "+s"(t_)); t_; })
#undef bx
#undef G
        TBEG(0);
        if (IN(pb + 0)) PHASE_REP(0) {
            const int bxo = OPQ_S(bx0), Go = OPQ_S(G0); (void)bxo; (void)Go;
#define bx bxo
#define G Go
            SchedDense S{XN, WIN + (size_t)l * NPROJ * D, D, D, T / 256, NPROJ / 256, G, bx, nullptr, 0u, nullptr, 16};
            EpiProj E{P1, Rr};
            pg8::gemm_phase<EpiProj, SchedDense, true>(ldsl, D, S, E);
        }
        SEAM(pb + 0); TEND(0);
#undef bx
#undef G
        TBEG(1);
        if (IN(pb + 1)) PHASE_REP(1) {
            const int bxo = OPQ_S(bx0), Go = OPQ_S(G0); (void)bxo; (void)Go;
#define bx bxo
#define G Go
            constexpr int U_LRU = NB * 64, U_GM = 128 * 2, U_CMP = 256;
            for (int u = bx; u < U_LRU + U_GM + U_CMP; u += G) {
                SUBT0(); const int ty_ = (u < U_CMP) ? 6 : (u < U_CMP + U_GM) ? 7 : 8; (void)ty_;
                if (u < U_CMP) cmp_unit2(ldsl, P1, KC, ARG_IN(I_PE) + (size_t)l * 2 * 2048, (const bf16*)(ws + WS_W1T) + (size_t)l * 4 * 64 * 2048, ARG_IN(I_CW2) + (size_t)l * 4 * 4096, u);
                else if (u < U_CMP + U_GM) gmlp_unit3(ldsl, P1, ARG_IN(I_GMNG) + l * 512, ARG_IN(I_GMWS) + (size_t)l * 4 * 16384, ARG_IN(I_GMB) + l * 512, u - U_CMP);
                else lru_unit2(ldsl, P1, XN, AGA, AGH, ARG_IN(I_CONVW) + l * 2048, ARG_IN(I_CONVB) + l * 512, (const bf16*)(ws + WS_LWT) + (size_t)(l * 2 + 0) * 8 * 4096, (const bf16*)(ws + WS_LWT) + (size_t)(l * 2 + 1) * 8 * 4096,
                               ARG_IN(I_LBA) + l * 512, ARG_IN(I_LBX) + l * 512, ARG_IN(I_LLAM) + l * 512, u - U_CMP - U_GM);
                SUBT1(ty_);
            }
            __syncthreads();
        }
        SEAM(pb + 1); TEND(1);
#undef bx
#undef G
        TBEG(2);
        if (IN(pb + 2)) PHASE_REP(2) {
            const int bxo = OPQ_S(bx0), Go = OPQ_S(G0); (void)bxo; (void)Go;
#define bx bxo
#define G Go
            constexpr int U_AT = NB * 2 * 64, U_PL = NB * 64 * 4, U_FX = NB * 64;
            const int U_CV = (l == 0 && NL > 1) ? (IT_BIG + 7) / 8 : 0;
            for (int u = bx; u < U_AT; u += G) {
                SUBT0(); const int ty_ = 1; (void)ty_;
                { const int k = u >> 3, bg = u & 7; const int ti = (u < 256) ? 63 - k : k - 32; attn_unit_mfma(ldsl, P1, KC, (bg << 6) | ti); }
                SUBT1(ty_);
            }
            {   const int NDYN = U_PL + U_FX + U_CV; unsigned* qctr = ctl + CW_Q + 64 * l; volatile LAS unsigned* qslot = (volatile LAS unsigned*)(ldsl + LDS_CTL + 192);
                unsigned nx = 0u; const bool ldr = (threadIdx.x == 0) && !is_dry();
                if (threadIdx.x == 0) nx = is_dry() ? (unsigned)NDYN : __hip_atomic_fetch_add(qctr, 1u, __ATOMIC_RELAXED, __HIP_MEMORY_SCOPE_AGENT);
                for (;;) {
                    __syncthreads(); if (threadIdx.x == 0) qslot[0] = nx; __syncthreads();
                    const int u = (int)qslot[0]; if (u >= NDYN) break;
                    if (ldr) nx = __hip_atomic_fetch_add(qctr, 1u, __ATOMIC_RELAXED, __HIP_MEMORY_SCOPE_AGENT);
                    SUBT0(); const int ty_ = (u < U_FX) ? 3 : (u < U_FX + U_PL) ? 2 : 4; (void)ty_;
                    if (u < U_FX) lrufix_unit2(ldsl, P1, XN, AGA, AGH, u);
                    else if (u < U_FX + U_PL) pool_unit2(ldsl, P1, (const bf16*)(ws + WS_PWT) + ((size_t)l * 4 + ((u - U_FX) & 3)) * 16384, ARG_IN(I_PS) + l * 512, u - U_FX);
                    else conv_unit(ldsf, u - U_FX - U_PL);
                    SUBT1(ty_);
                }
            }
            __syncthreads();
        }
        SEAM(pb + 2); TEND(2);
#undef bx
#undef G
        TBEG(3);
        if (IN(pb + 3)) PHASE_REP(3) {
            const int bxo = OPQ_S(bx0), Go = OPQ_S(G0); (void)bxo; (void)Go;
#define bx bxo
#define G Go
            SchedMerge S{P1, WB + (size_t)l * 4 * 1024 * 512, G, bx, ctl + CW_G2 + l * 4096};
            EpiMerge E{Rr, XN};
            pg8::gemm_phase<EpiMerge, SchedMerge, true>(ldsl, 512, S, E);
        }
        if (MK_SPLIT) { SEAM(pb + 3); } TEND(3);
#undef bx
#undef G
        TBEG(4);
        if (IN(pb + 4)) PHASE_REP(4) {
            const int bxo = OPQ_S(bx0), Go = OPQ_S(G0); (void)bxo; (void)Go;
#define bx bxo
#define G Go
            SchedDense S{XN, WOUT + (size_t)l * 1024 * 1024, D, D, T / 256, 4, G, bx, MK_SPLIT ? nullptr : ctl + CW_G2 + l * 4096, 32u, ctl, 0};
            EpiWout E{(l == 0) ? ARG_IN(I_X) : (const float*)H, H};
            pg8::gemm_phase<EpiWout, SchedDense, true>(ldsl, D, S, E);
        }
        SEAM(pb + 4); TEND(4);
#undef bx
#undef G
        TBEG(5);
        if (IN(pb + 5)) PHASE_REP(5) {
            const int bxo = OPQ_S(bx0), Go = OPQ_S(G0); (void)bxo; (void)Go;
#define bx bxo
#define G Go
            PHASE_IDS();
            {   SUBT0();
                float* scr = ldsf + wave * 4096;
                constexpr int IT_G = 16 * 16, IT_D = 8 * 32;
                auto dec1 = [&](int it) -> TrItem {
                    const int e = it / (2 * IT_G + IT_D); int r = it % (2 * IT_G + IT_D);
                    if (r < IT_G) return TrItem{ARG_IN(I_MG) + ((size_t)l * 16 + e) * 1024 * 512, WGU + (size_t)e * 1024 * 1024, 1024, 512, r / 16, r % 16, 2};
                    if (r < 2 * IT_G) { r -= IT_G; return TrItem{ARG_IN(I_MU) + ((size_t)l * 16 + e) * 1024 * 512, WGU + (size_t)e * 1024 * 1024, 1024, 512, r / 16, r % 16, 3}; }
                    r -= 2 * IT_G; return TrItem{ARG_IN(I_MD) + ((size_t)l * 16 + e) * 512 * 1024, WD + (size_t)e * 1024 * 512, 512, 1024, r / 32, r % 32, 0};
                };
                constexpr int NIT1 = 16 * (2 * IT_G + IT_D);
                if (gw < NIT1) { TrItem cur = dec1(gw); TrRegs rv = tr_load(cur, lane);
                    for (int it = gw; it < NIT1; it += NGW) { TrItem nxt = cur; TrRegs rn = rv; const bool more = it + NGW < NIT1;
                        if (more) { nxt = dec1(it + NGW); rn = tr_load(nxt, lane); }
                        tr_finish(cur, rv, scr, lane); cur = nxt; rv = rn; } }
                SUBT1(4);
            }
            SUBT0();
            __syncthreads();
            for (int k = tid; k < 1024; k += 512) { const f32x4 wg = *(const f32x4*)(ARG_IN(I_RWG) + (size_t)l * 4096 + k * 4); const float* we = ARG_IN(I_RWE) + (size_t)l * 16384 + k * 16;
                const f32x4 e0 = *(const f32x4*)we, e1 = *(const f32x4*)(we + 4), e2 = *(const f32x4*)(we + 8), e3 = *(const f32x4*)(we + 12);
                ldsf[0 * 1024 + k] = wg.x; ldsf[1 * 1024 + k] = wg.y; ldsf[2 * 1024 + k] = wg.z; ldsf[3 * 1024 + k] = wg.w;
                ldsf[4 * 1024 + k] = e0.x; ldsf[5 * 1024 + k] = e0.y; ldsf[6 * 1024 + k] = e0.z; ldsf[7 * 1024 + k] = e0.w; ldsf[8 * 1024 + k] = e1.x; ldsf[9 * 1024 + k] = e1.y; ldsf[10 * 1024 + k] = e1.z; ldsf[11 * 1024 + k] = e1.w;
                ldsf[12 * 1024 + k] = e2.x; ldsf[13 * 1024 + k] = e2.y; ldsf[14 * 1024 + k] = e2.z; ldsf[15 * 1024 + k] = e2.w; ldsf[16 * 1024 + k] = e3.x; ldsf[17 * 1024 + k] = e3.y; ldsf[18 * 1024 + k] = e3.z; ldsf[19 * 1024 + k] = e3.w; }
            __syncthreads();
            const float* g2 = ARG_IN(I_N2G) + l * D; const float* bg = ARG_IN(I_RBG) + l * 4; const float* be = ARG_IN(I_RBE) + l * 16;
            unsigned* cnt = ctl + CW_CNT + 64 * l;
            LAS unsigned* hist = (LAS unsigned*)(ldsl + 81920); LAS unsigned* baseL = hist + 16; LAS unsigned* rinfo = hist + 32;
            for (int ck = bx; ck < T / 64; ck += G) {
              if (tid < 16) hist[tid] = 0u;
              __syncthreads();
              f32x4 vnx[2][4];
#pragma unroll
              for (int rr = 0; rr < 2; ++rr) { const float* hr0 = H + (size_t)(ck * 64 + wave * 8 + rr) * D;
#pragma unroll
                for (int jj = 0; jj < 4; ++jj) vnx[rr][jj] = *(const f32x4*)(hr0 + 4 * lane + 256 * jj); }
#pragma unroll 1
              for (int ri = 0; ri < 8; ri += 2) { const int rl = wave * 8 + ri; const int m = ck * 64 + rl;
                f32x4 v[2][4];
#pragma unroll
                for (int rr = 0; rr < 2; ++rr)
#pragma unroll
                    for (int jj = 0; jj < 4; ++jj) v[rr][jj] = vnx[rr][jj];
                if (ri + 2 < 8) {
#pragma unroll
                    for (int rr = 0; rr < 2; ++rr) { const float* hr1 = H + (size_t)(m + 2 + rr) * D;
#pragma unroll
                        for (int jj = 0; jj < 4; ++jj) vnx[rr][jj] = *(const f32x4*)(hr1 + 4 * lane + 256 * jj); } }
#pragma unroll
                for (int rr = 0; rr < 2; ++rr) { float ss = 0.f;
#pragma unroll
                    for (int jj = 0; jj < 4; ++jj) ss += (v[rr][jj].x * v[rr][jj].x + v[rr][jj].y * v[rr][jj].y) + (v[rr][jj].z * v[rr][jj].z + v[rr][jj].w * v[rr][jj].w);
                    const float rstd = rsqrtf(wave_sum(ss) * (1.f / D) + EPS);
#pragma unroll
                    for (int jj = 0; jj < 4; ++jj) { const f32x4 gg = *(const f32x4*)(g2 + 4 * lane + 256 * jj); v[rr][jj].x *= rstd * gg.x; v[rr][jj].y *= rstd * gg.y; v[rr][jj].z *= rstd * gg.z; v[rr][jj].w *= rstd * gg.w;
                        u32x2 o; o.x = pk2(v[rr][jj].x, v[rr][jj].y); o.y = pk2(v[rr][jj].z, v[rr][jj].w); GST(*(u32x2*)(XN + (size_t)(m + rr) * D + 4 * lane + 256 * jj) = o); } }
                float lg[2][20];
#pragma unroll
                for (int o = 0; o < 20; ++o) { float a0 = 0.f, a1 = 0.f;
#pragma unroll
                    for (int jj = 0; jj < 4; ++jj) { const f32x4 wv = *(const f32x4*)(ldsf + o * 1024 + 4 * lane + 256 * jj);
                        a0 += v[0][jj].x * wv.x + v[0][jj].y * wv.y + v[0][jj].z * wv.z + v[0][jj].w * wv.w; a1 += v[1][jj].x * wv.x + v[1][jj].y * wv.y + v[1][jj].z * wv.z + v[1][jj].w * wv.w; }
                    lg[0][o] = wave_sum(a0); lg[1][o] = wave_sum(a1); if ((o & 3) == 3) __builtin_amdgcn_sched_barrier(0); }
#pragma unroll
                for (int rr = 0; rr < 2; ++rr) {
                float gl[4]; int grp = 0; float gmx;
#pragma unroll
                for (int k = 0; k < 4; ++k) gl[k] = lg[rr][k] + bg[k];
                gmx = gl[0];
#pragma unroll
                for (int k = 1; k < 4; ++k) if (gl[k] > gmx) { gmx = gl[k]; grp = k; }
                float den = 0.f;
#pragma unroll
                for (int k = 0; k < 4; ++k) den += __expf(gl[k] - gmx);
                const float grpw = 1.f / den;
                float el[4];
#pragma unroll
                for (int k = 0; k < 4; ++k) { float vsel = 0.f;
#pragma unroll
                    for (int gg = 0; gg < 4; ++gg) vsel = (grp == gg) ? (lg[rr][4 + gg * 4 + k] + be[gg * 4 + k]) : vsel;
                    el[k] = vsel; }
                int i1 = 0; float m1 = el[0];
#pragma unroll
                for (int k = 1; k < 4; ++k) if (el[k] > m1) { m1 = el[k]; i1 = k; }
                int i2 = -1; float m2 = 0.f;
#pragma unroll
                for (int k = 0; k < 4; ++k) if (k != i1 && (i2 < 0 || el[k] > m2)) { m2 = el[k]; i2 = k; }
                const float ex = __expf(m2 - m1); const float w1 = grpw / (1.f + ex), w2 = grpw * ex / (1.f + ex);
                if (lane == 0) {
                    const int e1 = grp * 4 + i1, e2 = grp * 4 + i2; const int rq = rl + rr;
                    const unsigned p1 = atomicAdd((unsigned*)&hist[e1], 1u), p2 = atomicAdd((unsigned*)&hist[e2], 1u);
                    rinfo[rq * 4 + 0] = (unsigned)e1 | ((unsigned)e2 << 8); rinfo[rq * 4 + 1] = p1 | (p2 << 16); rinfo[rq * 4 + 2] = __builtin_bit_cast(unsigned, w1); rinfo[rq * 4 + 3] = __builtin_bit_cast(unsigned, w2);
                }
                }
              }
              __syncthreads();
              if (tid < 16) { const unsigned hc = hist[tid]; baseL[tid] = (hc && !is_dry()) ? atomicAdd(&cnt[tid], hc) : 0u; }
              __syncthreads();
              if (tid < 64 && !is_dry()) { const unsigned ee = rinfo[tid * 4 + 0], pp = rinfo[tid * 4 + 1]; const unsigned e1 = ee & 255u, e2 = ee >> 8; const unsigned m = (unsigned)(ck * 64 + tid);
                  const size_t q1 = (size_t)e1 * T + baseL[e1] + (pp & 0xffffu), q2 = (size_t)e2 * T + baseL[e2] + (pp >> 16);
                  LIST[q1] = m; LISTW[q1] = __builtin_bit_cast(float, rinfo[tid * 4 + 2]); LIST[q2] = m | (1u << 14); LISTW[q2] = __builtin_bit_cast(float, rinfo[tid * 4 + 3]); }
              __syncthreads();
            }
            SUBT1(5);
        }
        SEAM(pb + 5); TEND(5);
#undef bx
#undef G
        TBEG(6);
        if (IN(pb + 6) || IN(pb + 7)) {
            __syncthreads();
            if (threadIdx.x == 0) { LAS int* tw = (LAS int*)(ldsl + LDS_MOE); int acc = 0;
                for (int e = 0; e < 16; ++e) { const int c = (int)__hip_atomic_load(ctl + CW_CNT + 64 * l + e, __ATOMIC_RELAXED, __HIP_MEMORY_SCOPE_AGENT); tw[e] = acc; tw[32 + e] = c; acc += (c + 255) >> 8; }
                tw[16] = acc; }
            __syncthreads();
        }
        if (IN(pb + 6)) PHASE_REP(6) {
            const int bxo = OPQ_S(bx0), Go = OPQ_S(G0); (void)bxo; (void)Go;
#define bx bxo
#define G Go
            SchedMoe S{XN, WGU, LIST, D, D, 1024, G, bx, true, ctl + CW_E1 + l * 16384, ctl};
            EpiGateUp E{HID, LISTW};
            pg8::gemm_phase<EpiGateUp, SchedMoe, true>(ldsl, D, S, E);
        }
        if (MK_SPLIT) { SEAM(pb + 6); } TEND(6);
#undef bx
#undef G
        TBEG(7);
        if (IN(pb + 7)) PHASE_REP(7) {
            const int bxo = OPQ_S(bx0), Go = OPQ_S(G0); (void)bxo; (void)Go;
#define bx bxo
#define G Go
            SchedMoe S{HID, WD, LIST, 512, 512, 1024, G, bx, false, ctl + CW_E1 + l * 16384, ctl};
            EpiDown E{Y, LIST};
            pg8::gemm_phase<EpiDown, SchedMoe, true>(ldsl, 512, S, E);
        }
        SEAM(pb + 7); TEND(7);
#undef bx
#undef G
        TBEG(8);
        if (IN(pb + 8)) PHASE_REP(8) {
            const int bxo = OPQ_S(bx0), Go = OPQ_S(G0); (void)bxo; (void)Go;
#define bx bxo
#define G Go
            PHASE_IDS();
            if (l + 1 < NL) { for (int m = gw; m < T; m += 2 * NGW) norm_rows<1>(nullptr, H, Y, Y + (size_t)T * D, ARG_IN(I_N1G) + (l + 1) * D, XN, m, m + NGW, m + NGW < T, lane); }
            else { for (int m = gw; m < T; m += 2 * NGW) norm_rows<2>(nullptr, H, Y, Y + (size_t)T * D, ARG_IN(I_FNG), nullptr, m, m + NGW, m + NGW < T, lane); }
        }
        if (l + 1 < NL) SEAM(pb + 8);
        TEND(8);
    }
#undef bx
#undef G
#ifdef PROBE_FINE
    tacc_ += *(volatile LAS unsigned long long*)(ldsl + LDS_CTL + 128);
#endif
    if (PROBE_T_LO >= 0 && bx == PROBE_BLK) { const unsigned long long tgt = __builtin_amdgcn_s_memrealtime() + PROBE_T_MULT * tacc_; while (__builtin_amdgcn_s_memrealtime() < tgt) __builtin_amdgcn_s_sleep(16); }
#undef IN
#undef SEAM
#undef ws
#undef ctl
#undef H
#undef XN
#undef P1
#undef Rr
#undef WIN
#undef WB
#undef WOUT
#undef WGU
#undef WD
#undef HID
#undef Y
#undef KC
#undef AGA
#undef AGH
#undef LIST
#undef LISTW
}

extern "C" void kernel_launch(void* const* d_in, const int* in_sizes, int n_in, void* d_out, int out_size, void* d_ws, size_t ws_size, hipStream_t stream) {
    static int grid = 0;
    if (grid == 0) {
        if (n_in != 29 || in_sizes[0] != T * D || out_size != T * D || ws_size < WS_END) { fprintf(stderr, "kernel_launch: unexpected shapes / workspace (%d inputs, ws %zu < %zu); nothing launched\n", n_in, ws_size, (size_t)WS_END); grid = -1; return; }
        int dev = 0, cus = 0;
        if (hipGetDevice(&dev) != hipSuccess || hipDeviceGetAttribute(&cus, hipDeviceAttributeMultiprocessorCount, dev) != hipSuccess) { grid = -1; return; }
        if (hipFuncSetAttribute((const void*)fwd_kernel, hipFuncAttributeMaxDynamicSharedMemorySize, LDS_BYTES) != hipSuccess) { fprintf(stderr, "kernel_launch: hipFuncSetAttribute failed\n"); grid = -1; return; }
        int per_cu = 0;
        if (hipOccupancyMaxActiveBlocksPerMultiprocessor(&per_cu, (const void*)fwd_kernel, 512, LDS_BYTES) != hipSuccess || per_cu < 1) { fprintf(stderr, "kernel_launch: occupancy query says %d\n", per_cu); }
        (void)hipGetLastError();
        grid = cus;
    }
    if (grid < 0) return;
    if (hipMemsetAsync((char*)d_ws + WS_CTL, 0, CTL_ZERO_BYTES, stream) != hipSuccess) return;
    Args a{};
    for (int i = 0; i < 29; ++i) a.in[i] = (const float*)d_in[i];
    a.out = (float*)d_out; a.ws = (unsigned char*)d_ws;
#if MK_SPLIT
    for (int p = 0; p < NPH; ++p) { a.ph_lo = p; a.ph_hi = p + 1; hipLaunchKernelGGL(fwd_kernel, dim3(grid), dim3(512), LDS_BYTES, stream, a); }
#else
    a.ph_lo = 0; a.ph_hi = NPH;
    hipLaunchKernelGGL(fwd_kernel, dim3(grid), dim3(512), LDS_BYTES, stream, a);
#endif
}
```

```cpp
#include <hip/hip_runtime.h>
#include <cstdio>
#include <cstdint>

#define GAS __attribute__((address_space(1)))
#define LAS __attribute__((address_space(3)))
typedef unsigned short bf16;
typedef unsigned u32x4 __attribute__((ext_vector_type(4)));
typedef unsigned u32x2 __attribute__((ext_vector_type(2)));
typedef float f32x4 __attribute__((ext_vector_type(4)));
typedef float f32x2 __attribute__((ext_vector_type(2)));
typedef short bf16x8 __attribute__((ext_vector_type(8)));
typedef unsigned long long u64;

#ifndef MK_SPLIT
#define MK_SPLIT 0
#endif

constexpr int NB = 4, SEQ = 4096, T = NB * SEQ, D = 1024, MIX = 512, NL = 2;
constexpr int NIN = 7960, NPROJ = 8192, P1W = 3904;
constexpr int C_U = 0, C_V = 512, C_GB = 1024, C_RB = 1536, C_Q = 2048, C_KV = 2560, C_XD = 3328, C_GC = 3840;
constexpr int SRC_GC = 3328, SRC_XD = 3352, SRC_MG = 3864;
constexpr float EPS = 1e-6f;
constexpr int NEXP = 16, DEXP = 512;
constexpr int HID_ROWS = 2 * T + 4096;

constexpr size_t MiB = 1u << 20;
constexpr size_t WS_CTL = 0, CTL_ZERO_BYTES = 1 * MiB;
constexpr size_t WS_KC = 1 * MiB;
constexpr size_t WS_LRUA = 2 * MiB;
constexpr size_t WS_LRUH = 2 * MiB + 512 * 1024;
constexpr size_t WS_LIST = 3 * MiB;
constexpr size_t WS_LISTW = 4 * MiB;
constexpr size_t WS_W1T = 5 * MiB;
constexpr size_t WS_LWT = 7 * MiB;
constexpr size_t WS_PWT = 7 * MiB + 256 * 1024;
constexpr size_t WS_WIN = 8 * MiB;
constexpr size_t WS_WB = 40 * MiB;
constexpr size_t WS_WOUT = 48 * MiB;
constexpr size_t WS_XN = 52 * MiB;
constexpr size_t WS_P1 = 84 * MiB;
constexpr size_t WS_R = 206 * MiB;
constexpr size_t WS_WGU = 84 * MiB;
constexpr size_t WS_WD = 116 * MiB;
constexpr size_t WS_HID = 132 * MiB;
constexpr size_t WS_Y = 168 * MiB;
constexpr size_t WS_END = 334 * MiB;
static_assert(WS_HID + (size_t)HID_ROWS * 512 * 2 <= WS_Y && WS_Y + (size_t)2 * T * 1024 * 2 <= WS_END && WS_P1 + (size_t)T * P1W * 2 <= WS_R && WS_R + (size_t)4 * T * 1024 * 2 <= WS_END, "ws map");

constexpr int CW_BAR = 4096;
constexpr int CW_CNT = 8192;
constexpr int CW_E1 = 16384;
constexpr int CW_G2 = 49152;
constexpr int CW_Q = 8448;

__device__ __forceinline__ unsigned f2bf(float f) { unsigned u = __builtin_bit_cast(unsigned, f); return (u + 0x7fffu + ((u >> 16) & 1u)) >> 16; }
typedef __bf16 bf16x2_hw __attribute__((ext_vector_type(2)));
__device__ __forceinline__ unsigned pk2(float lo, float hi) { f32x2 v = {lo, hi}; bf16x2_hw b = __builtin_convertvector(v, bf16x2_hw); return __builtin_bit_cast(unsigned, b); }
__device__ __forceinline__ float bflo(unsigned u) { return __builtin_bit_cast(float, u << 16); }
__device__ __forceinline__ float bfhi(unsigned u) { return __builtin_bit_cast(float, u & 0xffff0000u); }
__device__ __forceinline__ float bf2f(bf16 h) { return __builtin_bit_cast(float, (unsigned)h << 16); }
__device__ __forceinline__ float sigmoidf_(float x) { return __builtin_amdgcn_rcpf(1.0f + __builtin_amdgcn_exp2f(-1.4426950408889634f * x)); }
__device__ __forceinline__ float gelu_tanh(float x) { const float z = 1.5957691216057308f * (x + 0.044715f * x * x * x); return x * sigmoidf_(z); }
__device__ __forceinline__ float dpp_add_(float v, const int ctrl, const int row_mask) {
    return v;
}
#define DPP_ADD(v, ctrl, rmask) ((v) + __builtin_bit_cast(float, __builtin_amdgcn_update_dpp(0, __builtin_bit_cast(int, (v)), (ctrl), (rmask), 0xf, false)))
__device__ __forceinline__ float wave_sum(float v) {
    v = DPP_ADD(v, 0xB1, 0xf);
    v = DPP_ADD(v, 0x4E, 0xf);
    v = DPP_ADD(v, 0x141, 0xf);
    v = DPP_ADD(v, 0x140, 0xf);
    v = DPP_ADD(v, 0x142, 0xa);
    v = DPP_ADD(v, 0x143, 0xc);
    return __builtin_bit_cast(float, __builtin_amdgcn_readlane(__builtin_bit_cast(int, v), 63));
}
__device__ __forceinline__ u64 mask_lo(int n) { return n >= 64 ? ~0ull : (n <= 0 ? 0ull : ((1ull << n) - 1ull)); }
#define LDS_WAIT() asm volatile("s_waitcnt lgkmcnt(0)" ::: "memory")
#ifndef PROBE_PH
#define PROBE_PH -1
#endif
#ifndef PROBE_T_LO
#define PROBE_T_LO -1
#define PROBE_T_HI -1
#endif
#define PROBE_T_MULT 4
#ifndef ABL
#define ABL 0
#endif
#define ABL_ON(bit) ((ABL & (bit)) && is_dry())
#ifndef PROBE_BLK
#define PROBE_BLK 0
#endif
#ifdef PROBE_SUB
#define SUBT0() const unsigned long long ts0_ = __builtin_amdgcn_s_memrealtime()
#define SUBT1(ty) do { __syncthreads(); if ((ty) == PROBE_SUB) tacc_ += __builtin_amdgcn_s_memrealtime() - ts0_; } while (0)
#else
#define SUBT0() do {} while (0)
#define SUBT1(ty) do {} while (0)
#endif

constexpr int LDS_BYTES = 147456;
constexpr int LDS_CTL = 146432;
constexpr int LDS_MOE = LDS_CTL + 256;
__device__ __forceinline__ bool is_dry() {
#if PROBE_PH >= 0
    extern __shared__ __attribute__((aligned(16))) unsigned char lds_raw_[]; return ((volatile LAS int*)((LAS unsigned char*)lds_raw_ + LDS_CTL + 64))[0] != 0;
#else
    return false;
#endif
}
#define GST(...) do { if (!is_dry()) { __VA_ARGS__; } } while (0)
#ifdef PROBE_FINE
#define FT0(id) unsigned long long ft0_##id = ((id) == PROBE_FINE) ? __builtin_amdgcn_s_memrealtime() : 0ull
#define FT1(id) do { if ((id) == PROBE_FINE && threadIdx.x == 0) { extern __shared__ __attribute__((aligned(16))) unsigned char lds_raw_f[]; volatile LAS unsigned long long* a_ = (volatile LAS unsigned long long*)((LAS unsigned char*)lds_raw_f + LDS_CTL + 128); *a_ = *a_ + (__builtin_amdgcn_s_memrealtime() - ft0_##id); } } while (0)
#else
#define FT0(id) do {} while (0)
#define FT1(id) do {} while (0)
#endif
__device__ __forceinline__ int opaque_tid() { int t = (int)threadIdx.x; asm volatile("" : "+v"(t)); return t; }

namespace pg8 {
constexpr int BM = 256, BK = 64, HALF = 128, HTB = HALF * BK * 2, NXCD = 8, WGM = 8;
__host__ __device__ __forceinline__ int lds_byte(int r, int c) { const int st = (r >> 4) * 2 + (c >> 5), rr = r & 15, cc = c & 31, ob = rr * 64 + cc * 2; return st * 1024 + (ob ^ (((ob >> 9) & 1) << 5)); }
__host__ __device__ __forceinline__ void stage_rc(int b, int& R, int& C) { const int st = b / 1024, sb = b % 1024, swz = sb ^ (((sb >> 9) & 1) << 5); R = (st >> 1) * 16 + swz / 64; C = (st & 1) * 32 + (swz % 64) / 2; }
__host__ __device__ __forceinline__ int perm32(int rho) { const int n = rho >> 4, i = rho & 15; return 8 * (i >> 2) + 4 * n + (i & 3); }

struct Unit { const char* A; const char* B; int pm, pn, sub, e; };

__device__ __forceinline__ bool static_tile(int i, int G, int c, int nM, int nN, int& pm, int& pn) {
    const int nwg = nM * nN; const long L = (long)i * G + c; if (L >= nwg) return false;
    int wgid = (int)L; { const int q = nwg / NXCD, r = nwg % NXCD, xcd = wgid % NXCD, off = wgid / NXCD; wgid = (xcd < r ? xcd * (q + 1) : r * (q + 1) + (xcd - r) * q) + off; }
    const int nig = WGM * nN, gid = wgid / nig, fm = gid * WGM, gsz = (nM - fm) < WGM ? (nM - fm) : WGM;
    pm = fm + ((wgid % nig) % gsz); pn = (wgid % nig) / gsz; return true;
}

template <class Epi, class Sched, bool ALIGN_EPI>
__device__ __forceinline__ void gemm_phase(LAS unsigned char* lds, const int K, const Sched& S, const Epi& E) {
    const int tid = opaque_tid(), wid = __builtin_amdgcn_readfirstlane(tid >> 6), lane = tid & 63, wr = wid >> 2, wc = wid & 3, fr = lane & 15, fq = lane >> 4;
    const int nt = K / BK;
    unsigned voffB[2];
#pragma unroll
    for (int i = 0; i < 2; ++i) { int R, C; stage_rc(tid * 16 + i * 8192, R, C); const int Rb = (R & ~31) + perm32(R & 31); voffB[i] = (unsigned)(Rb * K + C) * 2u; }
    const size_t kstep = (size_t)(BK * 2);
    const size_t hstepB = (size_t)HALF * K * 2;
    const unsigned ldsw = (unsigned)wid * 1024u;
    const int aoff = lds_byte(wr * 64 + fr, fq * 8), boff = lds_byte(wc * 32 + fr, fq * 8);
#define PG8_SA(b, h) (((b) * 2 + (h)) * HTB)
#define PG8_SB(b, h) ((4 + (b) * 2 + (h)) * HTB)
#define PG8_STAGE(bufoff, gbase, voff) do { _Pragma("unroll") for (int _i = 0; _i < 2; ++_i) \
        __builtin_amdgcn_global_load_lds((const unsigned*)((const char*)(gbase) + (voff)[_i]), (LAS unsigned*)(lds + (bufoff) + ldsw + _i * 8192), 16, 0, 0); } while (0)
#define PG8_LDA(dst, b, h) do { _Pragma("unroll") for (int m = 0; m < 4; ++m) _Pragma("unroll") for (int k = 0; k < 2; ++k) dst[m][k] = *(const LAS bf16x8*)(lds + PG8_SA(b, h) + aoff + m * 2048 + k * 1024); } while (0)
#define PG8_LDB(dst, b, h) do { _Pragma("unroll") for (int n = 0; n < 2; ++n) _Pragma("unroll") for (int k = 0; k < 2; ++k) dst[n][k] = *(const LAS bf16x8*)(lds + PG8_SB(b, h) + boff + n * 2048 + k * 1024); } while (0)
#define PG8_MMA(ai, bj, At, Bt) do { __builtin_amdgcn_s_setprio(1); _Pragma("unroll") for (int m = 0; m < 4; ++m) _Pragma("unroll") for (int n = 0; n < 2; ++n) _Pragma("unroll") for (int k = 0; k < 2; ++k) \
        acc[ai][bj][m][n] = __builtin_amdgcn_mfma_f32_16x16x32_bf16(Bt[n][k], At[m][k], acc[ai][bj][m][n], 0, 0, 0); __builtin_amdgcn_s_setprio(0); } while (0)
#define PG8_WAIT_V(n) asm volatile("s_waitcnt vmcnt(" #n ")" ::: "memory")
#define PG8_WAIT_L(n) asm volatile("s_waitcnt lgkmcnt(" #n ")" ::: "memory")
#define PG8_BAR __builtin_amdgcn_s_barrier()
#define PG8_SCHED __builtin_amdgcn_sched_barrier(0)
#define PG8_ZERO() do { _Pragma("unroll") for (int a = 0; a < 2; ++a) _Pragma("unroll") for (int b = 0; b < 2; ++b) _Pragma("unroll") for (int m = 0; m < 4; ++m) _Pragma("unroll") for (int n = 0; n < 2; ++n) acc[a][b][m][n] = (f32x4){0.f, 0.f, 0.f, 0.f}; } while (0)
    Unit cur, nxt; int ui = 0;
    if (!S.next(0, cur)) return;
    f32x4 acc[2][2][4][2];
    PG8_ZERO();
    bf16x8 At[4][2], B0[2][2], B1[2][2];
    unsigned voA[2][2], voN[2][2];
    S.a_off(cur, voA);
    const char* cA = cur.A; const char* cB = cur.B;
    S.a_ready(cur);
    PG8_STAGE(PG8_SB(0, 0), cB, voffB); PG8_STAGE(PG8_SB(0, 1), cB + hstepB, voffB); PG8_STAGE(PG8_SA(0, 0), cA, voA[0]); PG8_STAGE(PG8_SA(0, 1), cA, voA[1]);
    if (wr == 1) PG8_BAR;
    PG8_WAIT_V(2); PG8_BAR;
    PG8_STAGE(PG8_SB(1, 0), cB + kstep, voffB); PG8_STAGE(PG8_SA(1, 0), cA + kstep, voA[0]); PG8_STAGE(PG8_SB(1, 1), cB + hstepB + kstep, voffB);
    PG8_WAIT_V(6); PG8_BAR;
    for (;;) {
        const bool has_next = S.next(ui + 1, nxt);
        if (has_next) S.a_ready(nxt);
        const char* nA = has_next ? nxt.A : cA; const char* nB = has_next ? nxt.B : cB;
        if (has_next) S.a_off(nxt, voN); else { voN[0][0] = voA[0][0]; voN[0][1] = voA[0][1]; voN[1][0] = voA[1][0]; voN[1][1] = voA[1][1]; }
        for (int t = 0; t < nt; t += 2) {
            const bool last = (t == nt - 2);
            const char* a1 = cA + (size_t)(t + 1) * kstep;
            const char* a2 = last ? nA : cA + (size_t)(t + 2) * kstep; const char* b2 = last ? nB : cB + (size_t)(t + 2) * kstep;
            const char* a3 = a2 + kstep; const char* b3 = b2 + kstep;
            PG8_LDB(B0, 0, 0); PG8_LDB(B1, 0, 1); PG8_SCHED; PG8_LDA(At, 0, 0); PG8_STAGE(PG8_SA(1, 1), a1, voA[1]);
            PG8_WAIT_V(8); PG8_WAIT_L(0); PG8_BAR; PG8_MMA(0, 0, At, B0); PG8_MMA(0, 1, At, B1); PG8_BAR; PG8_SCHED;
            if (last) { voA[0][0] = voN[0][0]; voA[0][1] = voN[0][1]; voA[1][0] = voN[1][0]; voA[1][1] = voN[1][1]; }
            PG8_LDA(At, 0, 1); PG8_STAGE(PG8_SB(0, 0), b2, voffB); PG8_STAGE(PG8_SB(0, 1), b2 + hstepB, voffB); PG8_STAGE(PG8_SA(0, 0), a2, voA[0]);
            PG8_WAIT_V(8); PG8_WAIT_L(0); PG8_BAR; PG8_MMA(1, 0, At, B0); PG8_MMA(1, 1, At, B1); PG8_BAR; PG8_SCHED;
            PG8_LDB(B0, 1, 0); PG8_LDB(B1, 1, 1); PG8_SCHED; PG8_LDA(At, 1, 0); PG8_STAGE(PG8_SA(0, 1), a2, voA[1]);
            PG8_WAIT_V(8); PG8_WAIT_L(0); PG8_BAR; PG8_MMA(0, 0, At, B0); PG8_MMA(0, 1, At, B1); PG8_BAR; PG8_SCHED;
            PG8_LDA(At, 1, 1); PG8_STAGE(PG8_SB(1, 0), b3, voffB); PG8_STAGE(PG8_SB(1, 1), b3 + hstepB, voffB); PG8_STAGE(PG8_SA(1, 0), a3, voA[0]);
            PG8_WAIT_V(8); PG8_WAIT_L(0); PG8_BAR; PG8_MMA(1, 0, At, B0); PG8_MMA(1, 1, At, B1); PG8_BAR; PG8_SCHED;
        }
        if constexpr (ALIGN_EPI) { if (wr == 0) PG8_BAR; }
        int tz = lane; asm volatile("" : "+v"(tz));
        const bool z = E(acc, cur, wr, wc, tz & 15, tz >> 4);
        S.done(cur);
        if (!has_next) break;
        if (z) PG8_ZERO();
        cur = nxt; cA = nA; cB = nB; ++ui;
        if constexpr (ALIGN_EPI) { if (wr == 1) PG8_BAR; }
    }
    PG8_WAIT_V(0);
    if constexpr (!ALIGN_EPI) { if (wr == 0) PG8_BAR; }
    PG8_BAR;
#undef PG8_SA
#undef PG8_SB
#undef PG8_STAGE
#undef PG8_LDA
#undef PG8_LDB
#undef PG8_MMA
#undef PG8_WAIT_V
#undef PG8_WAIT_L
#undef PG8_BAR
#undef PG8_SCHED
#undef PG8_ZERO
}
}

#define XB_TMO      128
#define XB_XCNT(j)  (256  + 64 * (j))
#define XB_XSUB(j)  (1280 + 64 * (j))
#define XB_XGEN(j)  (2304 + 64 * (j))
#define XB_TOP      3328
#define XB_TOPGEN   3392
#define XCD_BAR_WORDS 3456
#define XB_SPIN_CAP (1u << 23)
__device__ __forceinline__ unsigned xb_ld(unsigned* p)              { return __hip_atomic_load(p, __ATOMIC_RELAXED, __HIP_MEMORY_SCOPE_AGENT); }
__device__ __forceinline__ unsigned xb_add(unsigned* p, unsigned v) { return __hip_atomic_fetch_add(p, v, __ATOMIC_RELAXED, __HIP_MEMORY_SCOPE_AGENT); }
__device__ __forceinline__ unsigned xb_xcc_id() { return (unsigned)__builtin_amdgcn_s_getreg((3 << 11) | 20) & 0xFu; }
#define XB_SPIN(cond, bar) do { unsigned _sp = 0; while (cond) { __builtin_amdgcn_s_sleep(1); \
    if ((++_sp & 255u) == 0u) { if (xb_ld(&(bar)[XB_TMO])) break; if (_sp > XB_SPIN_CAP) { atomicAdd(&(bar)[XB_TMO], 1u); break; } } } } while (0)
struct XcdBarrier { unsigned* bar; unsigned x; volatile LAS unsigned* st; };
__device__ __forceinline__ XcdBarrier xcd_barrier_post(unsigned* bar, volatile LAS unsigned* st) {
    XcdBarrier b; b.bar = bar; b.x = xb_xcc_id(); b.st = st;
    if (threadIdx.x == 0) (void)xb_add(&bar[XB_XCNT(b.x)], 1u);
    return b;
}
__device__ __forceinline__ void xcd_barrier_complete(unsigned* bar, unsigned x, unsigned& nloc, unsigned& nx) {
    const unsigned G = gridDim.x * gridDim.y * gridDim.z;
    unsigned sum, cnt, mine, sp = 0u;
    for (;;) {
        sum = 0u; cnt = 0u; mine = 0u;
#pragma unroll
        for (unsigned j = 0; j < 16; ++j) { const unsigned c = xb_ld(&bar[XB_XCNT(j)]); sum += c; cnt += (c > 0u) ? 1u : 0u; mine = (j == x) ? c : mine; }
        if (sum == G) break;
        __builtin_amdgcn_s_sleep(1);
        if ((++sp & 255u) == 0u) { if (xb_ld(&bar[XB_TMO])) break; if (sp > XB_SPIN_CAP) { atomicAdd(&bar[XB_TMO], 1u); break; } }
    }
    nloc = mine > 0u ? mine : 1u; nx = cnt > 0u ? cnt : 1u;
}
__device__ __forceinline__ void xcd_barrier(const XcdBarrier& b) {
    asm volatile("s_waitcnt vmcnt(0)" ::: "memory");
    __syncthreads();
    if (threadIdx.x == 0) {
        unsigned* bar = b.bar;
        __builtin_amdgcn_s_waitcnt(0);
        unsigned nloc = b.st[0], nx = b.st[1];
        if (nloc == 0u) { xcd_barrier_complete(bar, b.x, nloc, nx); b.st[0] = nloc; b.st[1] = nx; }
        const unsigned old = xb_add(&bar[XB_XSUB(b.x)], 1u);
        const unsigned gen = old / nloc;
        if (old + 1u == (gen + 1u) * nloc) {
            __builtin_amdgcn_fence(__ATOMIC_RELEASE, "agent");
            asm volatile("s_waitcnt vmcnt(0)" ::: "memory");
            const unsigned og = xb_add(&bar[XB_TOP], 1u);
            const unsigned tg = og / nx;
            if (og + 1u == (tg + 1u) * nx) xb_add(&bar[XB_TOPGEN], 1u);
            else XB_SPIN(xb_ld(&bar[XB_TOPGEN]) == tg, bar);
            __builtin_amdgcn_fence(__ATOMIC_ACQUIRE, "agent");
            xb_add(&bar[XB_XGEN(b.x)], 1u);
            asm volatile("s_waitcnt vmcnt(0)" ::: "memory");
        } else {
            XB_SPIN(xb_ld(&bar[XB_XGEN(b.x)]) == gen, bar);
            __builtin_amdgcn_fence(__ATOMIC_ACQUIRE, "agent");
            asm volatile("s_waitcnt vmcnt(0)" ::: "memory");
        }
    }
    __syncthreads();
}

struct Args { const float* in[29]; float* out; unsigned char* ws; int ph_lo, ph_hi; };
enum { I_X = 0, I_N1G, I_WIN, I_GMNG, I_GMWS, I_GMB, I_CONVW, I_CONVB, I_LWA, I_LBA, I_LWX, I_LBX, I_LLAM, I_PE, I_CW1, I_CW2, I_PW, I_PS, I_WBR, I_WOUT, I_N2G, I_RWG, I_RBG, I_RWE, I_RBE, I_MG, I_MU, I_MD, I_FNG };

#define CAS __attribute__((address_space(4)))
__device__ __forceinline__ unsigned long long karg_u64(int off) { const CAS char* kp = (const CAS char*)__builtin_amdgcn_kernarg_segment_ptr(); asm volatile("" : "+s"(kp)); return *(const CAS unsigned long long*)(kp + off); }
#define ARG_IN(k) ((const float*)(const GAS float*)karg_u64(8 * (k)))
#define ARG_OUT() ((float*)(GAS float*)karg_u64(8 * 29))
#define ARG_WS() ((unsigned char*)(GAS unsigned char*)karg_u64(8 * 30))
__device__ __forceinline__ int win_dst_row(int s) {
    if (s < SRC_GC) return s;
    if (s < SRC_XD) return C_GC + (s - SRC_GC);
    if (s < SRC_MG) return C_XD + (s - SRC_XD);
    const int n = (s - SRC_MG) >> 10, d = (s - SRC_MG) & 1023;
    return 4096 + 256 * (d >> 6) + 128 * (n >> 1) + 32 * ((d >> 4) & 3) + 8 * ((d >> 2) & 3) + 4 * (n & 1) + (d & 3);
}
struct TrItem { const float* W; bf16* WT; int K, N, kb, nb, kind; };
struct TrRegs { f32x4 v[8]; };
__device__ __forceinline__ int tr_dst(int kind, int n) { return kind == 0 ? n : kind == 1 ? win_dst_row(n) : kind == 2 ? 256 * (n >> 7) + (n & 127) : 256 * (n >> 7) + 128 + (n & 127); }
__device__ __forceinline__ TrRegs tr_load(const TrItem& it, int lane) {
    TrRegs r; const int k0 = 64 * it.kb, n4 = 32 * it.nb + (lane & 7) * 4;
#pragma unroll
    for (int i = 0; i < 8; ++i) { const int kk = 8 * i + (lane >> 3); r.v[i] = *(const f32x4*)(it.W + (size_t)(k0 + kk) * it.N + (n4 < it.N ? n4 : 0)); }
    return r;
}
__device__ __forceinline__ void tr_finish(const TrItem& it, const TrRegs& r, float* scr, int lane) {
    const int k0 = 64 * it.kb, n0 = 32 * it.nb;
#pragma unroll
    for (int i = 0; i < 8; ++i) { const int kk = 8 * i + (lane >> 3); float* d = scr + kk * 33 + (lane & 7) * 4; d[0] = r.v[i].x; d[1] = r.v[i].y; d[2] = r.v[i].z; d[3] = r.v[i].w; }
    LDS_WAIT(); asm volatile("" ::: "memory");
    const int c = lane & 7;
#pragma unroll
    for (int j = 0; j < 4; ++j) { const int nl = (lane >> 3) + 8 * j; const int n = n0 + nl; const float* sp = scr + (8 * c) * 33 + nl;
        u32x4 o; o.x = pk2(sp[0 * 33], sp[1 * 33]); o.y = pk2(sp[2 * 33], sp[3 * 33]); o.z = pk2(sp[4 * 33], sp[5 * 33]); o.w = pk2(sp[6 * 33], sp[7 * 33]);
        if (n < it.N) GST(*(u32x4*)(it.WT + (size_t)tr_dst(it.kind, n) * it.K + k0 + 8 * c) = o); }
    LDS_WAIT(); asm volatile("" ::: "memory");
}
template <int MODE>
__device__ __forceinline__ void norm_rows(const float* xbase, float* hbase, const bf16* y0b, const bf16* y1b, const float* g, bf16* xnb, int m0, int m1, bool two, int lane) {
    f32x4 v[2][4]; u32x2 ya[2][4], yb[2][4];
#pragma unroll
    for (int r = 0; r < 2; ++r) { const size_t m = (size_t)(r ? m1 : m0); if (r == 0 || two) {
#pragma unroll
        for (int j = 0; j < 4; ++j) { const int c = 4 * lane + 256 * j; v[r][j] = *(const f32x4*)((MODE == 0 ? xbase : hbase) + m * D + c);
            if (MODE != 0) { ya[r][j] = *(const u32x2*)(y0b + m * D + c); yb[r][j] = *(const u32x2*)(y1b + m * D + c); } } } }
#pragma unroll
    for (int r = 0; r < 2; ++r) { if (r == 1 && !two) break; const size_t m = (size_t)(r ? m1 : m0); float ss = 0.f;
#pragma unroll
        for (int j = 0; j < 4; ++j) {
            if (MODE != 0) { const u32x2 a = ya[r][j], b = yb[r][j];
                v[r][j].x += bflo(a.x) + bflo(b.x); v[r][j].y += bfhi(a.x) + bfhi(b.x); v[r][j].z += bflo(a.y) + bflo(b.y); v[r][j].w += bfhi(a.y) + bfhi(b.y); }
            ss += (v[r][j].x * v[r][j].x + v[r][j].y * v[r][j].y) + (v[r][j].z * v[r][j].z + v[r][j].w * v[r][j].w); }
        const float rstd = rsqrtf(wave_sum(ss) * (1.f / D) + EPS);
#pragma unroll
        for (int j = 0; j < 4; ++j) { const int c = 4 * lane + 256 * j; const f32x4 gg = *(const f32x4*)(g + c); const f32x4 x = v[r][j];
            if (MODE == 2) { GST(*(f32x4*)(hbase + m * D + c) = (f32x4){x.x * rstd * gg.x, x.y * rstd * gg.y, x.z * rstd * gg.z, x.w * rstd * gg.w}); }
            else { if (MODE != 0) GST(*(f32x4*)(hbase + m * D + c) = x);
                u32x2 o; o.x = pk2(x.x * rstd * gg.x, x.y * rstd * gg.y); o.y = pk2(x.z * rstd * gg.z, x.w * rstd * gg.w); GST(*(u32x2*)(xnb + m * D + c) = o); } } }
}

constexpr int IT_WIN_ = 16 * 249, IT_WB_ = 8 * 32, IT_WO_ = 16 * 32, IT_BIG = IT_WIN_ + 4 * IT_WB_ + IT_WO_;
__device__ __forceinline__ TrItem dec_big(int it, int l) {
    unsigned char* wsb = ARG_WS(); int r = it;
    if (r < IT_WIN_) return TrItem{ARG_IN(I_WIN) + (size_t)l * D * NIN, (bf16*)(wsb + WS_WIN) + (size_t)l * NPROJ * D, D, NIN, r / 249, r % 249, 1};
    r -= IT_WIN_;
    if (r < 4 * IT_WB_) { const int n = r / IT_WB_; r -= n * IT_WB_; const int ln = l * 4 + n; return TrItem{ARG_IN(I_WBR) + (size_t)ln * 512 * 1024, (bf16*)(wsb + WS_WB) + (size_t)ln * 1024 * 512, 512, 1024, r / 32, r % 32, 0}; }
    r -= 4 * IT_WB_;
    return TrItem{ARG_IN(I_WOUT) + (size_t)l * 1024 * 1024, (bf16*)(wsb + WS_WOUT) + (size_t)l * 1024 * 1024, 1024, 1024, r / 32, r % 32, 0};
}
__device__ __forceinline__ void conv_unit(float* ldsf, int cu) {
    const int tid = opaque_tid(); const int wv = __builtin_amdgcn_readfirstlane(tid >> 6), lane = tid & 63; const int it = cu * 8 + wv;
    __syncthreads();
    if (it < IT_BIG) { const TrItem ti = dec_big(it, 1); const TrRegs rr = tr_load(ti, lane); tr_finish(ti, rr, ldsf + wv * 4096, lane); }
}
__device__ __forceinline__ void wait_counter(unsigned* cp, unsigned need, unsigned* tmo) {
    if (__builtin_amdgcn_readfirstlane((int)threadIdx.x) < 64) {
        unsigned polls = 0u;
        while ((unsigned)__builtin_amdgcn_readfirstlane(__hip_atomic_load(cp, __ATOMIC_RELAXED, __HIP_MEMORY_SCOPE_AGENT)) < need) {
            if (++polls > (1u << 22)) { __hip_atomic_store(tmo, 1u, __ATOMIC_RELAXED, __HIP_MEMORY_SCOPE_AGENT); break; }
            __builtin_amdgcn_s_sleep(2); }
        __builtin_amdgcn_fence(__ATOMIC_ACQUIRE, "agent");
        asm volatile("s_waitcnt vmcnt(0)" ::: "memory");
    }
    asm volatile("" ::: "memory"); __builtin_amdgcn_s_barrier(); asm volatile("" ::: "memory");
}
struct SchedDense {
    const bf16* A; const bf16* Bt; int lda, K, nM, nN, G, c; unsigned* cnt; unsigned need; unsigned* tmo; int pnrot;
    __device__ __forceinline__ void a_ready(const pg8::Unit& u) const { if (cnt) wait_counter(cnt + 64 * u.pm, need, tmo); }
    __device__ __forceinline__ void done(const pg8::Unit&) const {}
    __device__ __forceinline__ bool next(int i, pg8::Unit& u) const {
        int pm, pn; if (!pg8::static_tile(i, G, c, nM, nN, pm, pn)) return false;
        pn += pnrot; if (pn >= nN) pn -= nN;
        u.pm = pm; u.pn = pn; u.sub = 0; u.e = 0; u.A = (const char*)(A + (size_t)pm * 256 * lda); u.B = (const char*)(Bt + (size_t)pn * 256 * K); return true;
    }
    __device__ __forceinline__ void a_off(const pg8::Unit&, unsigned (&vo)[2][2]) const {
        const int tz = opaque_tid();
#pragma unroll
        for (int i = 0; i < 2; ++i) { int R, C; pg8::stage_rc(tz * 16 + i * 8192, R, C);
#pragma unroll
            for (int h = 0; h < 2; ++h) vo[h][i] = (unsigned)((h * 128 + R) * lda + C) * 2u; }
    }
};
struct SchedMerge {
    const bf16* P1; const bf16* Wb; int G, c; unsigned* cnt;
    __device__ __forceinline__ void a_ready(const pg8::Unit&) const {}
    __device__ __forceinline__ void done(const pg8::Unit& u) const {
        if (u.sub != 3) return;
        asm volatile("s_waitcnt vmcnt(0)" ::: "memory");
        if ((threadIdx.x & 63) == 0 && !is_dry()) (void)__hip_atomic_fetch_add(cnt + 64 * u.pm, 1u, __ATOMIC_RELAXED, __HIP_MEMORY_SCOPE_AGENT);
    }
    __device__ __forceinline__ bool next(int i, pg8::Unit& u) const {
        const int ti = i >> 2, sub = i & 3; int pm, pn; if (!pg8::static_tile(ti, G, c, T / 256, 4, pm, pn)) return false;
        const int ycol = (sub == 0) ? C_U : (sub == 1) ? C_GB : (sub == 2) ? C_Q : C_V;
        u.pm = pm; u.pn = pn; u.sub = sub; u.e = 0;
        u.A = (const char*)(P1 + (size_t)pm * 256 * P1W + ycol); u.B = (const char*)(Wb + ((size_t)sub * 1024 + (size_t)pn * 256) * 512); return true;
    }
    __device__ __forceinline__ void a_off(const pg8::Unit&, unsigned (&vo)[2][2]) const {
        const int tz = opaque_tid();
#pragma unroll
        for (int i = 0; i < 2; ++i) { int R, C; pg8::stage_rc(tz * 16 + i * 8192, R, C);
#pragma unroll
            for (int h = 0; h < 2; ++h) vo[h][i] = (unsigned)((h * 128 + R) * P1W + C) * 2u; }
    }
};
__device__ __forceinline__ const LAS int* moe_tab() { unsigned a = (unsigned)LDS_MOE; asm volatile("" : "+s"(a)); return (const LAS int*)(uintptr_t)a; }
struct SchedMoe {
    const bf16* A; const bf16* Bt; const unsigned* list; int lda, K, brows  , G, c; bool gather; unsigned* cnt; unsigned* tmo;
    __device__ __forceinline__ bool next(int i, pg8::Unit& u) const {
        const LAS int* tab = moe_tab(); const int L = i * G + (gather ? c : (G - 1 - c)); const int tot = __builtin_amdgcn_readfirstlane(tab[16]); if (L >= 4 * tot) return false;
        const int rtg = L >> 2, pn = L & 3; int e = 0, st = 0;
#pragma unroll
        for (int k = 1; k < 16; ++k) { const int tk = __builtin_amdgcn_readfirstlane(tab[k]); if (rtg >= tk) { e = k; st = tk; } }
        u.e = e; u.pm = rtg; u.sub = rtg - st; u.pn = pn;
        u.A = gather ? (const char*)A : (const char*)(A + (size_t)rtg * 256 * lda);
        u.B = (const char*)(Bt + ((size_t)e * brows + (size_t)pn * 256) * K); return true;
    }
    __device__ __forceinline__ void a_ready(const pg8::Unit& u) const {
        if (gather) return;
        if (__builtin_amdgcn_readfirstlane((int)threadIdx.x) < 64) {
            unsigned* cp = cnt + 64 * u.pm; unsigned polls = 0u;
            while ((unsigned)__builtin_amdgcn_readfirstlane(__hip_atomic_load(cp, __ATOMIC_RELAXED, __HIP_MEMORY_SCOPE_AGENT)) < 32u) {
                if (++polls > (1u << 22)) { __hip_atomic_store(tmo, 1u, __ATOMIC_RELAXED, __HIP_MEMORY_SCOPE_AGENT); break; }
                __builtin_amdgcn_s_sleep(2); }
            __builtin_amdgcn_fence(__ATOMIC_ACQUIRE, "agent");
            asm volatile("s_waitcnt vmcnt(0)" ::: "memory");
        }
        asm volatile("" ::: "memory"); __builtin_amdgcn_s_barrier(); asm volatile("" ::: "memory");
    }
    __device__ __forceinline__ void done(const pg8::Unit& u) const {
        if (!gather) return;
        asm volatile("s_waitcnt vmcnt(0)" ::: "memory");
        if ((threadIdx.x & 63) == 0 && !is_dry()) (void)__hip_atomic_fetch_add(cnt + 64 * u.pm, 1u, __ATOMIC_RELAXED, __HIP_MEMORY_SCOPE_AGENT);
    }
    __device__ __forceinline__ void a_off(const pg8::Unit& u, unsigned (&vo)[2][2]) const {
        const LAS int* tab = moe_tab(); const int cnt = __builtin_amdgcn_readfirstlane(tab[32 + u.e]); const unsigned* le = list + (size_t)u.e * T + u.sub * 256;
        int tz = (int)threadIdx.x; asm volatile("" : "+v"(tz));
#pragma unroll
        for (int i = 0; i < 2; ++i) { int R, C; pg8::stage_rc(tz * 16 + i * 8192, R, C);
#pragma unroll
            for (int h = 0; h < 2; ++h) {
                int row = h * 128 + R;
                if (gather) { row = (u.sub * 256 + row < cnt) ? (int)(le[row] & 0x3fffu) : 0; }
                vo[h][i] = (unsigned)(row * lda + C) * 2u;
            } }
    }
};

struct EpiProj {
    bf16* P1; bf16* Rr;
    __device__ __forceinline__ bool operator()(f32x4 (&acc)[2][2][4][2], const pg8::Unit& u, int wr, int wc, int fr, int fq) const {
        const int row0 = u.pm * 256 + wr * 64 + fr;
        if (u.pn < 16) {
            const int act = (u.pn < 6) ? 1 : (u.pn == 15 ? 2 : 0);
#pragma unroll
            for (int ai = 0; ai < 2; ++ai)
#pragma unroll
                for (int m = 0; m < 4; ++m) { bf16* rowp = P1 + (size_t)(row0 + ai * 128 + m * 16) * P1W + u.pn * 256 + wc * 32 + 8 * fq;
#pragma unroll
                    for (int bj = 0; bj < 2; ++bj) { f32x4 v0 = acc[ai][bj][m][0], v1 = acc[ai][bj][m][1];
                        if (act == 1) { v0 = (f32x4){gelu_tanh(v0.x), gelu_tanh(v0.y), gelu_tanh(v0.z), gelu_tanh(v0.w)}; v1 = (f32x4){gelu_tanh(v1.x), gelu_tanh(v1.y), gelu_tanh(v1.z), gelu_tanh(v1.w)}; }
                        else if (act == 2) { v0 = (f32x4){sigmoidf_(v0.x), sigmoidf_(v0.y), sigmoidf_(v0.z), sigmoidf_(v0.w)}; v1 = (f32x4){sigmoidf_(v1.x), sigmoidf_(v1.y), sigmoidf_(v1.z), sigmoidf_(v1.w)}; }
                        u32x4 w; w.x = pk2(v0.x, v0.y); w.y = pk2(v0.z, v0.w); w.z = pk2(v1.x, v1.y); w.w = pk2(v1.z, v1.w);
                        if (u.pn < 15 || (bj == 0 && wc < 2)) GST(*(u32x4*)(rowp + bj * 128) = w); } }
        } else {
            const int dcol = 64 * (u.pn - 16) + 16 * wc + 4 * fq;
#pragma unroll
            for (int ai = 0; ai < 2; ++ai)
#pragma unroll
                for (int m = 0; m < 4; ++m) { const size_t row = (size_t)(row0 + ai * 128 + m * 16);
                    float r0[4], r1[4], r2[4], r3[4];
#pragma unroll
                    for (int i = 0; i < 4; ++i) {
                        const float d0 = fminf(1.0f + __builtin_amdgcn_exp2f(-1.4426950408889634f * acc[ai][0][m][0][i]), 1e20f), d1 = fminf(1.0f + __builtin_amdgcn_exp2f(-1.4426950408889634f * acc[ai][0][m][1][i]), 1e20f);
                        const float d2 = fminf(1.0f + __builtin_amdgcn_exp2f(-1.4426950408889634f * acc[ai][1][m][0][i]), 1e20f), d3 = fminf(1.0f + __builtin_amdgcn_exp2f(-1.4426950408889634f * acc[ai][1][m][1][i]), 1e20f);
                        const float i0 = __builtin_amdgcn_rcpf(d0), i1 = __builtin_amdgcn_rcpf(d1), i2 = __builtin_amdgcn_rcpf(d2), i3 = __builtin_amdgcn_rcpf(d3);
                        r0[i] = d1 * i0; r1[i] = d2 * i1; r2[i] = d3 * i2; r3[i] = i3; }
                    u32x2 w;
                    w.x = pk2(r0[0], r0[1]); w.y = pk2(r0[2], r0[3]); GST(*(u32x2*)(Rr + ((size_t)0 * T + row) * 1024 + dcol) = w);
                    w.x = pk2(r1[0], r1[1]); w.y = pk2(r1[2], r1[3]); GST(*(u32x2*)(Rr + ((size_t)1 * T + row) * 1024 + dcol) = w);
                    w.x = pk2(r2[0], r2[1]); w.y = pk2(r2[2], r2[3]); GST(*(u32x2*)(Rr + ((size_t)2 * T + row) * 1024 + dcol) = w);
                    w.x = pk2(r3[0], r3[1]); w.y = pk2(r3[2], r3[3]); GST(*(u32x2*)(Rr + ((size_t)3 * T + row) * 1024 + dcol) = w); }
        }
        return true;
    }
};
struct EpiMerge {
    const bf16* Rr; bf16* O;
    __device__ __forceinline__ bool operator()(f32x4 (&acc)[2][2][4][2], const pg8::Unit& u, int wr, int wc, int fr, int fq) const {
        const int row0 = u.pm * 256 + wr * 64 + fr, col0 = u.pn * 256 + wc * 32 + 8 * fq;
        const bf16* Rn = Rr + (size_t)u.sub * T * 1024;
        const __amdgpu_buffer_rsrc_t rs = __builtin_amdgcn_make_buffer_rsrc((void*)O, (short)0, (int)((size_t)T * 1024 * 2), 0x00020000);
        u32x4 rv[2][4][2];
#pragma unroll
        for (int ai = 0; ai < 2; ++ai)
#pragma unroll
            for (int m = 0; m < 4; ++m)
#pragma unroll
                for (int bj = 0; bj < 2; ++bj) rv[ai][m][bj] = *(const u32x4*)(Rn + (size_t)(row0 + ai * 128 + m * 16) * 1024 + col0 + bj * 128);
        __builtin_amdgcn_sched_barrier(0);
#pragma unroll
        for (int ai = 0; ai < 2; ++ai)
#pragma unroll
            for (int m = 0; m < 4; ++m) { const size_t ro = (size_t)(row0 + ai * 128 + m * 16) * 1024 + col0;
#pragma unroll
                for (int bj = 0; bj < 2; ++bj) { const u32x4 r = rv[ai][m][bj];
                    f32x4& v0 = acc[ai][bj][m][0]; f32x4& v1 = acc[ai][bj][m][1];
                    v0.x *= bflo(r.x); v0.y *= bfhi(r.x); v0.z *= bflo(r.y); v0.w *= bfhi(r.y); v1.x *= bflo(r.z); v1.y *= bfhi(r.z); v1.z *= bflo(r.w); v1.w *= bfhi(r.w);
                    if (u.sub == 3) { u32x4 w; w.x = pk2(v0.x, v0.y); w.y = pk2(v0.z, v0.w); w.z = pk2(v1.x, v1.y); w.w = pk2(v1.z, v1.w); GST(__builtin_amdgcn_raw_buffer_store_b128(w, rs, (unsigned)((ro + bj * 128) * 2), 0, 16)); } } }
        return u.sub == 3;
    }
};
struct EpiWout {
    const float* Hin; float* H;
    __device__ __forceinline__ bool operator()(f32x4 (&acc)[2][2][4][2], const pg8::Unit& u, int wr, int wc, int fr, int fq) const {
        const int row0 = u.pm * 256 + wr * 64 + fr, col0 = u.pn * 256 + wc * 32 + 8 * fq;
#pragma unroll
        for (int ai = 0; ai < 2; ++ai)
        {   f32x4 hv[4][2][2];
#pragma unroll
            for (int m = 0; m < 4; ++m)
#pragma unroll
                for (int bj = 0; bj < 2; ++bj)
#pragma unroll
                    for (int n = 0; n < 2; ++n) hv[m][bj][n] = *(const f32x4*)(Hin + (size_t)(row0 + ai * 128 + m * 16) * 1024 + col0 + bj * 128 + 4 * n);
            __builtin_amdgcn_sched_barrier(0);
#pragma unroll
            for (int m = 0; m < 4; ++m)
#pragma unroll
                for (int bj = 0; bj < 2; ++bj)
#pragma unroll
                    for (int n = 0; n < 2; ++n) { const f32x4 h = hv[m][bj][n] + acc[ai][bj][m][n]; GST(*(f32x4*)(H + (size_t)(row0 + ai * 128 + m * 16) * 1024 + col0 + bj * 128 + 4 * n) = h); } }
        return true;
    }
};
struct EpiGateUp {
    bf16* HID; const float* lw;
    __device__ __forceinline__ bool operator()(f32x4 (&acc)[2][2][4][2], const pg8::Unit& u, int wr, int wc, int fr, int fq) const {
        const int cnt = __builtin_amdgcn_readfirstlane(moe_tab()[32 + u.e]);
        const __amdgpu_buffer_rsrc_t rs = __builtin_amdgcn_make_buffer_rsrc((void*)HID, (short)0, (int)((size_t)HID_ROWS * 512 * 2), 0x00020000);
#pragma unroll
        for (int ai = 0; ai < 2; ++ai)
#pragma unroll
            for (int m = 0; m < 4; ++m) { const int rl = ai * 128 + wr * 64 + m * 16 + fr; const int lr = u.sub * 256 + rl;
                const bool ok = lr < cnt; const float w = ok ? lw[(size_t)u.e * T + lr] : 0.f;
                float o[8];
#pragma unroll
                for (int n = 0; n < 2; ++n)
#pragma unroll
                    for (int i = 0; i < 4; ++i) { const float g = acc[ai][0][m][n][i], up = acc[ai][1][m][n][i]; o[4 * n + i] = ok ? g * sigmoidf_(g) * up * w : 0.f; }
                u32x4 wv; wv.x = pk2(o[0], o[1]); wv.y = pk2(o[2], o[3]); wv.z = pk2(o[4], o[5]); wv.w = pk2(o[6], o[7]);
                GST(__builtin_amdgcn_raw_buffer_store_b128(wv, rs, (unsigned)((((size_t)u.pm * 256 + rl) * 512 + u.pn * 128 + wc * 32 + 8 * fq) * 2), 0, 16)); }
        return true;
    }
};
struct EpiDown {
    bf16* Y; const unsigned* list;
    __device__ __forceinline__ bool operator()(f32x4 (&acc)[2][2][4][2], const pg8::Unit& u, int wr, int wc, int fr, int fq) const {
        const int cnt = __builtin_amdgcn_readfirstlane(moe_tab()[32 + u.e]);
        unsigned en[2][4];
#pragma unroll
        for (int ai = 0; ai < 2; ++ai)
#pragma unroll
            for (int m = 0; m < 4; ++m) { const int lr = u.sub * 256 + ai * 128 + wr * 64 + m * 16 + fr; en[ai][m] = list[(size_t)u.e * T + (lr < cnt ? lr : 0)]; }
        __builtin_amdgcn_sched_barrier(0);
#pragma unroll
        for (int ai = 0; ai < 2; ++ai)
#pragma unroll
            for (int m = 0; m < 4; ++m) { const int rl = ai * 128 + wr * 64 + m * 16 + fr; const int lr = u.sub * 256 + rl;
                if (lr < cnt) { const unsigned tok = en[ai][m] & 0x3fffu, slot = en[ai][m] >> 14;
                    bf16* rp = Y + ((size_t)slot * T + tok) * 1024 + u.pn * 256 + wc * 32 + 8 * fq;
#pragma unroll
                    for (int bj = 0; bj < 2; ++bj) { const f32x4 v0 = acc[ai][bj][m][0], v1 = acc[ai][bj][m][1];
                        u32x4 w; w.x = pk2(v0.x, v0.y); w.y = pk2(v0.z, v0.w); w.z = pk2(v1.x, v1.y); w.w = pk2(v1.z, v1.w); GST(*(u32x4*)(rp + bj * 128) = w); } } }
        return true;
    }
};


__device__ __forceinline__ void lru_unit2(LAS unsigned char* lds, const bf16* P1, bf16* XN, float* AGA, float* AGH, const float* convw, const float* convb,
                                          const bf16* WaT, const bf16* WxT, const float* ba, const float* bx, const float* lam, int unit) {
    const int tid = opaque_tid(); const int lane = tid & 63, w = __builtin_amdgcn_readfirstlane(tid >> 6);
    const int tile = unit & 63, b = unit >> 6; const int ch0 = w * 64;
    const size_t row0 = (size_t)b * SEQ + tile * 64;
    LAS unsigned char* wl = lds + w * 17920;
    LAS bf16* xcb = (LAS bf16*)wl; LAS float* AL = (LAS float*)(wl + 9216); LAS float* BL = (LAS float*)(wl + 9216 + 4352);
    __syncthreads();
    FT0(8);
    const int i16 = lane & 15, kb = lane >> 4;
    bf16x8 bfa[4][2], bfx[4][2]; float cba[4], cbx[4], csp[4];
    {
        const int tl = lane >> 3, c8 = (lane & 7) * 8;
        f32x4 cwv[4][2], cbv[2];
#pragma unroll
        for (int k = 0; k < 4; ++k) { cwv[k][0] = *(const f32x4*)(convw + k * 512 + ch0 + c8); cwv[k][1] = *(const f32x4*)(convw + k * 512 + ch0 + c8 + 4); }
        cbv[0] = *(const f32x4*)(convb + ch0 + c8); cbv[1] = *(const f32x4*)(convb + ch0 + c8 + 4);
        u32x4 xa[4][4], xb[4][4];
#pragma unroll
        for (int p = 0; p < 4; ++p)
#pragma unroll
            for (int k = 0; k < 4; ++k) { const int sp = tile * 64 + 8 * p + tl + k - 3; xa[p][k] = *(const u32x4*)(P1 + ((size_t)b * SEQ + (sp < 0 ? 0 : sp)) * P1W + C_RB + ch0 + c8); }
#pragma unroll
        for (int p = 0; p < 4; ++p)
#pragma unroll
            for (int k = 0; k < 4; ++k) { const int sp = tile * 64 + 8 * (p + 4) + tl + k - 3; xb[p][k] = *(const u32x4*)(P1 + ((size_t)b * SEQ + (sp < 0 ? 0 : sp)) * P1W + C_RB + ch0 + c8); }
        __builtin_amdgcn_sched_barrier(0);
#pragma unroll
        for (int hf = 0; hf < 2; ++hf) {
#pragma unroll
            for (int p = 0; p < 4; ++p) { const int tok = 8 * (p + 4 * hf) + tl; const int ts = tile * 64 + tok;
                float o[8] = {cbv[0].x, cbv[0].y, cbv[0].z, cbv[0].w, cbv[1].x, cbv[1].y, cbv[1].z, cbv[1].w};
#pragma unroll
                for (int k = 0; k < 4; ++k) { const u32x4 v = hf ? xb[p][k] : xa[p][k]; const float z = (ts + k - 3 >= 0) ? 1.f : 0.f; const f32x4 w0 = cwv[k][0] * z, w1 = cwv[k][1] * z;
                    o[0] += bflo(v.x) * w0.x; o[1] += bfhi(v.x) * w0.y; o[2] += bflo(v.y) * w0.z; o[3] += bfhi(v.y) * w0.w; o[4] += bflo(v.z) * w1.x; o[5] += bfhi(v.z) * w1.y; o[6] += bflo(v.w) * w1.z; o[7] += bfhi(v.w) * w1.w; }
                *(LAS u32x4*)(xcb + tok * 72 + c8) = (u32x4){pk2(o[0], o[1]), pk2(o[2], o[3]), pk2(o[4], o[5]), pk2(o[6], o[7])}; }
            if (hf == 0) {
#pragma unroll
                for (int n = 0; n < 4; ++n) {
#pragma unroll
                    for (int ks = 0; ks < 2; ++ks) { bfa[n][ks] = *(const bf16x8*)(WaT + ((size_t)ch0 + 16 * n + i16) * 64 + 32 * ks + 8 * kb); bfx[n][ks] = *(const bf16x8*)(WxT + ((size_t)ch0 + 16 * n + i16) * 64 + 32 * ks + 8 * kb); }
                    const int co = ch0 + 16 * n + i16; cba[n] = ba[co]; cbx[n] = bx[co]; csp[n] = lam[co]; }
                __builtin_amdgcn_sched_barrier(0); }
        }
#pragma unroll
        for (int n = 0; n < 4; ++n) { const float lm = csp[n]; csp[n] = 8.0f * ((-lm > 20.f) ? -lm : log1pf(__expf(-lm))); }
    }
    LDS_WAIT(); asm volatile("" ::: "memory");
    FT1(8); FT0(9);
    float hr = 0.f, ac = 1.f;
#pragma unroll 1
    for (int nt = 0; nt < 4; ++nt) {
        bf16x8 af[2];
#pragma unroll
        for (int ks = 0; ks < 2; ++ks) af[ks] = *(const LAS bf16x8*)(xcb + (16 * nt + i16) * 72 + 32 * ks + 8 * kb);
        f32x4 da[4], dx[4];
#pragma unroll
        for (int n = 0; n < 4; ++n) { da[n] = (f32x4){0.f, 0.f, 0.f, 0.f}; dx[n] = da[n];
#pragma unroll
            for (int ks = 0; ks < 2; ++ks) { da[n] = __builtin_amdgcn_mfma_f32_16x16x32_bf16(af[ks], bfa[n][ks], da[n], 0, 0, 0); dx[n] = __builtin_amdgcn_mfma_f32_16x16x32_bf16(af[ks], bfx[n][ks], dx[n], 0, 0, 0); } }
#pragma unroll
        for (int n = 0; n < 4; ++n)
#pragma unroll
            for (int r = 0; r < 4; ++r) { const int tokl = 4 * kb + r, co = 16 * n + i16; const float xcv = bf2f(xcb[(16 * nt + tokl) * 72 + co]);
                const float rg = sigmoidf_(da[n][r] + cba[n]), ig = sigmoidf_(dx[n][r] + cbx[n]); const float a = __expf(-rg * csp[n]);
                AL[tokl * 68 + co] = a; BL[tokl * 68 + co] = sqrtf(fmaxf(1.0f - a * a, 0.f)) * (ig * xcv); }
        LDS_WAIT(); asm volatile("" ::: "memory");
#pragma unroll
        for (int tt = 0; tt < 16; ++tt) { const float a = AL[tt * 68 + lane], bt = BL[tt * 68 + lane]; hr = a * hr + bt; ac *= a; BL[tt * 68 + lane] = hr; AL[tt * 68 + lane] = ac; }
        LDS_WAIT(); asm volatile("" ::: "memory");
        {   const int tk = lane >> 2, pc = (lane & 3) * 16;
            const f32x4 h0 = *(const LAS f32x4*)(BL + tk * 68 + pc), h1 = *(const LAS f32x4*)(BL + tk * 68 + pc + 4), h2 = *(const LAS f32x4*)(BL + tk * 68 + pc + 8), h3 = *(const LAS f32x4*)(BL + tk * 68 + pc + 12);
            const f32x4 a0 = *(const LAS f32x4*)(AL + tk * 68 + pc), a1 = *(const LAS f32x4*)(AL + tk * 68 + pc + 4), a2 = *(const LAS f32x4*)(AL + tk * 68 + pc + 8), a3 = *(const LAS f32x4*)(AL + tk * 68 + pc + 12);
            bf16* hp = XN + (row0 + 16 * nt + tk) * 1024 + ch0 + pc;
            GST(*(u32x4*)hp = (u32x4){pk2(h0.x, h0.y), pk2(h0.z, h0.w), pk2(h1.x, h1.y), pk2(h1.z, h1.w)}); GST(*(u32x4*)(hp + 8) = (u32x4){pk2(h2.x, h2.y), pk2(h2.z, h2.w), pk2(h3.x, h3.y), pk2(h3.z, h3.w)});
            GST(*(u32x4*)(hp + 512) = (u32x4){pk2(a0.x, a0.y), pk2(a0.z, a0.w), pk2(a1.x, a1.y), pk2(a1.z, a1.w)}); GST(*(u32x4*)(hp + 520) = (u32x4){pk2(a2.x, a2.y), pk2(a2.z, a2.w), pk2(a3.x, a3.y), pk2(a3.z, a3.w)}); }
        LDS_WAIT(); asm volatile("" ::: "memory");
    }
    FT1(9);
    GST(AGA[((size_t)b * 64 + tile) * 512 + ch0 + lane] = ac); GST(AGH[((size_t)b * 64 + tile) * 512 + ch0 + lane] = hr);
}
__device__ __forceinline__ void cmp_unit2(LAS unsigned char* lds, const bf16* P1, float* KC, const float* pe, const bf16* W1T, const float* w2, int unit) {
    const int tid = opaque_tid(); const int lane = tid & 63, w = __builtin_amdgcn_readfirstlane(tid >> 6);
    const int q = unit & 15, g = (unit >> 4) & 1, b = (unit >> 5) & 3, c = unit >> 7;
    LAS bf16* Fl = (LAS bf16*)lds;
    LAS float* part = (LAS float*)(lds + 65792);
    LAS float* hid = (LAS float*)(lds + 65792 + 32768);
    const float* pec = pe + (size_t)c * 2048; const bf16* w1t = W1T + ((size_t)c * 2 + g) * 64 * 2048; const float* w2c = w2 + ((size_t)c * 2 + g) * 4096;
    __syncthreads();
    {   u32x4 xv[8]; f32x4 pa[8], pb[8];
#pragma unroll
        for (int k = 0; k < 8; ++k) { const int e = tid + 512 * k; const int nl = e >> 8, l = (e >> 3) & 31, c8 = (e & 7) * 8; const int n = q * 16 + nl; const int nn = n < 255 ? n : 254;
            xv[k] = *(const u32x4*)(P1 + ((size_t)b * SEQ + nn * 16 + l) * P1W + C_KV + (c * 2 + g) * 64 + c8); pa[k] = *(const f32x4*)(pec + l * 64 + c8); pb[k] = *(const f32x4*)(pec + l * 64 + c8 + 4); }
#pragma unroll
        for (int k = 0; k < 8; ++k) { const int e = tid + 512 * k; const int nl = e >> 8, l = (e >> 3) & 31, c8 = (e & 7) * 8; const u32x4 v = xv[k];
            *(LAS u32x4*)(Fl + nl * 2056 + l * 64 + c8) = (u32x4){pk2(bflo(v.x) + pa[k].x, bfhi(v.x) + pa[k].y), pk2(bflo(v.y) + pa[k].z, bfhi(v.y) + pa[k].w), pk2(bflo(v.z) + pb[k].x, bfhi(v.z) + pb[k].y), pk2(bflo(v.w) + pb[k].z, bfhi(v.w) + pb[k].w)}; } }
    __syncthreads();
    {   const int i16 = lane & 15, kb = lane >> 4; f32x4 acc[4];
#pragma unroll
        for (int n = 0; n < 4; ++n) acc[n] = (f32x4){0.f, 0.f, 0.f, 0.f};
        bf16x8 bfr[8][4];
#pragma unroll
        for (int ks = 0; ks < 8; ++ks)
#pragma unroll
            for (int n = 0; n < 4; ++n) bfr[ks][n] = *(const bf16x8*)(w1t + (size_t)(16 * n + i16) * 2048 + 256 * w + 32 * ks + 8 * kb);
        __builtin_amdgcn_sched_barrier(0);
#pragma unroll
        for (int ks = 0; ks < 8; ++ks) { const int f0 = 256 * w + 32 * ks + 8 * kb;
            const bf16x8 af = *(const LAS bf16x8*)(Fl + i16 * 2056 + f0);
#pragma unroll
            for (int n = 0; n < 4; ++n) acc[n] = __builtin_amdgcn_mfma_f32_16x16x32_bf16(af, bfr[ks][n], acc[n], 0, 0, 0); }
#pragma unroll
        for (int n = 0; n < 4; ++n)
#pragma unroll
            for (int r = 0; r < 4; ++r) part[(w * 16 + 4 * kb + r) * 64 + 16 * n + i16] = acc[n][r];
    }
    __syncthreads();
    for (int e = tid; e < 1024; e += 512) { float a = 0.f;
#pragma unroll
        for (int ww = 0; ww < 8; ++ww) a += part[ww * 1024 + e];
        hid[e] = gelu_tanh(a); }
    __syncthreads();
    {   const int d = tid & 63, ng = tid >> 6; float a0 = 0.f, a1 = 0.f;
        for (int e = 0; e < 64; ++e) { const float wv = w2c[e * 64 + d]; a0 += hid[(ng * 2) * 64 + e] * wv; a1 += hid[(ng * 2 + 1) * 64 + e] * wv; }
        const int n0 = q * 16 + ng * 2; float* kp = KC + ((((size_t)c * NB + b) * 2 + g) * 256) * 64;
        if (n0 < 255) GST(kp[(size_t)n0 * 64 + d] = a0);
        if (n0 + 1 < 255) GST(kp[(size_t)(n0 + 1) * 64 + d] = a1); }
}
__device__ __forceinline__ void gmlp_unit3(LAS unsigned char* lds, bf16* P1, const float* gng, const float* gws, const float* gmb, int unit) {
    typedef float f32x16_ __attribute__((ext_vector_type(16))); typedef short s16x4_ __attribute__((ext_vector_type(4)));
    const int tid = opaque_tid(); const int lane = tid & 63, w = __builtin_amdgcn_readfirstlane(tid >> 6), r32 = lane & 31, h = lane >> 5;
    const int c = unit >> 1, gp = unit & 1; const size_t t0 = (size_t)c * 128;
    LAS unsigned char* VN = lds; LAS unsigned char* WT = lds + 65536; LAS float* rs = (LAS float*)(lds + 135168);
    __syncthreads();
    f32x4 wa[8], wb[8];
#pragma unroll
    for (int k = 0; k < 8; ++k) { const int e = tid + 512 * k; const int gi = e >> 11, t = (e >> 4) & 127, s8 = (e & 15) * 8; const float* wp = gws + (size_t)(2 * gp + gi) * 16384 + t * 128 + s8; wa[k] = *(const f32x4*)wp; wb[k] = *(const f32x4*)(wp + 4); }
    {   const int tk = tid >> 2, qu = tid & 3; const bf16* vp = P1 + (t0 + tk) * P1W + C_V + qu * 128; float ss = 0.f;
#pragma unroll 8
        for (int i = 0; i < 16; ++i) { const u32x4 x = *(const u32x4*)(vp + 8 * i);
            ss += bflo(x.x) * bflo(x.x) + bfhi(x.x) * bfhi(x.x) + bflo(x.y) * bflo(x.y) + bfhi(x.y) * bfhi(x.y) + bflo(x.z) * bflo(x.z) + bfhi(x.z) * bfhi(x.z) + bflo(x.w) * bflo(x.w) + bfhi(x.w) * bfhi(x.w); }
        ss += __shfl_xor(ss, 1); ss += __shfl_xor(ss, 2);
        if (qu == 0) rs[tk] = rsqrtf(ss * (1.f / 512.f) + EPS);
    }
#pragma unroll
    for (int k = 0; k < 8; ++k) { const int e = tid + 512 * k; const int gi = e >> 11, t = (e >> 4) & 127, s8 = (e & 15) * 8; const f32x4 a = wa[k], bq = wb[k];
        const float v0 = (s8 + 0 <= t) ? a.x : 0.f, v1 = (s8 + 1 <= t) ? a.y : 0.f, v2 = (s8 + 2 <= t) ? a.z : 0.f, v3 = (s8 + 3 <= t) ? a.w : 0.f;
        const float v4 = (s8 + 4 <= t) ? bq.x : 0.f, v5 = (s8 + 5 <= t) ? bq.y : 0.f, v6 = (s8 + 6 <= t) ? bq.z : 0.f, v7 = (s8 + 7 <= t) ? bq.w : 0.f;
        *(LAS u32x4*)(WT + gi * 34816 + t * 272 + s8 * 2) = (u32x4){pk2(v0, v1), pk2(v2, v3), pk2(v4, v5), pk2(v6, v7)}; }
    __syncthreads();
    {   u32x4 xv[8];
#pragma unroll
        for (int k = 0; k < 8; ++k) { const int e = tid + 512 * k; const int gi = e >> 11, sr = (e >> 4) & 127, c8 = e & 15; xv[k] = *(const u32x4*)(P1 + (t0 + sr) * P1W + C_V + (2 * gp + gi) * 128 + 8 * c8); }
#pragma unroll
        for (int k = 0; k < 8; ++k) { const int e = tid + 512 * k; const int gi = e >> 11, sr = (e >> 4) & 127, c8 = e & 15; const u32x4 x = xv[k];
            const float r = rs[sr]; const float* gq = gng + (2 * gp + gi) * 128 + 8 * c8;
            *(LAS u32x4*)(VN + gi * 32768 + (c8 >> 2) * 8192 + sr * 64 + (c8 & 3) * 16) = (u32x4){pk2(bflo(x.x) * r * gq[0], bfhi(x.x) * r * gq[1]), pk2(bflo(x.y) * r * gq[2], bfhi(x.y) * r * gq[3]), pk2(bflo(x.z) * r * gq[4], bfhi(x.z) * r * gq[5]), pk2(bflo(x.w) * r * gq[6], bfhi(x.w) * r * gq[7])}; } }
    __syncthreads();
    const int gi = w >> 2, cb = w & 3, g = 2 * gp + gi;
    const LAS unsigned char* vb = VN + gi * 32768 + cb * 8192 + ((lane >> 4) & 1) * 32 + (lane & 3) * 8 + (8 * h + ((lane & 15) >> 2)) * 64;
#pragma unroll 1
    for (int tb = 0; tb < 4; ++tb) {
        f32x16_ acc;
#pragma unroll
        for (int r = 0; r < 16; ++r) acc[r] = 0.f;
        const LAS unsigned char* wrow = WT + gi * 34816 + (32 * tb + r32) * 272 + 16 * h;
        for (int ks = 0; ks < 2 * tb + 2; ++ks) {
            const bf16x8 wf = *(const LAS bf16x8*)(wrow + 32 * ks);
            const s16x4_ lo = __builtin_bit_cast(s16x4_, __builtin_amdgcn_ds_read_tr16_b64_v4i16((LAS s16x4_*)(vb + ks * 1024)));
            const s16x4_ hi = __builtin_bit_cast(s16x4_, __builtin_amdgcn_ds_read_tr16_b64_v4i16((LAS s16x4_*)(vb + ks * 1024 + 256)));
            const bf16x8 vf = (bf16x8){lo[0], lo[1], lo[2], lo[3], hi[0], hi[1], hi[2], hi[3]};
            acc = __builtin_amdgcn_mfma_f32_32x32x16_bf16(vf, wf, acc, 0, 0, 0);
        }
        const int tl = 32 * tb + r32; const float bb = gmb[g * 128 + tl];
        bf16* up = P1 + (t0 + tl) * P1W + C_U + g * 128 + 32 * cb + 4 * h;
        u32x2 uu[4];
#pragma unroll
        for (int q4 = 0; q4 < 4; ++q4) uu[q4] = *(const u32x2*)(up + 8 * q4);
#pragma unroll
        for (int q4 = 0; q4 < 4; ++q4) {
            u32x2 o; o.x = pk2(bflo(uu[q4].x) * (acc[4 * q4] + bb), bfhi(uu[q4].x) * (acc[4 * q4 + 1] + bb)); o.y = pk2(bflo(uu[q4].y) * (acc[4 * q4 + 2] + bb), bfhi(uu[q4].y) * (acc[4 * q4 + 3] + bb));
            GST(*(u32x2*)(up + 8 * q4) = o); }
    }
}
__device__ __forceinline__ void pool_unit2(LAS unsigned char* lds, bf16* P1, const bf16* pwT, const float* ps, int unit) {
    typedef float f32x16_ __attribute__((ext_vector_type(16)));
    const int tid = opaque_tid(); const int lane = tid & 63, w = __builtin_amdgcn_readfirstlane(tid >> 6), r32 = lane & 31, h = lane >> 5;
    const int gi = unit & 3, tile = (unit >> 2) & 63, b = unit >> 8; const int wn = 2 << gi;
    LAS float* xs = (LAS float*)lds; LAS bf16* PL = (LAS bf16*)(lds + 40448);
    __syncthreads();
#pragma unroll
    for (int k = 0; k < 3; ++k) { const int e = tid + 512 * k; if (e < 79 * 16) { const int r = e >> 4, c8 = (e & 15) * 8; const int sp = tile * 64 + r - 15; const float z = sp >= 0 ? 1.f : 0.f;
        const u32x4 v = *(const u32x4*)(P1 + ((size_t)b * SEQ + (sp < 0 ? 0 : sp)) * P1W + C_XD + gi * 128 + c8);
        *(LAS f32x4*)(xs + r * 128 + c8) = (f32x4){bflo(v.x) * z, bfhi(v.x) * z, bflo(v.y) * z, bfhi(v.y) * z}; *(LAS f32x4*)(xs + r * 128 + c8 + 4) = (f32x4){bflo(v.z) * z, bfhi(v.z) * z, bflo(v.w) * z, bfhi(v.w) * z}; } }
    __syncthreads();
    {   const int ci = tid & 127, tq = tid >> 7;
        for (int k = 0; k < 16; ++k) { const int tt = tq * 16 + k; const int ts = tile * 64 + tt; float sacc = 0.f;
            for (int jj = 0; jj < wn; ++jj) sacc += xs[(tt + 15 - jj) * 128 + ci];
            const int cnt = (ts + 1 < wn) ? ts + 1 : wn;
            PL[tt * 136 + ci] = (bf16)f2bf(sacc / (float)cnt - xs[(tt + 15) * 128 + ci]); } }
    __syncthreads();
    {   const int cob = w >> 1, tokb = w & 1; f32x16_ acc;
#pragma unroll
        for (int r = 0; r < 16; ++r) acc[r] = 0.f;
        const bf16* wrow = pwT + (size_t)(32 * cob + r32) * 128 + 8 * h; const LAS bf16* prow = PL + (32 * tokb + r32) * 136 + 8 * h;
#pragma unroll
        for (int ks = 0; ks < 8; ++ks) { const bf16x8 wf = *(const bf16x8*)(wrow + 16 * ks); const bf16x8 pf = *(const LAS bf16x8*)(prow + 16 * ks);
            acc = __builtin_amdgcn_mfma_f32_32x32x16_bf16(wf, pf, acc, 0, 0, 0); }
        bf16* op = P1 + ((size_t)b * SEQ + tile * 64 + 32 * tokb + r32) * P1W + C_V + gi * 128 + 32 * cob + 4 * h; const float* sp = ps + gi * 128 + 32 * cob + 4 * h;
#pragma unroll
        for (int q4 = 0; q4 < 4; ++q4) { const f32x4 sc = *(const f32x4*)(sp + 8 * q4);
            u32x2 o; o.x = pk2(acc[4 * q4] * sc.x, acc[4 * q4 + 1] * sc.y); o.y = pk2(acc[4 * q4 + 2] * sc.z, acc[4 * q4 + 3] * sc.w); GST(*(u32x2*)(op + 8 * q4) = o); }
    }
}
__device__ __forceinline__ void lrufix_unit2(LAS unsigned char* lds, bf16* P1, const bf16* XN, const float* AGA, const float* AGH, int unit) {
    const int tid = opaque_tid(); const int cg = tid & 63, tl = tid >> 6; const int tile = unit & 63, b = unit >> 6;
    LAS float* seg = (LAS float*)lds;
    __syncthreads();
    {   float sa[8], sh[8];
#pragma unroll
        for (int i = 0; i < 8; ++i) { sa[i] = 1.f; sh[i] = 0.f; }
        f32x4 la0[8], la1[8], lh0[8], lh1[8];
#pragma unroll
        for (int k = 0; k < 8; ++k) { const int i = 8 * tl + k; const int ii = i < tile ? i : 0; const float* ap = AGA + ((size_t)b * 64 + ii) * 512 + 8 * cg; const float* hp = AGH + ((size_t)b * 64 + ii) * 512 + 8 * cg;
            la0[k] = *(const f32x4*)ap; la1[k] = *(const f32x4*)(ap + 4); lh0[k] = *(const f32x4*)hp; lh1[k] = *(const f32x4*)(hp + 4); }
#pragma unroll
        for (int k = 0; k < 8; ++k) { const int i = 8 * tl + k; if (i < tile) { const f32x4 a0 = la0[k], a1 = la1[k], h0 = lh0[k], h1 = lh1[k];
                sh[0] = a0.x * sh[0] + h0.x; sh[1] = a0.y * sh[1] + h0.y; sh[2] = a0.z * sh[2] + h0.z; sh[3] = a0.w * sh[3] + h0.w; sh[4] = a1.x * sh[4] + h1.x; sh[5] = a1.y * sh[5] + h1.y; sh[6] = a1.z * sh[6] + h1.z; sh[7] = a1.w * sh[7] + h1.w;
                sa[0] *= a0.x; sa[1] *= a0.y; sa[2] *= a0.z; sa[3] *= a0.w; sa[4] *= a1.x; sa[5] *= a1.y; sa[6] *= a1.z; sa[7] *= a1.w; } }
        LAS float* sp = seg + (tl * 64 + cg) * 16;
        *(LAS f32x4*)sp = (f32x4){sa[0], sa[1], sa[2], sa[3]}; *(LAS f32x4*)(sp + 4) = (f32x4){sa[4], sa[5], sa[6], sa[7]}; *(LAS f32x4*)(sp + 8) = (f32x4){sh[0], sh[1], sh[2], sh[3]}; *(LAS f32x4*)(sp + 12) = (f32x4){sh[4], sh[5], sh[6], sh[7]};
    }
    __syncthreads();
    float c[8];
#pragma unroll
    for (int i = 0; i < 8; ++i) c[i] = 0.f;
#pragma unroll
    for (int sgi = 0; sgi < 8; ++sgi) { const LAS float* sp = seg + (sgi * 64 + cg) * 16; const f32x4 a0 = *(const LAS f32x4*)sp, a1 = *(const LAS f32x4*)(sp + 4), h0 = *(const LAS f32x4*)(sp + 8), h1 = *(const LAS f32x4*)(sp + 12);
        c[0] = a0.x * c[0] + h0.x; c[1] = a0.y * c[1] + h0.y; c[2] = a0.z * c[2] + h0.z; c[3] = a0.w * c[3] + h0.w; c[4] = a1.x * c[4] + h1.x; c[5] = a1.y * c[5] + h1.y; c[6] = a1.z * c[6] + h1.z; c[7] = a1.w * c[7] + h1.w; }
    const size_t row0 = (size_t)b * SEQ + tile * 64;
#pragma unroll 4
    for (int p = 0; p < 8; ++p) { const size_t row = row0 + 8 * p + tl;
        const u32x4 hl = *(const u32x4*)(XN + row * 1024 + 8 * cg), ac = *(const u32x4*)(XN + row * 1024 + 512 + 8 * cg); bf16* gp = P1 + row * P1W + C_GB + 8 * cg; const u32x4 gg = *(const u32x4*)gp;
        u32x4 o;
        o.x = pk2(bflo(gg.x) * (bflo(hl.x) + bflo(ac.x) * c[0]), bfhi(gg.x) * (bfhi(hl.x) + bfhi(ac.x) * c[1])); o.y = pk2(bflo(gg.y) * (bflo(hl.y) + bflo(ac.y) * c[2]), bfhi(gg.y) * (bfhi(hl.y) + bfhi(ac.y) * c[3]));
        o.z = pk2(bflo(gg.z) * (bflo(hl.z) + bflo(ac.z) * c[4]), bfhi(gg.z) * (bfhi(hl.z) + bfhi(ac.z) * c[5])); o.w = pk2(bflo(gg.w) * (bflo(hl.w) + bflo(ac.w) * c[6]), bfhi(gg.w) * (bfhi(hl.w) + bfhi(ac.w) * c[7]));
        GST(*(u32x4*)gp = o); }
}

typedef float f32x16 __attribute__((ext_vector_type(16)));
typedef short s16x4 __attribute__((ext_vector_type(4)));
typedef __bf16 bf16x2_t __attribute__((ext_vector_type(2)));
constexpr int AT_KB = 8320, AT_VB = 8192;
constexpr int AT_TILE = AT_KB + AT_VB, AT_NT = 6, AT_IMP = AT_NT * AT_TILE, AT_SEL = AT_IMP + 16384, AT_SELU = AT_SEL + 512, AT_CNT = AT_SELU + 16;
__device__ __forceinline__ int at_koff(int slot, int sub) { return (2 * slot + sub) * AT_TILE; }
__device__ __forceinline__ int at_voff(int slot, int sub) { return (2 * slot + sub) * AT_TILE + AT_KB; }
__device__ __forceinline__ void ring_wait(LAS unsigned* p, unsigned target) { while (__hip_atomic_load(p, __ATOMIC_ACQUIRE, __HIP_MEMORY_SCOPE_WORKGROUP) < target) __builtin_amdgcn_s_sleep(1); }
__device__ __forceinline__ void ring_signal(LAS unsigned* p, int lane) { if (lane == 0) (void)__hip_atomic_fetch_add(p, 1u, __ATOMIC_RELEASE, __HIP_MEMORY_SCOPE_WORKGROUP); }
constexpr float AT_C2 = 0.125f * 1.4426950408889634f, AT_THR = 6.0f;
__device__ __forceinline__ unsigned cvtpk_bf16(float lo, float hi) { f32x2 v = {lo, hi}; bf16x2_t b = __builtin_convertvector(v, bf16x2_t); return __builtin_bit_cast(unsigned, b); }
__device__ __forceinline__ int crow(int r, int h) { return (r & 3) + 8 * (r >> 2) + 4 * h; }
__device__ __forceinline__ float max3f_(float a, float b, float c) { float r; asm("v_max3_f32 %0, %1, %2, %3" : "=v"(r) : "v"(a), "v"(b), "v"(c)); return r; }
__device__ __forceinline__ float swap32_max(float x) { auto rr = __builtin_amdgcn_permlane32_swap(__builtin_bit_cast(unsigned, x), __builtin_bit_cast(unsigned, x), false, false); float a = __builtin_bit_cast(float, rr[0]), b = __builtin_bit_cast(float, rr[1]); float r; asm("v_max_f32_e32 %0, %1, %2" : "=v"(r) : "v"(a), "v"(b)); return r; }
__device__ __forceinline__ float swap32_sum(float x) { auto rr = __builtin_amdgcn_permlane32_swap(__builtin_bit_cast(unsigned, x), __builtin_bit_cast(unsigned, x), false, false); return __builtin_bit_cast(float, rr[0]) + __builtin_bit_cast(float, rr[1]); }
struct AtRegs { u32x4 k, v; };
__device__ __forceinline__ AtRegs at_load_bf16(const bf16* kp, const bf16* vp, int tid) {
    AtRegs r; const int key = tid >> 3, c = tid & 7;
    if (ABL_ON(8)) { r.k = (u32x4){1u, 2u, 3u, 4u}; r.v = r.k; return r; }
    r.k = *(const u32x4*)(kp + (size_t)key * P1W + 8 * c); r.v = *(const u32x4*)(vp + (size_t)key * P1W + 8 * c); return r;
}
__device__ __forceinline__ AtRegs at_load_f32(const float* kp, const float* vp, int n0, int tid) {
    AtRegs r; const int key = tid >> 3, c = tid & 7; const int n = n0 + key;
    if (n < 255) { const f32x4 a0 = *(const f32x4*)(kp + (size_t)n * 64 + 8 * c), a1 = *(const f32x4*)(kp + (size_t)n * 64 + 8 * c + 4), b0 = *(const f32x4*)(vp + (size_t)n * 64 + 8 * c), b1 = *(const f32x4*)(vp + (size_t)n * 64 + 8 * c + 4);
        r.k = (u32x4){pk2(a0.x, a0.y), pk2(a0.z, a0.w), pk2(a1.x, a1.y), pk2(a1.z, a1.w)}; r.v = (u32x4){pk2(b0.x, b0.y), pk2(b0.z, b0.w), pk2(b1.x, b1.y), pk2(b1.z, b1.w)}; }
    else { r.k = (u32x4){0u, 0u, 0u, 0u}; r.v = (u32x4){0u, 0u, 0u, 0u}; }
    return r;
}
__device__ __forceinline__ void at_store(LAS unsigned char* lds, int slot, int sub, const AtRegs& r, int tid) {
    const int key = tid >> 3, c = tid & 7;
    *(LAS u32x4*)(lds + at_koff(slot, sub) + c * 1040 + key * 16) = r.k;
    *(LAS u32x4*)(lds + at_voff(slot, sub) + (c >> 2) * 4096 + key * 64 + (c & 3) * 16) = r.v;
}
__device__ __forceinline__ void at_qk(f32x16& p0, f32x16& p1, const LAS unsigned char* kb, const bf16x8 (&qr)[4], int r32, int h) {
    const f32x16 z = {0.f, 0.f, 0.f, 0.f, 0.f, 0.f, 0.f, 0.f, 0.f, 0.f, 0.f, 0.f, 0.f, 0.f, 0.f, 0.f};
    bf16x8 kf[8];
#pragma unroll
    for (int d0 = 0; d0 < 4; ++d0) { kf[2 * d0] = *(const LAS bf16x8*)(kb + (2 * d0 + h) * 1040 + r32 * 16); kf[2 * d0 + 1] = *(const LAS bf16x8*)(kb + (2 * d0 + h) * 1040 + (32 + r32) * 16); }
    __builtin_amdgcn_sched_barrier(0);
    p0 = __builtin_amdgcn_mfma_f32_32x32x16_bf16(kf[0], qr[0], z, 0, 0, 0); p1 = __builtin_amdgcn_mfma_f32_32x32x16_bf16(kf[1], qr[0], z, 0, 0, 0);
#pragma unroll
    for (int d0 = 1; d0 < 4; ++d0) { p0 = __builtin_amdgcn_mfma_f32_32x32x16_bf16(kf[2 * d0], qr[d0], p0, 0, 0, 0); p1 = __builtin_amdgcn_mfma_f32_32x32x16_bf16(kf[2 * d0 + 1], qr[d0], p1, 0, 0, 0); }
}
__device__ __forceinline__ void at_step(const LAS unsigned char* lds, int slot, int sub, const bf16x8 (&qr)[4], f32x16 (&o)[2], float& m, float& l, u64 vm, int lane) {
    if (!__any(vm != 0ull)) return;
    const int r32 = lane & 31, h = lane >> 5;
    f32x16 p0, p1;
    if (!ABL_ON(4)) at_qk(p0, p1, lds + at_koff(slot, sub), qr, r32, h); else { for (int r = 0; r < 16; ++r) { p0[r] = 0.f; p1[r] = 0.f; } }
    const LAS unsigned char* vb = lds + at_voff(slot, sub) + ((lane >> 4) & 1) * 32 + (lane & 3) * 8 + (4 * h + ((lane & 15) >> 2)) * 64;
    s16x4 tlo[8], thi[8];
#pragma unroll
    for (int i = 0; i < 8; ++i) { tlo[i] = __builtin_bit_cast(s16x4, __builtin_amdgcn_ds_read_tr16_b64_v4i16((LAS s16x4*)(vb + (i & 1) * 4096 + (i >> 1) * 1024)));
        thi[i] = __builtin_bit_cast(s16x4, __builtin_amdgcn_ds_read_tr16_b64_v4i16((LAS s16x4*)(vb + (i & 1) * 4096 + (i >> 1) * 1024 + 512))); }
    __builtin_amdgcn_sched_barrier(0);
    const bool full = __all(vm == ~0ull);
    const unsigned vlo = (unsigned)vm, vhi = (unsigned)(vm >> 32);
    if (!full && !ABL_ON(16)) {
#pragma unroll
        for (int r = 0; r < 16; ++r) { const int kx = crow(r, h); p0[r] = ((vlo >> kx) & 1u) ? p0[r] : -INFINITY; p1[r] = ((vhi >> kx) & 1u) ? p1[r] : -INFINITY; }
    }
    asm volatile("s_nop 15\n\ts_nop 7" : "+v"(p0), "+v"(p1));
    float rm = max3f_(p0[0], p1[0], p0[1]);
#pragma unroll
    for (int r = 1; r < 15; ++r) rm = max3f_(rm, p1[r], p0[r + 1]);
    rm = max3f_(rm, p1[15], rm);
    rm *= AT_C2;
    rm = fmaxf(rm, __shfl_xor(rm, 32));
    if (__any(rm > m + AT_THR)) { const float mn = fmaxf(m, rm); const float f = __builtin_amdgcn_exp2f(m - mn); m = mn; l *= f;
#pragma unroll
        for (int r = 0; r < 16; ++r) { o[0][r] *= f; o[1][r] *= f; } }
    const float nm = -m; float ls = 0.f;
#pragma unroll
    for (int r = 0; r < 16; ++r) { if (!ABL_ON(1)) { p0[r] = __builtin_amdgcn_exp2f(__builtin_fmaf(p0[r], AT_C2, nm)); p1[r] = __builtin_amdgcn_exp2f(__builtin_fmaf(p1[r], AT_C2, nm)); } ls += p0[r] + p1[r]; }
    l += ls;
    __builtin_amdgcn_sched_barrier(0);
#pragma unroll
    for (int ks = 0; ks < 4; ++ks) {
        u32x4 pw;
        if (ks == 0) pw = (u32x4){cvtpk_bf16(p0[0], p0[1]), cvtpk_bf16(p0[2], p0[3]), cvtpk_bf16(p0[4], p0[5]), cvtpk_bf16(p0[6], p0[7])};
        else if (ks == 1) pw = (u32x4){cvtpk_bf16(p0[8], p0[9]), cvtpk_bf16(p0[10], p0[11]), cvtpk_bf16(p0[12], p0[13]), cvtpk_bf16(p0[14], p0[15])};
        else if (ks == 2) pw = (u32x4){cvtpk_bf16(p1[0], p1[1]), cvtpk_bf16(p1[2], p1[3]), cvtpk_bf16(p1[4], p1[5]), cvtpk_bf16(p1[6], p1[7])};
        else pw = (u32x4){cvtpk_bf16(p1[8], p1[9]), cvtpk_bf16(p1[10], p1[11]), cvtpk_bf16(p1[12], p1[13]), cvtpk_bf16(p1[14], p1[15])};
        const bf16x8 pf = __builtin_bit_cast(bf16x8, pw);
#pragma unroll
        for (int db = 0; db < 2; ++db) { const int i = 2 * ks + db;
            const bf16x8 vf = (bf16x8){tlo[i][0], tlo[i][1], tlo[i][2], tlo[i][3], thi[i][0], thi[i][1], thi[i][2], thi[i][3]};
            if (!ABL_ON(2)) o[db] = __builtin_amdgcn_mfma_f32_32x32x16_bf16(vf, pf, o[db], 0, 0, 0); else asm volatile("" :: "v"(vf), "v"(pf)); }
    }
}
__device__ __forceinline__ void at_fold(f32x16 (&ot)[2], f32x16 (&o)[2], float& m, float& l, float gate, bool valid) {
    const float lt = l + __shfl_xor(l, 32); const float inv = (valid && lt > 0.f) ? gate / lt : 0.f;
#pragma unroll
    for (int r = 0; r < 16; ++r) { ot[0][r] += o[0][r] * inv; ot[1][r] += o[1][r] * inv; o[0][r] = 0.f; o[1][r] = 0.f; }
    m = -1e30f; l = 0.f;
}
__device__ __forceinline__ void attn_unit_mfma(LAS unsigned char* lds, bf16* P1, const float* KC, int unit) {
    const int tid = opaque_tid(); const int lane = tid & 63, w = __builtin_amdgcn_readfirstlane(tid >> 6), r32 = lane & 31, h = lane >> 5;
    const int ti = unit & 63, g = (unit >> 6) & 1, b = unit >> 7;
    const int tq = 8 * w + (r32 >> 2), j = r32 & 3, hd = 4 * g + j; const int ts = 64 * ti + tq;
    const size_t row = (size_t)b * SEQ + ts;
    LAS float* IMP = (LAS float*)(lds + AT_IMP); LAS u64* SEL = (LAS u64*)(lds + AT_SEL); LAS unsigned* SELU = (LAS unsigned*)(lds + AT_SELU);
    __syncthreads();
    for (int e = tid; e < 4096; e += 512) IMP[e] = 0.f;
    if (tid < 2) SELU[tid] = 0u;
    if (tid < 16) ((LAS unsigned*)(lds + AT_CNT))[tid] = 0u;
    bf16x8 qr[4];
    { const bf16* qp = P1 + row * P1W + C_Q + hd * 64 + 8 * h;
#pragma unroll
      for (int d0 = 0; d0 < 4; ++d0) qr[d0] = *(const bf16x8*)(qp + 16 * d0); }
    const float g0 = bf2f(P1[row * P1W + C_GC + hd * 3 + 0]), g1 = bf2f(P1[row * P1W + C_GC + hd * 3 + 1]), g2 = bf2f(P1[row * P1W + C_GC + hd * 3 + 2]);
    f32x16 o[2], ot[2];
#pragma unroll
    for (int r = 0; r < 16; ++r) { o[0][r] = 0.f; o[1][r] = 0.f; ot[0][r] = 0.f; ot[1][r] = 0.f; }
    float m = -1e30f, l = 0.f;
    const int nv = (ts >= 31) ? ((((ts + 1) >> 4) - 1 > 255) ? 255 : ((ts + 1) >> 4) - 1) : 0;
    const int nkt = (4 * ti + 3 + 63) >> 6;
    const float* kcp = KC + ((((size_t)0 * NB + b) * 2 + g) * 256) * 64; const float* vcp = KC + ((((size_t)1 * NB + b) * 2 + g) * 256) * 64;
    {   const int np = (nkt + 1) >> 1;
        AtRegs ra = at_load_f32(kcp, vcp, 0, tid), rb = ra; if (nkt > 1) rb = at_load_f32(kcp, vcp, 64, tid);
        at_store(lds, 0, 0, ra, tid); if (nkt > 1) at_store(lds, 0, 1, rb, tid); __syncthreads();
        for (int pi = 0; pi < np; ++pi) {
            const int k0 = 2 * pi, k2 = 2 * pi + 2;
            if (k2 < nkt) { ra = at_load_f32(kcp, vcp, 64 * k2, tid); if (k2 + 1 < nkt) rb = at_load_f32(kcp, vcp, 64 * (k2 + 1), tid); }
            at_step(lds, pi & 1, 0, qr, o, m, l, mask_lo(nv - 64 * k0), lane);
            if (k0 + 1 < nkt) at_step(lds, pi & 1, 1, qr, o, m, l, mask_lo(nv - 64 * (k0 + 1)), lane);
            if (k2 < nkt) { at_store(lds, (pi + 1) & 1, 0, ra, tid); if (k2 + 1 < nkt) at_store(lds, (pi + 1) & 1, 1, rb, tid); }
            __syncthreads();
        }
        const float lt = l + __shfl_xor(l, 32); const float invl = (nv > 0 && lt > 0.f) ? 1.f / lt : 0.f;
        float prevL = 0.f;
        ra = at_load_f32(kcp, vcp, 0, tid); if (nkt > 1) rb = at_load_f32(kcp, vcp, 64, tid);
        at_store(lds, 0, 0, ra, tid); if (nkt > 1) at_store(lds, 0, 1, rb, tid); __syncthreads();
        for (int pi = 0; pi < np; ++pi) {
            const int k2 = 2 * pi + 2;
            if (k2 < nkt) { ra = at_load_f32(kcp, vcp, 64 * k2, tid); if (k2 + 1 < nkt) rb = at_load_f32(kcp, vcp, 64 * (k2 + 1), tid); }
#pragma unroll 1
            for (int sub = 0; sub < 2; ++sub) {
                const int kt = 2 * pi + sub; if (kt >= nkt) break;
                f32x16 p0, p1; at_qk(p0, p1, lds + at_koff(pi & 1, sub), qr, r32, h);
                const u64 vm = mask_lo(nv - 64 * kt); const unsigned vlo = (unsigned)vm, vhi = (unsigned)(vm >> 32);
#pragma unroll
                for (int r = 0; r < 16; ++r) { const int kx = crow(r, h);
                    p0[r] = ((vlo >> kx) & 1u) ? __builtin_amdgcn_exp2f(p0[r] * AT_C2 - m) * invl : 0.f;
                    p1[r] = ((vhi >> kx) & 1u) ? __builtin_amdgcn_exp2f(p1[r] * AT_C2 - m) * invl : 0.f; }
#pragma unroll
                for (int hh = 0; hh < 2; ++hh) {
                    float G[4], Lp[4];
#pragma unroll
                    for (int q4 = 0; q4 < 4; ++q4) { const float a0 = hh ? p1[4 * q4] : p0[4 * q4], a1 = hh ? p1[4 * q4 + 1] : p0[4 * q4 + 1], a2 = hh ? p1[4 * q4 + 2] : p0[4 * q4 + 2], a3 = hh ? p1[4 * q4 + 3] : p0[4 * q4 + 3];
                        G[q4] = (a0 + a1) + (a2 + a3); Lp[q4] = __shfl_xor(a3, 32); }
#pragma unroll
                    for (int q4 = 0; q4 < 4; ++q4) {
                        const float carry = h ? Lp[q4] : (q4 == 0 ? prevL : Lp[q4 - 1]);
                        float v = G[q4] + carry; v += __shfl_xor(v, 1); v += __shfl_xor(v, 2);
                        if (j == 0) IMP[tq * 64 + 16 * kt + 8 * hh + 2 * q4 + h] = v;
                    }
                    prevL = Lp[3];
                }
            }
            if (k2 < nkt) { at_store(lds, (pi + 1) & 1, 0, ra, tid); if (k2 + 1 < nkt) at_store(lds, (pi + 1) & 1, 1, rb, tid); }
            __syncthreads();
        }
    }
    at_fold(ot, o, m, l, g0, nv > 0);
    __syncthreads();
    const int cur = ti;
    FT0(3);
    {
        const int tok = tid >> 3, j8 = tid & 7; u64 selt = 1ull | (1ull << cur) | (cur >= 1 ? (1ull << (cur - 1)) : 0ull);
        float cv[8];
#pragma unroll
        for (int k = 0; k < 8; ++k) { const int mm = j8 + 8 * k; cv[k] = (mm >= 1 && mm <= cur - 2) ? IMP[tok * 64 + mm] : -1.f; }
        const int npick = (cur - 2) < 5 ? (cur - 2) : 5;
        for (int pk = 0; pk < npick; ++pk) { float best = -1.f; int bi = 64;
#pragma unroll
            for (int k = 0; k < 8; ++k) if (cv[k] > best) { best = cv[k]; bi = j8 + 8 * k; }
#pragma unroll
            for (int off = 1; off < 8; off <<= 1) { const float ov = __shfl_xor(best, off); const int oi = __shfl_xor(bi, off); if (ov > best || (ov == best && oi < bi)) { best = ov; bi = oi; } }
            selt |= 1ull << (bi & 63);
#pragma unroll
            for (int k = 0; k < 8; ++k) if (j8 + 8 * k == bi) cv[k] = -2.f; }
        if (j8 == 0) { SEL[tok] = selt; atomicOr((unsigned*)&SELU[0], (unsigned)selt); atomicOr((unsigned*)&SELU[1], (unsigned)(selt >> 32)); }
    }
    __syncthreads();
    FT1(3);
    const u64 sel = SEL[tq];
    const u64 selu = ((u64)SELU[1] << 32) | (u64)SELU[0];
    {
        const bf16* kb = P1 + (size_t)b * SEQ * P1W + C_KV + (2 * 2 + g) * 64; const bf16* vbp = P1 + (size_t)b * SEQ * P1W + C_KV + (3 * 2 + g) * 64;
        LAS unsigned* FIL = (LAS unsigned*)(lds + AT_CNT); LAS unsigned* DON = FIL + 8;
        const int n = __builtin_popcountll(selu);
        u64 remL = selu, remC = selu;
        {   AtRegs r0, r1, r2; int b0 = __builtin_ctzll(remL); remL &= remL - 1; r0 = at_load_bf16(kb + (size_t)b0 * 64 * P1W, vbp + (size_t)b0 * 64 * P1W, tid); r1 = r0; r2 = r0;
            if (n > 1) { const int b1 = __builtin_ctzll(remL); remL &= remL - 1; r1 = at_load_bf16(kb + (size_t)b1 * 64 * P1W, vbp + (size_t)b1 * 64 * P1W, tid); }
            if (n > 2) { const int b2 = __builtin_ctzll(remL); remL &= remL - 1; r2 = at_load_bf16(kb + (size_t)b2 * 64 * P1W, vbp + (size_t)b2 * 64 * P1W, tid); }
            at_store(lds, 0, 0, r0, tid); ring_signal(FIL + 0, lane);
            if (n > 1) { at_store(lds, 0, 1, r1, tid); ring_signal(FIL + 1, lane); }
            if (n > 2) { at_store(lds, 1, 0, r2, tid); ring_signal(FIL + 2, lane); } }
        AtRegs rg; rg.k = (u32x4){0u, 0u, 0u, 0u}; rg.v = rg.k;
        if (n > 3) { const int b3 = __builtin_ctzll(remL); remL &= remL - 1; rg = at_load_bf16(kb + (size_t)b3 * 64 * P1W, vbp + (size_t)b3 * 64 * P1W, tid); }
        int jc = 0, gc = 1, js = 3, gs = 0;
#pragma unroll 1
        for (int t = 0; t < n; ++t) {
            const int mbc = __builtin_ctzll(remC); remC &= remC - 1;
            if (t + 3 < n) {
                FT0(4); ring_wait(DON + js, 8u * (unsigned)gs); FT1(4);
                FT0(5); at_store(lds, js >> 1, js & 1, rg, tid); ring_signal(FIL + js, lane); FT1(5);
                if (t + 4 < n) { const int bn = __builtin_ctzll(remL); remL &= remL - 1; rg = at_load_bf16(kb + (size_t)bn * 64 * P1W, vbp + (size_t)bn * 64 * P1W, tid); }
            }
            FT0(6); ring_wait(FIL + jc, 8u * (unsigned)gc); FT1(6);
            u64 vm = 0ull; if ((sel >> mbc) & 1ull) vm = (mbc == cur) ? mask_lo((ts & 63) + 1) : ~0ull;
            FT0(7); at_step(lds, jc >> 1, jc & 1, qr, o, m, l, vm, lane); FT1(7);
            ring_signal(DON + jc, lane);
            if (++jc == 6) { jc = 0; ++gc; }
            if (++js == 6) { js = 0; ++gs; }
        }
        __syncthreads();
    }
    at_fold(ot, o, m, l, g1, true);
    {   const bf16* kb = P1 + (size_t)b * SEQ * P1W + C_KV + (4 * 2 + g) * 64; const bf16* vbp = P1 + (size_t)b * SEQ * P1W + C_KV + (5 * 2 + g) * 64;
        const int mlo = (ti >= 8) ? ti - 8 : 0; const int nw = cur - mlo + 1, np = (nw + 1) >> 1;
        AtRegs ra = at_load_bf16(kb + (size_t)mlo * 64 * P1W, vbp + (size_t)mlo * 64 * P1W, tid), rb = ra; if (nw > 1) rb = at_load_bf16(kb + (size_t)(mlo + 1) * 64 * P1W, vbp + (size_t)(mlo + 1) * 64 * P1W, tid);
        at_store(lds, 0, 0, ra, tid); if (nw > 1) at_store(lds, 0, 1, rb, tid); __syncthreads();
        for (int pi = 0; pi < np; ++pi) {
            const int i0 = 2 * pi, i2 = 2 * pi + 2;
            if (i2 < nw) { ra = at_load_bf16(kb + (size_t)(mlo + i2) * 64 * P1W, vbp + (size_t)(mlo + i2) * 64 * P1W, tid); if (i2 + 1 < nw) rb = at_load_bf16(kb + (size_t)(mlo + i2 + 1) * 64 * P1W, vbp + (size_t)(mlo + i2 + 1) * 64 * P1W, tid); }
#pragma unroll 1
            for (int sub = 0; sub < 2; ++sub) { const int mb = mlo + i0 + sub; if (i0 + sub >= nw) break;
                const int lo = ts - 511 - mb * 64, hi = ts - mb * 64;
                u64 vm = 0ull; if (hi >= 0 && lo <= 63) vm = mask_lo(hi + 1) & ~mask_lo(lo);
                at_step(lds, pi & 1, sub, qr, o, m, l, vm, lane); }
            if (i2 < nw) { at_store(lds, (pi + 1) & 1, 0, ra, tid); if (i2 + 1 < nw) at_store(lds, (pi + 1) & 1, 1, rb, tid); }
            __syncthreads();
        }
    }
    at_fold(ot, o, m, l, g2, true);
    {   bf16* op = P1 + row * P1W + C_Q + hd * 64 + 4 * h;
#pragma unroll
        for (int db = 0; db < 2; ++db)
#pragma unroll
            for (int q4 = 0; q4 < 4; ++q4) { u32x2 wv; wv.x = cvtpk_bf16(ot[db][4 * q4], ot[db][4 * q4 + 1]); wv.y = cvtpk_bf16(ot[db][4 * q4 + 2], ot[db][4 * q4 + 3]); GST(*(u32x2*)(op + 32 * db + 8 * q4) = wv); } }
}

__device__ __forceinline__ void set_dry(LAS unsigned char* l, int v) { __syncthreads(); if (threadIdx.x == 0) ((volatile LAS int*)(l + LDS_CTL + 64))[0] = v; __syncthreads(); }
constexpr int NPH = 1 + 9 * NL;
__global__ void __launch_bounds__(512, 2) fwd_kernel(Args args) {
    extern __shared__ __attribute__((aligned(16))) unsigned char lds_raw[];
    LAS unsigned char* ldsl = (LAS unsigned char*)lds_raw;
    float* ldsf = (float*)lds_raw;
    const int G0 = gridDim.x, bx0 = blockIdx.x, G = G0, bx = bx0, NGW = G * 8;
#define PHASE_IDS() const int tid = opaque_tid(), lane = tid & 63, wave = __builtin_amdgcn_readfirstlane(tid >> 6), gw = bx * 8 + wave; (void)lane; (void)gw
#define ws ARG_WS()
#define ctl ((unsigned*)(ws + WS_CTL))
#define H ARG_OUT()
#define XN ((bf16*)(ws + WS_XN))
#define P1 ((bf16*)(ws + WS_P1))
#define Rr ((bf16*)(ws + WS_R))
#define WIN ((bf16*)(ws + WS_WIN))
#define WB ((bf16*)(ws + WS_WB))
#define WOUT ((bf16*)(ws + WS_WOUT))
#define WGU ((bf16*)(ws + WS_WGU))
#define WD ((bf16*)(ws + WS_WD))
#define HID ((bf16*)(ws + WS_HID))
#define Y ((bf16*)(ws + WS_Y))
#define KC ((float*)(ws + WS_KC))
#define AGA ((float*)(ws + WS_LRUA))
#define AGH ((float*)(ws + WS_LRUH))
#define LIST ((unsigned*)(ws + WS_LIST))
#define LISTW ((float*)(ws + WS_LISTW))
    { PHASE_IDS(); for (int u = tid; u < (LDS_BYTES - LDS_CTL) / 4; u += 512) ((LAS unsigned*)(ldsl + LDS_CTL))[u] = 0u; }
    __syncthreads();
    if (!MK_SPLIT) (void)xcd_barrier_post(ctl + CW_BAR, (volatile LAS unsigned*)(ldsl + LDS_CTL + 32));
    const int lo = args.ph_lo, hi = args.ph_hi;
#define IN(k) (lo <= (k) && (k) < hi)
#if PROBE_PH >= 0
#ifndef PROBE_REAL
#define PROBE_REAL 0
#endif
#define PHASE_REP(id) for (int rep_ = 0; rep_ < (((id) == PROBE_PH) ? 2 : 1); ++rep_, set_dry(ldsl, 0)) if (set_dry(ldsl, PROBE_REAL ? 0 : rep_), true)
#else
#define PHASE_REP(id) if (true)
#endif
#define SEAM(k) do { if (!MK_SPLIT && IN((k) + 1)) { XcdBarrier bb_; bb_.bar = ctl + CW_BAR; bb_.x = xb_xcc_id(); bb_.st = (volatile LAS unsigned*)(ldsl + LDS_CTL + 32); \
    for (int r_ = 0; r_ < ((PROBE_PH == 50) ? 3 : 1); ++r_) xcd_barrier(bb_); } } while (0)

    if (IN(0)) PHASE_REP(100) {
        PHASE_IDS();
        float* scr = ldsf + wave * 4096;
        constexpr int IT_W1 = 32 * 2, IT_LW = 2, IT_PW = 2 * 4;
        constexpr int NSMALL = NL * 4 * IT_W1 + NL * 16 * IT_LW + NL * 4 * IT_PW;
        auto dec0 = [&](int it) -> TrItem {
            if (it < IT_BIG) return dec_big(it, 0);
            int r = it - IT_BIG;
            if (r < NL * 4 * IT_W1) { const int m = r / IT_W1; r -= m * IT_W1; return TrItem{ARG_IN(I_CW1) + (size_t)m * 2048 * 64, (bf16*)(ws + WS_W1T) + (size_t)m * 64 * 2048, 2048, 64, r / 2, r % 2, 0}; }
            r -= NL * 4 * IT_W1;
            if (r < NL * 16 * IT_LW) { const int m = r / IT_LW; r -= m * IT_LW; const int l = m >> 4, mat = (m >> 3) & 1, hh = m & 7;
                return TrItem{ARG_IN(mat ? I_LWX : I_LWA) + ((size_t)l * 8 + hh) * 4096, (bf16*)(ws + WS_LWT) + (size_t)m * 4096, 64, 64, 0, r, 0}; }
            r -= NL * 16 * IT_LW;
            { const int m = r / IT_PW; r -= m * IT_PW; return TrItem{ARG_IN(I_PW) + (size_t)m * 16384, (bf16*)(ws + WS_PWT) + (size_t)m * 16384, 128, 128, r / 4, r % 4, 0}; }
        };
        constexpr int NIT0 = IT_BIG + NSMALL;
        if (gw < NIT0) { TrItem cur = dec0(gw); TrRegs rv = tr_load(cur, lane);
            for (int it = gw; it < NIT0; it += NGW) { TrItem nxt = cur; TrRegs rn = rv; const bool more = it + NGW < NIT0;
                if (more) { nxt = dec0(it + NGW); rn = tr_load(nxt, lane); }
                tr_finish(cur, rv, scr, lane); cur = nxt; rv = rn; } }
        for (int e = bx * 512 + tid; e < NL * 232 * 128; e += G * 512) { const int l = e / (232 * 128), rr = (e / 128) % 232, c8 = (e % 128) * 8;
            GST(*(u32x4*)(WIN + ((size_t)l * NPROJ + C_GC + 24 + rr) * D + c8) = (u32x4){0u, 0u, 0u, 0u}); }
        for (int m = gw; m < T; m += 2 * NGW) norm_rows<0>(ARG_IN(I_X), H, nullptr, nullptr, ARG_IN(I_N1G), XN, m, m + NGW, m + NGW < T, lane);
    }
    SEAM(0);

    unsigned long long tacc_ = 0ull, tbeg_ = 0ull; (void)tacc_; (void)tbeg_;
#define TBEG(id) do { if (PROBE_T_LO >= 0 && (id) == PROBE_T_LO) tbeg_ = __builtin_amdgcn_s_memrealtime(); } while (0)
#define TEND(id) do { if (PROBE_T_LO >= 0 && (id) + 1 == PROBE_T_HI) tacc_ += __builtin_amdgcn_s_memrealtime() - tbeg_; } while (0)
    for (int l = 0; l < NL; ++l) {
        const int pb = 1 + 9 * l;
#define OPQ_S(x) ({ int t_ = (x); asm volatile("" : "+s"(t_)); t_; })
#undef bx
#undef G
        TBEG(0);
        if (IN(pb + 0)) PHASE_REP(0) {
            const int bxo = OPQ_S(bx0), Go = OPQ_S(G0); (void)bxo; (void)Go;
#define bx bxo
#define G Go
            SchedDense S{XN, WIN + (size_t)l * NPROJ * D, D, D, T / 256, NPROJ / 256, G, bx, nullptr, 0u, nullptr, 16};
            EpiProj E{P1, Rr};
            pg8::gemm_phase<EpiProj, SchedDense, true>(ldsl, D, S, E);
        }
        SEAM(pb + 0); TEND(0);
#undef bx
#undef G
        TBEG(1);
        if (IN(pb + 1)) PHASE_REP(1) {
            const int bxo = OPQ_S(bx0), Go = OPQ_S(G0); (void)bxo; (void)Go;
#define bx bxo
#define G Go
            constexpr int U_LRU = NB * 64, U_GM = 128 * 2, U_CMP = 256;
            for (int u = bx; u < U_LRU + U_GM + U_CMP; u += G) {
                SUBT0(); const int ty_ = (u < U_CMP) ? 6 : (u < U_CMP + U_GM) ? 7 : 8; (void)ty_;
                if (u < U_CMP) cmp_unit2(ldsl, P1, KC, ARG_IN(I_PE) + (size_t)l * 2 * 2048, (const bf16*)(ws + WS_W1T) + (size_t)l * 4 * 64 * 2048, ARG_IN(I_CW2) + (size_t)l * 4 * 4096, u);
                else if (u < U_CMP + U_GM) gmlp_unit3(ldsl, P1, ARG_IN(I_GMNG) + l * 512, ARG_IN(I_GMWS) + (size_t)l * 4 * 16384, ARG_IN(I_GMB) + l * 512, u - U_CMP);
                else lru_unit2(ldsl, P1, XN, AGA, AGH, ARG_IN(I_CONVW) + l * 2048, ARG_IN(I_CONVB) + l * 512, (const bf16*)(ws + WS_LWT) + (size_t)(l * 2 + 0) * 8 * 4096, (const bf16*)(ws + WS_LWT) + (size_t)(l * 2 + 1) * 8 * 4096,
                               ARG_IN(I_LBA) + l * 512, ARG_IN(I_LBX) + l * 512, ARG_IN(I_LLAM) + l * 512, u - U_CMP - U_GM);
                SUBT1(ty_);
            }
            __syncthreads();
        }
        SEAM(pb + 1); TEND(1);
#undef bx
#undef G
        TBEG(2);
        if (IN(pb + 2)) PHASE_REP(2) {
            const int bxo = OPQ_S(bx0), Go = OPQ_S(G0); (void)bxo; (void)Go;
#define bx bxo
#define G Go
            constexpr int U_AT = NB * 2 * 64, U_PL = NB * 64 * 4, U_FX = NB * 64;
            const int U_CV = (l == 0 && NL > 1) ? (IT_BIG + 7) / 8 : 0;
            for (int u = bx; u < U_AT; u += G) {
                SUBT0(); const int ty_ = 1; (void)ty_;
                { const int k = u >> 3, bg = u & 7; const int ti = (u < 256) ? 63 - k : k - 32; attn_unit_mfma(ldsl, P1, KC, (bg << 6) | ti); }
                SUBT1(ty_);
            }
            {   const int NDYN = U_PL + U_FX + U_CV; unsigned* qctr = ctl + CW_Q + 64 * l; volatile LAS unsigned* qslot = (volatile LAS unsigned*)(ldsl + LDS_CTL + 192);
                unsigned nx = 0u; const bool ldr = (threadIdx.x == 0) && !is_dry();
                if (threadIdx.x == 0) nx = is_dry() ? (unsigned)NDYN : __hip_atomic_fetch_add(qctr, 1u, __ATOMIC_RELAXED, __HIP_MEMORY_SCOPE_AGENT);
                for (;;) {
                    __syncthreads(); if (threadIdx.x == 0) qslot[0] = nx; __syncthreads();
                    const int u = (int)qslot[0]; if (u >= NDYN) break;
                    if (ldr) nx = __hip_atomic_fetch_add(qctr, 1u, __ATOMIC_RELAXED, __HIP_MEMORY_SCOPE_AGENT);
                    SUBT0(); const int ty_ = (u < U_FX) ? 3 : (u < U_FX + U_PL) ? 2 : 4; (void)ty_;
                    if (u < U_FX) lrufix_unit2(ldsl, P1, XN, AGA, AGH, u);
                    else if (u < U_FX + U_PL) pool_unit2(ldsl, P1, (const bf16*)(ws + WS_PWT) + ((size_t)l * 4 + ((u - U_FX) & 3)) * 16384, ARG_IN(I_PS) + l * 512, u - U_FX);
                    else conv_unit(ldsf, u - U_FX - U_PL);
                    SUBT1(ty_);
                }
            }
            __syncthreads();
        }
        SEAM(pb + 2); TEND(2);
#undef bx
#undef G
        TBEG(3);
        if (IN(pb + 3)) PHASE_REP(3) {
            const int bxo = OPQ_S(bx0), Go = OPQ_S(G0); (void)bxo; (void)Go;
#define bx bxo
#define G Go
            SchedMerge S{P1, WB + (size_t)l * 4 * 1024 * 512, G, bx, ctl + CW_G2 + l * 4096};
            EpiMerge E{Rr, XN};
            pg8::gemm_phase<EpiMerge, SchedMerge, true>(ldsl, 512, S, E);
        }
        if (MK_SPLIT) { SEAM(pb + 3); } TEND(3);
#undef bx
#undef G
        TBEG(4);
        if (IN(pb + 4)) PHASE_REP(4) {
            const int bxo = OPQ_S(bx0), Go = OPQ_S(G0); (void)bxo; (void)Go;
#define bx bxo
#define G Go
            SchedDense S{XN, WOUT + (size_t)l * 1024 * 1024, D, D, T / 256, 4, G, bx, MK_SPLIT ? nullptr : ctl + CW_G2 + l * 4096, 32u, ctl, 0};
            EpiWout E{(l == 0) ? ARG_IN(I_X) : (const float*)H, H};
            pg8::gemm_phase<EpiWout, SchedDense, true>(ldsl, D, S, E);
        }
        SEAM(pb + 4); TEND(4);
#undef bx
#undef G
        TBEG(5);
        if (IN(pb + 5)) PHASE_REP(5) {
            const int bxo = OPQ_S(bx0), Go = OPQ_S(G0); (void)bxo; (void)Go;
#define bx bxo
#define G Go
            PHASE_IDS();
            {   SUBT0();
                float* scr = ldsf + wave * 4096;
                constexpr int IT_G = 16 * 16, IT_D = 8 * 32;
                auto dec1 = [&](int it) -> TrItem {
                    const int e = it / (2 * IT_G + IT_D); int r = it % (2 * IT_G + IT_D);
                    if (r < IT_G) return TrItem{ARG_IN(I_MG) + ((size_t)l * 16 + e) * 1024 * 512, WGU + (size_t)e * 1024 * 1024, 1024, 512, r / 16, r % 16, 2};
                    if (r < 2 * IT_G) { r -= IT_G; return TrItem{ARG_IN(I_MU) + ((size_t)l * 16 + e) * 1024 * 512, WGU + (size_t)e * 1024 * 1024, 1024, 512, r / 16, r % 16, 3}; }
                    r -= 2 * IT_G; return TrItem{ARG_IN(I_MD) + ((size_t)l * 16 + e) * 512 * 1024, WD + (size_t)e * 1024 * 512, 512, 1024, r / 32, r % 32, 0};
                };
                constexpr int NIT1 = 16 * (2 * IT_G + IT_D);
                if (gw < NIT1) { TrItem cur = dec1(gw); TrRegs rv = tr_load(cur, lane);
                    for (int it = gw; it < NIT1; it += NGW) { TrItem nxt = cur; TrRegs rn = rv; const bool more = it + NGW < NIT1;
                        if (more) { nxt = dec1(it + NGW); rn = tr_load(nxt, lane); }
                        tr_finish(cur, rv, scr, lane); cur = nxt; rv = rn; } }
                SUBT1(4);
            }
            SUBT0();
            __syncthreads();
            for (int k = tid; k < 1024; k += 512) { const f32x4 wg = *(const f32x4*)(ARG_IN(I_RWG) + (size_t)l * 4096 + k * 4); const float* we = ARG_IN(I_RWE) + (size_t)l * 16384 + k * 16;
                const f32x4 e0 = *(const f32x4*)we, e1 = *(const f32x4*)(we + 4), e2 = *(const f32x4*)(we + 8), e3 = *(const f32x4*)(we + 12);
                ldsf[0 * 1024 + k] = wg.x; ldsf[1 * 1024 + k] = wg.y; ldsf[2 * 1024 + k] = wg.z; ldsf[3 * 1024 + k] = wg.w;
                ldsf[4 * 1024 + k] = e0.x; ldsf[5 * 1024 + k] = e0.y; ldsf[6 * 1024 + k] = e0.z; ldsf[7 * 1024 + k] = e0.w; ldsf[8 * 1024 + k] = e1.x; ldsf[9 * 1024 + k] = e1.y; ldsf[10 * 1024 + k] = e1.z; ldsf[11 * 1024 + k] = e1.w;
                ldsf[12 * 1024 + k] = e2.x; ldsf[13 * 1024 + k] = e2.y; ldsf[14 * 1024 + k] = e2.z; ldsf[15 * 1024 + k] = e2.w; ldsf[16 * 1024 + k] = e3.x; ldsf[17 * 1024 + k] = e3.y; ldsf[18 * 1024 + k] = e3.z; ldsf[19 * 1024 + k] = e3.w; }
            __syncthreads();
            const float* g2 = ARG_IN(I_N2G) + l * D; const float* bg = ARG_IN(I_RBG) + l * 4; const float* be = ARG_IN(I_RBE) + l * 16;
            unsigned* cnt = ctl + CW_CNT + 64 * l;
            LAS unsigned* hist = (LAS unsigned*)(ldsl + 81920); LAS unsigned* baseL = hist + 16; LAS unsigned* rinfo = hist + 32;
            for (int ck = bx; ck < T / 64; ck += G) {
              if (tid < 16) hist[tid] = 0u;
              __syncthreads();
              f32x4 vnx[2][4];
#pragma unroll
              for (int rr = 0; rr < 2; ++rr) { const float* hr0 = H + (size_t)(ck * 64 + wave * 8 + rr) * D;
#pragma unroll
                for (int jj = 0; jj < 4; ++jj) vnx[rr][jj] = *(const f32x4*)(hr0 + 4 * lane + 256 * jj); }
#pragma unroll 1
              for (int ri = 0; ri < 8; ri += 2) { const int rl = wave * 8 + ri; const int m = ck * 64 + rl;
                f32x4 v[2][4];
#pragma unroll
                for (int rr = 0; rr < 2; ++rr)
#pragma unroll
                    for (int jj = 0; jj < 4; ++jj) v[rr][jj] = vnx[rr][jj];
                if (ri + 2 < 8) {
#pragma unroll
                    for (int rr = 0; rr < 2; ++rr) { const float* hr1 = H + (size_t)(m + 2 + rr) * D;
#pragma unroll
                        for (int jj = 0; jj < 4; ++jj) vnx[rr][jj] = *(const f32x4*)(hr1 + 4 * lane + 256 * jj); } }
#pragma unroll
                for (int rr = 0; rr < 2; ++rr) { float ss = 0.f;
#pragma unroll
                    for (int jj = 0; jj < 4; ++jj) ss += (v[rr][jj].x * v[rr][jj].x + v[rr][jj].y * v[rr][jj].y) + (v[rr][jj].z * v[rr][jj].z + v[rr][jj].w * v[rr][jj].w);
                    const float rstd = rsqrtf(wave_sum(ss) * (1.f / D) + EPS);
#pragma unroll
                    for (int jj = 0; jj < 4; ++jj) { const f32x4 gg = *(const f32x4*)(g2 + 4 * lane + 256 * jj); v[rr][jj].x *= rstd * gg.x; v[rr][jj].y *= rstd * gg.y; v[rr][jj].z *= rstd * gg.z; v[rr][jj].w *= rstd * gg.w;
                        u32x2 o; o.x = pk2(v[rr][jj].x, v[rr][jj].y); o.y = pk2(v[rr][jj].z, v[rr][jj].w); GST(*(u32x2*)(XN + (size_t)(m + rr) * D + 4 * lane + 256 * jj) = o); } }
                float lg[2][20];
#pragma unroll
                for (int o = 0; o < 20; ++o) { float a0 = 0.f, a1 = 0.f;
#pragma unroll
                    for (int jj = 0; jj < 4; ++jj) { const f32x4 wv = *(const f32x4*)(ldsf + o * 1024 + 4 * lane + 256 * jj);
                        a0 += v[0][jj].x * wv.x + v[0][jj].y * wv.y + v[0][jj].z * wv.z + v[0][jj].w * wv.w; a1 += v[1][jj].x * wv.x + v[1][jj].y * wv.y + v[1][jj].z * wv.z + v[1][jj].w * wv.w; }
                    lg[0][o] = wave_sum(a0); lg[1][o] = wave_sum(a1); if ((o & 3) == 3) __builtin_amdgcn_sched_barrier(0); }
#pragma unroll
                for (int rr = 0; rr < 2; ++rr) {
                float gl[4]; int grp = 0; float gmx;
#pragma unroll
                for (int k = 0; k < 4; ++k) gl[k] = lg[rr][k] + bg[k];
                gmx = gl[0];
#pragma unroll
                for (int k = 1; k < 4; ++k) if (gl[k] > gmx) { gmx = gl[k]; grp = k; }
                float den = 0.f;
#pragma unroll
                for (int k = 0; k < 4; ++k) den += __expf(gl[k] - gmx);
                const float grpw = 1.f / den;
                float el[4];
#pragma unroll
                for (int k = 0; k < 4; ++k) { float vsel = 0.f;
#pragma unroll
                    for (int gg = 0; gg < 4; ++gg) vsel = (grp == gg) ? (lg[rr][4 + gg * 4 + k] + be[gg * 4 + k]) : vsel;
                    el[k] = vsel; }
                int i1 = 0; float m1 = el[0];
#pragma unroll
                for (int k = 1; k < 4; ++k) if (el[k] > m1) { m1 = el[k]; i1 = k; }
                int i2 = -1; float m2 = 0.f;
#pragma unroll
                for (int k = 0; k < 4; ++k) if (k != i1 && (i2 < 0 || el[k] > m2)) { m2 = el[k]; i2 = k; }
                const float ex = __expf(m2 - m1); const float w1 = grpw / (1.f + ex), w2 = grpw * ex / (1.f + ex);
                if (lane == 0) {
                    const int e1 = grp * 4 + i1, e2 = grp * 4 + i2; const int rq = rl + rr;
                    const unsigned p1 = atomicAdd((unsigned*)&hist[e1], 1u), p2 = atomicAdd((unsigned*)&hist[e2], 1u);
                    rinfo[rq * 4 + 0] = (unsigned)e1 | ((unsigned)e2 << 8); rinfo[rq * 4 + 1] = p1 | (p2 << 16); rinfo[rq * 4 + 2] = __builtin_bit_cast(unsigned, w1); rinfo[rq * 4 + 3] = __builtin_bit_cast(unsigned, w2);
                }
                }
              }
              __syncthreads();
              if (tid < 16) { const unsigned hc = hist[tid]; baseL[tid] = (hc && !is_dry()) ? atomicAdd(&cnt[tid], hc) : 0u; }
              __syncthreads();
              if (tid < 64 && !is_dry()) { const unsigned ee = rinfo[tid * 4 + 0], pp = rinfo[tid * 4 + 1]; const unsigned e1 = ee & 255u, e2 = ee >> 8; const unsigned m = (unsigned)(ck * 64 + tid);
                  const size_t q1 = (size_t)e1 * T + baseL[e1] + (pp & 0xffffu), q2 = (size_t)e2 * T + baseL[e2] + (pp >> 16);
                  LIST[q1] = m; LISTW[q1] = __builtin_bit_cast(float, rinfo[tid * 4 + 2]); LIST[q2] = m | (1u << 14); LISTW[q2] = __builtin_bit_cast(float, rinfo[tid * 4 + 3]); }
              __syncthreads();
            }
            SUBT1(5);
        }
        SEAM(pb + 5); TEND(5);
#undef bx
#undef G
        TBEG(6);
        if (IN(pb + 6) || IN(pb + 7)) {
            __syncthreads();
            if (threadIdx.x == 0) { LAS int* tw = (LAS int*)(ldsl + LDS_MOE); int acc = 0;
                for (int e = 0; e < 16; ++e) { const int c = (int)__hip_atomic_load(ctl + CW_CNT + 64 * l + e, __ATOMIC_RELAXED, __HIP_MEMORY_SCOPE_AGENT); tw[e] = acc; tw[32 + e] = c; acc += (c + 255) >> 8; }
                tw[16] = acc; }
            __syncthreads();
        }
        if (IN(pb + 6)) PHASE_REP(6) {
            const int bxo = OPQ_S(bx0), Go = OPQ_S(G0); (void)bxo; (void)Go;
#define bx bxo
#define G Go
            SchedMoe S{XN, WGU, LIST, D, D, 1024, G, bx, true, ctl + CW_E1 + l * 16384, ctl};
            EpiGateUp E{HID, LISTW};
            pg8::gemm_phase<EpiGateUp, SchedMoe, true>(ldsl, D, S, E);
        }
        if (MK_SPLIT) { SEAM(pb + 6); } TEND(6);
#undef bx
#undef G
        TBEG(7);
        if (IN(pb + 7)) PHASE_REP(7) {
            const int bxo = OPQ_S(bx0), Go = OPQ_S(G0); (void)bxo; (void)Go;
#define bx bxo
#define G Go
            SchedMoe S{HID, WD, LIST, 512, 512, 1024, G, bx, false, ctl + CW_E1 + l * 16384, ctl};
            EpiDown E{Y, LIST};
            pg8::gemm_phase<EpiDown, SchedMoe, true>(ldsl, 512, S, E);
        }
        SEAM(pb + 7); TEND(7);
#undef bx
#undef G
        TBEG(8);
        if (IN(pb + 8)) PHASE_REP(8) {
            const int bxo = OPQ_S(bx0), Go = OPQ_S(G0); (void)bxo; (void)Go;
#define bx bxo
#define G Go
            PHASE_IDS();
            if (l + 1 < NL) { for (int m = gw; m < T; m += 2 * NGW) norm_rows<1>(nullptr, H, Y, Y + (size_t)T * D, ARG_IN(I_N1G) + (l + 1) * D, XN, m, m + NGW, m + NGW < T, lane); }
            else { for (int m = gw; m < T; m += 2 * NGW) norm_rows<2>(nullptr, H, Y, Y + (size_t)T * D, ARG_IN(I_FNG), nullptr, m, m + NGW, m + NGW < T, lane); }
        }
        if (l + 1 < NL) SEAM(pb + 8);
        TEND(8);
    }
#undef bx
#undef G
#ifdef PROBE_FINE
    tacc_ += *(volatile LAS unsigned long long*)(ldsl + LDS_CTL + 128);
#endif
    if (PROBE_T_LO >= 0 && bx == PROBE_BLK) { const unsigned long long tgt = __builtin_amdgcn_s_memrealtime() + PROBE_T_MULT * tacc_; while (__builtin_amdgcn_s_memrealtime() < tgt) __builtin_amdgcn_s_sleep(16); }
#undef IN
#undef SEAM
#undef ws
#undef ctl
#undef H
#undef XN
#undef P1
#undef Rr
#undef WIN
#undef WB
#undef WOUT
#undef WGU
#undef WD
#undef HID
#undef Y
#undef KC
#undef AGA
#undef AGH
#undef LIST
#undef LISTW
}

extern "C" void kernel_launch(void* const* d_in, const int* in_sizes, int n_in, void* d_out, int out_size, void* d_ws, size_t ws_size, hipStream_t stream) {
    static int grid = 0;
    if (grid == 0) {
        if (n_in != 29 || in_sizes[0] != T * D || out_size != T * D || ws_size < WS_END) { fprintf(stderr, "kernel_launch: unexpected shapes / workspace (%d inputs, ws %zu < %zu); nothing launched\n", n_in, ws_size, (size_t)WS_END); grid = -1; return; }
        int dev = 0, cus = 0;
        if (hipGetDevice(&dev) != hipSuccess || hipDeviceGetAttribute(&cus, hipDeviceAttributeMultiprocessorCount, dev) != hipSuccess) { grid = -1; return; }
        if (hipFuncSetAttribute((const void*)fwd_kernel, hipFuncAttributeMaxDynamicSharedMemorySize, LDS_BYTES) != hipSuccess) { fprintf(stderr, "kernel_launch: hipFuncSetAttribute failed\n"); grid = -1; return; }
        int per_cu = 0;
        if (hipOccupancyMaxActiveBlocksPerMultiprocessor(&per_cu, (const void*)fwd_kernel, 512, LDS_BYTES) != hipSuccess || per_cu < 1) { fprintf(stderr, "kernel_launch: occupancy query says %d\n", per_cu); }
        (void)hipGetLastError();
        grid = cus;
    }
    if (grid < 0) return;
    if (hipMemsetAsync((char*)d_ws + WS_CTL, 0, CTL_ZERO_BYTES, stream) != hipSuccess) return;
    Args a{};
    for (int i = 0; i < 29; ++i) a.in[i] = (const float*)d_in[i];
    a.out = (float*)d_out; a.ws = (unsigned char*)d_ws;
#if MK_SPLIT
    for (int p = 0; p < NPH; ++p) { a.ph_lo = p; a.ph_hi = p + 1; hipLaunchKernelGGL(fwd_kernel, dim3(grid), dim3(512), LDS_BYTES, stream, a); }
#else
    a.ph_lo = 0; a.ph_hi = NPH;
    hipLaunchKernelGGL(fwd_kernel, dim3(grid), dim3(512), LDS_BYTES, stream, a);
#endif
}
```

```cpp
#include <hip/hip_runtime.h>
#include <cstdio>
#include <cstdint>

#define GAS __attribute__((address_space(1)))
#define LAS __attribute__((address_space(3)))
typedef unsigned short bf16;
typedef unsigned u32x4 __attribute__((ext_vector_type(4)));
typedef unsigned u32x2 __attribute__((ext_vector_type(2)));
typedef float f32x4 __attribute__((ext_vector_type(4)));
typedef float f32x2 __attribute__((ext_vector_type(2)));
typedef short bf16x8 __attribute__((ext_vector_type(8)));
typedef unsigned long long u64;

#ifndef MK_SPLIT
#define MK_SPLIT 0
#endif

constexpr int NB = 4, SEQ = 4096, T = NB * SEQ, D = 1024, MIX = 512, NL = 2;
constexpr int NIN = 7960, NPROJ = 8192, P1W = 3904;
constexpr int C_U = 0, C_V = 512, C_GB = 1024, C_RB = 1536, C_Q = 2048, C_KV = 2560, C_XD = 3328, C_GC = 3840;
constexpr int SRC_GC = 3328, SRC_XD = 3352, SRC_MG = 3864;
constexpr float EPS = 1e-6f;
constexpr int NEXP = 16, DEXP = 512;
constexpr int HID_ROWS = 2 * T + 4096;

constexpr size_t MiB = 1u << 20;
constexpr size_t WS_CTL = 0, CTL_ZERO_BYTES = 1 * MiB;
constexpr size_t WS_KC = 1 * MiB;
constexpr size_t WS_LRUA = 2 * MiB;
constexpr size_t WS_LRUH = 2 * MiB + 512 * 1024;
constexpr size_t WS_LIST = 3 * MiB;
constexpr size_t WS_LISTW = 4 * MiB;
constexpr size_t WS_W1T = 5 * MiB;
constexpr size_t WS_LWT = 7 * MiB;
constexpr size_t WS_PWT = 7 * MiB + 256 * 1024;
constexpr size_t WS_WIN = 8 * MiB;
constexpr size_t WS_WB = 40 * MiB;
constexpr size_t WS_WOUT = 48 * MiB;
constexpr size_t WS_XN = 52 * MiB;
constexpr size_t WS_P1 = 84 * MiB;
constexpr size_t WS_R = 206 * MiB;
constexpr size_t WS_WGU = 84 * MiB;
constexpr size_t WS_WD = 116 * MiB;
constexpr size_t WS_HID = 132 * MiB;
constexpr size_t WS_Y = 168 * MiB;
constexpr size_t WS_END = 334 * MiB;
constexpr size_t OUT_XN8 = 32 * MiB, OUT_WG8 = 48 * MiB;
static_assert(WS_HID + (size_t)HID_ROWS * 512 * 2 <= WS_Y && WS_Y + (size_t)2 * T * 1024 * 2 <= WS_END && WS_P1 + (size_t)T * P1W * 2 <= WS_R && WS_R + (size_t)4 * T * 1024 * 2 <= WS_END, "ws map");

constexpr int CW_BAR = 4096;
constexpr int CW_CNT = 8192;
constexpr int CW_E1 = 16384;
constexpr int CW_G2 = 49152;
constexpr int CW_Q = 8448;

__device__ __forceinline__ unsigned f2bf(float f) { unsigned u = __builtin_bit_cast(unsigned, f); return (u + 0x7fffu + ((u >> 16) & 1u)) >> 16; }
typedef __bf16 bf16x2_hw __attribute__((ext_vector_type(2)));
__device__ __forceinline__ unsigned pk2(float lo, float hi) { f32x2 v = {lo, hi}; bf16x2_hw b = __builtin_convertvector(v, bf16x2_hw); return __builtin_bit_cast(unsigned, b); }
__device__ __forceinline__ float bflo(unsigned u) { return __builtin_bit_cast(float, u << 16); }
__device__ __forceinline__ float bfhi(unsigned u) { return __builtin_bit_cast(float, u & 0xffff0000u); }
__device__ __forceinline__ float bf2f(bf16 h) { return __builtin_bit_cast(float, (unsigned)h << 16); }
__device__ __forceinline__ float sigmoidf_(float x) { return __builtin_amdgcn_rcpf(1.0f + __builtin_amdgcn_exp2f(-1.4426950408889634f * x)); }
__device__ __forceinline__ float gelu_tanh(float x) { const float z = 1.5957691216057308f * (x + 0.044715f * x * x * x); return x * sigmoidf_(z); }
__device__ __forceinline__ float dpp_add_(float v, const int ctrl, const int row_mask) {
    return v;
}
#define DPP_ADD(v, ctrl, rmask) ((v) + __builtin_bit_cast(float, __builtin_amdgcn_update_dpp(0, __builtin_bit_cast(int, (v)), (ctrl), (rmask), 0xf, false)))
__device__ __forceinline__ float wave_sum(float v) {
    v = DPP_ADD(v, 0xB1, 0xf);
    v = DPP_ADD(v, 0x4E, 0xf);
    v = DPP_ADD(v, 0x141, 0xf);
    v = DPP_ADD(v, 0x140, 0xf);
    v = DPP_ADD(v, 0x142, 0xa);
    v = DPP_ADD(v, 0x143, 0xc);
    return __builtin_bit_cast(float, __builtin_amdgcn_readlane(__builtin_bit_cast(int, v), 63));
}
__device__ __forceinline__ float wave_sum63(float v) {
    v = DPP_ADD(v, 0xB1, 0xf); v = DPP_ADD(v, 0x4E, 0xf); v = DPP_ADD(v, 0x141, 0xf); v = DPP_ADD(v, 0x140, 0xf); v = DPP_ADD(v, 0x142, 0xa); v = DPP_ADD(v, 0x143, 0xc);
    return v;
}
__device__ __forceinline__ void wave_sum63x4(float& a, float& b, float& c, float& d) {
#define WS4_STEP(ctl_) "v_add_f32_dpp %0, %0, %0 " ctl_ "\n v_add_f32_dpp %1, %1, %1 " ctl_ "\n v_add_f32_dpp %2, %2, %2 " ctl_ "\n v_add_f32_dpp %3, %3, %3 " ctl_ "\n"
    asm("s_nop 1\n"
        WS4_STEP("quad_perm:[1,0,3,2] row_mask:0xf bank_mask:0xf bound_ctrl:1")
        WS4_STEP("quad_perm:[2,3,0,1] row_mask:0xf bank_mask:0xf bound_ctrl:1")
        WS4_STEP("row_half_mirror row_mask:0xf bank_mask:0xf bound_ctrl:1")
        WS4_STEP("row_mirror row_mask:0xf bank_mask:0xf bound_ctrl:1")
        WS4_STEP("row_bcast:15 row_mask:0xa bank_mask:0xf")
        WS4_STEP("row_bcast:31 row_mask:0xc bank_mask:0xf")
        : "+v"(a), "+v"(b), "+v"(c), "+v"(d));
#undef WS4_STEP
}
__device__ __forceinline__ u64 mask_lo(int n) { return n >= 64 ? ~0ull : (n <= 0 ? 0ull : ((1ull << n) - 1ull)); }
#define LDS_WAIT() asm volatile("s_waitcnt lgkmcnt(0)" ::: "memory")
#ifndef PROBE_PH
#define PROBE_PH -1
#endif
#ifndef PROBE_T_LO
#define PROBE_T_LO -1
#define PROBE_T_HI -1
#endif
#define PROBE_T_MULT 4
#ifndef ABL
#define ABL 0
#endif
#define ABL_ON(bit) ((ABL & (bit)) && is_dry())
#ifndef PROBE_BLK
#define PROBE_BLK 0
#endif
#ifdef PROBE_SUB
#define SUBT0() const unsigned long long ts0_ = __builtin_amdgcn_s_memrealtime()
#define SUBT1(ty) do { __syncthreads(); if ((ty) == PROBE_SUB) tacc_ += __builtin_amdgcn_s_memrealtime() - ts0_; } while (0)
#else
#define SUBT0() do {} while (0)
#define SUBT1(ty) do {} while (0)
#endif

constexpr int LDS_BYTES = 147456;
constexpr int LDS_CTL = 146432;
constexpr int LDS_MOE = LDS_CTL + 256;
__device__ __forceinline__ bool is_dry() {
#if PROBE_PH >= 0
    extern __shared__ __attribute__((aligned(16))) unsigned char lds_raw_[]; return ((volatile LAS int*)((LAS unsigned char*)lds_raw_ + LDS_CTL + 64))[0] != 0;
#else
    return false;
#endif
}
#define GST(...) do { if (!is_dry()) { __VA_ARGS__; } } while (0)
#ifdef PROBE_FINE
#define FT0(id) unsigned long long ft0_##id = ((id) == PROBE_FINE) ? __builtin_amdgcn_s_memrealtime() : 0ull
#define FT1(id) do { if ((id) == PROBE_FINE && threadIdx.x == 0) { extern __shared__ __attribute__((aligned(16))) unsigned char lds_raw_f[]; volatile LAS unsigned long long* a_ = (volatile LAS unsigned long long*)((LAS unsigned char*)lds_raw_f + LDS_CTL + 128); *a_ = *a_ + (__builtin_amdgcn_s_memrealtime() - ft0_##id); } } while (0)
#else
#define FT0(id) do {} while (0)
#define FT1(id) do {} while (0)
#endif
__device__ __forceinline__ int opaque_tid() { int t = (int)threadIdx.x; asm volatile("" : "+v"(t)); return t; }

namespace pg8 {
constexpr int BM = 256, BK = 64, HALF = 128, HTB = HALF * BK * 2, NXCD = 8, WGM = 8;
__host__ __device__ __forceinline__ int lds_byte(int r, int c) { const int st = (r >> 4) * 2 + (c >> 5), rr = r & 15, cc = c & 31, ob = rr * 64 + cc * 2; return st * 1024 + (ob ^ (((ob >> 9) & 1) << 5)); }
__host__ __device__ __forceinline__ void stage_rc(int b, int& R, int& C) { const int st = b / 1024, sb = b % 1024, swz = sb ^ (((sb >> 9) & 1) << 5); R = (st >> 1) * 16 + swz / 64; C = (st & 1) * 32 + (swz % 64) / 2; }
__host__ __device__ __forceinline__ int perm32(int rho) { const int n = rho >> 4, i = rho & 15; return 8 * (i >> 2) + 4 * n + (i & 3); }

struct Unit { const char* A; const char* B; int pm, pn, sub, e; };

__device__ __forceinline__ bool static_tile(int i, int G, int c, int nM, int nN, int& pm, int& pn) {
    const int nwg = nM * nN; const long L = (long)i * G + c; if (L >= nwg) return false;
    int wgid = (int)L; { const int q = nwg / NXCD, r = nwg % NXCD, xcd = wgid % NXCD, off = wgid / NXCD; wgid = (xcd < r ? xcd * (q + 1) : r * (q + 1) + (xcd - r) * q) + off; }
    const int nig = WGM * nN, gid = wgid / nig, fm = gid * WGM, gsz = (nM - fm) < WGM ? (nM - fm) : WGM;
    pm = fm + ((wgid % nig) % gsz); pn = (wgid % nig) / gsz; return true;
}

template <class Epi, class Sched, bool ALIGN_EPI, bool FP8 = false>
__device__ __forceinline__ void gemm_phase(LAS unsigned char* lds, const int K, const Sched& S, const Epi& E) {
    const int tid = opaque_tid(), wid = __builtin_amdgcn_readfirstlane(tid >> 6), lane = tid & 63, wr = wid >> 2, wc = wid & 3, fr = lane & 15, fq = lane >> 4;
    const int nt = K / BK;
    unsigned voffB[2];
#pragma unroll
    for (int i = 0; i < 2; ++i) { int R, C; stage_rc(tid * 16 + i * 8192, R, C); const int Rb = (R & ~31) + perm32(R & 31); voffB[i] = (unsigned)(Rb * K + C) * 2u; }
    const size_t kstep = (size_t)(BK * 2);
    const size_t hstepB = (size_t)HALF * K * 2;
    const unsigned ldsw = (unsigned)wid * 1024u;
    const int aoff = lds_byte(wr * 64 + fr, fq * 8), boff = lds_byte(wc * 32 + fr, fq * 8);
#define PG8_SA(b, h) (((b) * 2 + (h)) * HTB)
#define PG8_SB(b, h) ((4 + (b) * 2 + (h)) * HTB)
#define PG8_STAGE(bufoff, gbase, voff) do { _Pragma("unroll") for (int _i = 0; _i < 2; ++_i) \
        __builtin_amdgcn_global_load_lds((const unsigned*)((const char*)(gbase) + (voff)[_i]), (LAS unsigned*)(lds + (bufoff) + ldsw + _i * 8192), 16, 0, 0); } while (0)
#define PG8_LDA(dst, b, h) do { _Pragma("unroll") for (int m = 0; m < 4; ++m) { if constexpr (FP8) { const i32x4_ lo_ = *(const LAS i32x4_*)(lds + PG8_SA(b, h) + aoff + m * 2048), hi_ = *(const LAS i32x4_*)(lds + PG8_SA(b, h) + aoff + m * 2048 + 1024); \
        dst##8[m] = __builtin_shufflevector(lo_, hi_, 0, 1, 2, 3, 4, 5, 6, 7); } else { _Pragma("unroll") for (int k = 0; k < 2; ++k) dst[m][k] = *(const LAS bf16x8*)(lds + PG8_SA(b, h) + aoff + m * 2048 + k * 1024); } } } while (0)
#define PG8_LDB(dst, b, h) do { _Pragma("unroll") for (int n = 0; n < 2; ++n) { if constexpr (FP8) { const i32x4_ lo_ = *(const LAS i32x4_*)(lds + PG8_SB(b, h) + boff + n * 2048), hi_ = *(const LAS i32x4_*)(lds + PG8_SB(b, h) + boff + n * 2048 + 1024); \
        dst##8[n] = __builtin_shufflevector(lo_, hi_, 0, 1, 2, 3, 4, 5, 6, 7); } else { _Pragma("unroll") for (int k = 0; k < 2; ++k) dst[n][k] = *(const LAS bf16x8*)(lds + PG8_SB(b, h) + boff + n * 2048 + k * 1024); } } } while (0)
#define PG8_MMA(ai, bj, At, Bt) do { __builtin_amdgcn_s_setprio(1); _Pragma("unroll") for (int m = 0; m < 4; ++m) _Pragma("unroll") for (int n = 0; n < 2; ++n) { \
        if constexpr (FP8) asm volatile("v_mfma_f32_16x16x128_f8f6f4 %0, %1, %2, %0" : "+v"(acc[ai][bj][m][n]) : "v"(Bt##8[n]), "v"(At##8[m])); \
        else { _Pragma("unroll") for (int k = 0; k < 2; ++k) acc[ai][bj][m][n] = __builtin_amdgcn_mfma_f32_16x16x32_bf16(Bt[n][k], At[m][k], acc[ai][bj][m][n], 0, 0, 0); } } \
        __builtin_amdgcn_s_setprio(0); } while (0)
#define PG8_WAIT_V(n) asm volatile("s_waitcnt vmcnt(" #n ")" ::: "memory")
#define PG8_WAIT_L(n) asm volatile("s_waitcnt lgkmcnt(" #n ")" ::: "memory")
#define PG8_BAR __builtin_amdgcn_s_barrier()
#define PG8_SCHED __builtin_amdgcn_sched_barrier(0)
#define PG8_ZERO() do { _Pragma("unroll") for (int a = 0; a < 2; ++a) _Pragma("unroll") for (int b = 0; b < 2; ++b) _Pragma("unroll") for (int m = 0; m < 4; ++m) _Pragma("unroll") for (int n = 0; n < 2; ++n) acc[a][b][m][n] = (f32x4){0.f, 0.f, 0.f, 0.f}; } while (0)
    Unit cur, nxt; int ui = 0;
    if (!S.next(0, cur)) return;
    f32x4 acc[2][2][4][2];
    PG8_ZERO();
    typedef int i32x4_ __attribute__((ext_vector_type(4))); typedef int i32x8_ __attribute__((ext_vector_type(8)));
    bf16x8 At[4][2], B0[2][2], B1[2][2]; i32x8_ At8[4], B08[2], B18[2]; (void)At; (void)B0; (void)B1; (void)At8; (void)B08; (void)B18;
    unsigned voA[2][2], voN[2][2];
    S.a_off(cur, voA);
    const char* cA = cur.A; const char* cB = cur.B;
    S.a_ready(cur);
    PG8_STAGE(PG8_SB(0, 0), cB, voffB); PG8_STAGE(PG8_SB(0, 1), cB + hstepB, voffB); PG8_STAGE(PG8_SA(0, 0), cA, voA[0]); PG8_STAGE(PG8_SA(0, 1), cA, voA[1]);
    if (wr == 1) PG8_BAR;
    PG8_WAIT_V(2); PG8_BAR;
    PG8_STAGE(PG8_SB(1, 0), cB + kstep, voffB); PG8_STAGE(PG8_SA(1, 0), cA + kstep, voA[0]); PG8_STAGE(PG8_SB(1, 1), cB + hstepB + kstep, voffB);
    PG8_WAIT_V(6); PG8_BAR;
    for (;;) {
        const bool has_next = S.next(ui + 1, nxt);
        if (has_next) S.a_ready(nxt);
        const char* nA = has_next ? nxt.A : cA; const char* nB = has_next ? nxt.B : cB;
        if (has_next) S.a_off(nxt, voN); else { voN[0][0] = voA[0][0]; voN[0][1] = voA[0][1]; voN[1][0] = voA[1][0]; voN[1][1] = voA[1][1]; }
        for (int t = 0; t < nt; t += 2) {
            const bool last = (t == nt - 2);
            const char* a1 = cA + (size_t)(t + 1) * kstep;
            const char* a2 = last ? nA : cA + (size_t)(t + 2) * kstep; const char* b2 = last ? nB : cB + (size_t)(t + 2) * kstep;
            const char* a3 = a2 + kstep; const char* b3 = b2 + kstep;
            PG8_LDB(B0, 0, 0); PG8_LDB(B1, 0, 1); PG8_SCHED; PG8_LDA(At, 0, 0); PG8_STAGE(PG8_SA(1, 1), a1, voA[1]);
            PG8_WAIT_V(8); PG8_WAIT_L(0); PG8_BAR; PG8_MMA(0, 0, At, B0); PG8_MMA(0, 1, At, B1); PG8_BAR; PG8_SCHED;
            if (last) { voA[0][0] = voN[0][0]; voA[0][1] = voN[0][1]; voA[1][0] = voN[1][0]; voA[1][1] = voN[1][1]; }
            PG8_LDA(At, 0, 1); PG8_STAGE(PG8_SB(0, 0), b2, voffB); PG8_STAGE(PG8_SB(0, 1), b2 + hstepB, voffB); PG8_STAGE(PG8_SA(0, 0), a2, voA[0]);
            PG8_WAIT_V(8); PG8_WAIT_L(0); PG8_BAR; PG8_MMA(1, 0, At, B0); PG8_MMA(1, 1, At, B1); PG8_BAR; PG8_SCHED;
            PG8_LDB(B0, 1, 0); PG8_LDB(B1, 1, 1); PG8_SCHED; PG8_LDA(At, 1, 0); PG8_STAGE(PG8_SA(0, 1), a2, voA[1]);
            PG8_WAIT_V(8); PG8_WAIT_L(0); PG8_BAR; PG8_MMA(0, 0, At, B0); PG8_MMA(0, 1, At, B1); PG8_BAR; PG8_SCHED;
            PG8_LDA(At, 1, 1); PG8_STAGE(PG8_SB(1, 0), b3, voffB); PG8_STAGE(PG8_SB(1, 1), b3 + hstepB, voffB); PG8_STAGE(PG8_SA(1, 0), a3, voA[0]);
            PG8_WAIT_V(8); PG8_WAIT_L(0); PG8_BAR; PG8_MMA(1, 0, At, B0); PG8_MMA(1, 1, At, B1); PG8_BAR; PG8_SCHED;
        }
        if constexpr (ALIGN_EPI) { if (wr == 0) PG8_BAR; }
        if constexpr (FP8) asm volatile("s_nop 15\n\ts_nop 15" ::: "memory");
        int tz = lane; asm volatile("" : "+v"(tz));
        const bool z = E(acc, cur, wr, wc, tz & 15, tz >> 4);
        S.done(cur);
        if (!has_next) break;
        if (z) PG8_ZERO();
        cur = nxt; cA = nA; cB = nB; ++ui;
        if constexpr (ALIGN_EPI) { if (wr == 1) PG8_BAR; }
    }
    PG8_WAIT_V(0);
    if constexpr (!ALIGN_EPI) { if (wr == 0) PG8_BAR; }
    PG8_BAR;
#undef PG8_SA
#undef PG8_SB
#undef PG8_STAGE
#undef PG8_LDA
#undef PG8_LDB
#undef PG8_MMA
#undef PG8_WAIT_V
#undef PG8_WAIT_L
#undef PG8_BAR
#undef PG8_SCHED
#undef PG8_ZERO
}
}

#define XB_TMO      128
#define XB_XCNT(j)  (256  + 64 * (j))
#define XB_XSUB(j)  (1280 + 64 * (j))
#define XB_XGEN(j)  (2304 + 64 * (j))
#define XB_TOP      3328
#define XB_TOPGEN   3392
#define XCD_BAR_WORDS 3456
#define XB_SPIN_CAP (1u << 23)
__device__ __forceinline__ unsigned xb_ld(unsigned* p)              { return __hip_atomic_load(p, __ATOMIC_RELAXED, __HIP_MEMORY_SCOPE_AGENT); }
__device__ __forceinline__ unsigned xb_add(unsigned* p, unsigned v) { return __hip_atomic_fetch_add(p, v, __ATOMIC_RELAXED, __HIP_MEMORY_SCOPE_AGENT); }
__device__ __forceinline__ unsigned xb_xcc_id() { return (unsigned)__builtin_amdgcn_s_getreg((3 << 11) | 20) & 0xFu; }
#define XB_SPIN(cond, bar) do { unsigned _sp = 0; while (cond) { __builtin_amdgcn_s_sleep(1); \
    if ((++_sp & 255u) == 0u) { if (xb_ld(&(bar)[XB_TMO])) break; if (_sp > XB_SPIN_CAP) { atomicAdd(&(bar)[XB_TMO], 1u); break; } } } } while (0)
struct XcdBarrier { unsigned* bar; unsigned x; volatile LAS unsigned* st; };
__device__ __forceinline__ XcdBarrier xcd_barrier_post(unsigned* bar, volatile LAS unsigned* st) {
    XcdBarrier b; b.bar = bar; b.x = xb_xcc_id(); b.st = st;
    if (threadIdx.x == 0) (void)xb_add(&bar[XB_XCNT(b.x)], 1u);
    return b;
}
__device__ __forceinline__ void xcd_barrier_complete(unsigned* bar, unsigned x, unsigned& nloc, unsigned& nx) {
    const unsigned G = gridDim.x * gridDim.y * gridDim.z;
    unsigned sum, cnt, mine, sp = 0u;
    for (;;) {
        sum = 0u; cnt = 0u; mine = 0u;
#pragma unroll
        for (unsigned j = 0; j < 16; ++j) { const unsigned c = xb_ld(&bar[XB_XCNT(j)]); sum += c; cnt += (c > 0u) ? 1u : 0u; mine = (j == x) ? c : mine; }
        if (sum == G) break;
        __builtin_amdgcn_s_sleep(1);
        if ((++sp & 255u) == 0u) { if (xb_ld(&bar[XB_TMO])) break; if (sp > XB_SPIN_CAP) { atomicAdd(&bar[XB_TMO], 1u); break; } }
    }
    nloc = mine > 0u ? mine : 1u; nx = cnt > 0u ? cnt : 1u;
}
__device__ __forceinline__ void xcd_barrier(const XcdBarrier& b) {
    asm volatile("s_waitcnt vmcnt(0)" ::: "memory");
    __syncthreads();
    if (threadIdx.x == 0) {
        unsigned* bar = b.bar;
        __builtin_amdgcn_s_waitcnt(0);
        unsigned nloc = b.st[0], nx = b.st[1];
        if (nloc == 0u) { xcd_barrier_complete(bar, b.x, nloc, nx); b.st[0] = nloc; b.st[1] = nx; }
        const unsigned old = xb_add(&bar[XB_XSUB(b.x)], 1u);
        const unsigned gen = old / nloc;
        if (old + 1u == (gen + 1u) * nloc) {
            __builtin_amdgcn_fence(__ATOMIC_RELEASE, "agent");
            asm volatile("s_waitcnt vmcnt(0)" ::: "memory");
            const unsigned og = xb_add(&bar[XB_TOP], 1u);
            const unsigned tg = og / nx;
            if (og + 1u == (tg + 1u) * nx) xb_add(&bar[XB_TOPGEN], 1u);
            else XB_SPIN(xb_ld(&bar[XB_TOPGEN]) == tg, bar);
            __builtin_amdgcn_fence(__ATOMIC_ACQUIRE, "agent");
            xb_add(&bar[XB_XGEN(b.x)], 1u);
            asm volatile("s_waitcnt vmcnt(0)" ::: "memory");
        } else {
            XB_SPIN(xb_ld(&bar[XB_XGEN(b.x)]) == gen, bar);
            __builtin_amdgcn_fence(__ATOMIC_ACQUIRE, "agent");
            asm volatile("s_waitcnt vmcnt(0)" ::: "memory");
        }
    }
    __syncthreads();
}

struct Args { const float* in[29]; float* out; unsigned char* ws; int ph_lo, ph_hi; };
enum { I_X = 0, I_N1G, I_WIN, I_GMNG, I_GMWS, I_GMB, I_CONVW, I_CONVB, I_LWA, I_LBA, I_LWX, I_LBX, I_LLAM, I_PE, I_CW1, I_CW2, I_PW, I_PS, I_WBR, I_WOUT, I_N2G, I_RWG, I_RBG, I_RWE, I_RBE, I_MG, I_MU, I_MD, I_FNG };

#define CAS __attribute__((address_space(4)))
__device__ __forceinline__ unsigned long long karg_u64(int off) { const CAS char* kp = (const CAS char*)__builtin_amdgcn_kernarg_segment_ptr(); asm volatile("" : "+s"(kp)); return *(const CAS unsigned long long*)(kp + off); }
#define ARG_IN(k) ((const float*)(const GAS float*)karg_u64(8 * (k)))
#define ARG_OUT() ((float*)(GAS float*)karg_u64(8 * 29))
#define ARG_WS() ((unsigned char*)(GAS unsigned char*)karg_u64(8 * 30))
__device__ __forceinline__ int win_dst_row(int s) {
    if (s < SRC_GC) return s;
    if (s < SRC_XD) return C_GC + (s - SRC_GC);
    if (s < SRC_MG) return C_XD + (s - SRC_XD);
    const int n = (s - SRC_MG) >> 10, d = (s - SRC_MG) & 1023;
    return 4096 + 256 * (d >> 6) + 128 * (n >> 1) + 32 * ((d >> 4) & 3) + 8 * ((d >> 2) & 3) + 4 * (n & 1) + (d & 3);
}
struct TrItem { const float* W; bf16* WT; int K, N, kb, nb, kind; unsigned char* W8; };
struct TrRegs { f32x4 v[8]; };
__device__ __forceinline__ int tr_dst(int kind, int n) { return (kind == 0 || kind == 4) ? n : kind == 1 ? win_dst_row(n) : kind == 2 ? 256 * (n >> 7) + (n & 127) : 256 * (n >> 7) + 128 + (n & 127); }
__device__ __forceinline__ TrRegs tr_load(const TrItem& it, int lane) {
    TrRegs r; const int k0 = 64 * it.kb + 8 * (lane >> 3), n4 = 32 * it.nb + (lane & 7) * 4;
#pragma unroll
    for (int i = 0; i < 8; ++i) r.v[i] = *(const f32x4*)(it.W + (size_t)(k0 + i) * it.N + (n4 < it.N ? n4 : 0));
    return r;
}
__device__ __forceinline__ unsigned pk4_fp8(float a, float b, float c, float d) { int p = __builtin_amdgcn_cvt_pk_fp8_f32(a, b, 0, false); p = __builtin_amdgcn_cvt_pk_fp8_f32(c, d, p, true); return (unsigned)p; }
__device__ __forceinline__ void tr_finish(const TrItem& it, const TrRegs& r, float* scr, int lane) {
    (void)scr;
    const int src = (((lane & 7) << 3) | (lane >> 3)) << 2;
    const int k0 = 64 * it.kb + 8 * (lane & 7), n4 = 32 * it.nb + (lane >> 3) * 4;
#pragma unroll
    for (int j = 0; j < 4; ++j) { const int n = n4 + j; const int dst = tr_dst(it.kind, n);
        u32x4 o; o.x = pk2(r.v[0][j], r.v[1][j]); o.y = pk2(r.v[2][j], r.v[3][j]); o.z = pk2(r.v[4][j], r.v[5][j]); o.w = pk2(r.v[6][j], r.v[7][j]);
        o.x = (unsigned)__builtin_amdgcn_ds_bpermute(src, (int)o.x); o.y = (unsigned)__builtin_amdgcn_ds_bpermute(src, (int)o.y); o.z = (unsigned)__builtin_amdgcn_ds_bpermute(src, (int)o.z); o.w = (unsigned)__builtin_amdgcn_ds_bpermute(src, (int)o.w);
        if (it.W8 != nullptr) {
            unsigned q0 = pk4_fp8(r.v[0][j] * 64.f, r.v[1][j] * 64.f, r.v[2][j] * 64.f, r.v[3][j] * 64.f), q1 = pk4_fp8(r.v[4][j] * 64.f, r.v[5][j] * 64.f, r.v[6][j] * 64.f, r.v[7][j] * 64.f);
            q0 = (unsigned)__builtin_amdgcn_ds_bpermute(src, (int)q0); q1 = (unsigned)__builtin_amdgcn_ds_bpermute(src, (int)q1);
            if (n < it.N && dst >= 4096) { u32x2 q; q.x = q0; q.y = q1; GST(*(u32x2*)(it.W8 + (size_t)(dst - 4096) * it.K + k0) = q); }
            if (n < it.N && dst < 4096) GST(*(u32x4*)(it.WT + (size_t)dst * it.K + k0) = o);
        } else if (n < it.N) {
            const size_t eo = (it.kind == 4) ? ((((size_t)((k0 >> 8) * 8 + ((k0 >> 5) & 7)) * 4 + (dst >> 4)) * 4 + ((k0 >> 3) & 3)) * 16 + (dst & 15)) * 8 : (size_t)dst * it.K + k0;
            GST(*(u32x4*)(it.WT + eo) = o); } }
}
template <int MODE>
__device__ __forceinline__ void norm_rows(const float* xbase, const bf16* hin, bf16* hout, float* outf, const bf16* y0b, const bf16* y1b, const float* g, bf16* xnb, unsigned char* xn8, int m0, int m1, bool two, int lane) {
    f32x4 v[2][4]; u32x2 hr[2][4], ya[2][4], yb[2][4];
#pragma unroll
    for (int r = 0; r < 2; ++r) { const size_t m = (size_t)(r ? m1 : m0); if (r == 0 || two) {
#pragma unroll
        for (int j = 0; j < 4; ++j) { const int c = 4 * lane + 256 * j;
            if (MODE == 0) v[r][j] = *(const f32x4*)(xbase + m * D + c);
            else { hr[r][j] = *(const u32x2*)(hin + m * D + c); ya[r][j] = *(const u32x2*)(y0b + m * D + c); yb[r][j] = *(const u32x2*)(y1b + m * D + c); } } } }
#pragma unroll
    for (int r = 0; r < 2; ++r) { if (r == 1 && !two) break; const size_t m = (size_t)(r ? m1 : m0); float ss = 0.f;
#pragma unroll
        for (int j = 0; j < 4; ++j) {
            if (MODE != 0) { const u32x2 hh = hr[r][j], a = ya[r][j], b = yb[r][j];
                v[r][j].x = bflo(hh.x) + (bflo(a.x) + bflo(b.x)); v[r][j].y = bfhi(hh.x) + (bfhi(a.x) + bfhi(b.x)); v[r][j].z = bflo(hh.y) + (bflo(a.y) + bflo(b.y)); v[r][j].w = bfhi(hh.y) + (bfhi(a.y) + bfhi(b.y)); }
            ss += (v[r][j].x * v[r][j].x + v[r][j].y * v[r][j].y) + (v[r][j].z * v[r][j].z + v[r][j].w * v[r][j].w); }
        const float rstd = rsqrtf(wave_sum(ss) * (1.f / D) + EPS);
#pragma unroll
        for (int j = 0; j < 4; ++j) { const int c = 4 * lane + 256 * j; const f32x4 gg = *(const f32x4*)(g + c); const f32x4 x = v[r][j];
            if (MODE == 2) { GST(*(f32x4*)(outf + m * D + c) = (f32x4){x.x * rstd * gg.x, x.y * rstd * gg.y, x.z * rstd * gg.z, x.w * rstd * gg.w}); }
            else { if (MODE != 0) { u32x2 hw; hw.x = pk2(x.x, x.y); hw.y = pk2(x.z, x.w); GST(*(u32x2*)(hout + m * D + c) = hw); }
                u32x2 o; o.x = pk2(x.x * rstd * gg.x, x.y * rstd * gg.y); o.y = pk2(x.z * rstd * gg.z, x.w * rstd * gg.w); GST(*(u32x2*)(xnb + m * D + c) = o);
                GST(*(unsigned*)(xn8 + m * D + c) = pk4_fp8(x.x * rstd * gg.x, x.y * rstd * gg.y, x.z * rstd * gg.z, x.w * rstd * gg.w)); } } }
}

constexpr int IT_WIN_ = 16 * 249, IT_WB_ = 8 * 32, IT_WO_ = 16 * 32, IT_BIG = IT_WIN_ + 4 * IT_WB_ + IT_WO_;
__device__ __forceinline__ TrItem dec_big(int it, int l) {
    unsigned char* wsb = ARG_WS(); int r = it;
    if (r < IT_WIN_) return TrItem{ARG_IN(I_WIN) + (size_t)l * D * NIN, (bf16*)(wsb + WS_WIN) + (size_t)l * NPROJ * D, D, NIN, r / 249, r % 249, 1, (unsigned char*)ARG_OUT() + OUT_WG8 + (size_t)l * 4096 * 1024};
    r -= IT_WIN_;
    if (r < 4 * IT_WB_) { const int n = r / IT_WB_; r -= n * IT_WB_; const int ln = l * 4 + n; return TrItem{ARG_IN(I_WBR) + (size_t)ln * 512 * 1024, (bf16*)(wsb + WS_WB) + (size_t)ln * 1024 * 512, 512, 1024, r / 32, r % 32, 0}; }
    r -= 4 * IT_WB_;
    return TrItem{ARG_IN(I_WOUT) + (size_t)l * 1024 * 1024, (bf16*)(wsb + WS_WOUT) + (size_t)l * 1024 * 1024, 1024, 1024, r / 32, r % 32, 0};
}
__device__ __forceinline__ void conv_unit(float* ldsf, int cu) {
    const int tid = opaque_tid(); const int wv = __builtin_amdgcn_readfirstlane(tid >> 6), lane = tid & 63; const int it = cu * 8 + wv;
    __syncthreads();
    if (it < IT_BIG) { const TrItem ti = dec_big(it, 1); const TrRegs rr = tr_load(ti, lane); tr_finish(ti, rr, ldsf + wv * 4096, lane); }
}
__device__ __forceinline__ void wait_counter(unsigned* cp, unsigned need, unsigned* tmo) {
    if (__builtin_amdgcn_readfirstlane((int)threadIdx.x) < 64) {
        unsigned polls = 0u;
        while ((unsigned)__builtin_amdgcn_readfirstlane(__hip_atomic_load(cp, __ATOMIC_RELAXED, __HIP_MEMORY_SCOPE_AGENT)) < need) {
            if (++polls > (1u << 22)) { __hip_atomic_store(tmo, 1u, __ATOMIC_RELAXED, __HIP_MEMORY_SCOPE_AGENT); break; }
            __builtin_amdgcn_s_sleep(2); }
        __builtin_amdgcn_fence(__ATOMIC_ACQUIRE, "agent");
        asm volatile("s_waitcnt vmcnt(0)" ::: "memory");
    }
    asm volatile("" ::: "memory"); __builtin_amdgcn_s_barrier(); asm volatile("" ::: "memory");
}
struct SchedDense {
    const bf16* A; const bf16* Bt; int lda, K, nM, nN, G, c; unsigned* cnt; unsigned need; unsigned* tmo; int pnrot; int pnbase;
    __device__ __forceinline__ void a_ready(const pg8::Unit& u) const { if (cnt) wait_counter(cnt + 64 * u.pm, need, tmo); }
    __device__ __forceinline__ void done(const pg8::Unit&) const {}
    __device__ __forceinline__ bool next(int i, pg8::Unit& u) const {
        int pm, pn; if (!pg8::static_tile(i, G, c, nM, nN, pm, pn)) return false;
        pn += pnrot; if (pn >= nN) pn -= nN;
        u.pm = pm; u.pn = pn + pnbase; u.sub = 0; u.e = 0; u.A = (const char*)(A + (size_t)pm * 256 * lda); u.B = (const char*)(Bt + (size_t)pn * 256 * K); return true;
    }
    __device__ __forceinline__ void a_off(const pg8::Unit&, unsigned (&vo)[2][2]) const {
        const int tz = opaque_tid();
#pragma unroll
        for (int i = 0; i < 2; ++i) { int R, C; pg8::stage_rc(tz * 16 + i * 8192, R, C);
#pragma unroll
            for (int h = 0; h < 2; ++h) vo[h][i] = (unsigned)((h * 128 + R) * lda + C) * 2u; }
    }
};
struct SchedMerge {
    const bf16* P1; const bf16* Wb; int G, c; unsigned* cnt;
    __device__ __forceinline__ void a_ready(const pg8::Unit&) const {}
    __device__ __forceinline__ void done(const pg8::Unit& u) const {
        if (u.sub != 3) return;
        asm volatile("s_waitcnt vmcnt(0)" ::: "memory");
        if ((threadIdx.x & 63) == 0 && !is_dry()) (void)__hip_atomic_fetch_add(cnt + 64 * u.pm, 1u, __ATOMIC_RELAXED, __HIP_MEMORY_SCOPE_AGENT);
    }
    __device__ __forceinline__ bool next(int i, pg8::Unit& u) const {
        const int ti = i >> 2, sub = i & 3; int pm, pn; if (!pg8::static_tile(ti, G, c, T / 256, 4, pm, pn)) return false;
        const int ycol = (sub == 0) ? C_U : (sub == 1) ? C_GB : (sub == 2) ? C_Q : C_V;
        u.pm = pm; u.pn = pn; u.sub = sub; u.e = 0;
        u.A = (const char*)(P1 + (size_t)pm * 256 * P1W + ycol); u.B = (const char*)(Wb + ((size_t)sub * 1024 + (size_t)pn * 256) * 512); return true;
    }
    __device__ __forceinline__ void a_off(const pg8::Unit&, unsigned (&vo)[2][2]) const {
        const int tz = opaque_tid();
#pragma unroll
        for (int i = 0; i < 2; ++i) { int R, C; pg8::stage_rc(tz * 16 + i * 8192, R, C);
#pragma unroll
            for (int h = 0; h < 2; ++h) vo[h][i] = (unsigned)((h * 128 + R) * P1W + C) * 2u; }
    }
};
__device__ __forceinline__ const LAS int* moe_tab() { unsigned a = (unsigned)LDS_MOE; asm volatile("" : "+s"(a)); return (const LAS int*)(uintptr_t)a; }
struct SchedMoe {
    const bf16* A; const bf16* Bt; const unsigned* list; int lda, K, brows  , G, c; bool gather; unsigned* cnt; unsigned* tmo;
    __device__ __forceinline__ bool next(int i, pg8::Unit& u) const {
        const LAS int* tab = moe_tab(); const int tot = __builtin_amdgcn_readfirstlane(tab[16]); int L;
        const int U = 4 * tot, n1 = (3 * G / 4) & ~3, n2 = U - G - n1;
        if (n2 >= 0 && n1 - n2 >= G / 4 && (G & 3) == 0) {
            if (gather) {
                if (i == 0) L = c; else if (i == 1) { if (c >= n1) return false; L = G + c; } else if (i == 2) { if (c >= n2) return false; L = G + n1 + c; } else return false;
            } else {
                if (c < n2) { if (i > 0) return false; L = G + n1 + c; }
                else if (c < n1) { L = G + (c - n2) + i * (n1 - n2); if (L >= G + n1) return false; }
                else { L = (c - n1) + i * (G - n1); if (L >= G) return false; }
            }
        } else L = i * G + c;
        if (L >= 4 * tot) return false;
        const int rtg = L >> 2, pn = L & 3; int e = 0, st = 0;
#pragma unroll
        for (int k = 1; k < 16; ++k) { const int tk = __builtin_amdgcn_readfirstlane(tab[k]); if (rtg >= tk) { e = k; st = tk; } }
        u.e = e; u.pm = rtg; u.sub = rtg - st; u.pn = pn;
        u.A = gather ? (const char*)A : (const char*)(A + (size_t)rtg * 256 * lda);
        u.B = (const char*)(Bt + ((size_t)e * brows + (size_t)pn * 256) * K); return true;
    }
    __device__ __forceinline__ void a_ready(const pg8::Unit& u) const {
        if (gather) return;
        if (__builtin_amdgcn_readfirstlane((int)threadIdx.x) < 64) {
            unsigned* cp = cnt + 64 * u.pm; unsigned polls = 0u;
            while ((unsigned)__builtin_amdgcn_readfirstlane(__hip_atomic_load(cp, __ATOMIC_RELAXED, __HIP_MEMORY_SCOPE_AGENT)) < 32u) {
                if (++polls > (1u << 22)) { __hip_atomic_store(tmo, 1u, __ATOMIC_RELAXED, __HIP_MEMORY_SCOPE_AGENT); break; }
                __builtin_amdgcn_s_sleep(2); }
            __builtin_amdgcn_fence(__ATOMIC_ACQUIRE, "agent");
            asm volatile("s_waitcnt vmcnt(0)" ::: "memory");
        }
        asm volatile("" ::: "memory"); __builtin_amdgcn_s_barrier(); asm volatile("" ::: "memory");
    }
    __device__ __forceinline__ void done(const pg8::Unit& u) const {
        if (!gather) return;
        asm volatile("s_waitcnt vmcnt(0)" ::: "memory");
        if ((threadIdx.x & 63) == 0 && !is_dry()) (void)__hip_atomic_fetch_add(cnt + 64 * u.pm, 1u, __ATOMIC_RELAXED, __HIP_MEMORY_SCOPE_AGENT);
    }
    __device__ __forceinline__ void a_off(const pg8::Unit& u, unsigned (&vo)[2][2]) const {
        const LAS int* tab = moe_tab(); const int cnt = __builtin_amdgcn_readfirstlane(tab[32 + u.e]); const unsigned* le = list + (size_t)u.e * T + u.sub * 256;
        int tz = (int)threadIdx.x; asm volatile("" : "+v"(tz));
#pragma unroll
        for (int i = 0; i < 2; ++i) { int R, C; pg8::stage_rc(tz * 16 + i * 8192, R, C);
#pragma unroll
            for (int h = 0; h < 2; ++h) {
                int row = h * 128 + R;
                if (gather) { row = (u.sub * 256 + row < cnt) ? (int)(le[row] & 0x3fffu) : 0; }
                vo[h][i] = (unsigned)(row * lda + C) * 2u;
            } }
    }
};

struct EpiProj {
    bf16* P1; bf16* Rr; float gsc;
    __device__ __forceinline__ bool operator()(f32x4 (&acc)[2][2][4][2], const pg8::Unit& u, int wr, int wc, int fr, int fq) const {
        const int row0 = u.pm * 256 + wr * 64 + fr;
        if (u.pn < 16) {
            const int act = (u.pn < 6) ? 1 : (u.pn == 15 ? 2 : 0);
#pragma unroll
            for (int ai = 0; ai < 2; ++ai)
#pragma unroll
                for (int m = 0; m < 4; ++m) { bf16* rowp = P1 + (size_t)(row0 + ai * 128 + m * 16) * P1W + u.pn * 256 + wc * 32 + 8 * fq;
#pragma unroll
                    for (int bj = 0; bj < 2; ++bj) { f32x4 v0 = acc[ai][bj][m][0], v1 = acc[ai][bj][m][1];
                        if (act == 1) { v0 = (f32x4){gelu_tanh(v0.x), gelu_tanh(v0.y), gelu_tanh(v0.z), gelu_tanh(v0.w)}; v1 = (f32x4){gelu_tanh(v1.x), gelu_tanh(v1.y), gelu_tanh(v1.z), gelu_tanh(v1.w)}; }
                        else if (act == 2) { v0 = (f32x4){sigmoidf_(v0.x), sigmoidf_(v0.y), sigmoidf_(v0.z), sigmoidf_(v0.w)}; v1 = (f32x4){sigmoidf_(v1.x), sigmoidf_(v1.y), sigmoidf_(v1.z), sigmoidf_(v1.w)}; }
                        u32x4 w; w.x = pk2(v0.x, v0.y); w.y = pk2(v0.z, v0.w); w.z = pk2(v1.x, v1.y); w.w = pk2(v1.z, v1.w);
                        if (u.pn < 15 || (bj == 0 && wc < 2)) GST(*(u32x4*)(rowp + bj * 128) = w); } }
        } else {
            const int dcol = 64 * (u.pn - 16) + 16 * wc + 4 * fq;
#pragma unroll
            for (int ai = 0; ai < 2; ++ai)
#pragma unroll
                for (int m = 0; m < 4; ++m) { const size_t row = (size_t)(row0 + ai * 128 + m * 16);
                    float r0[4], r1[4], r2[4], r3[4];
#pragma unroll
                    for (int i = 0; i < 4; ++i) {
                        const float d0 = fminf(1.0f + __builtin_amdgcn_exp2f(gsc * acc[ai][0][m][0][i]), 1e20f), d1 = fminf(1.0f + __builtin_amdgcn_exp2f(gsc * acc[ai][0][m][1][i]), 1e20f);
                        const float d2 = fminf(1.0f + __builtin_amdgcn_exp2f(gsc * acc[ai][1][m][0][i]), 1e20f), d3 = fminf(1.0f + __builtin_amdgcn_exp2f(gsc * acc[ai][1][m][1][i]), 1e20f);
                        const float i0 = __builtin_amdgcn_rcpf(d0), i1 = __builtin_amdgcn_rcpf(d1), i2 = __builtin_amdgcn_rcpf(d2), i3 = __builtin_amdgcn_rcpf(d3);
                        r0[i] = d1 * i0; r1[i] = d2 * i1; r2[i] = d3 * i2; r3[i] = i3; }
                    u32x2 w;
                    w.x = pk2(r0[0], r0[1]); w.y = pk2(r0[2], r0[3]); GST(*(u32x2*)(Rr + ((size_t)0 * T + row) * 1024 + dcol) = w);
                    w.x = pk2(r1[0], r1[1]); w.y = pk2(r1[2], r1[3]); GST(*(u32x2*)(Rr + ((size_t)1 * T + row) * 1024 + dcol) = w);
                    w.x = pk2(r2[0], r2[1]); w.y = pk2(r2[2], r2[3]); GST(*(u32x2*)(Rr + ((size_t)2 * T + row) * 1024 + dcol) = w);
                    w.x = pk2(r3[0], r3[1]); w.y = pk2(r3[2], r3[3]); GST(*(u32x2*)(Rr + ((size_t)3 * T + row) * 1024 + dcol) = w); }
        }
        return true;
    }
};
struct EpiMerge {
    const bf16* Rr; bf16* O;
    __device__ __forceinline__ bool operator()(f32x4 (&acc)[2][2][4][2], const pg8::Unit& u, int wr, int wc, int fr, int fq) const {
        const int row0 = u.pm * 256 + wr * 64 + fr, col0 = u.pn * 256 + wc * 32 + 8 * fq;
        const bf16* Rn = Rr + (size_t)u.sub * T * 1024;
        const __amdgpu_buffer_rsrc_t rs = __builtin_amdgcn_make_buffer_rsrc((void*)O, (short)0, (int)((size_t)T * 1024 * 2), 0x00020000);
        u32x4 rv[2][4][2];
#pragma unroll
        for (int ai = 0; ai < 2; ++ai)
#pragma unroll
            for (int m = 0; m < 4; ++m)
#pragma unroll
                for (int bj = 0; bj < 2; ++bj) rv[ai][m][bj] = *(const u32x4*)(Rn + (size_t)(row0 + ai * 128 + m * 16) * 1024 + col0 + bj * 128);
        __builtin_amdgcn_sched_barrier(0);
#pragma unroll
        for (int ai = 0; ai < 2; ++ai)
#pragma unroll
            for (int m = 0; m < 4; ++m) { const size_t ro = (size_t)(row0 + ai * 128 + m * 16) * 1024 + col0;
#pragma unroll
                for (int bj = 0; bj < 2; ++bj) { const u32x4 r = rv[ai][m][bj];
                    f32x4& v0 = acc[ai][bj][m][0]; f32x4& v1 = acc[ai][bj][m][1];
                    v0.x *= bflo(r.x); v0.y *= bfhi(r.x); v0.z *= bflo(r.y); v0.w *= bfhi(r.y); v1.x *= bflo(r.z); v1.y *= bfhi(r.z); v1.z *= bflo(r.w); v1.w *= bfhi(r.w);
                    if (u.sub == 3) { u32x4 w; w.x = pk2(v0.x, v0.y); w.y = pk2(v0.z, v0.w); w.z = pk2(v1.x, v1.y); w.w = pk2(v1.z, v1.w); GST(__builtin_amdgcn_raw_buffer_store_b128(w, rs, (unsigned)((ro + bj * 128) * 2), 0, 16)); } } }
        return u.sub == 3;
    }
};
struct EpiWout {
    const float* Hin32; const bf16* Hin16; bf16* H;
    __device__ __forceinline__ bool operator()(f32x4 (&acc)[2][2][4][2], const pg8::Unit& u, int wr, int wc, int fr, int fq) const {
        const int row0 = u.pm * 256 + wr * 64 + fr, col0 = u.pn * 256 + wc * 32 + 8 * fq;
        if (Hin32) {
#pragma unroll
            for (int ai = 0; ai < 2; ++ai)
            {   f32x4 hv[4][2][2];
#pragma unroll
                for (int m = 0; m < 4; ++m)
#pragma unroll
                    for (int bj = 0; bj < 2; ++bj)
#pragma unroll
                        for (int n = 0; n < 2; ++n) hv[m][bj][n] = *(const f32x4*)(Hin32 + (size_t)(row0 + ai * 128 + m * 16) * 1024 + col0 + bj * 128 + 4 * n);
                __builtin_amdgcn_sched_barrier(0);
#pragma unroll
                for (int m = 0; m < 4; ++m)
#pragma unroll
                    for (int bj = 0; bj < 2; ++bj) { const f32x4 h0 = hv[m][bj][0] + acc[ai][bj][m][0], h1 = hv[m][bj][1] + acc[ai][bj][m][1];
                        GST(*(u32x4*)(H + (size_t)(row0 + ai * 128 + m * 16) * 1024 + col0 + bj * 128) = (u32x4){pk2(h0.x, h0.y), pk2(h0.z, h0.w), pk2(h1.x, h1.y), pk2(h1.z, h1.w)}); } }
        } else {
#pragma unroll
            for (int ai = 0; ai < 2; ++ai)
            {   u32x4 hb[4][2];
#pragma unroll
                for (int m = 0; m < 4; ++m)
#pragma unroll
                    for (int bj = 0; bj < 2; ++bj) hb[m][bj] = *(const u32x4*)(Hin16 + (size_t)(row0 + ai * 128 + m * 16) * 1024 + col0 + bj * 128);
                __builtin_amdgcn_sched_barrier(0);
#pragma unroll
                for (int m = 0; m < 4; ++m)
#pragma unroll
                    for (int bj = 0; bj < 2; ++bj) { const u32x4 r = hb[m][bj]; const f32x4 a0 = acc[ai][bj][m][0], a1 = acc[ai][bj][m][1];
                        GST(*(u32x4*)(H + (size_t)(row0 + ai * 128 + m * 16) * 1024 + col0 + bj * 128) = (u32x4){pk2(bflo(r.x) + a0.x, bfhi(r.x) + a0.y), pk2(bflo(r.y) + a0.z, bfhi(r.y) + a0.w), pk2(bflo(r.z) + a1.x, bfhi(r.z) + a1.y), pk2(bflo(r.w) + a1.z, bfhi(r.w) + a1.w)}); } }
        }
        return true;
    }
};
struct EpiGateUp {
    bf16* HID; const float* lw;
    __device__ __forceinline__ bool operator()(f32x4 (&acc)[2][2][4][2], const pg8::Unit& u, int wr, int wc, int fr, int fq) const {
        const int cnt = __builtin_amdgcn_readfirstlane(moe_tab()[32 + u.e]);
        const __amdgpu_buffer_rsrc_t rs = __builtin_amdgcn_make_buffer_rsrc((void*)HID, (short)0, (int)((size_t)HID_ROWS * 512 * 2), 0x00020000);
        float wl[2][4];
#pragma unroll
        for (int ai = 0; ai < 2; ++ai)
#pragma unroll
            for (int m = 0; m < 4; ++m) { const int lr = u.sub * 256 + ai * 128 + wr * 64 + m * 16 + fr; wl[ai][m] = lw[(size_t)u.e * T + (lr < cnt ? lr : 0)]; }
        __builtin_amdgcn_sched_barrier(0);
#pragma unroll
        for (int ai = 0; ai < 2; ++ai)
#pragma unroll
            for (int m = 0; m < 4; ++m) { const int rl = ai * 128 + wr * 64 + m * 16 + fr; const int lr = u.sub * 256 + rl;
                const bool ok = lr < cnt; const float w = ok ? wl[ai][m] : 0.f;
                float o[8];
#pragma unroll
                for (int n = 0; n < 2; ++n)
#pragma unroll
                    for (int i = 0; i < 4; ++i) { const float g = acc[ai][0][m][n][i], up = acc[ai][1][m][n][i]; o[4 * n + i] = ok ? g * sigmoidf_(g) * up * w : 0.f; }
                u32x4 wv; wv.x = pk2(o[0], o[1]); wv.y = pk2(o[2], o[3]); wv.z = pk2(o[4], o[5]); wv.w = pk2(o[6], o[7]);
                GST(__builtin_amdgcn_raw_buffer_store_b128(wv, rs, (unsigned)((((size_t)u.pm * 256 + rl) * 512 + u.pn * 128 + wc * 32 + 8 * fq) * 2), 0, 16)); }
        return true;
    }
};
struct EpiDown {
    bf16* Y; const unsigned* list;
    __device__ __forceinline__ bool operator()(f32x4 (&acc)[2][2][4][2], const pg8::Unit& u, int wr, int wc, int fr, int fq) const {
        const int cnt = __builtin_amdgcn_readfirstlane(moe_tab()[32 + u.e]);
        unsigned en[2][4];
#pragma unroll
        for (int ai = 0; ai < 2; ++ai)
#pragma unroll
            for (int m = 0; m < 4; ++m) { const int lr = u.sub * 256 + ai * 128 + wr * 64 + m * 16 + fr; en[ai][m] = list[(size_t)u.e * T + (lr < cnt ? lr : 0)]; }
        __builtin_amdgcn_sched_barrier(0);
#pragma unroll
        for (int ai = 0; ai < 2; ++ai)
#pragma unroll
            for (int m = 0; m < 4; ++m) { const int rl = ai * 128 + wr * 64 + m * 16 + fr; const int lr = u.sub * 256 + rl;
                if (lr < cnt) { const unsigned tok = en[ai][m] & 0x3fffu, slot = en[ai][m] >> 14;
                    bf16* rp = Y + ((size_t)slot * T + tok) * 1024 + u.pn * 256 + wc * 32 + 8 * fq;
#pragma unroll
                    for (int bj = 0; bj < 2; ++bj) { const f32x4 v0 = acc[ai][bj][m][0], v1 = acc[ai][bj][m][1];
                        u32x4 w; w.x = pk2(v0.x, v0.y); w.y = pk2(v0.z, v0.w); w.z = pk2(v1.x, v1.y); w.w = pk2(v1.z, v1.w); GST(*(u32x4*)(rp + bj * 128) = w); } } }
        return true;
    }
};


__device__ __forceinline__ void lru_unit2(LAS unsigned char* lds, const bf16* P1, bf16* XN, float* AGA, float* AGH, const float* convw, const float* convb,
                                          const bf16* WaT, const bf16* WxT, const float* ba, const float* bx, const float* lam, int unit) {
    const int tid = opaque_tid(); const int lane = tid & 63, w = __builtin_amdgcn_readfirstlane(tid >> 6);
    const int tile = unit & 63, b = unit >> 6; const int ch0 = w * 64;
    const size_t row0 = (size_t)b * SEQ + tile * 64;
    LAS unsigned char* wl = lds + w * 17920;
    LAS bf16* xcb = (LAS bf16*)wl; LAS float* AL = (LAS float*)(wl + 9216); LAS float* BL = (LAS float*)(wl + 9216 + 4352);
    __syncthreads();
    FT0(8);
    const int i16 = lane & 15, kb = lane >> 4;
    bf16x8 bfa[4][2], bfx[4][2]; float cba[4], cbx[4], csp[4];
    {
        const int tl = lane >> 3, c8 = (lane & 7) * 8;
        f32x4 cwv[4][2], cbv[2];
#pragma unroll
        for (int k = 0; k < 4; ++k) { cwv[k][0] = *(const f32x4*)(convw + k * 512 + ch0 + c8); cwv[k][1] = *(const f32x4*)(convw + k * 512 + ch0 + c8 + 4); }
        cbv[0] = *(const f32x4*)(convb + ch0 + c8); cbv[1] = *(const f32x4*)(convb + ch0 + c8 + 4);
        u32x4 xa[4][4], xb[4][4];
#pragma unroll
        for (int p = 0; p < 4; ++p)
#pragma unroll
            for (int k = 0; k < 4; ++k) { const int sp = tile * 64 + 8 * p + tl + k - 3; xa[p][k] = *(const u32x4*)(P1 + ((size_t)b * SEQ + (sp < 0 ? 0 : sp)) * P1W + C_RB + ch0 + c8); }
#pragma unroll
        for (int p = 0; p < 4; ++p)
#pragma unroll
            for (int k = 0; k < 4; ++k) { const int sp = tile * 64 + 8 * (p + 4) + tl + k - 3; xb[p][k] = *(const u32x4*)(P1 + ((size_t)b * SEQ + (sp < 0 ? 0 : sp)) * P1W + C_RB + ch0 + c8); }
        __builtin_amdgcn_sched_barrier(0);
#pragma unroll
        for (int hf = 0; hf < 2; ++hf) {
#pragma unroll
            for (int p = 0; p < 4; ++p) { const int tok = 8 * (p + 4 * hf) + tl; const int ts = tile * 64 + tok;
                float o[8] = {cbv[0].x, cbv[0].y, cbv[0].z, cbv[0].w, cbv[1].x, cbv[1].y, cbv[1].z, cbv[1].w};
#pragma unroll
                for (int k = 0; k < 4; ++k) { const u32x4 v = hf ? xb[p][k] : xa[p][k]; const float z = (ts + k - 3 >= 0) ? 1.f : 0.f; const f32x4 w0 = cwv[k][0] * z, w1 = cwv[k][1] * z;
                    o[0] += bflo(v.x) * w0.x; o[1] += bfhi(v.x) * w0.y; o[2] += bflo(v.y) * w0.z; o[3] += bfhi(v.y) * w0.w; o[4] += bflo(v.z) * w1.x; o[5] += bfhi(v.z) * w1.y; o[6] += bflo(v.w) * w1.z; o[7] += bfhi(v.w) * w1.w; }
                *(LAS u32x4*)(xcb + tok * 72 + c8) = (u32x4){pk2(o[0], o[1]), pk2(o[2], o[3]), pk2(o[4], o[5]), pk2(o[6], o[7])}; }
            if (hf == 0) {
#pragma unroll
                for (int n = 0; n < 4; ++n) {
#pragma unroll
                    for (int ks = 0; ks < 2; ++ks) { bfa[n][ks] = *(const bf16x8*)(WaT + ((size_t)ch0 + 16 * n + i16) * 64 + 32 * ks + 8 * kb); bfx[n][ks] = *(const bf16x8*)(WxT + ((size_t)ch0 + 16 * n + i16) * 64 + 32 * ks + 8 * kb); }
                    const int co = ch0 + 16 * n + i16; cba[n] = ba[co]; cbx[n] = bx[co]; csp[n] = lam[co]; }
                __builtin_amdgcn_sched_barrier(0); }
        }
#pragma unroll
        for (int n = 0; n < 4; ++n) { const float lm = csp[n]; const float ex = __expf(-lm), y1 = 1.0f + ex;
            const float l1p = (y1 == 1.0f) ? ex : logf(y1) * (ex / (y1 - 1.0f));
            csp[n] = 8.0f * ((-lm > 20.f) ? -lm : l1p); }
    }
    LDS_WAIT(); asm volatile("" ::: "memory");
    FT1(8); FT0(9);
    float hr = 0.f, ac = 1.f;
#pragma unroll 1
    for (int nt = 0; nt < 4; ++nt) {
        bf16x8 af[2];
#pragma unroll
        for (int ks = 0; ks < 2; ++ks) af[ks] = *(const LAS bf16x8*)(xcb + (16 * nt + i16) * 72 + 32 * ks + 8 * kb);
        f32x4 da[4], dx[4];
#pragma unroll
        for (int n = 0; n < 4; ++n) { da[n] = (f32x4){0.f, 0.f, 0.f, 0.f}; dx[n] = da[n];
#pragma unroll
            for (int ks = 0; ks < 2; ++ks) { da[n] = __builtin_amdgcn_mfma_f32_16x16x32_bf16(af[ks], bfa[n][ks], da[n], 0, 0, 0); dx[n] = __builtin_amdgcn_mfma_f32_16x16x32_bf16(af[ks], bfx[n][ks], dx[n], 0, 0, 0); } }
#pragma unroll
        for (int n = 0; n < 4; ++n)
#pragma unroll
            for (int r = 0; r < 4; ++r) { const int tokl = 4 * kb + r, co = 16 * n + i16; const float xcv = bf2f(xcb[(16 * nt + tokl) * 72 + co]);
                const float rg = sigmoidf_(da[n][r] + cba[n]), ig = sigmoidf_(dx[n][r] + cbx[n]); const float a = __expf(-rg * csp[n]);
                AL[tokl * 68 + co] = a; BL[tokl * 68 + co] = sqrtf(fmaxf(1.0f - a * a, 0.f)) * (ig * xcv); }
        LDS_WAIT(); asm volatile("" ::: "memory");
#pragma unroll
        for (int tt = 0; tt < 16; ++tt) { const float a = AL[tt * 68 + lane], bt = BL[tt * 68 + lane]; hr = a * hr + bt; ac *= a; BL[tt * 68 + lane] = hr; AL[tt * 68 + lane] = ac; }
        LDS_WAIT(); asm volatile("" ::: "memory");
        {   const int tk = lane >> 2, pc = (lane & 3) * 16;
            const f32x4 h0 = *(const LAS f32x4*)(BL + tk * 68 + pc), h1 = *(const LAS f32x4*)(BL + tk * 68 + pc + 4), h2 = *(const LAS f32x4*)(BL + tk * 68 + pc + 8), h3 = *(const LAS f32x4*)(BL + tk * 68 + pc + 12);
            const f32x4 a0 = *(const LAS f32x4*)(AL + tk * 68 + pc), a1 = *(const LAS f32x4*)(AL + tk * 68 + pc + 4), a2 = *(const LAS f32x4*)(AL + tk * 68 + pc + 8), a3 = *(const LAS f32x4*)(AL + tk * 68 + pc + 12);
            bf16* hp = XN + (row0 + 16 * nt + tk) * 1024 + ch0 + pc;
            GST(*(u32x4*)hp = (u32x4){pk2(h0.x, h0.y), pk2(h0.z, h0.w), pk2(h1.x, h1.y), pk2(h1.z, h1.w)}); GST(*(u32x4*)(hp + 8) = (u32x4){pk2(h2.x, h2.y), pk2(h2.z, h2.w), pk2(h3.x, h3.y), pk2(h3.z, h3.w)});
            GST(*(u32x4*)(hp + 512) = (u32x4){pk2(a0.x, a0.y), pk2(a0.z, a0.w), pk2(a1.x, a1.y), pk2(a1.z, a1.w)}); GST(*(u32x4*)(hp + 520) = (u32x4){pk2(a2.x, a2.y), pk2(a2.z, a2.w), pk2(a3.x, a3.y), pk2(a3.z, a3.w)}); }
        LDS_WAIT(); asm volatile("" ::: "memory");
    }
    FT1(9);
    GST(AGA[((size_t)b * 64 + tile) * 512 + ch0 + lane] = ac); GST(AGH[((size_t)b * 64 + tile) * 512 + ch0 + lane] = hr);
}
__device__ __forceinline__ void cmp_unit2(LAS unsigned char* lds, const bf16* P1, float* KC, const float* pe, const bf16* W1T, const float* w2, int unit) {
    const int tid = opaque_tid(); const int lane = tid & 63, w = __builtin_amdgcn_readfirstlane(tid >> 6);
    const int q = unit & 15, g = (unit >> 4) & 1, b = (unit >> 5) & 3, c = unit >> 7;
    LAS bf16* Fl = (LAS bf16*)lds;
    LAS float* part = (LAS float*)(lds + 65792);
    LAS float* hid = (LAS float*)(lds + 65792 + 32768);
    const float* pec = pe + (size_t)c * 2048; const bf16* w1t = W1T + ((size_t)c * 2 + g) * 64 * 2048; const float* w2c = w2 + ((size_t)c * 2 + g) * 4096;
    __syncthreads();
    {   u32x4 xv[8]; f32x4 pa[8], pb[8];
#pragma unroll
        for (int k = 0; k < 8; ++k) { const int e = tid + 512 * k; const int nl = e >> 8, l = (e >> 3) & 31, c8 = (e & 7) * 8; const int n = q * 16 + nl; const int nn = n < 255 ? n : 254;
            xv[k] = *(const u32x4*)(P1 + ((size_t)b * SEQ + nn * 16 + l) * P1W + C_KV + (c * 2 + g) * 64 + c8); pa[k] = *(const f32x4*)(pec + l * 64 + c8); pb[k] = *(const f32x4*)(pec + l * 64 + c8 + 4); }
#pragma unroll
        for (int k = 0; k < 8; ++k) { const int e = tid + 512 * k; const int nl = e >> 8, l = (e >> 3) & 31, c8 = (e & 7) * 8; const u32x4 v = xv[k];
            *(LAS u32x4*)(Fl + nl * 2056 + l * 64 + c8) = (u32x4){pk2(bflo(v.x) + pa[k].x, bfhi(v.x) + pa[k].y), pk2(bflo(v.y) + pa[k].z, bfhi(v.y) + pa[k].w), pk2(bflo(v.z) + pb[k].x, bfhi(v.z) + pb[k].y), pk2(bflo(v.w) + pb[k].z, bfhi(v.w) + pb[k].w)}; } }
    __syncthreads();
    {   const int i16 = lane & 15, kb = lane >> 4; f32x4 acc[4];
#pragma unroll
        for (int n = 0; n < 4; ++n) acc[n] = (f32x4){0.f, 0.f, 0.f, 0.f};
        bf16x8 bfr[8][4];
#pragma unroll
        for (int ks = 0; ks < 8; ++ks)
#pragma unroll
            for (int n = 0; n < 4; ++n) bfr[ks][n] = *(const bf16x8*)(w1t + ((size_t)((w * 8 + ks) * 4 + n) * 64 + lane) * 8);
        __builtin_amdgcn_sched_barrier(0);
#pragma unroll
        for (int ks = 0; ks < 8; ++ks) { const int f0 = 256 * w + 32 * ks + 8 * kb;
            const bf16x8 af = *(const LAS bf16x8*)(Fl + i16 * 2056 + f0);
#pragma unroll
            for (int n = 0; n < 4; ++n) acc[n] = __builtin_amdgcn_mfma_f32_16x16x32_bf16(af, bfr[ks][n], acc[n], 0, 0, 0); }
#pragma unroll
        for (int n = 0; n < 4; ++n)
#pragma unroll
            for (int r = 0; r < 4; ++r) part[(w * 16 + 4 * kb + r) * 64 + 16 * n + i16] = acc[n][r];
    }
    __syncthreads();
    for (int e = tid; e < 1024; e += 512) { float a = 0.f;
#pragma unroll
        for (int ww = 0; ww < 8; ++ww) a += part[ww * 1024 + e];
        hid[e] = gelu_tanh(a); }
    __syncthreads();
    {   const int d = tid & 63, ng = tid >> 6; float a0 = 0.f, a1 = 0.f;
        for (int e = 0; e < 64; ++e) { const float wv = w2c[e * 64 + d]; a0 += hid[(ng * 2) * 64 + e] * wv; a1 += hid[(ng * 2 + 1) * 64 + e] * wv; }
        const int n0 = q * 16 + ng * 2; float* kp = KC + ((((size_t)c * NB + b) * 2 + g) * 256) * 64;
        if (n0 < 255) GST(kp[(size_t)n0 * 64 + d] = a0);
        if (n0 + 1 < 255) GST(kp[(size_t)(n0 + 1) * 64 + d] = a1); }
}
__device__ __forceinline__ void gmlp_unit3(LAS unsigned char* lds, bf16* P1, const float* gng, const float* gws, const float* gmb, int unit) {
    typedef float f32x16_ __attribute__((ext_vector_type(16))); typedef short s16x4_ __attribute__((ext_vector_type(4)));
    const int tid = opaque_tid(); const int lane = tid & 63, w = __builtin_amdgcn_readfirstlane(tid >> 6), r32 = lane & 31, h = lane >> 5;
    const int c = unit >> 1, gp = unit & 1; const size_t t0 = (size_t)c * 128;
    LAS unsigned char* VN = lds; LAS unsigned char* WT = lds + 65536; LAS float* rs = (LAS float*)(lds + 135168);
    __syncthreads();
    f32x4 wa[8], wb[8];
#pragma unroll
    for (int k = 0; k < 8; ++k) { const int e = tid + 512 * k; const int gi = e >> 11, t = (e >> 4) & 127, s8 = (e & 15) * 8; const float* wp = gws + (size_t)(2 * gp + gi) * 16384 + t * 128 + s8; wa[k] = *(const f32x4*)wp; wb[k] = *(const f32x4*)(wp + 4); }
    {   const int tk = tid >> 2, qu = tid & 3; const bf16* vp = P1 + (t0 + tk) * P1W + C_V + qu * 128; float ss = 0.f;
#pragma unroll
        for (int i = 0; i < 16; ++i) { const u32x4 x = *(const u32x4*)(vp + 8 * i);
            ss += bflo(x.x) * bflo(x.x) + bfhi(x.x) * bfhi(x.x) + bflo(x.y) * bflo(x.y) + bfhi(x.y) * bfhi(x.y) + bflo(x.z) * bflo(x.z) + bfhi(x.z) * bfhi(x.z) + bflo(x.w) * bflo(x.w) + bfhi(x.w) * bfhi(x.w); }
        ss += __shfl_xor(ss, 1); ss += __shfl_xor(ss, 2);
        if (qu == 0) rs[tk] = rsqrtf(ss * (1.f / 512.f) + EPS);
    }
#pragma unroll
    for (int k = 0; k < 8; ++k) { const int e = tid + 512 * k; const int gi = e >> 11, t = (e >> 4) & 127, s8 = (e & 15) * 8; const f32x4 a = wa[k], bq = wb[k];
        const float v0 = (s8 + 0 <= t) ? a.x : 0.f, v1 = (s8 + 1 <= t) ? a.y : 0.f, v2 = (s8 + 2 <= t) ? a.z : 0.f, v3 = (s8 + 3 <= t) ? a.w : 0.f;
        const float v4 = (s8 + 4 <= t) ? bq.x : 0.f, v5 = (s8 + 5 <= t) ? bq.y : 0.f, v6 = (s8 + 6 <= t) ? bq.z : 0.f, v7 = (s8 + 7 <= t) ? bq.w : 0.f;
        *(LAS u32x4*)(WT + gi * 34816 + t * 272 + s8 * 2) = (u32x4){pk2(v0, v1), pk2(v2, v3), pk2(v4, v5), pk2(v6, v7)}; }
    __syncthreads();
    {   u32x4 xv[8];
#pragma unroll
        for (int k = 0; k < 8; ++k) { const int e = tid + 512 * k; const int gi = e >> 11, sr = (e >> 4) & 127, c8 = e & 15; xv[k] = *(const u32x4*)(P1 + (t0 + sr) * P1W + C_V + (2 * gp + gi) * 128 + 8 * c8); }
#pragma unroll
        for (int k = 0; k < 8; ++k) { const int e = tid + 512 * k; const int gi = e >> 11, sr = (e >> 4) & 127, c8 = e & 15; const u32x4 x = xv[k];
            const float r = rs[sr]; const float* gq = gng + (2 * gp + gi) * 128 + 8 * c8;
            *(LAS u32x4*)(VN + gi * 32768 + (c8 >> 2) * 8192 + sr * 64 + (c8 & 3) * 16) = (u32x4){pk2(bflo(x.x) * r * gq[0], bfhi(x.x) * r * gq[1]), pk2(bflo(x.y) * r * gq[2], bfhi(x.y) * r * gq[3]), pk2(bflo(x.z) * r * gq[4], bfhi(x.z) * r * gq[5]), pk2(bflo(x.w) * r * gq[6], bfhi(x.w) * r * gq[7])}; } }
    __syncthreads();
    const int gi = w >> 2, cb = w & 3, g = 2 * gp + gi;
    const LAS unsigned char* vb = VN + gi * 32768 + cb * 8192 + ((lane >> 4) & 1) * 32 + (lane & 3) * 8 + (8 * h + ((lane & 15) >> 2)) * 64;
#pragma unroll 1
    for (int tb = 0; tb < 4; ++tb) {
        f32x16_ acc;
#pragma unroll
        for (int r = 0; r < 16; ++r) acc[r] = 0.f;
        const LAS unsigned char* wrow = WT + gi * 34816 + (32 * tb + r32) * 272 + 16 * h;
        for (int ks = 0; ks < 2 * tb + 2; ++ks) {
            const bf16x8 wf = *(const LAS bf16x8*)(wrow + 32 * ks);
            const s16x4_ lo = __builtin_bit_cast(s16x4_, __builtin_amdgcn_ds_read_tr16_b64_v4i16((LAS s16x4_*)(vb + ks * 1024)));
            const s16x4_ hi = __builtin_bit_cast(s16x4_, __builtin_amdgcn_ds_read_tr16_b64_v4i16((LAS s16x4_*)(vb + ks * 1024 + 256)));
            const bf16x8 vf = (bf16x8){lo[0], lo[1], lo[2], lo[3], hi[0], hi[1], hi[2], hi[3]};
            acc = __builtin_amdgcn_mfma_f32_32x32x16_bf16(vf, wf, acc, 0, 0, 0);
        }
        const int tl = 32 * tb + r32; const float bb = gmb[g * 128 + tl];
        bf16* up = P1 + (t0 + tl) * P1W + C_U + g * 128 + 32 * cb + 4 * h;
        u32x2 uu[4];
#pragma unroll
        for (int q4 = 0; q4 < 4; ++q4) uu[q4] = *(const u32x2*)(up + 8 * q4);
#pragma unroll
        for (int q4 = 0; q4 < 4; ++q4) {
            u32x2 o; o.x = pk2(bflo(uu[q4].x) * (acc[4 * q4] + bb), bfhi(uu[q4].x) * (acc[4 * q4 + 1] + bb)); o.y = pk2(bflo(uu[q4].y) * (acc[4 * q4 + 2] + bb), bfhi(uu[q4].y) * (acc[4 * q4 + 3] + bb));
            GST(*(u32x2*)(up + 8 * q4) = o); }
    }
}
__device__ __forceinline__ void pool_unit3(LAS unsigned char* lds, bf16* P1, const bf16* pwT, const float* ps, int unit) {
    typedef float f32x16_ __attribute__((ext_vector_type(16)));
    const int tid = opaque_tid(); const int lane = tid & 63, w = __builtin_amdgcn_readfirstlane(tid >> 6), r32 = lane & 31, h = lane >> 5;
    const int gp = unit & 1, tile = (unit >> 1) & 63, b = unit >> 7;
    bf16x8 wfr[8];
    { const bf16* wrow0 = pwT + (size_t)(2 * gp) * 16384 + (size_t)(32 * (w >> 1) + r32) * 128 + 8 * h;
#pragma unroll
      for (int ks = 0; ks < 8; ++ks) wfr[ks] = *(const bf16x8*)(wrow0 + 16 * ks); }
    __syncthreads();
    {   u32x4 xv[6];
#pragma unroll
        for (int k = 0; k < 6; ++k) { const int g2 = k / 3; const int e = tid + 512 * (k % 3); const int ee = e < 79 * 16 ? e : 79 * 16 - 1; const int r = ee >> 4, c8 = (ee & 15) * 8; const int sp = tile * 64 + r - 15;
            xv[k] = *(const u32x4*)(P1 + ((size_t)b * SEQ + (sp < 0 ? 0 : sp)) * P1W + C_XD + (2 * gp + g2) * 128 + c8); }
#pragma unroll
        for (int k = 0; k < 6; ++k) { const int g2 = k / 3; const int e = tid + 512 * (k % 3); if (e < 79 * 16) { const int r = e >> 4, c8 = (e & 15) * 8; const int sp = tile * 64 + r - 15; const float z = sp >= 0 ? 1.f : 0.f; const u32x4 v = xv[k];
            LAS float* xs = (LAS float*)(lds + g2 * 57856);
            *(LAS f32x4*)(xs + r * 128 + c8) = (f32x4){bflo(v.x) * z, bfhi(v.x) * z, bflo(v.y) * z, bfhi(v.y) * z}; *(LAS f32x4*)(xs + r * 128 + c8 + 4) = (f32x4){bflo(v.z) * z, bfhi(v.z) * z, bflo(v.w) * z, bfhi(v.w) * z}; } } }
    __syncthreads();
    if (tid < 256) {
        const int g2 = tid >> 7, tq = (tid >> 5) & 3, c4 = (tid & 31) * 4; const int wn = 2 << (2 * gp + g2);
        const LAS float* xs = (const LAS float*)(lds + g2 * 57856); LAS bf16* PL = (LAS bf16*)(lds + g2 * 57856 + 40448);
        f32x4 sacc = (f32x4){0.f, 0.f, 0.f, 0.f};
        for (int jj = 1; jj < wn; ++jj) sacc += *(const LAS f32x4*)(xs + (tq * 16 + 15 - jj) * 128 + c4);
#pragma unroll 8
        for (int k = 0; k < 16; ++k) { const int tt = tq * 16 + k; const int ts = tile * 64 + tt; const f32x4 xc = *(const LAS f32x4*)(xs + (tt + 15) * 128 + c4);
            sacc += xc;
            const int cnt = (ts + 1 < wn) ? ts + 1 : wn; const float ic = __builtin_amdgcn_rcpf((float)cnt);
            u32x2 o; o.x = pk2(sacc.x * ic - xc.x, sacc.y * ic - xc.y); o.y = pk2(sacc.z * ic - xc.z, sacc.w * ic - xc.w);
            *(LAS u32x2*)(PL + tt * 136 + c4) = o;
            sacc -= *(const LAS f32x4*)(xs + (tt + 16 - wn) * 128 + c4); } }
    f32x4 scv0[4], scv1[4];
    { const float* sp0 = ps + (2 * gp) * 128 + 32 * (w >> 1) + 4 * h;
#pragma unroll
      for (int q4 = 0; q4 < 4; ++q4) { scv0[q4] = *(const f32x4*)(sp0 + 8 * q4); scv1[q4] = *(const f32x4*)(sp0 + 128 + 8 * q4); } }
    __syncthreads();
    {   const int cob = w >> 1, tokb = w & 1;
#pragma unroll
        for (int g2 = 0; g2 < 2; ++g2) { const int gi = 2 * gp + g2; f32x16_ acc;
#pragma unroll
            for (int r = 0; r < 16; ++r) acc[r] = 0.f;
            const LAS bf16* prow = (const LAS bf16*)(lds + g2 * 57856 + 40448) + (32 * tokb + r32) * 136 + 8 * h;
            bf16x8 pfr[8], wf2[8];
#pragma unroll
            for (int ks = 0; ks < 8; ++ks) pfr[ks] = *(const LAS bf16x8*)(prow + 16 * ks);
            if (g2 == 0) { const bf16* wrow1 = pwT + (size_t)(2 * gp + 1) * 16384 + (size_t)(32 * cob + r32) * 128 + 8 * h;
#pragma unroll
                for (int ks = 0; ks < 8; ++ks) wf2[ks] = *(const bf16x8*)(wrow1 + 16 * ks); }
#pragma unroll
            for (int ks = 0; ks < 8; ++ks) acc = __builtin_amdgcn_mfma_f32_32x32x16_bf16(wfr[ks], pfr[ks], acc, 0, 0, 0);
            bf16* op = P1 + ((size_t)b * SEQ + tile * 64 + 32 * tokb + r32) * P1W + C_V + gi * 128 + 32 * cob + 4 * h;
#pragma unroll
            for (int q4 = 0; q4 < 4; ++q4) { const f32x4 sc = g2 ? scv1[q4] : scv0[q4];
                u32x2 o; o.x = pk2(acc[4 * q4] * sc.x, acc[4 * q4 + 1] * sc.y); o.y = pk2(acc[4 * q4 + 2] * sc.z, acc[4 * q4 + 3] * sc.w); GST(*(u32x2*)(op + 8 * q4) = o); }
            if (g2 == 0) {
#pragma unroll
                for (int ks = 0; ks < 8; ++ks) wfr[ks] = wf2[ks]; }
        }
    }
}
__device__ __forceinline__ void lrufix_unit2(LAS unsigned char* lds, bf16* P1, const bf16* XN, const float* AGA, const float* AGH, int unit) {
    const int tid = opaque_tid(); const int cg = tid & 63, tl = tid >> 6; const int tile = unit & 63, b = unit >> 6;
    LAS float* seg = (LAS float*)lds;
    __syncthreads();
    {   float sa[8], sh[8];
        float one_ = 1.f, zero_ = 0.f; asm volatile("" : "+v"(one_), "+v"(zero_));
#pragma unroll
        for (int i = 0; i < 8; ++i) { sa[i] = one_; sh[i] = zero_; }
        f32x4 la0[8], la1[8], lh0[8], lh1[8];
#pragma unroll
        for (int k = 0; k < 8; ++k) { const int i = 8 * tl + k; const int ii = i < tile ? i : 0; const float* ap = AGA + ((size_t)b * 64 + ii) * 512 + 8 * cg; const float* hp = AGH + ((size_t)b * 64 + ii) * 512 + 8 * cg;
            la0[k] = *(const f32x4*)ap; la1[k] = *(const f32x4*)(ap + 4); lh0[k] = *(const f32x4*)hp; lh1[k] = *(const f32x4*)(hp + 4); }
#pragma unroll
        for (int k = 0; k < 8; ++k) { const int i = 8 * tl + k; if (i < tile) { const f32x4 a0 = la0[k], a1 = la1[k], h0 = lh0[k], h1 = lh1[k];
                sh[0] = a0.x * sh[0] + h0.x; sh[1] = a0.y * sh[1] + h0.y; sh[2] = a0.z * sh[2] + h0.z; sh[3] = a0.w * sh[3] + h0.w; sh[4] = a1.x * sh[4] + h1.x; sh[5] = a1.y * sh[5] + h1.y; sh[6] = a1.z * sh[6] + h1.z; sh[7] = a1.w * sh[7] + h1.w;
                sa[0] *= a0.x; sa[1] *= a0.y; sa[2] *= a0.z; sa[3] *= a0.w; sa[4] *= a1.x; sa[5] *= a1.y; sa[6] *= a1.z; sa[7] *= a1.w; } }
        LAS float* sp = seg + (tl * 64 + cg) * 16;
        *(LAS f32x4*)sp = (f32x4){sa[0], sa[1], sa[2], sa[3]}; *(LAS f32x4*)(sp + 4) = (f32x4){sa[4], sa[5], sa[6], sa[7]}; *(LAS f32x4*)(sp + 8) = (f32x4){sh[0], sh[1], sh[2], sh[3]}; *(LAS f32x4*)(sp + 12) = (f32x4){sh[4], sh[5], sh[6], sh[7]};
    }
    const size_t row0 = (size_t)b * SEQ + tile * 64;
    u32x4 hlv[8], acv[8], ggv[8];
#pragma unroll
    for (int p = 0; p < 8; ++p) { const size_t row = row0 + 8 * p + tl;
        hlv[p] = *(const u32x4*)(XN + row * 1024 + 8 * cg); acv[p] = *(const u32x4*)(XN + row * 1024 + 512 + 8 * cg); ggv[p] = *(const u32x4*)(P1 + row * P1W + C_GB + 8 * cg); }
    __syncthreads();
    float c[8];
#pragma unroll
    for (int i = 0; i < 8; ++i) c[i] = 0.f;
#pragma unroll
    for (int sgi = 0; sgi < 8; ++sgi) { const LAS float* sp = seg + (sgi * 64 + cg) * 16; const f32x4 a0 = *(const LAS f32x4*)sp, a1 = *(const LAS f32x4*)(sp + 4), h0 = *(const LAS f32x4*)(sp + 8), h1 = *(const LAS f32x4*)(sp + 12);
        c[0] = a0.x * c[0] + h0.x; c[1] = a0.y * c[1] + h0.y; c[2] = a0.z * c[2] + h0.z; c[3] = a0.w * c[3] + h0.w; c[4] = a1.x * c[4] + h1.x; c[5] = a1.y * c[5] + h1.y; c[6] = a1.z * c[6] + h1.z; c[7] = a1.w * c[7] + h1.w; }
#pragma unroll 8
    for (int p = 0; p < 8; ++p) { const size_t row = row0 + 8 * p + tl;
        const u32x4 hl = hlv[p], ac = acv[p]; bf16* gp = P1 + row * P1W + C_GB + 8 * cg; const u32x4 gg = ggv[p];
        u32x4 o;
        o.x = pk2(bflo(gg.x) * (bflo(hl.x) + bflo(ac.x) * c[0]), bfhi(gg.x) * (bfhi(hl.x) + bfhi(ac.x) * c[1])); o.y = pk2(bflo(gg.y) * (bflo(hl.y) + bflo(ac.y) * c[2]), bfhi(gg.y) * (bfhi(hl.y) + bfhi(ac.y) * c[3]));
        o.z = pk2(bflo(gg.z) * (bflo(hl.z) + bflo(ac.z) * c[4]), bfhi(gg.z) * (bfhi(hl.z) + bfhi(ac.z) * c[5])); o.w = pk2(bflo(gg.w) * (bflo(hl.w) + bflo(ac.w) * c[6]), bfhi(gg.w) * (bfhi(hl.w) + bfhi(ac.w) * c[7]));
        GST(*(u32x4*)gp = o); }
}

typedef float f32x16 __attribute__((ext_vector_type(16)));
typedef short s16x4 __attribute__((ext_vector_type(4)));
typedef __bf16 bf16x2_t __attribute__((ext_vector_type(2)));
constexpr int AT_KB = 8320, AT_VB = 8192;
constexpr int AT_TILE = AT_KB + AT_VB, AT_NT = 6, AT_IMP = AT_NT * AT_TILE, AT_SEL = AT_IMP + 16384, AT_SELU = AT_SEL + 512, AT_CNT = AT_SELU + 16;
__device__ __forceinline__ int at_koff(int slot, int sub) { return (2 * slot + sub) * AT_TILE; }
__device__ __forceinline__ int at_voff(int slot, int sub) { return (2 * slot + sub) * AT_TILE + AT_KB; }
__device__ __forceinline__ void ring_wait(LAS unsigned* p, unsigned target) { while (__hip_atomic_load(p, __ATOMIC_ACQUIRE, __HIP_MEMORY_SCOPE_WORKGROUP) < target) __builtin_amdgcn_s_sleep(1); }
__device__ __forceinline__ void ring_signal(LAS unsigned* p, int lane) { if (lane == 0) (void)__hip_atomic_fetch_add(p, 1u, __ATOMIC_RELEASE, __HIP_MEMORY_SCOPE_WORKGROUP); }
constexpr float AT_C2 = 0.125f * 1.4426950408889634f, AT_THR = 6.0f;
__device__ __forceinline__ unsigned cvtpk_bf16(float lo, float hi) { f32x2 v = {lo, hi}; bf16x2_t b = __builtin_convertvector(v, bf16x2_t); return __builtin_bit_cast(unsigned, b); }
__device__ __forceinline__ int crow(int r, int h) { return (r & 3) + 8 * (r >> 2) + 4 * h; }
__device__ __forceinline__ float max3f_(float a, float b, float c) { float r; asm("v_max3_f32 %0, %1, %2, %3" : "=v"(r) : "v"(a), "v"(b), "v"(c)); return r; }
__device__ __forceinline__ float swap32_max(float x) { auto rr = __builtin_amdgcn_permlane32_swap(__builtin_bit_cast(unsigned, x), __builtin_bit_cast(unsigned, x), false, false); float a = __builtin_bit_cast(float, rr[0]), b = __builtin_bit_cast(float, rr[1]); float r; asm("v_max_f32_e32 %0, %1, %2" : "=v"(r) : "v"(a), "v"(b)); return r; }
__device__ __forceinline__ float swap32_sum(float x) { auto rr = __builtin_amdgcn_permlane32_swap(__builtin_bit_cast(unsigned, x), __builtin_bit_cast(unsigned, x), false, false); return __builtin_bit_cast(float, rr[0]) + __builtin_bit_cast(float, rr[1]); }
struct AtRegs { u32x4 k, v; };
__device__ __forceinline__ AtRegs at_load_bf16(const bf16* kp, const bf16* vp, int tid) {
    AtRegs r; const int key = tid >> 3, c = tid & 7;
    if (ABL_ON(8)) { r.k = (u32x4){1u, 2u, 3u, 4u}; r.v = r.k; return r; }
    r.k = *(const u32x4*)(kp + (size_t)key * P1W + 8 * c); r.v = *(const u32x4*)(vp + (size_t)key * P1W + 8 * c); return r;
}
__device__ __forceinline__ AtRegs at_load_f32(const float* kp, const float* vp, int n0, int tid) {
    AtRegs r; const int key = tid >> 3, c = tid & 7; const int n = n0 + key;
    if (n < 255) { const f32x4 a0 = *(const f32x4*)(kp + (size_t)n * 64 + 8 * c), a1 = *(const f32x4*)(kp + (size_t)n * 64 + 8 * c + 4), b0 = *(const f32x4*)(vp + (size_t)n * 64 + 8 * c), b1 = *(const f32x4*)(vp + (size_t)n * 64 + 8 * c + 4);
        r.k = (u32x4){pk2(a0.x, a0.y), pk2(a0.z, a0.w), pk2(a1.x, a1.y), pk2(a1.z, a1.w)}; r.v = (u32x4){pk2(b0.x, b0.y), pk2(b0.z, b0.w), pk2(b1.x, b1.y), pk2(b1.z, b1.w)}; }
    else { r.k = (u32x4){0u, 0u, 0u, 0u}; r.v = (u32x4){0u, 0u, 0u, 0u}; }
    return r;
}
__device__ __forceinline__ void at_store(LAS unsigned char* lds, int slot, int sub, const AtRegs& r, int tid) {
    const int key = tid >> 3, c = tid & 7;
    *(LAS u32x4*)(lds + at_koff(slot, sub) + c * 1040 + key * 16) = r.k;
    *(LAS u32x4*)(lds + at_voff(slot, sub) + (c >> 2) * 4096 + key * 64 + (c & 3) * 16) = r.v;
}
__device__ __forceinline__ void at_qk(f32x16& p0, f32x16& p1, const LAS unsigned char* kb, const bf16x8 (&qr)[4], int r32, int h) {
    const f32x16 z = {0.f, 0.f, 0.f, 0.f, 0.f, 0.f, 0.f, 0.f, 0.f, 0.f, 0.f, 0.f, 0.f, 0.f, 0.f, 0.f};
    bf16x8 kf[8];
#pragma unroll
    for (int d0 = 0; d0 < 4; ++d0) { kf[2 * d0] = *(const LAS bf16x8*)(kb + (2 * d0 + h) * 1040 + r32 * 16); kf[2 * d0 + 1] = *(const LAS bf16x8*)(kb + (2 * d0 + h) * 1040 + (32 + r32) * 16); }
    __builtin_amdgcn_sched_barrier(0);
    p0 = __builtin_amdgcn_mfma_f32_32x32x16_bf16(kf[0], qr[0], z, 0, 0, 0); p1 = __builtin_amdgcn_mfma_f32_32x32x16_bf16(kf[1], qr[0], z, 0, 0, 0);
#pragma unroll
    for (int d0 = 1; d0 < 4; ++d0) { p0 = __builtin_amdgcn_mfma_f32_32x32x16_bf16(kf[2 * d0], qr[d0], p0, 0, 0, 0); p1 = __builtin_amdgcn_mfma_f32_32x32x16_bf16(kf[2 * d0 + 1], qr[d0], p1, 0, 0, 0); }
}
__device__ __forceinline__ void at_step(const LAS unsigned char* lds, int slot, int sub, const bf16x8 (&qr)[4], f32x16 (&o)[2], float& m, float& l, u64 vm, int lane) {
    if (!__any(vm != 0ull)) return;
    const int r32 = lane & 31, h = lane >> 5;
    f32x16 p0, p1;
    if (!ABL_ON(4)) at_qk(p0, p1, lds + at_koff(slot, sub), qr, r32, h); else { for (int r = 0; r < 16; ++r) { p0[r] = 0.f; p1[r] = 0.f; } }
    const LAS unsigned char* vb = lds + at_voff(slot, sub) + ((lane >> 4) & 1) * 32 + (lane & 3) * 8 + (4 * h + ((lane & 15) >> 2)) * 64;
    s16x4 tlo[8], thi[8];
#pragma unroll
    for (int i = 0; i < 8; ++i) { tlo[i] = __builtin_bit_cast(s16x4, __builtin_amdgcn_ds_read_tr16_b64_v4i16((LAS s16x4*)(vb + (i & 1) * 4096 + (i >> 1) * 1024)));
        thi[i] = __builtin_bit_cast(s16x4, __builtin_amdgcn_ds_read_tr16_b64_v4i16((LAS s16x4*)(vb + (i & 1) * 4096 + (i >> 1) * 1024 + 512))); }
    __builtin_amdgcn_sched_barrier(0);
    const bool full = __all(vm == ~0ull);
    const unsigned vlo = (unsigned)vm, vhi = (unsigned)(vm >> 32);
    if (!full && !ABL_ON(16)) {
#pragma unroll
        for (int r = 0; r < 16; ++r) { const int kx = crow(r, h); p0[r] = ((vlo >> kx) & 1u) ? p0[r] : -INFINITY; p1[r] = ((vhi >> kx) & 1u) ? p1[r] : -INFINITY; }
    }
    asm volatile("s_nop 15\n\ts_nop 7" : "+v"(p0), "+v"(p1));
    float rm = max3f_(p0[0], p1[0], p0[1]);
#pragma unroll
    for (int r = 1; r < 15; ++r) rm = max3f_(rm, p1[r], p0[r + 1]);
    rm = max3f_(rm, p1[15], rm);
    rm *= AT_C2;
    rm = fmaxf(rm, __shfl_xor(rm, 32));
    if (__any(rm > m + AT_THR)) { const float mn = fmaxf(m, rm); const float f = __builtin_amdgcn_exp2f(m - mn); m = mn; l *= f;
#pragma unroll
        for (int r = 0; r < 16; ++r) { o[0][r] *= f; o[1][r] *= f; } }
    const float nm = -m; float ls = 0.f;
#pragma unroll
    for (int r = 0; r < 16; ++r) { if (!ABL_ON(1)) { p0[r] = __builtin_amdgcn_exp2f(__builtin_fmaf(p0[r], AT_C2, nm)); p1[r] = __builtin_amdgcn_exp2f(__builtin_fmaf(p1[r], AT_C2, nm)); } ls += p0[r] + p1[r]; }
    l += ls;
    __builtin_amdgcn_sched_barrier(0);
#pragma unroll
    for (int ks = 0; ks < 4; ++ks) {
        u32x4 pw;
        if (ks == 0) pw = (u32x4){cvtpk_bf16(p0[0], p0[1]), cvtpk_bf16(p0[2], p0[3]), cvtpk_bf16(p0[4], p0[5]), cvtpk_bf16(p0[6], p0[7])};
        else if (ks == 1) pw = (u32x4){cvtpk_bf16(p0[8], p0[9]), cvtpk_bf16(p0[10], p0[11]), cvtpk_bf16(p0[12], p0[13]), cvtpk_bf16(p0[14], p0[15])};
        else if (ks == 2) pw = (u32x4){cvtpk_bf16(p1[0], p1[1]), cvtpk_bf16(p1[2], p1[3]), cvtpk_bf16(p1[4], p1[5]), cvtpk_bf16(p1[6], p1[7])};
        else pw = (u32x4){cvtpk_bf16(p1[8], p1[9]), cvtpk_bf16(p1[10], p1[11]), cvtpk_bf16(p1[12], p1[13]), cvtpk_bf16(p1[14], p1[15])};
        const bf16x8 pf = __builtin_bit_cast(bf16x8, pw);
#pragma unroll
        for (int db = 0; db < 2; ++db) { const int i = 2 * ks + db;
            const bf16x8 vf = (bf16x8){tlo[i][0], tlo[i][1], tlo[i][2], tlo[i][3], thi[i][0], thi[i][1], thi[i][2], thi[i][3]};
            if (!ABL_ON(2)) o[db] = __builtin_amdgcn_mfma_f32_32x32x16_bf16(vf, pf, o[db], 0, 0, 0); else asm volatile("" :: "v"(vf), "v"(pf)); }
    }
}
__device__ __forceinline__ void at_fold(f32x16 (&ot)[2], f32x16 (&o)[2], float& m, float& l, float gate, bool valid) {
    const float lt = l + __shfl_xor(l, 32); const float inv = (valid && lt > 0.f) ? gate / lt : 0.f;
#pragma unroll
    for (int r = 0; r < 16; ++r) { ot[0][r] += o[0][r] * inv; ot[1][r] += o[1][r] * inv; o[0][r] = 0.f; o[1][r] = 0.f; }
    m = -1e30f; l = 0.f;
}
__device__ __forceinline__ void attn_unit_mfma(LAS unsigned char* lds, bf16* P1, const float* KC, int unit) {
    const int tid = opaque_tid(); const int lane = tid & 63, w = __builtin_amdgcn_readfirstlane(tid >> 6), r32 = lane & 31, h = lane >> 5;
    const int ti = unit & 63, g = (unit >> 6) & 1, b = unit >> 7;
    const int tq = 8 * w + (r32 >> 2), j = r32 & 3, hd = 4 * g + j; const int ts = 64 * ti + tq;
    const size_t row = (size_t)b * SEQ + ts;
    LAS float* IMP = (LAS float*)(lds + AT_IMP); LAS u64* SEL = (LAS u64*)(lds + AT_SEL); LAS unsigned* SELU = (LAS unsigned*)(lds + AT_SELU);
    __syncthreads();
    for (int e = tid; e < 4096; e += 512) IMP[e] = 0.f;
    if (tid < 2) SELU[tid] = 0u;
    if (tid < 16) ((LAS unsigned*)(lds + AT_CNT))[tid] = 0u;
    bf16x8 qr[4];
    { const bf16* qp = P1 + row * P1W + C_Q + hd * 64 + 8 * h;
#pragma unroll
      for (int d0 = 0; d0 < 4; ++d0) qr[d0] = *(const bf16x8*)(qp + 16 * d0); }
    const float g0 = bf2f(P1[row * P1W + C_GC + hd * 3 + 0]), g1 = bf2f(P1[row * P1W + C_GC + hd * 3 + 1]), g2 = bf2f(P1[row * P1W + C_GC + hd * 3 + 2]);
    f32x16 o[2], ot[2];
#pragma unroll
    for (int r = 0; r < 16; ++r) { o[0][r] = 0.f; o[1][r] = 0.f; ot[0][r] = 0.f; ot[1][r] = 0.f; }
    float m = -1e30f, l = 0.f;
    const int nv = (ts >= 31) ? ((((ts + 1) >> 4) - 1 > 255) ? 255 : ((ts + 1) >> 4) - 1) : 0;
    const int nkt = (4 * ti + 3 + 63) >> 6;
    const float* kcp = KC + ((((size_t)0 * NB + b) * 2 + g) * 256) * 64; const float* vcp = KC + ((((size_t)1 * NB + b) * 2 + g) * 256) * 64;
    {   const int np = (nkt + 1) >> 1;
        AtRegs ra = at_load_f32(kcp, vcp, 0, tid), rb = ra; if (nkt > 1) rb = at_load_f32(kcp, vcp, 64, tid);
        at_store(lds, 0, 0, ra, tid); if (nkt > 1) at_store(lds, 0, 1, rb, tid); __syncthreads();
        for (int pi = 0; pi < np; ++pi) {
            const int k0 = 2 * pi, k2 = 2 * pi + 2;
            if (k2 < nkt) { ra = at_load_f32(kcp, vcp, 64 * k2, tid); if (k2 + 1 < nkt) rb = at_load_f32(kcp, vcp, 64 * (k2 + 1), tid); }
            at_step(lds, pi & 1, 0, qr, o, m, l, mask_lo(nv - 64 * k0), lane);
            if (k0 + 1 < nkt) at_step(lds, pi & 1, 1, qr, o, m, l, mask_lo(nv - 64 * (k0 + 1)), lane);
            if (k2 < nkt) { at_store(lds, (pi + 1) & 1, 0, ra, tid); if (k2 + 1 < nkt) at_store(lds, (pi + 1) & 1, 1, rb, tid); }
            __syncthreads();
        }
        const float lt = l + __shfl_xor(l, 32); const float invl = (nv > 0 && lt > 0.f) ? 1.f / lt : 0.f;
        float prevL = 0.f;
        static_assert(SEQ / 16 <= 256, "the compressed branch keeps all its tiles in two LDS slots");
        for (int pi = 0; pi < np; ++pi) {
#pragma unroll 1
            for (int sub = 0; sub < 2; ++sub) {
                const int kt = 2 * pi + sub; if (kt >= nkt) break;
                f32x16 p0, p1; at_qk(p0, p1, lds + at_koff(pi & 1, sub), qr, r32, h);
                const u64 vm = mask_lo(nv - 64 * kt); const unsigned vlo = (unsigned)vm, vhi = (unsigned)(vm >> 32);
#pragma unroll
                for (int r = 0; r < 16; ++r) { const int kx = crow(r, h);
                    p0[r] = ((vlo >> kx) & 1u) ? __builtin_amdgcn_exp2f(p0[r] * AT_C2 - m) * invl : 0.f;
                    p1[r] = ((vhi >> kx) & 1u) ? __builtin_amdgcn_exp2f(p1[r] * AT_C2 - m) * invl : 0.f; }
#pragma unroll
                for (int hh = 0; hh < 2; ++hh) {
                    float G[4], Lp[4];
#pragma unroll
                    for (int q4 = 0; q4 < 4; ++q4) { const float a0 = hh ? p1[4 * q4] : p0[4 * q4], a1 = hh ? p1[4 * q4 + 1] : p0[4 * q4 + 1], a2 = hh ? p1[4 * q4 + 2] : p0[4 * q4 + 2], a3 = hh ? p1[4 * q4 + 3] : p0[4 * q4 + 3];
                        G[q4] = (a0 + a1) + (a2 + a3); Lp[q4] = __shfl_xor(a3, 32); }
#pragma unroll
                    for (int q4 = 0; q4 < 4; ++q4) {
                        const float carry = h ? Lp[q4] : (q4 == 0 ? prevL : Lp[q4 - 1]);
                        float v = G[q4] + carry; v += __shfl_xor(v, 1); v += __shfl_xor(v, 2);
                        if (j == 0) IMP[tq * 64 + 16 * kt + 8 * hh + 2 * q4 + h] = v;
                    }
                    prevL = Lp[3];
                }
            }
        }
    }
    at_fold(ot, o, m, l, g0, nv > 0);
    __syncthreads();
    const int cur = ti;
    FT0(3);
    {
        const int tok = tid >> 3, j8 = tid & 7; u64 selt = 1ull | (1ull << cur) | (cur >= 1 ? (1ull << (cur - 1)) : 0ull);
        float cv[8];
#pragma unroll
        for (int k = 0; k < 8; ++k) { const int mm = j8 + 8 * k; cv[k] = (mm >= 1 && mm <= cur - 2) ? IMP[tok * 64 + mm] : -1.f; }
        const int npick = (cur - 2) < 5 ? (cur - 2) : 5;
        for (int pk = 0; pk < npick; ++pk) { float best = -1.f; int bi = 64;
#pragma unroll
            for (int k = 0; k < 8; ++k) if (cv[k] > best) { best = cv[k]; bi = j8 + 8 * k; }
#pragma unroll
            for (int off = 1; off < 8; off <<= 1) { const float ov = __shfl_xor(best, off); const int oi = __shfl_xor(bi, off); if (ov > best || (ov == best && oi < bi)) { best = ov; bi = oi; } }
            selt |= 1ull << (bi & 63);
#pragma unroll
            for (int k = 0; k < 8; ++k) if (j8 + 8 * k == bi) cv[k] = -2.f; }
        if (j8 == 0) { SEL[tok] = selt; atomicOr((unsigned*)&SELU[0], (unsigned)selt); atomicOr((unsigned*)&SELU[1], (unsigned)(selt >> 32)); }
    }
    __syncthreads();
    FT1(3);
    const u64 sel = SEL[tq];
    const u64 selu = ((u64)SELU[1] << 32) | (u64)SELU[0];
    {
        const bf16* kb = P1 + (size_t)b * SEQ * P1W + C_KV + (2 * 2 + g) * 64; const bf16* vbp = P1 + (size_t)b * SEQ * P1W + C_KV + (3 * 2 + g) * 64;
        LAS unsigned* FIL = (LAS unsigned*)(lds + AT_CNT); LAS unsigned* DON = FIL + 8;
        const int n = __builtin_popcountll(selu);
        u64 remL = selu, remC = selu;
        {   AtRegs r0, r1, r2; int b0 = __builtin_ctzll(remL); remL &= remL - 1; r0 = at_load_bf16(kb + (size_t)b0 * 64 * P1W, vbp + (size_t)b0 * 64 * P1W, tid); r1 = r0; r2 = r0;
            if (n > 1) { const int b1 = __builtin_ctzll(remL); remL &= remL - 1; r1 = at_load_bf16(kb + (size_t)b1 * 64 * P1W, vbp + (size_t)b1 * 64 * P1W, tid); }
            if (n > 2) { const int b2 = __builtin_ctzll(remL); remL &= remL - 1; r2 = at_load_bf16(kb + (size_t)b2 * 64 * P1W, vbp + (size_t)b2 * 64 * P1W, tid); }
            at_store(lds, 0, 0, r0, tid); ring_signal(FIL + 0, lane);
            if (n > 1) { at_store(lds, 0, 1, r1, tid); ring_signal(FIL + 1, lane); }
            if (n > 2) { at_store(lds, 1, 0, r2, tid); ring_signal(FIL + 2, lane); } }
        AtRegs rg; rg.k = (u32x4){0u, 0u, 0u, 0u}; rg.v = rg.k;
        if (n > 3) { const int b3 = __builtin_ctzll(remL); remL &= remL - 1; rg = at_load_bf16(kb + (size_t)b3 * 64 * P1W, vbp + (size_t)b3 * 64 * P1W, tid); }
        int jc = 0, gc = 1, js = 3, gs = 0;
#pragma unroll 1
        for (int t = 0; t < n; ++t) {
            const int mbc = __builtin_ctzll(remC); remC &= remC - 1;
            if (t + 3 < n) {
                FT0(4); ring_wait(DON + js, 8u * (unsigned)gs); FT1(4);
                FT0(5); at_store(lds, js >> 1, js & 1, rg, tid); ring_signal(FIL + js, lane); FT1(5);
                if (t + 4 < n) { const int bn = __builtin_ctzll(remL); remL &= remL - 1; rg = at_load_bf16(kb + (size_t)bn * 64 * P1W, vbp + (size_t)bn * 64 * P1W, tid); }
            }
            FT0(6); ring_wait(FIL + jc, 8u * (unsigned)gc); FT1(6);
            u64 vm = 0ull; if ((sel >> mbc) & 1ull) vm = (mbc == cur) ? mask_lo((ts & 63) + 1) : ~0ull;
            FT0(7); at_step(lds, jc >> 1, jc & 1, qr, o, m, l, vm, lane); FT1(7);
            ring_signal(DON + jc, lane);
            if (++jc == 6) { jc = 0; ++gc; }
            if (++js == 6) { js = 0; ++gs; }
        }
        __syncthreads();
    }
    at_fold(ot, o, m, l, g1, true);
    {   const bf16* kb = P1 + (size_t)b * SEQ * P1W + C_KV + (4 * 2 + g) * 64; const bf16* vbp = P1 + (size_t)b * SEQ * P1W + C_KV + (5 * 2 + g) * 64;
        const int mlo = (ti >= 8) ? ti - 8 : 0; const int nw = cur - mlo + 1, np = (nw + 1) >> 1;
        AtRegs ra = at_load_bf16(kb + (size_t)mlo * 64 * P1W, vbp + (size_t)mlo * 64 * P1W, tid), rb = ra; if (nw > 1) rb = at_load_bf16(kb + (size_t)(mlo + 1) * 64 * P1W, vbp + (size_t)(mlo + 1) * 64 * P1W, tid);
        at_store(lds, 0, 0, ra, tid); if (nw > 1) at_store(lds, 0, 1, rb, tid); __syncthreads();
        for (int pi = 0; pi < np; ++pi) {
            const int i0 = 2 * pi, i2 = 2 * pi + 2;
            if (i2 < nw) { ra = at_load_bf16(kb + (size_t)(mlo + i2) * 64 * P1W, vbp + (size_t)(mlo + i2) * 64 * P1W, tid); if (i2 + 1 < nw) rb = at_load_bf16(kb + (size_t)(mlo + i2 + 1) * 64 * P1W, vbp + (size_t)(mlo + i2 + 1) * 64 * P1W, tid); }
#pragma unroll 1
            for (int sub = 0; sub < 2; ++sub) { const int mb = mlo + i0 + sub; if (i0 + sub >= nw) break;
                const int lo = ts - 511 - mb * 64, hi = ts - mb * 64;
                u64 vm = 0ull; if (hi >= 0 && lo <= 63) vm = mask_lo(hi + 1) & ~mask_lo(lo);
                at_step(lds, pi & 1, sub, qr, o, m, l, vm, lane); }
            if (i2 < nw) { at_store(lds, (pi + 1) & 1, 0, ra, tid); if (i2 + 1 < nw) at_store(lds, (pi + 1) & 1, 1, rb, tid); }
            __syncthreads();
        }
    }
    at_fold(ot, o, m, l, g2, true);
    {   bf16* op = P1 + row * P1W + C_Q + hd * 64 + 4 * h;
#pragma unroll
        for (int db = 0; db < 2; ++db)
#pragma unroll
            for (int q4 = 0; q4 < 4; ++q4) { u32x2 wv; wv.x = cvtpk_bf16(ot[db][4 * q4], ot[db][4 * q4 + 1]); wv.y = cvtpk_bf16(ot[db][4 * q4 + 2], ot[db][4 * q4 + 3]); GST(*(u32x2*)(op + 32 * db + 8 * q4) = wv); } }
}

__device__ __forceinline__ void set_dry(LAS unsigned char* l, int v) { __syncthreads(); if (threadIdx.x == 0) ((volatile LAS int*)(l + LDS_CTL + 64))[0] = v; __syncthreads(); }
constexpr int NPH = 1 + 9 * NL;
__global__ void __launch_bounds__(512, 2) fwd_kernel(Args args) {
    extern __shared__ __attribute__((aligned(16))) unsigned char lds_raw[];
    LAS unsigned char* ldsl = (LAS unsigned char*)lds_raw;
    float* ldsf = (float*)lds_raw;
    const int G0 = gridDim.x, bx0 = blockIdx.x, G = G0, bx = bx0, NGW = G * 8;
#define PHASE_IDS() const int tid = opaque_tid(), lane = tid & 63, wave = __builtin_amdgcn_readfirstlane(tid >> 6), gw = bx * 8 + wave; (void)lane; (void)gw
#define ws ARG_WS()
#define ctl ((unsigned*)(ws + WS_CTL))
#define H ARG_OUT()
#define HB(li) (((li) == NL - 1) ? (bf16*)(ws + WS_WIN) : (bf16*)ARG_OUT())
#define XN ((bf16*)(ws + WS_XN))
#define P1 ((bf16*)(ws + WS_P1))
#define Rr ((bf16*)(ws + WS_R))
#define WIN ((bf16*)(ws + WS_WIN))
#define WB ((bf16*)(ws + WS_WB))
#define WOUT ((bf16*)(ws + WS_WOUT))
#define WGU ((bf16*)(ws + WS_WGU))
#define WD ((bf16*)(ws + WS_WD))
#define HID ((bf16*)(ws + WS_HID))
#define Y ((bf16*)(ws + WS_Y))
#define KC ((float*)(ws + WS_KC))
#define AGA ((float*)(ws + WS_LRUA))
#define AGH ((float*)(ws + WS_LRUH))
#define LIST ((unsigned*)(ws + WS_LIST))
#define LISTW ((float*)(ws + WS_LISTW))
    { PHASE_IDS(); for (int u = tid; u < (LDS_BYTES - LDS_CTL) / 4; u += 512) ((LAS unsigned*)(ldsl + LDS_CTL))[u] = 0u; }
    __syncthreads();
    if (!MK_SPLIT) (void)xcd_barrier_post(ctl + CW_BAR, (volatile LAS unsigned*)(ldsl + LDS_CTL + 32));
    const int lo = args.ph_lo, hi = args.ph_hi;
#define IN(k) (lo <= (k) && (k) < hi)
#if PROBE_PH >= 0
#ifndef PROBE_REAL
#define PROBE_REAL 0
#endif
#define PHASE_REP(id) for (int rep_ = 0; rep_ < (((id) == PROBE_PH) ? 2 : 1); ++rep_, set_dry(ldsl, 0)) if (set_dry(ldsl, PROBE_REAL ? 0 : rep_), true)
#else
#define PHASE_REP(id) if (true)
#endif
#define SEAM(k) do { if (!MK_SPLIT && IN((k) + 1)) { XcdBarrier bb_; bb_.bar = ctl + CW_BAR; bb_.x = xb_xcc_id(); bb_.st = (volatile LAS unsigned*)(ldsl + LDS_CTL + 32); \
    for (int r_ = 0; r_ < ((PROBE_PH == 50) ? 3 : 1); ++r_) xcd_barrier(bb_); } } while (0)

    if (IN(0)) PHASE_REP(100) {
        PHASE_IDS();
        float* scr = ldsf + wave * 4096;
        constexpr int IT_W1 = 32 * 2, IT_LW = 2, IT_PW = 2 * 4;
        constexpr int NSMALL = NL * 4 * IT_W1 + NL * 16 * IT_LW + NL * 4 * IT_PW;
        auto dec0 = [&](int it) -> TrItem {
            if (it < IT_BIG) return dec_big(it, 0);
            int r = it - IT_BIG;
            if (r < NL * 4 * IT_W1) { const int m = r / IT_W1; r -= m * IT_W1; return TrItem{ARG_IN(I_CW1) + (size_t)m * 2048 * 64, (bf16*)(ws + WS_W1T) + (size_t)m * 64 * 2048, 2048, 64, r / 2, r % 2, 4}; }
            r -= NL * 4 * IT_W1;
            if (r < NL * 16 * IT_LW) { const int m = r / IT_LW; r -= m * IT_LW; const int l = m >> 4, mat = (m >> 3) & 1, hh = m & 7;
                return TrItem{ARG_IN(mat ? I_LWX : I_LWA) + ((size_t)l * 8 + hh) * 4096, (bf16*)(ws + WS_LWT) + (size_t)m * 4096, 64, 64, 0, r, 0}; }
            r -= NL * 16 * IT_LW;
            { const int m = r / IT_PW; r -= m * IT_PW; return TrItem{ARG_IN(I_PW) + (size_t)m * 16384, (bf16*)(ws + WS_PWT) + (size_t)m * 16384, 128, 128, r / 4, r % 4, 0}; }
        };
        constexpr int NIT0 = IT_BIG + NSMALL;
        if (gw < NIT0) { TrItem cur = dec0(gw); TrRegs rv = tr_load(cur, lane);
            for (int it = gw; it < NIT0; it += NGW) { TrItem nxt = cur; TrRegs rn = rv; const bool more = it + NGW < NIT0;
                if (more) { nxt = dec0(it + NGW); rn = tr_load(nxt, lane); }
                tr_finish(cur, rv, scr, lane); cur = nxt; rv = rn; } }
        for (int e = bx * 512 + tid; e < NL * 232 * 128; e += G * 512) { const int l = e / (232 * 128), rr = (e / 128) % 232, c8 = (e % 128) * 8;
            GST(*(u32x4*)(WIN + ((size_t)l * NPROJ + C_GC + 24 + rr) * D + c8) = (u32x4){0u, 0u, 0u, 0u}); }
        for (int m = gw; m < T; m += 2 * NGW) norm_rows<0>(ARG_IN(I_X), nullptr, nullptr, nullptr, nullptr, nullptr, ARG_IN(I_N1G), XN, (unsigned char*)H + OUT_XN8, m, m + NGW, m + NGW < T, lane);
    }
    SEAM(0);

    unsigned long long tacc_ = 0ull, tbeg_ = 0ull; (void)tacc_; (void)tbeg_;
#define TBEG(id) do { if (PROBE_T_LO >= 0 && (id) == PROBE_T_LO) tbeg_ = __builtin_amdgcn_s_memrealtime(); } while (0)
#define TEND(id) do { if (PROBE_T_LO >= 0 && (id) + 1 == PROBE_T_HI) tacc_ += __builtin_amdgcn_s_memrealtime() - tbeg_; } while (0)
    for (int l = 0; l < NL; ++l) {
        const int pb = 1 + 9 * l;
#define OPQ_S(x) ({ int t_ = (x); asm volatile("" : "+s"(t_)); t_; })
#undef bx
#undef G
        TBEG(0);
        if (IN(pb + 0)) PHASE_REP(0) {
            const int bxo = OPQ_S(bx0), Go = OPQ_S(G0); (void)bxo; (void)Go;
#define bx bxo
#define G Go
            EpiProj E{P1, Rr, -1.4426950408889634f / 64.f};
            {   SchedDense S8{(const bf16*)((unsigned char*)H + OUT_XN8), (const bf16*)((unsigned char*)H + OUT_WG8 + (size_t)l * 4096 * 1024), D / 2, D / 2, T / 256, 16, G, bx, nullptr, 0u, nullptr, 0, 16};
                pg8::gemm_phase<EpiProj, SchedDense, false, true>(ldsl, OPQ_S(D / 2), S8, E); }
            {   SchedDense S{XN, WIN + (size_t)l * NPROJ * D, D, D, T / 256, 16, G, bx, nullptr, 0u, nullptr, 0, 0};
                pg8::gemm_phase<EpiProj, SchedDense, true, false>(ldsl, D, S, E); }
        }
        SEAM(pb + 0); TEND(0);
#undef bx
#undef G
        TBEG(1);
        if (IN(pb + 1)) PHASE_REP(1) {
            const int bxo = OPQ_S(bx0), Go = OPQ_S(G0); (void)bxo; (void)Go;
#define bx bxo
#define G Go
            constexpr int U_LRU = NB * 64, U_GM = 128 * 2, U_CMP = 256;
            for (int u0 = bx; u0 < U_LRU + U_GM + U_CMP; u0 += G) {
                const int u = (G == 256) ? (((u0 >> 8) + bx % 3) % 3) * 256 + bx : u0;
                SUBT0(); const int ty_ = (u < U_CMP) ? 6 : (u < U_CMP + U_GM) ? 7 : 8; (void)ty_;
                if (u < U_CMP) cmp_unit2(ldsl, P1, KC, ARG_IN(I_PE) + (size_t)l * 2 * 2048, (const bf16*)(ws + WS_W1T) + (size_t)l * 4 * 64 * 2048, ARG_IN(I_CW2) + (size_t)l * 4 * 4096, u);
                else if (u < U_CMP + U_GM) gmlp_unit3(ldsl, P1, ARG_IN(I_GMNG) + l * 512, ARG_IN(I_GMWS) + (size_t)l * 4 * 16384, ARG_IN(I_GMB) + l * 512, u - U_CMP);
                else lru_unit2(ldsl, P1, XN, AGA, AGH, ARG_IN(I_CONVW) + l * 2048, ARG_IN(I_CONVB) + l * 512, (const bf16*)(ws + WS_LWT) + (size_t)(l * 2 + 0) * 8 * 4096, (const bf16*)(ws + WS_LWT) + (size_t)(l * 2 + 1) * 8 * 4096,
                               ARG_IN(I_LBA) + l * 512, ARG_IN(I_LBX) + l * 512, ARG_IN(I_LLAM) + l * 512, u - U_CMP - U_GM);
                SUBT1(ty_);
            }
            __syncthreads();
        }
        SEAM(pb + 1); TEND(1);
#undef bx
#undef G
        TBEG(2);
        if (IN(pb + 2)) PHASE_REP(2) {
            const int bxo = OPQ_S(bx0), Go = OPQ_S(G0); (void)bxo; (void)Go;
#define bx bxo
#define G Go
            constexpr int U_AT = NB * 2 * 64, U_PL = NB * 64 * 2, U_FX = NB * 64;
            const int U_CV = (l == 0 && NL > 1) ? (IT_BIG + 7) / 8 : 0;
            for (int u = bx; u < U_AT; u += G) {
                SUBT0(); const int ty_ = 1; (void)ty_;
                { const int k = u >> 3, bg = u & 7; const int ti = (u < 256) ? 63 - k : k - 32; attn_unit_mfma(ldsl, P1, KC, (bg << 6) | ti); }
                SUBT1(ty_);
            }
            {   const int NDYN = U_PL + U_FX + U_CV; unsigned* qctr = ctl + CW_Q + 64 * l; volatile LAS unsigned* qslot = (volatile LAS unsigned*)(ldsl + LDS_CTL + 192);
                unsigned nx = 0u; const bool ldr = (threadIdx.x == 0) && !is_dry();
                if (threadIdx.x == 0) nx = is_dry() ? (unsigned)NDYN : __hip_atomic_fetch_add(qctr, 1u, __ATOMIC_RELAXED, __HIP_MEMORY_SCOPE_AGENT);
                for (;;) {
                    __syncthreads(); if (threadIdx.x == 0) qslot[0] = nx; __syncthreads();
                    const int u = (int)qslot[0]; if (u >= NDYN) break;
                    if (ldr) nx = __hip_atomic_fetch_add(qctr, 1u, __ATOMIC_RELAXED, __HIP_MEMORY_SCOPE_AGENT);
                    SUBT0(); const int ty_ = (u < U_PL) ? 2 : (u < U_FX + U_PL) ? 3 : 4; (void)ty_;
                    if (u < U_PL) pool_unit3(ldsl, P1, (const bf16*)(ws + WS_PWT) + (size_t)l * 4 * 16384, ARG_IN(I_PS) + l * 512, u);
                    else if (u < U_FX + U_PL) lrufix_unit2(ldsl, P1, XN, AGA, AGH, u - U_PL);
                    else conv_unit(ldsf, u - U_FX - U_PL);
                    SUBT1(ty_);
                }
            }
            __syncthreads();
        }
        SEAM(pb + 2); TEND(2);
#undef bx
#undef G
        TBEG(3);
        if (IN(pb + 3)) PHASE_REP(3) {
            const int bxo = OPQ_S(bx0), Go = OPQ_S(G0); (void)bxo; (void)Go;
#define bx bxo
#define G Go
            SchedMerge S{P1, WB + (size_t)l * 4 * 1024 * 512, G, bx, ctl + CW_G2 + l * 4096};
            EpiMerge E{Rr, XN};
            pg8::gemm_phase<EpiMerge, SchedMerge, true>(ldsl, 512, S, E);
        }
        if (MK_SPLIT) { SEAM(pb + 3); } TEND(3);
#undef bx
#undef G
        TBEG(4);
        if (IN(pb + 4)) PHASE_REP(4) {
            const int bxo = OPQ_S(bx0), Go = OPQ_S(G0); (void)bxo; (void)Go;
#define bx bxo
#define G Go
            SchedDense S{XN, WOUT + (size_t)l * 1024 * 1024, D, D, T / 256, 4, G, bx, MK_SPLIT ? nullptr : ctl + CW_G2 + l * 4096, 32u, ctl, 0, 0};
            EpiWout E{(l == 0) ? ARG_IN(I_X) : (const float*)nullptr, (l == 0) ? (const bf16*)nullptr : (const bf16*)HB(l - 1), HB(l)};
            pg8::gemm_phase<EpiWout, SchedDense, true>(ldsl, D, S, E);
        }
        SEAM(pb + 4); TEND(4);
#undef bx
#undef G
        TBEG(5);
        if (IN(pb + 5)) PHASE_REP(5) {
            const int bxo = OPQ_S(bx0), Go = OPQ_S(G0); (void)bxo; (void)Go;
#define bx bxo
#define G Go
            PHASE_IDS();
            float* scr = nullptr;
            constexpr int IT_G = 16 * 16, IT_D = 8 * 32;
            auto dec1 = [&](int it) -> TrItem {
                const int e = it / (2 * IT_G + IT_D); int r = it % (2 * IT_G + IT_D);
                if (r < IT_G) return TrItem{ARG_IN(I_MG) + ((size_t)l * 16 + e) * 1024 * 512, WGU + (size_t)e * 1024 * 1024, 1024, 512, r / 16, r % 16, 2};
                if (r < 2 * IT_G) { r -= IT_G; return TrItem{ARG_IN(I_MU) + ((size_t)l * 16 + e) * 1024 * 512, WGU + (size_t)e * 1024 * 1024, 1024, 512, r / 16, r % 16, 3}; }
                r -= 2 * IT_G; return TrItem{ARG_IN(I_MD) + ((size_t)l * 16 + e) * 512 * 1024, WD + (size_t)e * 1024 * 512, 512, 1024, r / 32, r % 32, 0};
            };
            constexpr int NIT1 = 16 * (2 * IT_G + IT_D);
            TrRegs rq0, rq1; int rit0 = -1, rit1 = -1, cnext = gw;
#pragma unroll
            for (int i = 0; i < 8; ++i) { rq0.v[i] = (f32x4){0.f, 0.f, 0.f, 0.f}; rq1.v[i] = rq0.v[i]; }
#define CP_FIN(Q) if (rit##Q >= 0) { const TrItem ci_ = dec1(rit##Q); tr_finish(ci_, rq##Q, scr, lane); }
#define CP_LD(Q) { const int it_ = cnext; if (it_ < NIT1) { cnext += NGW; rit##Q = it_; const TrItem ci_ = dec1(it_); rq##Q = tr_load(ci_, lane); } else rit##Q = -1; }
#define COPY_STEP() do { CP_FIN(0) CP_FIN(1) CP_LD(0) CP_LD(1) } while (0)
            SUBT0();
            __syncthreads();
            for (int k = tid; k < 1024; k += 512) { const f32x4 wg = *(const f32x4*)(ARG_IN(I_RWG) + (size_t)l * 4096 + k * 4); const float* we = ARG_IN(I_RWE) + (size_t)l * 16384 + k * 16;
                const f32x4 e0 = *(const f32x4*)we, e1 = *(const f32x4*)(we + 4), e2 = *(const f32x4*)(we + 8), e3 = *(const f32x4*)(we + 12);
                ldsf[0 * 1024 + k] = wg.x; ldsf[1 * 1024 + k] = wg.y; ldsf[2 * 1024 + k] = wg.z; ldsf[3 * 1024 + k] = wg.w;
                ldsf[4 * 1024 + k] = e0.x; ldsf[5 * 1024 + k] = e0.y; ldsf[6 * 1024 + k] = e0.z; ldsf[7 * 1024 + k] = e0.w; ldsf[8 * 1024 + k] = e1.x; ldsf[9 * 1024 + k] = e1.y; ldsf[10 * 1024 + k] = e1.z; ldsf[11 * 1024 + k] = e1.w;
                ldsf[12 * 1024 + k] = e2.x; ldsf[13 * 1024 + k] = e2.y; ldsf[14 * 1024 + k] = e2.z; ldsf[15 * 1024 + k] = e2.w; ldsf[16 * 1024 + k] = e3.x; ldsf[17 * 1024 + k] = e3.y; ldsf[18 * 1024 + k] = e3.z; ldsf[19 * 1024 + k] = e3.w; }
            __syncthreads();
            const float* g2 = ARG_IN(I_N2G) + l * D; const float* bg = ARG_IN(I_RBG) + l * 4; const float* be = ARG_IN(I_RBE) + l * 16;
            unsigned* cnt = ctl + CW_CNT + 64 * l;
            LAS unsigned* hist = (LAS unsigned*)(ldsl + 81920); LAS unsigned* baseL = hist + 16; LAS float* LG = (LAS float*)(ldsl + 81920 + 2048);
            for (int ck = bx; ck < T / 64; ck += G) {
              if (tid < 16) hist[tid] = 0u;
              __syncthreads();
              u32x2 vnx[2][4]; f32x4 g2v[4]; const bf16* const hp_ = HB(l); bf16* const xnp_ = XN;
#pragma unroll
              for (int jj = 0; jj < 4; ++jj) g2v[jj] = *(const f32x4*)(g2 + 4 * lane + 256 * jj);
#pragma unroll
              for (int rr = 0; rr < 2; ++rr) { const bf16* hr0 = hp_ + (size_t)(ck * 64 + wave * 8 + rr) * D;
#pragma unroll
                for (int jj = 0; jj < 4; ++jj) vnx[rr][jj] = *(const u32x2*)(hr0 + 4 * lane + 256 * jj); }
#pragma unroll 1
              for (int ri = 0; ri < 8; ri += 2) { const int rl = wave * 8 + ri; const int m = ck * 64 + rl;
                f32x4 v[2][4];
#pragma unroll
                for (int rr = 0; rr < 2; ++rr)
#pragma unroll
                    for (int jj = 0; jj < 4; ++jj) { const u32x2 t_ = vnx[rr][jj]; v[rr][jj] = (f32x4){bflo(t_.x), bfhi(t_.x), bflo(t_.y), bfhi(t_.y)}; }
                if (ri + 2 < 8) {
#pragma unroll
                    for (int rr = 0; rr < 2; ++rr) { const bf16* hr1 = hp_ + (size_t)(m + 2 + rr) * D;
#pragma unroll
                        for (int jj = 0; jj < 4; ++jj) vnx[rr][jj] = *(const u32x2*)(hr1 + 4 * lane + 256 * jj); } }
                __builtin_amdgcn_sched_barrier(0); COPY_STEP(); __builtin_amdgcn_sched_barrier(0);
#pragma unroll
                for (int rr = 0; rr < 2; ++rr) { float ss = 0.f;
#pragma unroll
                    for (int jj = 0; jj < 4; ++jj) ss += (v[rr][jj].x * v[rr][jj].x + v[rr][jj].y * v[rr][jj].y) + (v[rr][jj].z * v[rr][jj].z + v[rr][jj].w * v[rr][jj].w);
                    const float rstd = rsqrtf(wave_sum(ss) * (1.f / D) + EPS);
#pragma unroll
                    for (int jj = 0; jj < 4; ++jj) { const f32x4 gg = g2v[jj]; v[rr][jj].x *= rstd * gg.x; v[rr][jj].y *= rstd * gg.y; v[rr][jj].z *= rstd * gg.z; v[rr][jj].w *= rstd * gg.w;
                        u32x2 o; o.x = pk2(v[rr][jj].x, v[rr][jj].y); o.y = pk2(v[rr][jj].z, v[rr][jj].w); GST(*(u32x2*)(xnp_ + (size_t)(m + rr) * D + 4 * lane + 256 * jj) = o); } }
                f32x2 pr[4][4];
#pragma unroll
                for (int jj = 0; jj < 4; ++jj) { pr[jj][0] = (f32x2){v[0][jj].x, v[1][jj].x}; pr[jj][1] = (f32x2){v[0][jj].y, v[1][jj].y}; pr[jj][2] = (f32x2){v[0][jj].z, v[1][jj].z}; pr[jj][3] = (f32x2){v[0][jj].w, v[1][jj].w}; }
#pragma unroll
                for (int o4 = 0; o4 < 5; ++o4) { f32x2 a2[4];
#pragma unroll
                    for (int oo = 0; oo < 4; ++oo) { const int o = 4 * o4 + oo; a2[oo] = (f32x2){0.f, 0.f};
#pragma unroll
                        for (int jj = 0; jj < 4; ++jj) { const f32x4 wv = *(const f32x4*)(ldsf + o * 1024 + 4 * lane + 256 * jj);
                            a2[oo] += pr[jj][0] * wv.x; a2[oo] += pr[jj][1] * wv.y; a2[oo] += pr[jj][2] * wv.z; a2[oo] += pr[jj][3] * wv.w; } }
                    float x0 = a2[0].x, x1 = a2[1].x, x2 = a2[2].x, x3 = a2[3].x, y0 = a2[0].y, y1 = a2[1].y, y2 = a2[2].y, y3 = a2[3].y;
                    wave_sum63x4(x0, x1, x2, x3); wave_sum63x4(y0, y1, y2, y3);
                    const f32x4 s0 = (f32x4){x0, x1, x2, x3}, s1 = (f32x4){y0, y1, y2, y3};
                    if (lane == 63) { *(LAS f32x4*)(LG + rl * 20 + 4 * o4) = s0; *(LAS f32x4*)(LG + (rl + 1) * 20 + 4 * o4) = s1; }
                    __builtin_amdgcn_sched_barrier(0); }
              }
              __syncthreads();
              unsigned se1 = 0u, se2 = 0u, sp1 = 0u, sp2 = 0u; float sw1 = 0.f, sw2 = 0.f;
              if (tid < 64) {
                const f32x4 glv = *(const LAS f32x4*)(LG + tid * 20); const f32x4 bgv = *(const f32x4*)bg;
                const float gl[4] = {glv.x + bgv.x, glv.y + bgv.y, glv.z + bgv.z, glv.w + bgv.w}; int grp = 0; float gmx = gl[0];
#pragma unroll
                for (int k = 1; k < 4; ++k) if (gl[k] > gmx) { gmx = gl[k]; grp = k; }
                float den = 0.f;
#pragma unroll
                for (int k = 0; k < 4; ++k) den += __expf(gl[k] - gmx);
                const float grpw = 1.f / den;
                const f32x4 elv = *(const LAS f32x4*)(LG + tid * 20 + 4 + grp * 4); const f32x4 bev = *(const f32x4*)(be + grp * 4);
                const float el[4] = {elv.x + bev.x, elv.y + bev.y, elv.z + bev.z, elv.w + bev.w};
                int i1 = 0; float m1 = el[0];
#pragma unroll
                for (int k = 1; k < 4; ++k) if (el[k] > m1) { m1 = el[k]; i1 = k; }
                int i2 = -1; float m2 = 0.f;
#pragma unroll
                for (int k = 0; k < 4; ++k) if (k != i1 && (i2 < 0 || el[k] > m2)) { m2 = el[k]; i2 = k; }
                const float ex = __expf(m2 - m1); sw1 = grpw / (1.f + ex); sw2 = grpw * ex / (1.f + ex);
                se1 = (unsigned)(grp * 4 + i1); se2 = (unsigned)(grp * 4 + i2);
                sp1 = atomicAdd((unsigned*)&hist[se1], 1u); sp2 = atomicAdd((unsigned*)&hist[se2], 1u);
              }
              __syncthreads();
              if (tid < 16) { const unsigned hc = hist[tid]; baseL[tid] = (hc && !is_dry()) ? atomicAdd(&cnt[tid], hc) : 0u; }
              __syncthreads();
              if (tid < 64 && !is_dry()) { const unsigned m = (unsigned)(ck * 64 + tid);
                  const size_t q1 = (size_t)se1 * T + baseL[se1] + sp1, q2 = (size_t)se2 * T + baseL[se2] + sp2;
                  LIST[q1] = m; LISTW[q1] = sw1; LIST[q2] = m | (1u << 14); LISTW[q2] = sw2; }
              __syncthreads();
            }
            while (rit0 >= 0 || cnext < NIT1) COPY_STEP();
            SUBT1(5);
        }
        SEAM(pb + 5); TEND(5);
#undef bx
#undef G
        TBEG(6);
        if (IN(pb + 6) || IN(pb + 7)) {
            __syncthreads();
            if (threadIdx.x == 0) { LAS int* tw = (LAS int*)moe_tab(); int acc = 0;
#pragma unroll 1
                for (int e = 0; e < 16; ++e) { const int c = (int)__hip_atomic_load(ctl + CW_CNT + 64 * l + e, __ATOMIC_RELAXED, __HIP_MEMORY_SCOPE_AGENT); tw[e] = acc; tw[32 + e] = c; acc += (c + 255) >> 8; }
                tw[16] = acc; }
            __syncthreads();
        }
        if (IN(pb + 6)) PHASE_REP(6) {
            const int bxo = OPQ_S(bx0), Go = OPQ_S(G0); (void)bxo; (void)Go;
#define bx bxo
#define G Go
            SchedMoe S{XN, WGU, LIST, D, D, 1024, G, bx, true, ctl + CW_E1 + l * 16384, ctl};
            EpiGateUp E{HID, LISTW};
            pg8::gemm_phase<EpiGateUp, SchedMoe, true>(ldsl, D, S, E);
        }
        if (MK_SPLIT) { SEAM(pb + 6); } TEND(6);
#undef bx
#undef G
        TBEG(7);
        if (IN(pb + 7)) PHASE_REP(7) {
            const int bxo = OPQ_S(bx0), Go = OPQ_S(G0); (void)bxo; (void)Go;
#define bx bxo
#define G Go
            SchedMoe S{HID, WD, LIST, 512, 512, 1024, G, bx, false, ctl + CW_E1 + l * 16384, ctl};
            EpiDown E{Y, LIST};
            pg8::gemm_phase<EpiDown, SchedMoe, true>(ldsl, 512, S, E);
        }
        SEAM(pb + 7); TEND(7);
#undef bx
#undef G
        TBEG(8);
        if (IN(pb + 8)) PHASE_REP(8) {
            const int bxo = OPQ_S(bx0), Go = OPQ_S(G0); (void)bxo; (void)Go;
#define bx bxo
#define G Go
            PHASE_IDS();
            if (l + 1 < NL) { for (int m = gw; m < T; m += 2 * NGW) norm_rows<1>(nullptr, HB(l), HB(l), nullptr, Y, Y + (size_t)T * D, ARG_IN(I_N1G) + (l + 1) * D, XN, (unsigned char*)H + OUT_XN8, m, m + NGW, m + NGW < T, lane); }
            else { for (int m = gw; m < T; m += 2 * NGW) norm_rows<2>(nullptr, HB(l), nullptr, H, Y, Y + (size_t)T * D, ARG_IN(I_FNG), nullptr, nullptr, m, m + NGW, m + NGW < T, lane); }
        }
        if (l + 1 < NL) SEAM(pb + 8);
        TEND(8);
    }
#undef bx
#undef G
#ifdef PROBE_FINE
    tacc_ += *(volatile LAS unsigned long long*)(ldsl + LDS_CTL + 128);
#endif
    if (PROBE_T_LO >= 0 && bx == PROBE_BLK) { const unsigned long long tgt = __builtin_amdgcn_s_memrealtime() + PROBE_T_MULT * tacc_; while (__builtin_amdgcn_s_memrealtime() < tgt) __builtin_amdgcn_s_sleep(16); }
#undef IN
#undef SEAM
#undef ws
#undef ctl
#undef H
#undef XN
#undef P1
#undef Rr
#undef WIN
#undef WB
#undef WOUT
#undef WGU
#undef WD
#undef HID
#undef Y
#undef KC
#undef AGA
#undef AGH
#undef LIST
#undef LISTW
}

extern "C" void kernel_launch(void* const* d_in, const int* in_sizes, int n_in, void* d_out, int out_size, void* d_ws, size_t ws_size, hipStream_t stream) {
    static int grid = 0;
    if (grid == 0) {
        if (n_in != 29 || in_sizes[0] != T * D || out_size != T * D || ws_size < WS_END) { fprintf(stderr, "kernel_launch: unexpected shapes / workspace (%d inputs, ws %zu < %zu); nothing launched\n", n_in, ws_size, (size_t)WS_END); grid = -1; return; }
        int dev = 0, cus = 0;
        if (hipGetDevice(&dev) != hipSuccess || hipDeviceGetAttribute(&cus, hipDeviceAttributeMultiprocessorCount, dev) != hipSuccess) { grid = -1; return; }
        if (hipFuncSetAttribute((const void*)fwd_kernel, hipFuncAttributeMaxDynamicSharedMemorySize, LDS_BYTES) != hipSuccess) { fprintf(stderr, "kernel_launch: hipFuncSetAttribute failed\n"); grid = -1; return; }
        int per_cu = 0;
        if (hipOccupancyMaxActiveBlocksPerMultiprocessor(&per_cu, (const void*)fwd_kernel, 512, LDS_BYTES) != hipSuccess || per_cu < 1) { fprintf(stderr, "kernel_launch: occupancy query says %d\n", per_cu); }
        (void)hipGetLastError();
        grid = cus;
    }
    if (grid < 0) return;
    if (hipMemsetAsync((char*)d_ws + WS_CTL, 0, CTL_ZERO_BYTES, stream) != hipSuccess) return;
    Args a{};
    for (int i = 0; i < 29; ++i) a.in[i] = (const float*)d_in[i];
    a.out = (float*)d_out; a.ws = (unsigned char*)d_ws;
#if MK_SPLIT
    for (int p = 0; p < NPH; ++p) { a.ph_lo = p; a.ph_hi = p + 1; hipLaunchKernelGGL(fwd_kernel, dim3(grid), dim3(512), LDS_BYTES, stream, a); }
#else
    a.ph_lo = 0; a.ph_hi = NPH;
    hipLaunchKernelGGL(fwd_kernel, dim3(grid), dim3(512), LDS_BYTES, stream, a);
#endif
}
```
